# Optimizing an MI355X kernel written in HIP

```python
import jax, jax.numpy as jnp
from jax import lax
import numpy as np

D_MODEL = 1024
BATCH = 4
SEQ = 8192
DEPTH = 4

GRID_W = 64
CTX_LEN = 256

N_HEADS = 8
QK_NOPE = 64
QK_ROPE = 32
QK_HEAD = QK_NOPE + QK_ROPE
V_HEAD = 64
Q_LORA = 384
KV_LORA = 256
Q_BLOCK = 128
ATTN_SCALE = QK_HEAD ** -0.5
ROPE_BASE = 10000.0
ROPE_PAIRS = QK_ROPE // 4

LRU_WIDTH = 512
LRU_BLOCKS = 8
LRU_BLOCK = LRU_WIDTH // LRU_BLOCKS
CONV_W = 4
CONV_PAD_LEFT = 2
RG_C = 8.0

D_FF = 2816

N_MOD = 9
EPS = 1e-6

IN_SPLITS = (Q_LORA, Q_LORA + KV_LORA, Q_LORA + KV_LORA + QK_ROPE,
             Q_LORA + KV_LORA + QK_ROPE + LRU_WIDTH, Q_LORA + KV_LORA + QK_ROPE + 2 * LRU_WIDTH)
D_IN = Q_LORA + KV_LORA + QK_ROPE + 2 * LRU_WIDTH + 2 * D_MODEL

kernel_name = 'hybrid_mla_rglru_macaron_dit'


def rms_norm(x, gain=None):
    xf = x.astype(jnp.float32)
    y = xf * lax.rsqrt(jnp.mean(jnp.square(xf), axis=-1, keepdims=True) + EPS)
    if gain is not None:
        y = y * gain.astype(jnp.float32)
    return y.astype(x.dtype)


def modulate(xn, shift, scale):
    return xn * (1.0 + scale) + shift


def swiglu(x, w_in, w_out):
    g, u = jnp.split(x @ w_in, 2, axis=-1)
    return (jax.nn.silu(g) * u) @ w_out


def axial_rope_tables(n_tokens):
    rows = n_tokens // GRID_W
    row = jnp.repeat(jnp.arange(rows, dtype=jnp.float32), GRID_W)
    col = jnp.tile(jnp.arange(GRID_W, dtype=jnp.float32), rows)
    inv_freq = ROPE_BASE ** (-jnp.arange(ROPE_PAIRS, dtype=jnp.float32) / ROPE_PAIRS)
    ang = jnp.concatenate([row[:, None] * inv_freq, col[:, None] * inv_freq], axis=-1)
    return jnp.cos(ang), jnp.sin(ang)


def apply_rope_2d(x, cos, sin):
    shp = x.shape
    xr = x.reshape(shp[:-1] + (2, 2, ROPE_PAIRS))
    x1, x2 = xr[..., 0, :], xr[..., 1, :]
    c = cos.reshape(-1, 1, 2, ROPE_PAIRS).astype(x.dtype)
    s = sin.reshape(-1, 1, 2, ROPE_PAIRS).astype(x.dtype)
    out = jnp.stack([x1 * c - x2 * s, x1 * s + x2 * c], axis=-2)
    return out.reshape(shp)


def rope_part(t, rope):
    if rope is None:
        return t
    return jnp.concatenate([t[..., :QK_NOPE], apply_rope_2d(t[..., QK_NOPE:], *rope)], axis=-1)


def mla_queries(q_a, p, rope):
    B, T, _ = q_a.shape
    q = (rms_norm(q_a, p['q_a_norm']) @ p['w_uq']).reshape(B, T, N_HEADS, QK_HEAD)
    q = rope_part(rms_norm(q, p['q_norm']), rope)
    return q.transpose(0, 2, 1, 3)


def mla_keys_values(kv_a, k_r, p, rope):
    B, T, _ = kv_a.shape
    kv = (rms_norm(kv_a, p['kv_a_norm']) @ p['w_ukv']).reshape(B, T, N_HEADS, QK_NOPE + V_HEAD)
    k_nope, v = kv[..., :QK_NOPE], kv[..., QK_NOPE:]
    k_shared = jnp.broadcast_to(k_r[:, :, None, :], (B, T, N_HEADS, QK_ROPE))
    k = rope_part(rms_norm(jnp.concatenate([k_nope, k_shared], axis=-1), p['k_norm']), rope)
    return k.transpose(0, 2, 1, 3), v.transpose(0, 2, 1, 3)


def attend(q, k, v):
    s = jnp.einsum('bhqd,bhkd->bhqk', q, k).astype(jnp.float32) * ATTN_SCALE
    return jnp.einsum('bhqk,bhkd->bhqd', jax.nn.softmax(s, axis=-1).astype(v.dtype), v)


def latent_attention(q, k, v):
    B, H, S, _ = q.shape
    nb = S // Q_BLOCK
    qb = q.reshape(B, H, nb, Q_BLOCK, QK_HEAD).transpose(2, 0, 1, 3, 4)
    out = lax.map(lambda qblk: attend(qblk, k, v), qb)
    return out.transpose(1, 0, 3, 2, 4).reshape(B, S, N_HEADS * V_HEAD)


def short_conv(x, w, b):
    T = x.shape[1]
    xp = jnp.pad(x, ((0, 0), (CONV_PAD_LEFT, CONV_W - 1 - CONV_PAD_LEFT), (0, 0)))
    y = b
    for k in range(CONV_W):
        y = y + xp[:, k:k + T] * w[k]
    return y


def rglru_coeffs(x, lam, w_r, b_r, w_i, b_i):
    B, T, W = x.shape
    xb = x.reshape(B, T, LRU_BLOCKS, LRU_BLOCK)
    r = jax.nn.sigmoid(jnp.einsum('btgi,gij->btgj', xb, w_r).reshape(B, T, W) + b_r)
    i = jax.nn.sigmoid(jnp.einsum('btgi,gij->btgj', xb, w_i).reshape(B, T, W) + b_i)
    log_a = -RG_C * r.astype(jnp.float32) * jax.nn.softplus(-lam.astype(jnp.float32))
    a = jnp.exp(log_a)
    b = jnp.sqrt(-jnp.expm1(2.0 * log_a)) * (i * x).astype(jnp.float32)
    return a, b


def _lin_combine(e1, e2):
    a1, b1 = e1
    a2, b2 = e2
    return a1 * a2, a2 * b1 + b2


def linear_scan(a, b, h0, reverse):
    if h0 is not None:
        edge = -1 if reverse else 0
        b = b.at[:, edge].add(a[:, edge] * h0)
    _, h = lax.associative_scan(_lin_combine, (a, b), axis=1, reverse=reverse)
    return h


def scan_direction(xc, xl, p, d, reverse):
    prm = (p['lru_lambda'][d], p['w_rgate'][d], p['b_rgate'][d], p['w_igate'][d], p['b_igate'][d])
    hc = linear_scan(*rglru_coeffs(xc, *prm), None, reverse)
    h0 = hc[:, 0] if reverse else hc[:, -1]
    hl = linear_scan(*rglru_coeffs(xl, *prm), h0, reverse)
    return hc, hl


def rglru_mixer(ux_c, uy_c, ux_l, uy_l, p, last):
    xc = short_conv(ux_c, p['conv_w'], p['conv_b'])
    xl = short_conv(ux_l, p['conv_w'], p['conv_b'])
    hc_f, hl_f = scan_direction(xc, xl, p, 0, False)
    hc_b, hl_b = scan_direction(xc, xl, p, 1, True)
    out_l = (hl_f + hl_b).astype(ux_l.dtype) * jax.nn.gelu(uy_l)
    out_c = None if last else (hc_f + hc_b).astype(ux_c.dtype) * jax.nn.gelu(uy_c)
    return out_l, out_c


def merge_branches(att, lru, gate_logits, p):
    g_att, g_lru = jnp.split(jax.nn.sigmoid(gate_logits), 2, axis=-1)
    return (g_att * (att @ p['w_o_attn']) + g_lru * (lru @ p['w_o_lru'])) @ p['w_out']


def hybrid_layer(xl, xc, mod_l, mod_c, rope, p, last):
    sh1_l, sc1_l, g1_l, sh2_l, sc2_l, g2_l, sh3_l, sc3_l, g3_l = jnp.split(mod_l, N_MOD, axis=-1)
    sh1_c, sc1_c, g1_c, sh2_c, sc2_c, g2_c, sh3_c, sc3_c, g3_c = jnp.split(mod_c, N_MOD, axis=-1)
    B, C, _ = xc.shape
    xl = xl + 0.5 * g1_l * swiglu(modulate(rms_norm(xl), sh1_l, sc1_l), p['ff1_w_in'], p['ff1_w_out'])
    xc = xc + 0.5 * g1_c * swiglu(modulate(rms_norm(xc), sh1_c, sc1_c), p['ff1_w_in'], p['ff1_w_out'])
    hl = modulate(rms_norm(xl), sh2_l, sc2_l) @ p['w_in']
    hc = modulate(rms_norm(xc), sh2_c, sc2_c) @ p['w_in']
    qa_l, kva_l, kr_l, ux_l, uy_l, gate_l = jnp.split(hl, IN_SPLITS, axis=-1)
    qa_c, kva_c, kr_c, ux_c, uy_c, gate_c = jnp.split(hc, IN_SPLITS, axis=-1)
    k_c, v_c = mla_keys_values(kva_c, kr_c, p, None)
    k_l, v_l = mla_keys_values(kva_l, kr_l, p, rope)
    q_l = mla_queries(qa_l, p, rope)
    att_l = latent_attention(q_l, jnp.concatenate([k_l, k_c], axis=2), jnp.concatenate([v_l, v_c], axis=2))
    lru_l, lru_c = rglru_mixer(ux_c, uy_c, ux_l, uy_l, p, last)
    xl = xl + g2_l * merge_branches(att_l, lru_l, gate_l, p)
    xl = xl + 0.5 * g3_l * swiglu(modulate(rms_norm(xl), sh3_l, sc3_l), p['ff2_w_in'], p['ff2_w_out'])
    if not last:
        q_c = mla_queries(qa_c, p, None)
        att_c = attend(q_c, k_c, v_c).transpose(0, 2, 1, 3).reshape(B, C, N_HEADS * V_HEAD)
        xc = xc + g2_c * merge_branches(att_c, lru_c, gate_c, p)
        xc = xc + 0.5 * g3_c * swiglu(modulate(rms_norm(xc), sh3_c, sc3_c), p['ff2_w_in'], p['ff2_w_out'])
    return xl, xc


def setup_inputs(seed: int = 0) -> dict:
    key = jax.random.key(seed)
    ks = jax.random.split(key, 32)
    f32 = jnp.float32

    def nrm(k, shape, fan_in):
        return jax.random.normal(k, shape, f32) * fan_in ** -0.5

    def small(k, shape):
        return 0.01 * jax.random.normal(k, shape, f32)

    def gain(k, shape):
        return 1.0 + 0.01 * jax.random.normal(k, shape, f32)

    a0 = jax.random.uniform(ks[20], (DEPTH, 2, LRU_WIDTH), f32, minval=0.9, maxval=0.999)
    s0 = a0 ** (1.0 / RG_C)
    lru_lambda = jnp.log(s0) - jnp.log1p(-s0)
    return {
        'x': jax.random.normal(ks[0], (BATCH, SEQ, D_MODEL), f32),
        'c': jax.random.normal(ks[1], (BATCH, D_MODEL), f32),
        'ctx': jax.random.normal(ks[2], (BATCH, CTX_LEN, D_MODEL), f32),
        'c_ctx': jax.random.normal(ks[3], (D_MODEL,), f32),
        'w_ada': nrm(ks[4], (DEPTH, D_MODEL, N_MOD * D_MODEL), D_MODEL),
        'b_ada': small(ks[5], (DEPTH, N_MOD * D_MODEL)),
        'ff1_w_in': nrm(ks[6], (DEPTH, D_MODEL, 2 * D_FF), D_MODEL),
        'ff1_w_out': nrm(ks[7], (DEPTH, D_FF, D_MODEL), D_FF),
        'ff2_w_in': nrm(ks[8], (DEPTH, D_MODEL, 2 * D_FF), D_MODEL),
        'ff2_w_out': nrm(ks[9], (DEPTH, D_FF, D_MODEL), D_FF),
        'w_in': nrm(ks[10], (DEPTH, D_MODEL, D_IN), D_MODEL),
        'q_a_norm': gain(ks[11], (DEPTH, Q_LORA)),
        'w_uq': nrm(ks[12], (DEPTH, Q_LORA, N_HEADS * QK_HEAD), Q_LORA),
        'kv_a_norm': gain(ks[13], (DEPTH, KV_LORA)),
        'w_ukv': nrm(ks[14], (DEPTH, KV_LORA, N_HEADS * (QK_NOPE + V_HEAD)), KV_LORA),
        'q_norm': gain(ks[15], (DEPTH, QK_HEAD)),
        'k_norm': gain(ks[16], (DEPTH, QK_HEAD)),
        'conv_w': nrm(ks[17], (DEPTH, CONV_W, LRU_WIDTH), CONV_W),
        'conv_b': small(ks[18], (DEPTH, LRU_WIDTH)),
        'lru_lambda': lru_lambda,
        'w_rgate': nrm(ks[21], (DEPTH, 2, LRU_BLOCKS, LRU_BLOCK, LRU_BLOCK), LRU_BLOCK),
        'b_rgate': small(ks[22], (DEPTH, 2, LRU_WIDTH)),
        'w_igate': nrm(ks[23], (DEPTH, 2, LRU_BLOCKS, LRU_BLOCK, LRU_BLOCK), LRU_BLOCK),
        'b_igate': small(ks[24], (DEPTH, 2, LRU_WIDTH)),
        'w_o_attn': nrm(ks[25], (DEPTH, N_HEADS * V_HEAD, D_MODEL), N_HEADS * V_HEAD),
        'w_o_lru': nrm(ks[26], (DEPTH, LRU_WIDTH, D_MODEL), LRU_WIDTH),
        'w_out': nrm(ks[27], (DEPTH, D_MODEL, D_MODEL), D_MODEL),
    }


def reference(x, c, ctx, c_ctx, w_ada, b_ada, ff1_w_in, ff1_w_out, ff2_w_in, ff2_w_out, w_in,
              q_a_norm, w_uq, kv_a_norm, w_ukv, q_norm, k_norm, conv_w, conv_b, lru_lambda,
              w_rgate, b_rgate, w_igate, b_igate, w_o_attn, w_o_lru, w_out):
    rope = axial_rope_tables(x.shape[1])
    cond_l = jax.nn.silu(c)
    cond_c = jax.nn.silu(c_ctx)[None, :]
    xl, xc = x, ctx
    for l in range(DEPTH):
        p = {
            'ff1_w_in': ff1_w_in[l], 'ff1_w_out': ff1_w_out[l],
            'ff2_w_in': ff2_w_in[l], 'ff2_w_out': ff2_w_out[l],
            'w_in': w_in[l],
            'q_a_norm': q_a_norm[l], 'w_uq': w_uq[l],
            'kv_a_norm': kv_a_norm[l], 'w_ukv': w_ukv[l],
            'q_norm': q_norm[l], 'k_norm': k_norm[l],
            'conv_w': conv_w[l], 'conv_b': conv_b[l],
            'lru_lambda': lru_lambda[l], 'w_rgate': w_rgate[l], 'b_rgate': b_rgate[l],
            'w_igate': w_igate[l], 'b_igate': b_igate[l],
            'w_o_attn': w_o_attn[l], 'w_o_lru': w_o_lru[l], 'w_out': w_out[l],
        }
        mod_l = (cond_l @ w_ada[l] + b_ada[l])[:, None, :]
        mod_c = (cond_c @ w_ada[l] + b_ada[l])[:, None, :]
        xl, xc = hybrid_layer(xl, xc, mod_l, mod_c, rope, p, l == DEPTH - 1)
    return xl
```

```cpp
#include <hip/hip_runtime.h>
#include <hip/hip_cooperative_groups.h>
#include <cstdio>
namespace cg = cooperative_groups;

#define DI __device__ __forceinline__
#define LAS __attribute__((address_space(3)))
typedef unsigned short bf16_t;
typedef short bf16x8 __attribute__((ext_vector_type(8)));
typedef float f32x2 __attribute__((ext_vector_type(2)));
typedef float f32x4 __attribute__((ext_vector_type(4)));
typedef float f32x16 __attribute__((ext_vector_type(16)));
typedef unsigned u32x2 __attribute__((ext_vector_type(2)));
typedef unsigned u32x4 __attribute__((ext_vector_type(4)));
typedef __bf16 bfv2 __attribute__((ext_vector_type(2)));

constexpr int DM = 1024, NB = 4, SEQ = 8192, CTXL = 256, DEPTH = 4;
constexpr int ML = NB * SEQ, MC = NB * CTXL, MA = ML + MC;
constexpr int DFF = 2816, NH = 8, TK = SEQ + CTXL;
constexpr int NIN = 3840;
constexpr int NMOD = 9 * DM;
constexpr float EPS = 1e-6f;
constexpr float QSCALE = 0.10206207261596577f * 1.4426950408889634f;
constexpr int NCH = 132;

constexpr size_t SZ_FFIN = (size_t)2 * DFF * DM * 2, SZ_FFOUT = (size_t)DM * DFF * 2;
constexpr size_t O_WFF1IN = 0;
constexpr size_t O_WFF1OUT = O_WFF1IN + SZ_FFIN;
constexpr size_t O_WFF2IN = O_WFF1OUT + SZ_FFOUT;
constexpr size_t O_WFF2OUT = O_WFF2IN + SZ_FFIN;
constexpr size_t O_WIN = O_WFF2OUT + SZ_FFOUT;
constexpr size_t O_WUQ = O_WIN + (size_t)NIN * DM * 2;
constexpr size_t O_WUKV = O_WUQ + (size_t)768 * 384 * 2;
constexpr size_t O_WOA = O_WUKV + (size_t)1024 * 256 * 2;
constexpr size_t O_WOL = O_WOA + (size_t)1024 * 512 * 2;
constexpr size_t O_WOUT = O_WOL + (size_t)1024 * 512 * 2;
constexpr size_t O_WGATE = O_WOUT + (size_t)1024 * 1024 * 2;
constexpr size_t O_MOD = O_WGATE + (size_t)2048 * 256 * 2;
constexpr size_t O_RSQ = O_MOD + (size_t)DEPTH * 5 * NMOD * 4;
constexpr size_t O_RSKV = O_RSQ + (size_t)MA * 4;
constexpr size_t O_AGG = O_RSKV + (size_t)MA * 4;
constexpr size_t O_SP = O_AGG + (size_t)2 * NB * NCH * 512 * 8;
constexpr size_t O_X = O_SP + 4096;
constexpr size_t O_R1 = O_X + (size_t)MA * DM * 4;
constexpr size_t O_UXY = O_R1 + (size_t)MA * DFF * 2;
constexpr size_t O_XNY = O_UXY + (size_t)MA * 1024 * 2;
constexpr size_t O_S = O_XNY + (size_t)MA * 1024 * 2;
constexpr size_t WS_END = O_S + (size_t)MA * 1024 * 4;
constexpr int LDS_BYTES = 131072;

struct Params {
    const float *x, *c, *ctx, *c_ctx, *w_ada, *b_ada, *ff1_w_in, *ff1_w_out, *ff2_w_in, *ff2_w_out, *w_in, *q_a_norm, *w_uq, *kv_a_norm, *w_ukv, *q_norm, *k_norm,
        *conv_w, *conv_b, *lru_lambda, *w_rgate, *b_rgate, *w_igate, *b_igate, *w_o_attn, *w_o_lru, *w_out;
    float* out; unsigned char* ws;
    int ph_lo, ph_hi, coop, pad;
};

DI int tidx_() { int t = threadIdx.x; asm volatile("" : "+v"(t)); return t; }
DI int bidx_() { int t = blockIdx.x; asm volatile("" : "+s"(t)); return t; }
#define TIDX tidx_()
#define BIDX bidx_()
DI unsigned pk2(float lo, float hi) { f32x2 v = {lo, hi}; bfv2 r = __builtin_convertvector(v, bfv2); return __builtin_bit_cast(unsigned, r); }
DI bf16_t f2bf(float x) { return (bf16_t)(pk2(x, 0.f) & 0xffffu); }
DI float bf2f(bf16_t v) { return __uint_as_float((unsigned)v << 16); }
DI float bflo(unsigned v) { return __uint_as_float(v << 16); }
DI float bfhi(unsigned v) { return __uint_as_float(v & 0xffff0000u); }
DI float wave_sum(float v) {
#pragma unroll
    for (int o = 1; o < 64; o <<= 1) v += __shfl_xor(v, o);
    return v;
}
DI float sigmoidf_(float x) { return __frcp_rn(1.f + __expf(-x)); }
DI int mod_row(int row) { return row < ML ? (row >> 13) : 4; }

constexpr int BM = 256, BK = 64, HALF = 128, HTB = HALF * BK * 2, NXCD = 8, WGM = 8;
DI int lds_byte(int r, int c) { const int st = (r >> 4) * 2 + (c >> 5), rr = r & 15, cc = c & 31, ob = rr * 64 + cc * 2; return st * 1024 + (ob ^ (((ob >> 9) & 1) << 5)); }
DI void stage_rc(int b, int& R, int& C) { const int st = b / 1024, sb = b % 1024, swz = sb ^ (((sb >> 9) & 1) << 5); R = (st >> 1) * 16 + swz / 64; C = (st & 1) * 32 + (swz % 64) / 2; }
struct Unit { int pm, pn; };
struct Gemm { const bf16_t* A; const bf16_t* Bt; int M, N, K, lda, ldb; };
struct StaticOrder {
    int nM, nN, nwg, G, c;
    DI void init(int M, int N, int G_, int c_) { nM = M / BM; nN = N / BM; nwg = nM * nN; G = G_; c = c_; }
    DI bool next(int i, Unit& u) const {
        const long L = (long)i * G + c; if (L >= nwg) return false;
        int wgid = (int)L; { const int q = nwg / NXCD, r = nwg % NXCD, xcd = wgid % NXCD, off = wgid / NXCD; wgid = (xcd < r ? xcd * (q + 1) : r * (q + 1) + (xcd - r) * q) + off; }
        const int nig = WGM * nN, gid = wgid / nig, fm = gid * WGM, gsz = (nM - fm) < WGM ? (nM - fm) : WGM;
        u.pm = fm + ((wgid % nig) % gsz); u.pn = (wgid % nig) / gsz; return true;
    }
};

template <class Epi, bool GATE_A>
DI void gemm_phase(LAS unsigned char* lds, const Gemm g, const Epi& E) {
    const int tid = TIDX, wid = __builtin_amdgcn_readfirstlane(tid >> 6), lane = tid & 63, wr = wid >> 2, wc = wid & 3, fr = lane & 15, fq = lane >> 4;
    const int K = g.K, nt = K / BK;
    StaticOrder S; S.init(g.M, g.N, gridDim.x, BIDX);
    unsigned voffA[2], voffB[2];
#pragma unroll
    for (int i = 0; i < 2; ++i) { int R, C; stage_rc(tid * 16 + i * 8192, R, C); voffA[i] = (unsigned)(R * g.lda + C) * 2u; voffB[i] = (unsigned)(R * g.ldb + C) * 2u; }
#pragma unroll
    for (int i = 0; i < 2; ++i) { asm volatile("" : "+v"(voffA[i])); asm volatile("" : "+v"(voffB[i])); }
    const size_t kstep = (size_t)(BK * 2);
    const size_t hstepA = (size_t)HALF * g.lda * 2, hstepB = (size_t)HALF * g.ldb * 2;
    const size_t tstepA = 2 * hstepA, tstepB = 2 * hstepB;
    const unsigned ldsw = (unsigned)wid * 1024u;
    const int aoff = lds_byte(wr * 64 + fr, fq * 8), boff = lds_byte(wc * 32 + fr, fq * 8);
#define PG8_SA(b, h) (((b) * 2 + (h)) * HTB)
#define PG8_SB(b, h) ((4 + (b) * 2 + (h)) * HTB)
#define PG8_STAGE(bufoff, gbase, voff) do { _Pragma("unroll") for (int _i = 0; _i < 2; ++_i) \
        __builtin_amdgcn_global_load_lds((const unsigned*)((const char*)(gbase) + (voff)[_i]), (LAS unsigned*)(lds + (bufoff) + ldsw + _i * 8192), 16, 0, 0); } while (0)
#define PG8_LDA(dst, b, h) do { _Pragma("unroll") for (int m = 0; m < 4; ++m) _Pragma("unroll") for (int k = 0; k < 2; ++k) dst[m][k] = *(const LAS bf16x8*)(lds + PG8_SA(b, h) + aoff + m * 2048 + k * 1024); } while (0)
#define PG8_LDB(dst, b, h) do { _Pragma("unroll") for (int n = 0; n < 2; ++n) _Pragma("unroll") for (int k = 0; k < 2; ++k) dst[n][k] = *(const LAS bf16x8*)(lds + PG8_SB(b, h) + boff + n * 2048 + k * 1024); } while (0)
#define PG8_MMA(ai, bj, At, Bt) do { __builtin_amdgcn_s_setprio(1); _Pragma("unroll") for (int m = 0; m < 4; ++m) _Pragma("unroll") for (int n = 0; n < 2; ++n) _Pragma("unroll") for (int k = 0; k < 2; ++k) \
        acc[ai][bj][m][n] = __builtin_amdgcn_mfma_f32_16x16x32_bf16(Bt[n][k], At[m][k], acc[ai][bj][m][n], 0, 0, 0); __builtin_amdgcn_s_setprio(0); } while (0)
#define PG8_WAIT_V(n) asm volatile("s_waitcnt vmcnt(" #n ")" ::: "memory")
#define PG8_WAIT_L(n) asm volatile("s_waitcnt lgkmcnt(" #n ")" ::: "memory")
#define PG8_BAR __builtin_amdgcn_s_barrier()
#define PG8_SCHED __builtin_amdgcn_sched_barrier(0)
#define PG8_ABASE(u) ((const char*)g.A + (size_t)(u).pm * tstepA + (GATE_A ? (size_t)((((u).pn & 3) >> 1) * 512) : (size_t)0))
    Unit cur, nxt; int ui = 0;
    if (!S.next(0, cur)) return;
    f32x4 acc[2][2][4][2];
#pragma unroll
    for (int a = 0; a < 2; ++a)
#pragma unroll
        for (int b = 0; b < 2; ++b)
#pragma unroll
            for (int m = 0; m < 4; ++m)
#pragma unroll
                for (int n = 0; n < 2; ++n) acc[a][b][m][n] = (f32x4){0.f, 0.f, 0.f, 0.f};
    bf16x8 At[4][2], B0[2][2], B1[2][2];
    const char* cA = PG8_ABASE(cur); const char* cB = (const char*)g.Bt + (size_t)cur.pn * tstepB;
    PG8_STAGE(PG8_SB(0, 0), cB, voffB); PG8_STAGE(PG8_SA(0, 0), cA, voffA); PG8_STAGE(PG8_SB(0, 1), cB + hstepB, voffB); PG8_STAGE(PG8_SA(0, 1), cA + hstepA, voffA);
    if (wr == 1) PG8_BAR;
    PG8_WAIT_V(4); PG8_BAR;
    PG8_STAGE(PG8_SB(1, 0), cB + kstep, voffB); PG8_STAGE(PG8_SA(1, 0), cA + kstep, voffA); PG8_STAGE(PG8_SB(1, 1), cB + hstepB + kstep, voffB);
    PG8_WAIT_V(6); PG8_BAR;
    for (;;) {
        const bool has_next = S.next(ui + 1, nxt);
        const char* nA = has_next ? PG8_ABASE(nxt) : cA; const char* nB = has_next ? (const char*)g.Bt + (size_t)nxt.pn * tstepB : cB;
#pragma nounroll
        for (int t = 0; t < nt; t += 2) {
            const bool last = (t == nt - 2);
            const char* a1 = cA + (size_t)(t + 1) * kstep;
            const char* a2 = last ? nA : cA + (size_t)(t + 2) * kstep; const char* b2 = last ? nB : cB + (size_t)(t + 2) * kstep;
            const char* a3 = a2 + kstep; const char* b3 = b2 + kstep;
            PG8_LDB(B0, 0, 0); PG8_SCHED; PG8_LDA(At, 0, 0); PG8_STAGE(PG8_SA(1, 1), a1 + hstepA, voffA);
            PG8_WAIT_L(8); PG8_BAR; PG8_WAIT_L(0); PG8_MMA(0, 0, At, B0); PG8_BAR; PG8_SCHED;
            PG8_LDB(B1, 0, 1); PG8_STAGE(PG8_SB(0, 0), b2, voffB);
            PG8_BAR; PG8_WAIT_L(0); PG8_MMA(0, 1, At, B1); PG8_BAR;
            PG8_LDA(At, 0, 1); PG8_STAGE(PG8_SA(0, 0), a2, voffA);
            PG8_BAR; PG8_WAIT_L(0); PG8_MMA(1, 0, At, B0); PG8_BAR; PG8_SCHED;
            PG8_STAGE(PG8_SB(0, 1), b2 + hstepB, voffB);
            PG8_WAIT_V(6); PG8_BAR; PG8_MMA(1, 1, At, B1); PG8_BAR;
            PG8_LDB(B0, 1, 0); PG8_SCHED; PG8_LDA(At, 1, 0); PG8_STAGE(PG8_SA(0, 1), a2 + hstepA, voffA);
            PG8_WAIT_L(8); PG8_BAR; PG8_WAIT_L(0); PG8_MMA(0, 0, At, B0); PG8_BAR; PG8_SCHED;
            PG8_LDB(B1, 1, 1); PG8_STAGE(PG8_SB(1, 0), b3, voffB);
            PG8_BAR; PG8_WAIT_L(0); PG8_MMA(0, 1, At, B1); PG8_BAR;
            PG8_LDA(At, 1, 1); PG8_STAGE(PG8_SA(1, 0), a3, voffA);
            PG8_BAR; PG8_WAIT_L(0); PG8_MMA(1, 0, At, B0); PG8_BAR; PG8_SCHED;
            PG8_STAGE(PG8_SB(1, 1), b3 + hstepB, voffB);
            PG8_WAIT_V(6); PG8_BAR; PG8_MMA(1, 1, At, B1); PG8_BAR;
        }
        E(acc, cur, wr, wc, fr, fq);
        if (!has_next) break;
#pragma unroll
        for (int a = 0; a < 2; ++a)
#pragma unroll
            for (int b = 0; b < 2; ++b)
#pragma unroll
                for (int m = 0; m < 4; ++m)
#pragma unroll
                    for (int n = 0; n < 2; ++n) acc[a][b][m][n] = (f32x4){0.f, 0.f, 0.f, 0.f};
        cur = nxt; cA = nA; cB = nB; ++ui;
    }
    PG8_WAIT_V(0);
    if (wr == 0) PG8_BAR;
    PG8_BAR;
#undef PG8_SA
#undef PG8_SB
#undef PG8_STAGE
#undef PG8_LDA
#undef PG8_LDB
#undef PG8_MMA
#undef PG8_WAIT_V
#undef PG8_WAIT_L
#undef PG8_BAR
#undef PG8_SCHED
#undef PG8_ABASE
}

template <class F> struct EpiElem {
    F f;
    DI void operator()(const f32x4 (&acc)[2][2][4][2], const Unit& u, int wr, int wc, int fr, int fq) const {
        const int row0 = u.pm * BM + wr * 64 + fr, col0 = u.pn * BM + wc * 32 + 4 * fq;
#pragma unroll
        for (int ai = 0; ai < 2; ++ai)
#pragma unroll
            for (int m = 0; m < 4; ++m)
#pragma unroll
                for (int bj = 0; bj < 2; ++bj)
#pragma unroll
                    for (int n = 0; n < 2; ++n) { f(row0 + ai * HALF + m * 16, col0 + bj * HALF + n * 16, acc[ai][bj][m][n]); __builtin_amdgcn_sched_barrier(0); }
    }
};
template <class F> struct EpiPair {
    F f;
    DI void operator()(const f32x4 (&acc)[2][2][4][2], const Unit& u, int wr, int wc, int fr, int fq) const {
        const int row0 = u.pm * BM + wr * 64 + fr, c0 = wc * 32 + 4 * fq;
#pragma unroll
        for (int ai = 0; ai < 2; ++ai)
#pragma unroll
            for (int m = 0; m < 4; ++m)
#pragma unroll
                for (int n = 0; n < 2; ++n) { f(row0 + ai * HALF + m * 16, u.pn, c0 + n * 16, acc[ai][0][m][n], acc[ai][1][m][n]); __builtin_amdgcn_sched_barrier(0); }
    }
};
DI void st_bf4(bf16_t* p, f32x4 v) { u32x2 o; o.x = pk2(v[0], v[1]); o.y = pk2(v[2], v[3]); *(u32x2*)p = o; }

struct FSwiglu { bf16_t* H;
    DI void operator()(int row, int pn, int c, f32x4 g, f32x4 u) const {
        f32x4 h;
#pragma unroll
        for (int e = 0; e < 4; ++e) h[e] = g[e] * sigmoidf_(g[e]) * u[e];
        st_bf4(H + (size_t)row * DFF + pn * 128 + c, h);
    } };
struct FResid { const float* src; float* dst; const float* mod; float coef;
    DI void operator()(int row, int col, f32x4 v) const {
        const f32x4 g = *(const f32x4*)(mod + mod_row(row) * NMOD + col);
        const f32x4 x = *(const f32x4*)(src + (size_t)row * DM + col);
        *(f32x4*)(dst + (size_t)row * DM + col) = x + coef * g * v;
    } };
struct FWin { bf16_t *P1, *UXY, *GATE;
    DI void operator()(int row, int col, f32x4 v) const {
        bf16_t* p = col < 768 ? P1 + (size_t)row * 768 + col : (col < 1792 ? UXY + (size_t)row * 1024 + (col - 768) : GATE + (size_t)row * 2048 + (col - 1792));
        st_bf4(p, v);
    } };
struct FRowScale { bf16_t* dst; int ld; const float* rs;
    DI void operator()(int row, int col, f32x4 v) const { const float s = rs[row]; st_bf4(dst + (size_t)row * ld + col, v * s); } };
struct FVt { bf16_t* Vt; const float* rs;
    DI void operator()(int row, int col, f32x4 v) const {
        const f32x4 s = *(const f32x4*)(rs + col);
        int b, kpos; if (col < ML) { b = col >> 13; kpos = col & (SEQ - 1); } else { const int r = col - ML; b = r >> 8; kpos = SEQ + (r & 255); }
        st_bf4(Vt + ((size_t)(b * NH + (row >> 6)) * 64 + (row & 63)) * TK + kpos, v * s);
    } };
struct FGate { const bf16_t* xc; bf16_t *OM, *BB; const float *sp8, *br, *bi;
    DI void operator()(int row, int pn, int c, f32x4 r4, f32x4 i4) const {
        const int d = pn >> 2, ch = (pn & 3) * 128 + c;
        const u32x2 xv = *(const u32x2*)(xc + (size_t)row * 512 + ch);
        const f32x4 xf = {bflo(xv.x), bfhi(xv.x), bflo(xv.y), bfhi(xv.y)};
        const f32x4 s4 = *(const f32x4*)(sp8 + d * 512 + ch), br4 = *(const f32x4*)(br + d * 512 + ch), bi4 = *(const f32x4*)(bi + d * 512 + ch);
        f32x4 om, bb;
#pragma unroll
        for (int e = 0; e < 4; ++e) {
            const float r = sigmoidf_(r4[e] + br4[e]), ig = sigmoidf_(i4[e] + bi4[e]);
            const float la = s4[e] * r, a = __expf(la), a2 = a * a;
            om[e] = 1.f - a; bb[e] = __fsqrt_rn(fmaxf(1.f - a2, 0.f)) * (ig * xf[e]);
        }
        const size_t o = ((size_t)d * MA + row) * 512 + ch;
        st_bf4(OM + o, om); st_bf4(BB + o, bb);
    } };
struct FMergeA { const bf16_t* GATE; bf16_t* Y;
    DI void operator()(int row, int col, f32x4 v) const {
        const u32x2 gv = *(const u32x2*)(GATE + (size_t)row * 2048 + col);
        f32x4 o; o[0] = sigmoidf_(bflo(gv.x)) * v[0]; o[1] = sigmoidf_(bfhi(gv.x)) * v[1]; o[2] = sigmoidf_(bflo(gv.y)) * v[2]; o[3] = sigmoidf_(bfhi(gv.y)) * v[3];
        st_bf4(Y + (size_t)row * DM + col, o);
    } };
struct FMergeB { const bf16_t* GATE; bf16_t* Y;
    DI void operator()(int row, int col, f32x4 v) const {
        const u32x2 gv = *(const u32x2*)(GATE + (size_t)row * 2048 + 1024 + col);
        const u32x2 yv = *(const u32x2*)(Y + (size_t)row * DM + col);
        f32x4 o; o[0] = bflo(yv.x) + sigmoidf_(bflo(gv.x)) * v[0]; o[1] = bfhi(yv.x) + sigmoidf_(bfhi(gv.x)) * v[1];
        o[2] = bflo(yv.y) + sigmoidf_(bflo(gv.y)) * v[2]; o[3] = bfhi(yv.y) + sigmoidf_(bfhi(gv.y)) * v[3];
        st_bf4(Y + (size_t)row * DM + col, o);
    } };

DI void phase_mod(const Params& p, float* lds) {
    float* sc = lds;
    float* red = lds + 5 * DM;
    const int tid = TIDX, lane = tid & 63, wave = tid >> 6;
    for (int i = tid; i < 5 * DM; i += 512) { const float v = i < 4 * DM ? p.c[i] : p.c_ctx[i - 4 * DM]; sc[i] = v * sigmoidf_(v); }
    __syncthreads();
    float* mod = (float*)(p.ws + O_MOD);
    for (int it = BIDX; it < DEPTH * (NMOD / 64); it += gridDim.x) {
        const int l = it / (NMOD / 64), n = (it % (NMOD / 64)) * 64 + lane;
        const float* w = p.w_ada + ((size_t)l * DM + wave * 128) * NMOD + n;
        float a0 = 0.f, a1 = 0.f, a2 = 0.f, a3 = 0.f, a4 = 0.f;
#pragma unroll 8
        for (int k = 0; k < 128; ++k) { const float wv = w[(size_t)k * NMOD]; const int kk = wave * 128 + k;
            a0 += sc[kk] * wv; a1 += sc[DM + kk] * wv; a2 += sc[2 * DM + kk] * wv; a3 += sc[3 * DM + kk] * wv; a4 += sc[4 * DM + kk] * wv; }
        red[(wave * 5 + 0) * 64 + lane] = a0; red[(wave * 5 + 1) * 64 + lane] = a1; red[(wave * 5 + 2) * 64 + lane] = a2; red[(wave * 5 + 3) * 64 + lane] = a3; red[(wave * 5 + 4) * 64 + lane] = a4;
        __syncthreads();
        if (tid < 320) { const int r = tid >> 6; float s = p.b_ada[(size_t)l * NMOD + n];
#pragma unroll
            for (int w8 = 0; w8 < 8; ++w8) s += red[(w8 * 5 + r) * 64 + lane];
            mod[((size_t)l * 5 + r) * NMOD + n] = s; }
        __syncthreads();
    }
}

template <int MAP> DI int colmap(int n) {
    if (MAP == 0) return n;
    if (MAP == 1) { const int pn = n >> 8, bj = (n >> 7) & 1, c = n & 127; return bj * DFF + pn * 128 + c; }
    if (MAP == 2) return n < 672 ? n : (n < 768 ? -1 : n - 96);
    { const int m = n & 511, h = m >> 6, d = m & 63; return h * 128 + (n >> 9) * 64 + d; }
}
template <int MAP> DI void tjob(const float* src, int ld, int K, int N, bf16_t* dst, const float* kscale, float* tile, int& base) {
    const int tid = TIDX, ntn = N / 64, ntiles = ntn * (K / 64), G = gridDim.x;
    int first = ((int)BIDX - base % G + G) % G;
    for (int t = first; t < ntiles; t += G) {
        const int n0 = (t % ntn) * 64, k0 = (t / ntn) * 64;
        const int c = colmap<MAP>(n0 + (tid & 63));
#pragma unroll
        for (int i = 0; i < 8; ++i) { const int kk = (tid >> 6) + 8 * i; float v = c >= 0 ? src[(size_t)(k0 + kk) * ld + c] : 0.f; if (kscale) v *= kscale[k0 + kk]; tile[kk * 65 + (tid & 63)] = v; }
        __syncthreads();
#pragma unroll
        for (int i = 0; i < 8; ++i) { const int nn = (tid >> 6) + 8 * i; dst[(size_t)(n0 + nn) * K + k0 + (tid & 63)] = f2bf(tile[(tid & 63) * 65 + nn]); }
        __syncthreads();
    }
    base += ntiles;
}
DI void phase_prep(const Params& p, int l, float* tile) {
    unsigned char* ws = p.ws; int base = 0;
    tjob<1>(p.ff1_w_in + (size_t)l * DM * 2 * DFF, 2 * DFF, DM, 2 * DFF, (bf16_t*)(ws + O_WFF1IN), nullptr, tile, base);
    tjob<0>(p.ff1_w_out + (size_t)l * DFF * DM, DM, DFF, DM, (bf16_t*)(ws + O_WFF1OUT), nullptr, tile, base);
    tjob<1>(p.ff2_w_in + (size_t)l * DM * 2 * DFF, 2 * DFF, DM, 2 * DFF, (bf16_t*)(ws + O_WFF2IN), nullptr, tile, base);
    tjob<0>(p.ff2_w_out + (size_t)l * DFF * DM, DM, DFF, DM, (bf16_t*)(ws + O_WFF2OUT), nullptr, tile, base);
    tjob<2>(p.w_in + (size_t)l * DM * 3744, 3744, DM, NIN, (bf16_t*)(ws + O_WIN), nullptr, tile, base);
    tjob<0>(p.w_uq + (size_t)l * 384 * 768, 768, 384, 768, (bf16_t*)(ws + O_WUQ), p.q_a_norm + l * 384, tile, base);
    tjob<3>(p.w_ukv + (size_t)l * 256 * 1024, 1024, 256, 1024, (bf16_t*)(ws + O_WUKV), p.kv_a_norm + l * 256, tile, base);
    tjob<0>(p.w_o_attn + (size_t)l * 512 * 1024, 1024, 512, 1024, (bf16_t*)(ws + O_WOA), nullptr, tile, base);
    tjob<0>(p.w_o_lru + (size_t)l * 512 * 1024, 1024, 512, 1024, (bf16_t*)(ws + O_WOL), nullptr, tile, base);
    tjob<0>(p.w_out + (size_t)l * 1024 * 1024, 1024, 1024, 1024, (bf16_t*)(ws + O_WOUT), nullptr, tile, base);
    if (BIDX == 0) { float* sp8 = (float*)(ws + O_SP);
        for (int i = TIDX; i < 1024; i += 512) { const float nl = -p.lru_lambda[l * 1024 + i]; sp8[i] = -8.f * (fmaxf(nl, 0.f) + log1pf(__expf(-fabsf(nl)))); } }
    bf16_t* wg = (bf16_t*)(ws + O_WGATE);
    for (int idx = BIDX * 512 + TIDX; idx < 2048 * 256; idx += gridDim.x * 512) {
        const int n = idx >> 8, k = idx & 255, d = n >> 10, cb = (n >> 8) & 3, gt = (n >> 7) & 1, c = n & 127, ch = cb * 128 + c, g = ch >> 6, j = ch & 63, ci = 256 * (cb >> 1) + k, gi = ci >> 6, i = ci & 63;
        float v = 0.f;
        if (gi == g) v = (gt ? p.w_igate : p.w_rgate)[((((size_t)l * 2 + d) * 8 + g) * 64 + i) * 64 + j];
        wg[idx] = f2bf(v);
    }
}

template <bool FIRST> DI void phase_norm(const Params& p, int l, int sidx, int M) {
    const int lane = TIDX & 63, gw = BIDX * 8 + (TIDX >> 6), nw = gridDim.x * 8;
    float* X = (float*)(p.ws + O_X); bf16_t* Xn = (bf16_t*)(p.ws + O_XNY);
    const float* mod = (const float*)(p.ws + O_MOD) + (size_t)l * 5 * NMOD;
    for (int row = gw; row < M; row += nw) {
        const float* src = FIRST ? (row < ML ? p.x + (size_t)row * DM : p.ctx + (size_t)(row - ML) * DM) : X + (size_t)row * DM;
        f32x4 v[4]; float s = 0.f;
#pragma unroll
        for (int j = 0; j < 4; ++j) { v[j] = *(const f32x4*)(src + 256 * j + 4 * lane); s += (v[j][0] * v[j][0] + v[j][1] * v[j][1]) + (v[j][2] * v[j][2] + v[j][3] * v[j][3]); }
        const float rstd = rsqrtf(wave_sum(s) * (1.f / DM) + EPS);
        const float* mr = mod + (size_t)mod_row(row) * NMOD + sidx * DM;
#pragma unroll
        for (int j = 0; j < 4; ++j) {
            const int col = 256 * j + 4 * lane;
            if (FIRST) *(f32x4*)(X + (size_t)row * DM + col) = v[j];
            const f32x4 sh = *(const f32x4*)(mr + col), sc = *(const f32x4*)(mr + DM + col);
            st_bf4(Xn + (size_t)row * DM + col, v[j] * rstd * (1.f + sc) + sh);
        }
    }
}

DI void phase_conv(const Params& p, int l) {
    const bf16_t* UXY = (const bf16_t*)(p.ws + O_UXY); const bf16_t* P1 = (const bf16_t*)(p.ws + O_R1);
    bf16_t* xc = (bf16_t*)(p.ws + O_XNY);
    const float* cw = p.conv_w + (size_t)l * 4 * 512; const float* cb = p.conv_b + (size_t)l * 512;
    for (int e = BIDX * 512 + TIDX; e < MA * 64; e += gridDim.x * 512) {
        const int row = e >> 6, ch = (e & 63) * 8;
        int t, T; if (row < ML) { t = row & (SEQ - 1); T = SEQ; } else { t = (row - ML) & 255; T = CTXL; }
        float y[8];
#pragma unroll
        for (int i = 0; i < 8; ++i) y[i] = cb[ch + i];
#pragma unroll
        for (int k = 0; k < 4; ++k) {
            const int tt = t + k - 2;
            if (tt >= 0 && tt < T) {
                const u32x4 uv = *(const u32x4*)(UXY + (size_t)(row + k - 2) * 1024 + ch);
                const f32x4 w0 = *(const f32x4*)(cw + k * 512 + ch), w1 = *(const f32x4*)(cw + k * 512 + ch + 4);
                y[0] += w0[0] * bflo(uv.x); y[1] += w0[1] * bfhi(uv.x); y[2] += w0[2] * bflo(uv.y); y[3] += w0[3] * bfhi(uv.y);
                y[4] += w1[0] * bflo(uv.z); y[5] += w1[1] * bfhi(uv.z); y[6] += w1[2] * bflo(uv.w); y[7] += w1[3] * bfhi(uv.w);
            }
        }
        u32x4 o; o.x = pk2(y[0], y[1]); o.y = pk2(y[2], y[3]); o.z = pk2(y[4], y[5]); o.w = pk2(y[6], y[7]);
        *(u32x4*)(xc + (size_t)row * 512 + ch) = o;
    }
    float* rsq = (float*)(p.ws + O_RSQ); float* rskv = (float*)(p.ws + O_RSKV);
    const int lane = TIDX & 63, gw = BIDX * 8 + (TIDX >> 6), nw = gridDim.x * 8;
    for (int row = gw; row < MA; row += nw) {
        const bf16_t* pr = P1 + (size_t)row * 768;
        float sq = 0.f, skv = 0.f;
        { const u32x4 v = *(const u32x4*)(pr + lane * 8);
          const float s = bflo(v.x) * bflo(v.x) + bfhi(v.x) * bfhi(v.x) + bflo(v.y) * bflo(v.y) + bfhi(v.y) * bfhi(v.y) + bflo(v.z) * bflo(v.z) + bfhi(v.z) * bfhi(v.z) + bflo(v.w) * bflo(v.w) + bfhi(v.w) * bfhi(v.w);
          if (lane < 48) sq += s; else skv += s; }
        if (lane < 16) { const u32x4 v = *(const u32x4*)(pr + 512 + lane * 8);
          skv += bflo(v.x) * bflo(v.x) + bfhi(v.x) * bfhi(v.x) + bflo(v.y) * bflo(v.y) + bfhi(v.y) * bfhi(v.y) + bflo(v.z) * bflo(v.z) + bfhi(v.z) * bfhi(v.z) + bflo(v.w) * bflo(v.w) + bfhi(v.w) * bfhi(v.w); }
        sq = wave_sum(sq); skv = wave_sum(skv);
        if (lane == 0) { rsq[row] = rsqrtf(sq * (1.f / 384.f) + EPS); rskv[row] = rsqrtf(skv * (1.f / 256.f) + EPS); }
    }
}

DI int chunk_row0(int b, int pch) { return pch < 4 ? ML + b * CTXL + pch * 64 : b * SEQ + (pch - 4) * 64; }
DI void phase_scan_agg(const Params& p) {
    const bf16_t* OM = (const bf16_t*)(p.ws + O_S); const bf16_t* BB = OM + (size_t)2 * MA * 512;
    f32x2* agg = (f32x2*)(p.ws + O_AGG);
    const int ch = TIDX;
    for (int it = BIDX; it < 2 * NB * NCH; it += gridDim.x) {
        const int d = it & 1, bp = it >> 1, b = bp / NCH, pch = bp % NCH, row0 = chunk_row0(b, pch);
        const bf16_t* om = OM + ((size_t)d * MA + row0) * 512 + ch; const bf16_t* bb = BB + ((size_t)d * MA + row0) * 512 + ch;
        float h = 0.f, A = 1.f;
#pragma unroll 8
        for (int t = 0; t < 64; ++t) { const int tt = d ? 63 - t : t; const float a = 1.f - bf2f(om[(size_t)tt * 512]); h = a * h + bf2f(bb[(size_t)tt * 512]); A *= a; }
        agg[((size_t)(d * NB + b) * NCH + pch) * 512 + ch] = (f32x2){A, h};
    }
}
DI float gelu_tanh(float x) { const float u = 0.7978845608028654f * (x + 0.044715f * x * x * x); const float e = __expf(2.f * u); const float th = 1.f - 2.f * __frcp_rn(e + 1.f); return 0.5f * x * (1.f + th); }
DI void phase_scan_apply(const Params& p, float* sh) {
    const bf16_t* OM = (const bf16_t*)(p.ws + O_S); const bf16_t* BB = OM + (size_t)2 * MA * 512;
    const f32x2* agg = (const f32x2*)(p.ws + O_AGG);
    bf16_t* UXY = (bf16_t*)(p.ws + O_UXY);
    const int ch = TIDX;
    for (int it = BIDX; it < NB * NCH; it += gridDim.x) {
        const int b = it / NCH, pch = it % NCH, row0 = chunk_row0(b, pch);
        const f32x2* af = agg + ((size_t)(0 * NB + b) * NCH) * 512 + ch; const f32x2* ab = agg + ((size_t)(1 * NB + b) * NCH) * 512 + ch;
        float h = 0.f;
#pragma unroll 4
        for (int q = 0; q < pch; ++q) { const f32x2 e = af[(size_t)q * 512]; h = e[0] * h + e[1]; }
        { const bf16_t* om = OM + ((size_t)row0) * 512 + ch; const bf16_t* bb = BB + ((size_t)row0) * 512 + ch;
#pragma unroll 8
          for (int t = 0; t < 64; ++t) { const float a = 1.f - bf2f(om[(size_t)t * 512]); h = a * h + bf2f(bb[(size_t)t * 512]); sh[t * 512 + ch] = h; } }
        h = 0.f;
        if (pch >= 4) {
#pragma unroll
            for (int q = 3; q >= 0; --q) { const f32x2 e = ab[(size_t)q * 512]; h = e[0] * h + e[1]; }
#pragma unroll 4
            for (int q = NCH - 1; q > pch; --q) { const f32x2 e = ab[(size_t)q * 512]; h = e[0] * h + e[1]; }
        } else {
            for (int q = 3; q > pch; --q) { const f32x2 e = ab[(size_t)q * 512]; h = e[0] * h + e[1]; }
        }
        { const bf16_t* om = OM + ((size_t)MA + row0) * 512 + ch; const bf16_t* bb = BB + ((size_t)MA + row0) * 512 + ch;
#pragma unroll 8
          for (int t = 63; t >= 0; --t) { const float a = 1.f - bf2f(om[(size_t)t * 512]); h = a * h + bf2f(bb[(size_t)t * 512]);
              const float uy = bf2f(UXY[(size_t)(row0 + t) * 1024 + 512 + ch]);
              UXY[(size_t)(row0 + t) * 1024 + ch] = f2bf((sh[t * 512 + ch] + h) * gelu_tanh(uy)); } }
    }
}

DI void phase_qk(const Params& p, int l) {
    const bf16_t* qraw = (const bf16_t*)p.out; const bf16_t* kn = qraw + (size_t)MA * 768;
    const bf16_t* P1 = (const bf16_t*)(p.ws + O_R1);
    bf16_t* Q = (bf16_t*)(p.ws + O_S); bf16_t* Kb = Q + (size_t)32 * TK * 96;
    const int lane = TIDX & 63, gw = BIDX * 8 + (TIDX >> 6), nw = gridDim.x * 8, h = lane >> 3, j = lane & 7;
    const float* qn = p.q_norm + l * 96; const float* knm = p.k_norm + l * 96;
    float gq[12], gk[12];
#pragma unroll
    for (int i = 0; i < 12; ++i) { gq[i] = qn[8 * i + j] * QSCALE; gk[i] = knm[8 * i + j]; }
    const float freq = exp2f(-(float)j * 1.6609640474436813f);
    for (int row = gw; row < MA; row += nw) {
        const bool lat = row < ML; int b, pos;
        if (lat) { b = row >> 13; pos = row & (SEQ - 1); } else { const int r = row - ML; b = r >> 8; pos = SEQ + (r & 255); }
        float c0 = 1.f, s0 = 0.f, c1 = 1.f, s1 = 0.f;
        if (lat) { float r0 = (float)(pos >> 6) * freq * 0.15915494309189535f, r1 = (float)(pos & 63) * freq * 0.15915494309189535f;
            r0 -= floorf(r0); r1 -= floorf(r1);
            c0 = __builtin_amdgcn_cosf(r0); s0 = __builtin_amdgcn_sinf(r0); c1 = __builtin_amdgcn_cosf(r1); s1 = __builtin_amdgcn_sinf(r1); }
        float x[12], ss;
        ss = 0.f;
#pragma unroll
        for (int i = 0; i < 12; ++i) { x[i] = bf2f(qraw[(size_t)row * 768 + h * 96 + 8 * i + j]); ss += x[i] * x[i]; }
        ss += __shfl_xor(ss, 1); ss += __shfl_xor(ss, 2); ss += __shfl_xor(ss, 4);
        { const float rs = rsqrtf(ss * (1.f / 96.f) + EPS);
#pragma unroll
          for (int i = 0; i < 12; ++i) x[i] *= rs * gq[i];
          const float y8 = x[8] * c0 - x[9] * s0, y9 = x[8] * s0 + x[9] * c0, y10 = x[10] * c1 - x[11] * s1, y11 = x[10] * s1 + x[11] * c1;
          x[8] = y8; x[9] = y9; x[10] = y10; x[11] = y11;
          bf16_t* dst = Q + ((size_t)(b * NH + h) * TK + pos) * 96 + j;
#pragma unroll
          for (int i = 0; i < 12; ++i) dst[8 * i] = f2bf(x[i]); }
        ss = 0.f;
#pragma unroll
        for (int i = 0; i < 8; ++i) { x[i] = bf2f(kn[(size_t)row * 512 + h * 64 + 8 * i + j]); ss += x[i] * x[i]; }
#pragma unroll
        for (int i = 8; i < 12; ++i) { x[i] = bf2f(P1[(size_t)row * 768 + 640 + 8 * (i - 8) + j]); ss += x[i] * x[i]; }
        ss += __shfl_xor(ss, 1); ss += __shfl_xor(ss, 2); ss += __shfl_xor(ss, 4);
        { const float rs = rsqrtf(ss * (1.f / 96.f) + EPS);
#pragma unroll
          for (int i = 0; i < 12; ++i) x[i] *= rs * gk[i];
          const float y8 = x[8] * c0 - x[9] * s0, y9 = x[8] * s0 + x[9] * c0, y10 = x[10] * c1 - x[11] * s1, y11 = x[10] * s1 + x[11] * c1;
          x[8] = y8; x[9] = y9; x[10] = y10; x[11] = y11;
          bf16_t* dst = Kb + ((size_t)(b * NH + h) * TK + pos) * 96 + j;
#pragma unroll
          for (int i = 0; i < 12; ++i) dst[8 * i] = f2bf(x[i]); }
    }
}

constexpr int KROW = 208, VROW = 136, KBYTES = 64 * KROW, ABUF = KBYTES + 64 * VROW;
DI void attn_item(unsigned char* lds, const bf16_t* Q, const bf16_t* Kb, const bf16_t* Vt, bf16_t* att, int bh, int qpos0, int kt0, int kt1, int outrow0) {
    const int tid = TIDX, lane = tid & 63, wave = tid >> 6, l31 = lane & 31, half = lane >> 5;
    bf16x8 qf[6];
    { const bf16_t* qp = Q + ((size_t)bh * TK + qpos0 + wave * 32 + l31) * 96 + 8 * half;
#pragma unroll
      for (int ks = 0; ks < 6; ++ks) qf[ks] = *(const bf16x8*)(qp + 16 * ks); }
    f32x16 ot0, ot1;
#pragma unroll
    for (int i = 0; i < 16; ++i) { ot0[i] = 0.f; ot1[i] = 0.f; }
    float m_run = -INFINITY, l_run = 0.f;
    const unsigned char* kg = (const unsigned char*)(Kb + (size_t)bh * TK * 96) + (size_t)tid * 16;
    const unsigned char* vg = (const unsigned char*)(Vt + ((size_t)bh * 64 + (tid >> 3)) * TK) + (tid & 7) * 16;
    const int kc1 = 512 + tid;
    const int koff0 = (tid / 12) * KROW + (tid % 12) * 16, koff1 = (kc1 / 12) * KROW + (kc1 % 12) * 16, voff = KBYTES + (tid >> 3) * VROW + (tid & 7) * 16;
    u32x4 kr0, kr1 = {0u, 0u, 0u, 0u}, vr;
#define AT_GLOAD(kt) do { kr0 = *(const u32x4*)(kg + (size_t)(kt) * 12288); if (tid < 256) kr1 = *(const u32x4*)(kg + (size_t)(kt) * 12288 + 8192); vr = *(const u32x4*)(vg + (size_t)(kt) * 128); } while (0)
#define AT_SSTORE(buf) do { unsigned char* bp_ = lds + (buf) * ABUF; *(u32x4*)(bp_ + koff0) = kr0; if (tid < 256) *(u32x4*)(bp_ + koff1) = kr1; \
        *(u32x2*)(bp_ + voff) = (u32x2){vr.x, vr.y}; *(u32x2*)(bp_ + voff + 8) = (u32x2){vr.z, vr.w}; } while (0)
    AT_GLOAD(kt0); AT_SSTORE(0);
    __syncthreads();
    for (int kt = kt0; kt < kt1; ++kt) {
        const int cur = (kt - kt0) & 1;
        const bool more = kt + 1 < kt1;
        if (more) AT_GLOAD(kt + 1);
        const unsigned char* kl = lds + cur * ABUF + l31 * KROW + 16 * half;
        const unsigned char* vl = lds + cur * ABUF + KBYTES + l31 * VROW + 8 * half;
        f32x16 st0, st1;
#pragma unroll
        for (int i = 0; i < 16; ++i) { st0[i] = 0.f; st1[i] = 0.f; }
#pragma unroll
        for (int ks = 0; ks < 6; ++ks) {
            const bf16x8 a0 = *(const bf16x8*)(kl + 32 * ks), a1 = *(const bf16x8*)(kl + 32 * KROW + 32 * ks);
            st0 = __builtin_amdgcn_mfma_f32_32x32x16_bf16(a0, qf[ks], st0, 0, 0, 0);
            st1 = __builtin_amdgcn_mfma_f32_32x32x16_bf16(a1, qf[ks], st1, 0, 0, 0);
        }
        float mx = st0[0];
#pragma unroll
        for (int i = 1; i < 16; ++i) mx = fmaxf(mx, st0[i]);
#pragma unroll
        for (int i = 0; i < 16; ++i) mx = fmaxf(mx, st1[i]);
        mx = fmaxf(mx, __shfl_xor(mx, 32));
        const float m_new = fmaxf(m_run, mx), alpha = __builtin_amdgcn_exp2f(m_run - m_new);
        m_run = m_new;
        float ps = 0.f;
#pragma unroll
        for (int i = 0; i < 16; ++i) { st0[i] = __builtin_amdgcn_exp2f(st0[i] - m_new); st1[i] = __builtin_amdgcn_exp2f(st1[i] - m_new); ps += st0[i] + st1[i]; }
        l_run = l_run * alpha + ps;
#pragma unroll
        for (int i = 0; i < 16; ++i) { ot0[i] *= alpha; ot1[i] *= alpha; }
#pragma unroll
        for (int s = 0; s < 4; ++s) {
            u32x4 pw;
            if (s < 2) { pw.x = pk2(st0[8 * s + 0], st0[8 * s + 1]); pw.y = pk2(st0[8 * s + 2], st0[8 * s + 3]); pw.z = pk2(st0[8 * s + 4], st0[8 * s + 5]); pw.w = pk2(st0[8 * s + 6], st0[8 * s + 7]); }
            else { const int s2 = s - 2; pw.x = pk2(st1[8 * s2 + 0], st1[8 * s2 + 1]); pw.y = pk2(st1[8 * s2 + 2], st1[8 * s2 + 3]); pw.z = pk2(st1[8 * s2 + 4], st1[8 * s2 + 5]); pw.w = pk2(st1[8 * s2 + 6], st1[8 * s2 + 7]); }
            const bf16x8 pf = __builtin_bit_cast(bf16x8, pw);
            const u32x2 v0a = *(const u32x2*)(vl + 32 * s), v0b = *(const u32x2*)(vl + 32 * s + 16);
            const u32x2 v1a = *(const u32x2*)(vl + 32 * VROW + 32 * s), v1b = *(const u32x2*)(vl + 32 * VROW + 32 * s + 16);
            const bf16x8 vf0 = __builtin_bit_cast(bf16x8, (u32x4){v0a.x, v0a.y, v0b.x, v0b.y});
            const bf16x8 vf1 = __builtin_bit_cast(bf16x8, (u32x4){v1a.x, v1a.y, v1b.x, v1b.y});
            ot0 = __builtin_amdgcn_mfma_f32_32x32x16_bf16(vf0, pf, ot0, 0, 0, 0);
            ot1 = __builtin_amdgcn_mfma_f32_32x32x16_bf16(vf1, pf, ot1, 0, 0, 0);
        }
        if (more) AT_SSTORE(cur ^ 1);
        __syncthreads();
    }
#undef AT_GLOAD
#undef AT_SSTORE
    const float lt = l_run + __shfl_xor(l_run, 32), inv = 1.f / lt;
    bf16_t* op = att + (size_t)(outrow0 + wave * 32 + l31) * 512 + (bh & 7) * 64 + 4 * half;
#pragma unroll
    for (int g = 0; g < 4; ++g) {
        st_bf4(op + 8 * g, (f32x4){ot0[4 * g] * inv, ot0[4 * g + 1] * inv, ot0[4 * g + 2] * inv, ot0[4 * g + 3] * inv});
        st_bf4(op + 32 + 8 * g, (f32x4){ot1[4 * g] * inv, ot1[4 * g + 1] * inv, ot1[4 * g + 2] * inv, ot1[4 * g + 3] * inv});
    }
}
DI void phase_attn(const Params& p, unsigned char* lds, bool with_ctx) {
    const bf16_t* Q = (const bf16_t*)(p.ws + O_S); const bf16_t* Kb = Q + (size_t)32 * TK * 96; const bf16_t* Vt = Kb + (size_t)32 * TK * 96;
    bf16_t* att = (bf16_t*)p.out;
    const int nitems = 1024 + (with_ctx ? 32 : 0);
    for (int it = BIDX; it < nitems; it += gridDim.x) {
        if (it < 1024) { const int bh = (it >> 8) * 8 + (it & 7), qb = (it >> 3) & 31; attn_item(lds, Q, Kb, Vt, att, bh, qb * 256, 0, TK / 64, (bh >> 3) * SEQ + qb * 256); }
        else { const int bh = it - 1024; attn_item(lds, Q, Kb, Vt, att, bh, SEQ, SEQ / 64, TK / 64, ML + (bh >> 3) * CTXL); }
    }
}

constexpr int PH_PER_LAYER = 17, N_PHASES = 1 + DEPTH * PH_PER_LAYER;
DI void run_phase(const Params& p, int ph, unsigned char* smem) {
    LAS unsigned char* lds = (LAS unsigned char*)smem;
    unsigned char* ws = p.ws;
    if (ph == 0) { phase_mod(p, (float*)smem); return; }
    const int l = (ph - 1) / PH_PER_LAYER, s = (ph - 1) % PH_PER_LAYER;
    const bool last = (l == DEPTH - 1);
    const float* mod = (const float*)(ws + O_MOD) + (size_t)l * 5 * NMOD;
    float* X = (float*)(ws + O_X);
    bf16_t* XNY = (bf16_t*)(ws + O_XNY); bf16_t* H = (bf16_t*)(ws + O_R1); bf16_t* P1 = (bf16_t*)(ws + O_R1); bf16_t* GATE = P1 + (size_t)MA * 768;
    bf16_t* UXY = (bf16_t*)(ws + O_UXY);
    const int Mtail = last ? ML : MA;
    switch (s) {
    case 0: phase_prep(p, l, (float*)smem); if (l == 0) phase_norm<true>(p, l, 0, MA); else phase_norm<false>(p, l, 0, MA); break;
    case 1: { EpiPair<FSwiglu> E{{H}}; gemm_phase<EpiPair<FSwiglu>, false>(lds, Gemm{XNY, (const bf16_t*)(ws + O_WFF1IN), MA, 2 * DFF, DM, DM, DM}, E); } break;
    case 2: { EpiElem<FResid> E{{X, X, mod + 2 * DM, 0.5f}}; gemm_phase<EpiElem<FResid>, false>(lds, Gemm{H, (const bf16_t*)(ws + O_WFF1OUT), MA, DM, DFF, DFF, DFF}, E); } break;
    case 3: phase_norm<false>(p, l, 3, MA); break;
    case 4: { EpiElem<FWin> E{{P1, UXY, GATE}}; gemm_phase<EpiElem<FWin>, false>(lds, Gemm{XNY, (const bf16_t*)(ws + O_WIN), MA, NIN, DM, DM, DM}, E); } break;
    case 5: phase_conv(p, l); break;
    case 6: { bf16_t* OM = (bf16_t*)(ws + O_S); EpiPair<FGate> E{{XNY, OM, OM + (size_t)2 * MA * 512, (const float*)(ws + O_SP), p.b_rgate + l * 1024, p.b_igate + l * 1024}};
              gemm_phase<EpiPair<FGate>, true>(lds, Gemm{XNY, (const bf16_t*)(ws + O_WGATE), MA, 2048, 256, 512, 256}, E); } break;
    case 7: phase_scan_agg(p); break;
    case 8: phase_scan_apply(p, (float*)smem); break;
    case 9: { bf16_t* qraw = (bf16_t*)p.out; bf16_t* kn = qraw + (size_t)MA * 768; bf16_t* Vt = (bf16_t*)(ws + O_S) + (size_t)2 * 32 * TK * 96;
              const float* rsq = (const float*)(ws + O_RSQ); const float* rskv = (const float*)(ws + O_RSKV);
              const bf16_t* wukv = (const bf16_t*)(ws + O_WUKV);
#if !defined(C9) || C9 == 0
              { EpiElem<FRowScale> E{{qraw, 768, rsq}}; gemm_phase<EpiElem<FRowScale>, false>(lds, Gemm{P1, (const bf16_t*)(ws + O_WUQ), MA, 768, 384, 768, 384}, E); }
#endif
#if !defined(C9) || C9 == 1
              { EpiElem<FRowScale> E{{kn, 512, rskv}}; gemm_phase<EpiElem<FRowScale>, false>(lds, Gemm{P1 + 384, wukv, MA, 512, 256, 768, 256}, E); }
#endif
#if !defined(C9) || C9 == 2
              { EpiElem<FVt> E{{Vt, rskv}}; gemm_phase<EpiElem<FVt>, false>(lds, Gemm{wukv + (size_t)512 * 256, P1 + 384, 512, MA, 256, 256, 768}, E); }
#endif
              } break;
    case 10: phase_qk(p, l); break;
    case 11: phase_attn(p, smem, !last); break;
    case 12: { { EpiElem<FMergeA> E{{GATE, XNY}}; gemm_phase<EpiElem<FMergeA>, false>(lds, Gemm{(const bf16_t*)p.out, (const bf16_t*)(ws + O_WOA), Mtail, DM, 512, 512, 512}, E); }
               { EpiElem<FMergeB> E{{GATE, XNY}}; gemm_phase<EpiElem<FMergeB>, false>(lds, Gemm{UXY, (const bf16_t*)(ws + O_WOL), Mtail, DM, 512, 1024, 512}, E); } } break;
    case 13: { EpiElem<FResid> E{{X, X, mod + 5 * DM, 1.0f}}; gemm_phase<EpiElem<FResid>, false>(lds, Gemm{XNY, (const bf16_t*)(ws + O_WOUT), Mtail, DM, DM, DM, DM}, E); } break;
    case 14: phase_norm<false>(p, l, 6, Mtail); break;
    case 15: { EpiPair<FSwiglu> E{{H}}; gemm_phase<EpiPair<FSwiglu>, false>(lds, Gemm{XNY, (const bf16_t*)(ws + O_WFF2IN), Mtail, 2 * DFF, DM, DM, DM}, E); } break;
    case 16: { EpiElem<FResid> E{{X, last ? p.out : X, mod + 8 * DM, 0.5f}}; gemm_phase<EpiElem<FResid>, false>(lds, Gemm{H, (const bf16_t*)(ws + O_WFF2OUT), Mtail, DM, DFF, DFF, DFF}, E); } break;
    }
}

__global__ void __launch_bounds__(512) mega(Params p) {
    extern __shared__ __attribute__((aligned(16))) unsigned char smem[];
    cg::grid_group grid = cg::this_grid();
    for (int ph = p.ph_lo; ph < p.ph_hi; ++ph) {
        run_phase(p, ph, smem);
        if (p.coop && ph + 1 < p.ph_hi) grid.sync();
    }
}

extern "C" void kernel_launch(void* const* d_in, const int* in_sizes, int n_in, void* d_out, int out_size, void* d_ws, size_t ws_size, hipStream_t stream) {
    static int grid = 0;
    if (grid == 0) {
        if (n_in != 27 || ws_size < WS_END) { fprintf(stderr, "kernel_launch: need 27 inputs and %zu bytes of workspace; got %d, %zu\n", (size_t)WS_END, n_in, ws_size); grid = -1; return; }
        int dev = 0, cus = 0, per_cu = 0;
        hipGetDevice(&dev); hipDeviceGetAttribute(&cus, hipDeviceAttributeMultiprocessorCount, dev);
        if (hipFuncSetAttribute((const void*)mega, hipFuncAttributeMaxDynamicSharedMemorySize, LDS_BYTES) != hipSuccess) { fprintf(stderr, "kernel_launch: hipFuncSetAttribute failed\n"); grid = -1; return; }
        if (hipOccupancyMaxActiveBlocksPerMultiprocessor(&per_cu, (const void*)mega, 512, LDS_BYTES) != hipSuccess || per_cu < 1) { fprintf(stderr, "kernel_launch: occupancy query gave %d\n", per_cu); per_cu = 1; }
        (void)hipGetLastError();
        grid = cus;
    }
    if (grid < 0) return;
    Params p{};
    const float** pp = (const float**)&p;
    for (int i = 0; i < 27; ++i) pp[i] = (const float*)d_in[i];
    p.out = (float*)d_out; p.ws = (unsigned char*)d_ws; p.ph_lo = 0; p.ph_hi = N_PHASES; p.coop = 1; p.pad = 0;
    void* args[] = {&p};
    hipError_t e = hipLaunchCooperativeKernel((const void*)mega, dim3(grid), dim3(512), args, LDS_BYTES, stream);
    if (e != hipSuccess) {
        fprintf(stderr, "cooperative launch failed: %s (grid %d); falling back to one launch per phase\n", hipGetErrorString(e), grid);
        (void)hipGetLastError();
        p.coop = 0;
        for (int ph = 0; ph < N_PHASES; ++ph) { p.ph_lo = ph; p.ph_hi = ph + 1; hipLaunchKernelGGL(mega, dim3(grid), dim3(512), LDS_BYTES, stream, p); }
    }
}
```

```cpp
#include <hip/hip_runtime.h>
#include <hip/hip_cooperative_groups.h>
#include <cstdio>
namespace cg = cooperative_groups;

#define DI __device__ __forceinline__
#define LAS __attribute__((address_space(3)))
typedef unsigned short bf16_t;
typedef short bf16x8 __attribute__((ext_vector_type(8)));
typedef float f32x2 __attribute__((ext_vector_type(2)));
typedef float f32x4 __attribute__((ext_vector_type(4)));
typedef float f32x16 __attribute__((ext_vector_type(16)));
typedef unsigned u32x2 __attribute__((ext_vector_type(2)));
typedef unsigned u32x4 __attribute__((ext_vector_type(4)));
typedef __bf16 bfv2 __attribute__((ext_vector_type(2)));

constexpr int DM = 1024, NB = 4, SEQ = 8192, CTXL = 256, DEPTH = 4;
constexpr int ML = NB * SEQ, MC = NB * CTXL, MA = ML + MC;
constexpr int DFF = 2816, NH = 8, TK = SEQ + CTXL;
constexpr int NIN = 3840;
constexpr int NMOD = 9 * DM;
constexpr float EPS = 1e-6f;
constexpr float QSCALE = 0.10206207261596577f * 1.4426950408889634f;
constexpr int NCH = 132;

constexpr size_t SZ_FFIN = (size_t)2 * DFF * DM * 2, SZ_FFOUT = (size_t)DM * DFF * 2;
constexpr size_t O_WFF1IN = 0;
constexpr size_t O_WFF1OUT = O_WFF1IN + SZ_FFIN;
constexpr size_t O_WFF2IN = O_WFF1OUT + SZ_FFOUT;
constexpr size_t O_WFF2OUT = O_WFF2IN + SZ_FFIN;
constexpr size_t O_WIN = O_WFF2OUT + SZ_FFOUT;
constexpr size_t O_WUQ = O_WIN + (size_t)NIN * DM * 2;
constexpr size_t O_WUKV = O_WUQ + (size_t)768 * 384 * 2;
constexpr size_t O_WOA = O_WUKV + (size_t)1024 * 256 * 2;
constexpr size_t O_WOL = O_WOA + (size_t)1024 * 512 * 2;
constexpr size_t O_WOUT = O_WOL + (size_t)1024 * 512 * 2;
constexpr size_t O_WGATE = O_WOUT + (size_t)1024 * 1024 * 2;
constexpr size_t O_MOD = O_WGATE + (size_t)2048 * 256 * 2;
constexpr size_t O_RSQ = O_MOD + (size_t)DEPTH * 5 * NMOD * 4;
constexpr size_t O_RSKV = O_RSQ + (size_t)MA * 4;
constexpr size_t O_AGG = O_RSKV + (size_t)MA * 4;
constexpr size_t O_SP = O_AGG + (size_t)2 * NB * NCH * 512 * 8;
constexpr size_t O_BAR = O_SP + 4096;
constexpr size_t O_SS = O_BAR + 16384;
constexpr size_t O_SHW = O_SS + (size_t)3 * MA * 16 * 4;
constexpr size_t O_X = O_SHW + (size_t)3 * 5 * 5632 * 4;
constexpr size_t O_R1 = O_X + (size_t)MA * DM * 4;
constexpr size_t O_UXY = O_R1 + (size_t)MA * DFF * 2;
constexpr size_t O_XNY = O_UXY + (size_t)MA * 1024 * 2;
constexpr size_t O_S = O_XNY + (size_t)MA * 1024 * 2;
constexpr size_t WS_END = O_S + (size_t)MA * 1024 * 4;
constexpr int LDS_BYTES = 131072;

struct Params {
    const float *x, *c, *ctx, *c_ctx, *w_ada, *b_ada, *ff1_w_in, *ff1_w_out, *ff2_w_in, *ff2_w_out, *w_in, *q_a_norm, *w_uq, *kv_a_norm, *w_ukv, *q_norm, *k_norm,
        *conv_w, *conv_b, *lru_lambda, *w_rgate, *b_rgate, *w_igate, *b_igate, *w_o_attn, *w_o_lru, *w_out;
    float* out; unsigned char* ws;
    int ph_lo, ph_hi, coop, pad;
};

DI int tidx_() { int t = threadIdx.x; asm volatile("" : "+v"(t)); return t; }
DI int bidx_() { int t = blockIdx.x; asm volatile("" : "+s"(t)); return t; }
#define TIDX tidx_()
#define BIDX bidx_()
DI unsigned pk2(float lo, float hi) { f32x2 v = {lo, hi}; bfv2 r = __builtin_convertvector(v, bfv2); return __builtin_bit_cast(unsigned, r); }
DI bf16_t f2bf(float x) { return (bf16_t)(pk2(x, 0.f) & 0xffffu); }
DI float bf2f(bf16_t v) { return __uint_as_float((unsigned)v << 16); }
DI float bflo(unsigned v) { return __uint_as_float(v << 16); }
DI float bfhi(unsigned v) { return __uint_as_float(v & 0xffff0000u); }
DI float wave_sum(float v) {
#pragma unroll
    for (int o = 1; o < 64; o <<= 1) v += __shfl_xor(v, o);
    return v;
}
DI float sigmoidf_(float x) { return __builtin_amdgcn_rcpf(1.f + __expf(-x)); }
DI int mod_row(int row) { return row < ML ? (row >> 13) : 4; }
DI float row_rstd(const float* SSP, int row) {
    const f32x4* q = (const f32x4*)(SSP + (size_t)row * 16); const f32x4 a = q[0], b = q[1], c = q[2], d = q[3];
    const float s = ((a[0] + a[1]) + (a[2] + a[3])) + ((b[0] + b[1]) + (b[2] + b[3])) + ((c[0] + c[1]) + (c[2] + c[3])) + ((d[0] + d[1]) + (d[2] + d[3]));
    return __builtin_amdgcn_rsqf(s * (1.f / DM) + EPS);
}

constexpr int BM = 256, BK = 64, HALF = 128, HTB = HALF * BK * 2, NXCD = 8, WGM = 8;
DI int lds_byte(int r, int c) { const int st = (r >> 4) * 2 + (c >> 5), rr = r & 15, cc = c & 31, ob = rr * 64 + cc * 2; return st * 1024 + (ob ^ (((ob >> 9) & 1) << 5)); }
DI void stage_rc(int b, int& R, int& C) { const int st = b / 1024, sb = b % 1024, swz = sb ^ (((sb >> 9) & 1) << 5); R = (st >> 1) * 16 + swz / 64; C = (st & 1) * 32 + (swz % 64) / 2; }
struct Unit { int pm, pn; };
struct Gemm { const bf16_t* A; const bf16_t* Bt; int M, N, K, lda, ldb; };
struct StaticOrder {
    int nM, nN, nwg, G, c;
    DI void init(int M, int N, int G_, int c_) { nM = M / BM; nN = N / BM; nwg = nM * nN; G = G_; c = c_; }
    DI bool next(int i, Unit& u) const {
        const long L = (long)i * G + c; if (L >= nwg) return false;
        int wgid = (int)L; { const int q = nwg / NXCD, r = nwg % NXCD, xcd = wgid % NXCD, off = wgid / NXCD; wgid = (xcd < r ? xcd * (q + 1) : r * (q + 1) + (xcd - r) * q) + off; }
        const int nig = WGM * nN, gid = wgid / nig, fm = gid * WGM, gsz = (nM - fm) < WGM ? (nM - fm) : WGM;
        u.pm = fm + ((wgid % nig) % gsz); u.pn = (wgid % nig) / gsz; return true;
    }
};

DI int perm32(int rho) { const int n = rho >> 4, i = rho & 15; return 8 * (i >> 2) + 4 * n + (i & 3); }
template <class Epi, bool GATE_A, bool PERM = false>
DI void gemm_phase(LAS unsigned char* lds, const Gemm g, const Epi& E) {
    const int tid = TIDX, wid = __builtin_amdgcn_readfirstlane(tid >> 6), lane = tid & 63, wr = wid >> 2, wc = wid & 3, fr = lane & 15, fq = lane >> 4;
    const int K = g.K, nt = K / BK;
    StaticOrder S; S.init(g.M, g.N, gridDim.x, BIDX);
    unsigned voffA[2], voffB[2];
#pragma unroll
    for (int i = 0; i < 2; ++i) { int R, C; stage_rc(tid * 16 + i * 8192, R, C); const int Rb = PERM ? ((R & ~31) + perm32(R & 31)) : R; voffA[i] = (unsigned)(R * g.lda + C) * 2u; voffB[i] = (unsigned)(Rb * g.ldb + C) * 2u; }
#pragma unroll
    for (int i = 0; i < 2; ++i) { asm volatile("" : "+v"(voffA[i])); asm volatile("" : "+v"(voffB[i])); }
    const size_t kstep = (size_t)(BK * 2);
    const size_t hstepA = (size_t)HALF * g.lda * 2, hstepB = (size_t)HALF * g.ldb * 2;
    const size_t tstepA = 2 * hstepA, tstepB = 2 * hstepB;
    const unsigned ldsw = (unsigned)wid * 1024u;
    const int aoff = lds_byte(wr * 64 + fr, fq * 8), boff = lds_byte(wc * 32 + fr, fq * 8);
#define PG8_SA(b, h) (((b) * 2 + (h)) * HTB)
#define PG8_SB(b, h) ((4 + (b) * 2 + (h)) * HTB)
#define PG8_STAGE(bufoff, gbase, voff) do { _Pragma("unroll") for (int _i = 0; _i < 2; ++_i) \
        __builtin_amdgcn_global_load_lds((const unsigned*)((const char*)(gbase) + (voff)[_i]), (LAS unsigned*)(lds + (bufoff) + ldsw + _i * 8192), 16, 0, 0); } while (0)
#define PG8_LDA(dst, b, h) do { _Pragma("unroll") for (int m = 0; m < 4; ++m) _Pragma("unroll") for (int k = 0; k < 2; ++k) dst[m][k] = *(const LAS bf16x8*)(lds + PG8_SA(b, h) + aoff + m * 2048 + k * 1024); } while (0)
#define PG8_LDB(dst, b, h) do { _Pragma("unroll") for (int n = 0; n < 2; ++n) _Pragma("unroll") for (int k = 0; k < 2; ++k) dst[n][k] = *(const LAS bf16x8*)(lds + PG8_SB(b, h) + boff + n * 2048 + k * 1024); } while (0)
#define PG8_MMA(ai, bj, At, Bt) do { __builtin_amdgcn_s_setprio(1); _Pragma("unroll") for (int m = 0; m < 4; ++m) _Pragma("unroll") for (int n = 0; n < 2; ++n) _Pragma("unroll") for (int k = 0; k < 2; ++k) \
        acc[ai][bj][m][n] = __builtin_amdgcn_mfma_f32_16x16x32_bf16(Bt[n][k], At[m][k], acc[ai][bj][m][n], 0, 0, 0); __builtin_amdgcn_s_setprio(0); } while (0)
#define PG8_WAIT_V(n) asm volatile("s_waitcnt vmcnt(" #n ")" ::: "memory")
#define PG8_WAIT_L(n) asm volatile("s_waitcnt lgkmcnt(" #n ")" ::: "memory")
#define PG8_BAR __builtin_amdgcn_s_barrier()
#define PG8_SCHED __builtin_amdgcn_sched_barrier(0)
#define PG8_ABASE(u) ((const char*)g.A + (size_t)(u).pm * tstepA + (GATE_A ? (size_t)((((u).pn & 3) >> 1) * 512) : (size_t)0))
    Unit cur, nxt; int ui = 0;
    if (!S.next(0, cur)) return;
    f32x4 acc[2][2][4][2];
#pragma unroll
    for (int a = 0; a < 2; ++a)
#pragma unroll
        for (int b = 0; b < 2; ++b)
#pragma unroll
            for (int m = 0; m < 4; ++m)
#pragma unroll
                for (int n = 0; n < 2; ++n) acc[a][b][m][n] = (f32x4){0.f, 0.f, 0.f, 0.f};
    bf16x8 At[4][2], B0[2][2], B1[2][2];
    const char* cA = PG8_ABASE(cur); const char* cB = (const char*)g.Bt + (size_t)cur.pn * tstepB;
    PG8_STAGE(PG8_SB(0, 0), cB, voffB); PG8_STAGE(PG8_SA(0, 0), cA, voffA); PG8_STAGE(PG8_SB(0, 1), cB + hstepB, voffB); PG8_STAGE(PG8_SA(0, 1), cA + hstepA, voffA);
    if (wr == 1) PG8_BAR;
    PG8_WAIT_V(4); PG8_BAR;
    PG8_STAGE(PG8_SB(1, 0), cB + kstep, voffB); PG8_STAGE(PG8_SA(1, 0), cA + kstep, voffA); PG8_STAGE(PG8_SB(1, 1), cB + hstepB + kstep, voffB);
    PG8_WAIT_V(6); PG8_BAR;
    for (;;) {
        const bool has_next = S.next(ui + 1, nxt);
        const char* nA = has_next ? PG8_ABASE(nxt) : cA; const char* nB = has_next ? (const char*)g.Bt + (size_t)nxt.pn * tstepB : cB;
#pragma nounroll
        for (int t = 0; t < nt; t += 2) {
            const bool last = (t == nt - 2);
            const char* a1 = cA + (size_t)(t + 1) * kstep;
            const char* a2 = last ? nA : cA + (size_t)(t + 2) * kstep; const char* b2 = last ? nB : cB + (size_t)(t + 2) * kstep;
            const char* a3 = a2 + kstep; const char* b3 = b2 + kstep;
            PG8_LDB(B0, 0, 0); PG8_SCHED; PG8_LDA(At, 0, 0); PG8_STAGE(PG8_SA(1, 1), a1 + hstepA, voffA);
            PG8_WAIT_L(8); PG8_BAR; PG8_WAIT_L(0); PG8_MMA(0, 0, At, B0); PG8_BAR; PG8_SCHED;
            PG8_LDB(B1, 0, 1); PG8_STAGE(PG8_SB(0, 0), b2, voffB);
            PG8_BAR; PG8_WAIT_L(0); PG8_MMA(0, 1, At, B1); PG8_BAR;
            PG8_LDA(At, 0, 1); PG8_STAGE(PG8_SA(0, 0), a2, voffA);
            PG8_BAR; PG8_WAIT_L(0); PG8_MMA(1, 0, At, B0); PG8_BAR; PG8_SCHED;
            PG8_STAGE(PG8_SB(0, 1), b2 + hstepB, voffB);
            PG8_WAIT_V(6); PG8_BAR; PG8_MMA(1, 1, At, B1); PG8_BAR;
            PG8_LDB(B0, 1, 0); PG8_SCHED; PG8_LDA(At, 1, 0); PG8_STAGE(PG8_SA(0, 1), a2 + hstepA, voffA);
            PG8_WAIT_L(8); PG8_BAR; PG8_WAIT_L(0); PG8_MMA(0, 0, At, B0); PG8_BAR; PG8_SCHED;
            PG8_LDB(B1, 1, 1); PG8_STAGE(PG8_SB(1, 0), b3, voffB);
            PG8_BAR; PG8_WAIT_L(0); PG8_MMA(0, 1, At, B1); PG8_BAR;
            PG8_LDA(At, 1, 1); PG8_STAGE(PG8_SA(1, 0), a3, voffA);
            PG8_BAR; PG8_WAIT_L(0); PG8_MMA(1, 0, At, B0); PG8_BAR; PG8_SCHED;
            PG8_STAGE(PG8_SB(1, 1), b3 + hstepB, voffB);
            PG8_WAIT_V(6); PG8_BAR; PG8_MMA(1, 1, At, B1); PG8_BAR;
        }
        E(acc, cur, wr, wc, fr, fq);
        if (!has_next) break;
#pragma unroll
        for (int a = 0; a < 2; ++a)
#pragma unroll
            for (int b = 0; b < 2; ++b)
#pragma unroll
                for (int m = 0; m < 4; ++m)
#pragma unroll
                    for (int n = 0; n < 2; ++n) acc[a][b][m][n] = (f32x4){0.f, 0.f, 0.f, 0.f};
        cur = nxt; cA = nA; cB = nB; ++ui;
    }
    PG8_WAIT_V(0);
    if (wr == 0) PG8_BAR;
    PG8_BAR;
#undef PG8_SA
#undef PG8_SB
#undef PG8_STAGE
#undef PG8_LDA
#undef PG8_LDB
#undef PG8_MMA
#undef PG8_WAIT_V
#undef PG8_WAIT_L
#undef PG8_BAR
#undef PG8_SCHED
#undef PG8_ABASE
}

template <class F> struct EpiElem {
    F f;
    DI void operator()(const f32x4 (&acc)[2][2][4][2], const Unit& u, int wr, int wc, int fr, int fq) const {
        const int row0 = u.pm * BM + wr * 64 + fr, col0 = u.pn * BM + wc * 32 + 4 * fq;
#pragma unroll
        for (int ai = 0; ai < 2; ++ai)
#pragma unroll
            for (int m = 0; m < 4; ++m)
#pragma unroll
                for (int bj = 0; bj < 2; ++bj)
#pragma unroll
                    for (int n = 0; n < 2; ++n) { f(row0 + ai * HALF + m * 16, col0 + bj * HALF + n * 16, acc[ai][bj][m][n]); }
    }
};
template <class F> struct EpiElemRow {
    F f;
    DI void operator()(const f32x4 (&acc)[2][2][4][2], const Unit& u, int wr, int wc, int fr, int fq) const {
        const int row0 = u.pm * BM + wr * 64 + fr, col0 = u.pn * BM + wc * 32 + 4 * fq;
#pragma unroll
        for (int ai = 0; ai < 2; ++ai)
#pragma unroll
            for (int m = 0; m < 4; ++m) {
                float ssq = 0.f;
#pragma unroll
                for (int bj = 0; bj < 2; ++bj)
#pragma unroll
                    for (int n = 0; n < 2; ++n) { ssq += f(row0 + ai * HALF + m * 16, col0 + bj * HALF + n * 16, acc[ai][bj][m][n]); }
                ssq += __shfl_xor(ssq, 16); ssq += __shfl_xor(ssq, 32);
                if (fq == 0) f.row(row0 + ai * HALF + m * 16, (u.pn & 3) * 4 + wc, ssq);
            }
    }
};
template <class F> struct EpiElemRS {
    F f;
    DI void operator()(const f32x4 (&acc)[2][2][4][2], const Unit& u, int wr, int wc, int fr, int fq) const {
        const int row0 = u.pm * BM + wr * 64 + fr, col0 = u.pn * BM + wc * 32 + 4 * fq;
#pragma unroll
        for (int ai = 0; ai < 2; ++ai)
#pragma unroll
            for (int m = 0; m < 4; ++m) {
                const float rs = f.rs(row0 + ai * HALF + m * 16);
#pragma unroll
                for (int bj = 0; bj < 2; ++bj)
#pragma unroll
                    for (int n = 0; n < 2; ++n) { f(row0 + ai * HALF + m * 16, col0 + bj * HALF + n * 16, acc[ai][bj][m][n], rs); }
            }
    }
};
template <class F> struct EpiPairRS {
    F f;
    DI void operator()(const f32x4 (&acc)[2][2][4][2], const Unit& u, int wr, int wc, int fr, int fq) const {
        const int row0 = u.pm * BM + wr * 64 + fr, c0 = wc * 32 + 4 * fq;
#pragma unroll
        for (int ai = 0; ai < 2; ++ai)
#pragma unroll
            for (int m = 0; m < 4; ++m) {
                const float rs = f.rs(row0 + ai * HALF + m * 16);
#pragma unroll
                for (int n = 0; n < 2; ++n) { f(row0 + ai * HALF + m * 16, u.pn, c0 + n * 16, acc[ai][0][m][n], acc[ai][1][m][n], rs); }
            }
    }
};
template <class F> struct EpiElem2 {
    F f;
    DI void operator()(const f32x4 (&acc)[2][2][4][2], const Unit& u, int wr, int wc, int fr, int fq) const {
        const int row0 = u.pm * BM + wr * 64 + fr, col0 = u.pn * BM + wc * 32 + 4 * fq;
        typename F::L cur[2][2], nxt[2][2];
#pragma unroll
        for (int bj = 0; bj < 2; ++bj)
#pragma unroll
            for (int n = 0; n < 2; ++n) cur[bj][n] = f.load(row0, col0 + bj * HALF + n * 16);
#pragma unroll
        for (int i = 0; i < 8; ++i) {
            const int row = row0 + (i >> 2) * HALF + (i & 3) * 16;
            if (i < 7) { const int rown = row0 + ((i + 1) >> 2) * HALF + ((i + 1) & 3) * 16;
#pragma unroll
                for (int bj = 0; bj < 2; ++bj)
#pragma unroll
                    for (int n = 0; n < 2; ++n) nxt[bj][n] = f.load(rown, col0 + bj * HALF + n * 16); }
#pragma unroll
            for (int bj = 0; bj < 2; ++bj)
#pragma unroll
                for (int n = 0; n < 2; ++n) f.apply(row, col0 + bj * HALF + n * 16, acc[i >> 2][bj][i & 3][n], cur[bj][n]);
#pragma unroll
            for (int bj = 0; bj < 2; ++bj)
#pragma unroll
                for (int n = 0; n < 2; ++n) cur[bj][n] = nxt[bj][n];
        }
    }
};
template <class F> struct EpiElem8 {
    F f;
    DI void operator()(const f32x4 (&acc)[2][2][4][2], const Unit& u, int wr, int wc, int fr, int fq) const {
        const int row0 = u.pm * BM + wr * 64 + fr, col0 = u.pn * BM + wc * 32 + 8 * fq;
        typename F::L cur[2], nxt[2];
#pragma unroll
        for (int bj = 0; bj < 2; ++bj) cur[bj] = f.load(row0, col0 + bj * HALF);
#pragma unroll
        for (int i = 0; i < 8; ++i) {
            const int row = row0 + (i >> 2) * HALF + (i & 3) * 16;
            if (i < 7) { const int rown = row0 + ((i + 1) >> 2) * HALF + ((i + 1) & 3) * 16;
#pragma unroll
                for (int bj = 0; bj < 2; ++bj) nxt[bj] = f.load(rown, col0 + bj * HALF); }
#pragma unroll
            for (int bj = 0; bj < 2; ++bj) f.apply(row, col0 + bj * HALF, acc[i >> 2][bj][i & 3][0], acc[i >> 2][bj][i & 3][1], cur[bj]);
#pragma unroll
            for (int bj = 0; bj < 2; ++bj) cur[bj] = nxt[bj];
        }
    }
};
template <class F> struct EpiPair {
    F f;
    DI void operator()(const f32x4 (&acc)[2][2][4][2], const Unit& u, int wr, int wc, int fr, int fq) const {
        const int row0 = u.pm * BM + wr * 64 + fr, c0 = wc * 32 + 4 * fq;
#pragma unroll
        for (int ai = 0; ai < 2; ++ai)
#pragma unroll
            for (int m = 0; m < 4; ++m)
#pragma unroll
                for (int n = 0; n < 2; ++n) { f(row0 + ai * HALF + m * 16, u.pn, c0 + n * 16, acc[ai][0][m][n], acc[ai][1][m][n]); }
    }
};
DI void st_bf4(bf16_t* p, f32x4 v) { u32x2 o; o.x = pk2(v[0], v[1]); o.y = pk2(v[2], v[3]); *(u32x2*)p = o; }
DI void st_bf8(bf16_t* p, f32x4 lo, f32x4 hi) { u32x4 o; o.x = pk2(lo[0], lo[1]); o.y = pk2(lo[2], lo[3]); o.z = pk2(hi[0], hi[1]); o.w = pk2(hi[2], hi[3]); *(u32x4*)p = o; }

struct FSwiglu { bf16_t* H; const float* SS; const float* shw;
    DI float rs(int row) const { return row_rstd(SS, row); }
    DI void operator()(int row, int pn, int c, f32x4 g, f32x4 u, float rs) const {
        const float* sw = shw + mod_row(row) * 5632 + pn * 256 + c;
        g = g * rs + *(const f32x4*)sw; u = u * rs + *(const f32x4*)(sw + 128);
        f32x4 h;
#pragma unroll
        for (int e = 0; e < 4; ++e) h[e] = g[e] * sigmoidf_(g[e]) * u[e];
        st_bf4(H + (size_t)row * DFF + pn * 128 + c, h);
    } };
struct FResid { const float* src; float* dst; const float* mod; float coef;
    DI void operator()(int row, int col, f32x4 v) const {
        const f32x4 g = *(const f32x4*)(mod + mod_row(row) * NMOD + col);
        const f32x4 x = *(const f32x4*)(src + (size_t)row * DM + col);
        *(f32x4*)(dst + (size_t)row * DM + col) = x + coef * g * v;
    } };
template <int COEF2> struct FResidN { const float* src; float* dst; const float* mod; const float* scn; bf16_t* XS; float* SS;
    DI float operator()(int row, int col, f32x4 v) const {
        const int r = mod_row(row);
        const f32x4 g = *(const f32x4*)(mod + r * NMOD + col);
        const f32x4 x = *(const f32x4*)(src + (size_t)row * DM + col);
        const f32x4 xn = x + (0.5f * COEF2) * g * v;
        *(f32x4*)(dst + (size_t)row * DM + col) = xn;
        const f32x4 sc = *(const f32x4*)(scn + r * NMOD + col);
        st_bf4(XS + (size_t)row * DM + col, xn * (1.f + sc));
        return (xn[0] * xn[0] + xn[1] * xn[1]) + (xn[2] * xn[2] + xn[3] * xn[3]);
    }
    DI void row(int row, int slot, float ssq) const { SS[(size_t)row * 16 + slot] = ssq; } };
struct FWin { bf16_t *P1, *UXY, *GATE; const float* SS; const float* shw;
    DI float rs(int row) const { return row_rstd(SS, row); }
    DI void operator()(int row, int col, f32x4 v, float rs) const {
        v = v * rs + *(const f32x4*)(shw + mod_row(row) * 5632 + col);
        bf16_t* p = col < 768 ? P1 + (size_t)row * 768 + col : (col < 1792 ? UXY + (size_t)row * 1024 + (col - 768) : GATE + (size_t)row * 2048 + (col - 1792));
        st_bf4(p, v);
    } };
struct FRowScale { bf16_t* dst; int ld; const float* rs;
    typedef float L;
    DI L load(int row, int) const { return rs[row]; }
    DI void apply(int row, int col, f32x4 v0, f32x4 v1, L sc) const { st_bf8(dst + (size_t)row * ld + col, v0 * sc, v1 * sc); } };
struct FVt { bf16_t* Vt; const float* rs;
    struct L { f32x4 a, b; };
    DI L load(int, int col) const { return L{*(const f32x4*)(rs + col), *(const f32x4*)(rs + col + 4)}; }
    DI void apply(int row, int col, f32x4 v0, f32x4 v1, L sc) const {
        int b, kpos; if (col < ML) { b = col >> 13; kpos = col & (SEQ - 1); } else { const int r = col - ML; b = r >> 8; kpos = SEQ + (r & 255); }
        st_bf8(Vt + ((size_t)(b * NH + (row >> 6)) * 64 + (row & 63)) * TK + kpos, v0 * sc.a, v1 * sc.b);
    } };
struct EGate { const bf16_t* xc; bf16_t *OM, *BB; const float *sp8, *br, *bi;
    DI void operator()(const f32x4 (&acc)[2][2][4][2], const Unit& u, int wr, int wc, int fr, int fq) const {
        const int row0 = u.pm * BM + wr * 64 + fr, d = u.pn >> 2, ch0 = (u.pn & 3) * 128 + wc * 32 + 8 * fq;
        f32x4 s4[2], br4[2], bi4[2]; u32x4 xcur, xnxt;
#pragma unroll
        for (int n = 0; n < 2; ++n) { s4[n] = *(const f32x4*)(sp8 + d * 512 + ch0 + 4 * n); br4[n] = *(const f32x4*)(br + d * 512 + ch0 + 4 * n); bi4[n] = *(const f32x4*)(bi + d * 512 + ch0 + 4 * n); }
        xcur = *(const u32x4*)(xc + (size_t)row0 * 512 + ch0);
#pragma unroll
        for (int i = 0; i < 8; ++i) {
            const int row = row0 + (i >> 2) * HALF + (i & 3) * 16;
            if (i < 7) { const int rown = row0 + ((i + 1) >> 2) * HALF + ((i + 1) & 3) * 16; xnxt = *(const u32x4*)(xc + (size_t)rown * 512 + ch0); }
            f32x4 om[2], bb[2];
#pragma unroll
            for (int n = 0; n < 2; ++n) {
                const f32x4 r4 = acc[i >> 2][0][i & 3][n], i4 = acc[i >> 2][1][i & 3][n];
                const unsigned w0 = n == 0 ? xcur.x : xcur.z, w1 = n == 0 ? xcur.y : xcur.w;
                const f32x4 xf = {bflo(w0), bfhi(w0), bflo(w1), bfhi(w1)};
#pragma unroll
                for (int e = 0; e < 4; ++e) {
                    const float r = sigmoidf_(r4[e] + br4[n][e]), ig = sigmoidf_(i4[e] + bi4[n][e]);
                    const float a = __expf(s4[n][e] * r);
                    om[n][e] = 1.f - a; bb[n][e] = __fsqrt_rn(fmaxf(1.f - a * a, 0.f)) * (ig * xf[e]);
                }
            }
            const size_t o = ((size_t)d * MA + row) * 512 + ch0;
            st_bf8(OM + o, om[0], om[1]); st_bf8(BB + o, bb[0], bb[1]);
            xcur = xnxt;
        }
    } };
DI f32x4 sig_lo(u32x4 g) { return (f32x4){sigmoidf_(bflo(g.x)), sigmoidf_(bfhi(g.x)), sigmoidf_(bflo(g.y)), sigmoidf_(bfhi(g.y))}; }
DI f32x4 sig_hi(u32x4 g) { return (f32x4){sigmoidf_(bflo(g.z)), sigmoidf_(bfhi(g.z)), sigmoidf_(bflo(g.w)), sigmoidf_(bfhi(g.w))}; }
struct FMergeA { const bf16_t* GATE; bf16_t* Y;
    typedef u32x4 L;
    DI L load(int row, int col) const { return *(const u32x4*)(GATE + (size_t)row * 2048 + col); }
    DI void apply(int row, int col, f32x4 v0, f32x4 v1, L gv) const { st_bf8(Y + (size_t)row * DM + col, sig_lo(gv) * v0, sig_hi(gv) * v1); } };
struct FMergeB { const bf16_t* GATE; bf16_t* Y;
    struct L { u32x4 g, y; };
    DI L load(int row, int col) const { return L{*(const u32x4*)(GATE + (size_t)row * 2048 + 1024 + col), *(const u32x4*)(Y + (size_t)row * DM + col)}; }
    DI void apply(int row, int col, f32x4 v0, f32x4 v1, L q) const {
        const f32x4 y0 = {bflo(q.y.x), bfhi(q.y.x), bflo(q.y.y), bfhi(q.y.y)}, y1 = {bflo(q.y.z), bfhi(q.y.z), bflo(q.y.w), bfhi(q.y.w)};
        st_bf8(Y + (size_t)row * DM + col, y0 + sig_lo(q.g) * v0, y1 + sig_hi(q.g) * v1);
    } };

struct ESwiglu { bf16_t* H; const float* SS; const float* shw;
    DI void operator()(const f32x4 (&acc)[2][2][4][2], const Unit& u, int wr, int wc, int fr, int fq) const {
        const int row0 = u.pm * BM + wr * 64 + fr, c0 = wc * 32 + 8 * fq;
        const float* sw = shw + mod_row(u.pm * BM) * 5632 + u.pn * 256 + c0;
        f32x4 sg[2], su[2]; float rs[8];
#pragma unroll
        for (int n = 0; n < 2; ++n) { sg[n] = *(const f32x4*)(sw + 4 * n); su[n] = *(const f32x4*)(sw + 128 + 4 * n); }
#pragma unroll
        for (int i = 0; i < 8; ++i) rs[i] = row_rstd(SS, row0 + (i >> 2) * HALF + (i & 3) * 16);
#pragma unroll
        for (int ai = 0; ai < 2; ++ai)
#pragma unroll
            for (int m = 0; m < 4; ++m) {
                f32x4 h[2];
#pragma unroll
                for (int n = 0; n < 2; ++n) {
                    const f32x4 g = acc[ai][0][m][n] * rs[ai * 4 + m] + sg[n], uu = acc[ai][1][m][n] * rs[ai * 4 + m] + su[n];
#pragma unroll
                    for (int e = 0; e < 4; ++e) h[n][e] = g[e] * sigmoidf_(g[e]) * uu[e];
                }
                st_bf8(H + (size_t)(row0 + ai * HALF + m * 16) * DFF + u.pn * 128 + c0, h[0], h[1]);
            }
    } };
struct EWin { bf16_t *P1, *UXY, *GATE; const float* SS; const float* shw;
    template <int LD> DI void body(const f32x4 (&acc)[2][2][4][2], bf16_t* dst, const f32x4 (&sh)[2][2], const float (&rs)[8]) const {
#pragma unroll
        for (int ai = 0; ai < 2; ++ai)
#pragma unroll
            for (int m = 0; m < 4; ++m)
#pragma unroll
                for (int bj = 0; bj < 2; ++bj)
                    st_bf8(dst + (size_t)(ai * HALF + m * 16) * LD + 128 * bj, acc[ai][bj][m][0] * rs[ai * 4 + m] + sh[bj][0], acc[ai][bj][m][1] * rs[ai * 4 + m] + sh[bj][1]);
    }
    DI void operator()(const f32x4 (&acc)[2][2][4][2], const Unit& u, int wr, int wc, int fr, int fq) const {
        const int row0 = u.pm * BM + wr * 64 + fr, c0 = wc * 32 + 8 * fq;
        const float* sw = shw + mod_row(u.pm * BM) * 5632 + u.pn * 256 + c0;
        f32x4 sh[2][2]; float rs[8];
#pragma unroll
        for (int bj = 0; bj < 2; ++bj)
#pragma unroll
            for (int n = 0; n < 2; ++n) sh[bj][n] = *(const f32x4*)(sw + 128 * bj + 4 * n);
#pragma unroll
        for (int i = 0; i < 8; ++i) { rs[i] = row_rstd(SS, row0 + (i >> 2) * HALF + (i & 3) * 16); if ((i & 1) == 1) __builtin_amdgcn_sched_barrier(0); }
        if (u.pn < 3) body<768>(acc, P1 + (size_t)row0 * 768 + u.pn * 256 + c0, sh, rs);
        else if (u.pn < 7) body<1024>(acc, UXY + (size_t)row0 * 1024 + (u.pn - 3) * 256 + c0, sh, rs);
        else body<2048>(acc, GATE + (size_t)row0 * 2048 + (u.pn - 7) * 256 + c0, sh, rs);
    } };
template <int COEF2, bool NORM> struct EResid { const float* src; float* dst; const float* mod; const float* scn; bf16_t* XS; float* SS;
    DI void operator()(const f32x4 (&acc)[2][2][4][2], const Unit& u, int wr, int wc, int fr, int fq) const {
        const int row0 = u.pm * BM + wr * 64 + fr, col0 = u.pn * BM + wc * 32 + 8 * fq, r = mod_row(u.pm * BM);
        f32x4 g[2][2], sc[2][2];
#pragma unroll
        for (int bj = 0; bj < 2; ++bj)
#pragma unroll
            for (int n = 0; n < 2; ++n) { g[bj][n] = *(const f32x4*)(mod + r * NMOD + col0 + 128 * bj + 4 * n) * (0.5f * COEF2);
                if (NORM) sc[bj][n] = *(const f32x4*)(scn + r * NMOD + col0 + 128 * bj + 4 * n) + 1.f; }
        f32x4 xc[2][2], xn_[2][2];
#pragma unroll
        for (int bj = 0; bj < 2; ++bj)
#pragma unroll
            for (int n = 0; n < 2; ++n) xc[bj][n] = *(const f32x4*)(src + (size_t)row0 * DM + col0 + 128 * bj + 4 * n);
#pragma unroll
        for (int i = 0; i < 8; ++i) {
            const int row = row0 + (i >> 2) * HALF + (i & 3) * 16;
            if (i < 7) { const int rown = row0 + ((i + 1) >> 2) * HALF + ((i + 1) & 3) * 16;
#pragma unroll
                for (int bj = 0; bj < 2; ++bj)
#pragma unroll
                    for (int n = 0; n < 2; ++n) xn_[bj][n] = *(const f32x4*)(src + (size_t)rown * DM + col0 + 128 * bj + 4 * n); }
            float ssq = 0.f;
#pragma unroll
            for (int bj = 0; bj < 2; ++bj) {
                f32x4 y[2];
#pragma unroll
                for (int n = 0; n < 2; ++n) {
                    y[n] = xc[bj][n] + g[bj][n] * acc[i >> 2][bj][i & 3][n];
                    *(f32x4*)(dst + (size_t)row * DM + col0 + 128 * bj + 4 * n) = y[n];
                    if (NORM) ssq += (y[n][0] * y[n][0] + y[n][1] * y[n][1]) + (y[n][2] * y[n][2] + y[n][3] * y[n][3]);
                }
                if (NORM) st_bf8(XS + (size_t)row * DM + col0 + 128 * bj, y[0] * sc[bj][0], y[1] * sc[bj][1]);
            }
            if (NORM) { ssq += __shfl_xor(ssq, 16); ssq += __shfl_xor(ssq, 32); if (fq == 0) SS[(size_t)row * 16 + (u.pn & 3) * 4 + wc] = ssq; }
#pragma unroll
            for (int bj = 0; bj < 2; ++bj)
#pragma unroll
                for (int n = 0; n < 2; ++n) xc[bj][n] = xn_[bj][n];
        }
    } };

DI void phase_mod(const Params& p, float* lds) {
    float* sc = lds;
    float* red = lds + 5 * DM;
    const int tid = TIDX, lane = tid & 63, wave = tid >> 6;
    for (int i = tid; i < 5 * DM; i += 512) { const float v = i < 4 * DM ? p.c[i] : p.c_ctx[i - 4 * DM]; sc[i] = v * sigmoidf_(v); }
    __syncthreads();
    float* mod = (float*)(p.ws + O_MOD);
    for (int it = BIDX; it < DEPTH * (NMOD / 64); it += gridDim.x) {
        const int l = it / (NMOD / 64), n = (it % (NMOD / 64)) * 64 + lane;
        const float* w = p.w_ada + ((size_t)l * DM + wave * 128) * NMOD + n;
        float a0 = 0.f, a1 = 0.f, a2 = 0.f, a3 = 0.f, a4 = 0.f;
#pragma unroll 8
        for (int k = 0; k < 128; ++k) { const float wv = w[(size_t)k * NMOD]; const int kk = wave * 128 + k;
            a0 += sc[kk] * wv; a1 += sc[DM + kk] * wv; a2 += sc[2 * DM + kk] * wv; a3 += sc[3 * DM + kk] * wv; a4 += sc[4 * DM + kk] * wv; }
        red[(wave * 5 + 0) * 64 + lane] = a0; red[(wave * 5 + 1) * 64 + lane] = a1; red[(wave * 5 + 2) * 64 + lane] = a2; red[(wave * 5 + 3) * 64 + lane] = a3; red[(wave * 5 + 4) * 64 + lane] = a4;
        __syncthreads();
        if (tid < 320) { const int r = tid >> 6; float s = p.b_ada[(size_t)l * NMOD + n];
#pragma unroll
            for (int w8 = 0; w8 < 8; ++w8) s += red[(w8 * 5 + r) * 64 + lane];
            mod[((size_t)l * 5 + r) * NMOD + n] = s; }
        __syncthreads();
    }
}

template <int MAP> DI int colmap(int n) {
    if (MAP == 0) return n;
    if (MAP == 1) { const int pn = n >> 8, bj = (n >> 7) & 1, c = n & 127; return bj * DFF + pn * 128 + c; }
    if (MAP == 2) return n < 672 ? n : (n < 768 ? -1 : n - 96);
    { const int m = n & 511, h = m >> 6, d = m & 63; return h * 128 + (n >> 9) * 64 + d; }
}
template <int MAP> DI void tjob(const float* src, int ld, int K, int N, bf16_t* dst, const float* kscale, float* tile, int& base, int vbid, int G) {
    const int tid = TIDX, ntn = N / 64, ntiles = ntn * (K / 64);
    int first = (vbid - base % G + G) % G;
    for (int t = first; t < ntiles; t += G) {
        const int n0 = (t % ntn) * 64, k0 = (t / ntn) * 64;
        const int c = colmap<MAP>(n0 + (tid & 63));
#pragma unroll
        for (int i = 0; i < 8; ++i) { const int kk = (tid >> 6) + 8 * i; float v = c >= 0 ? src[(size_t)(k0 + kk) * ld + c] : 0.f; if (kscale) v *= kscale[k0 + kk]; tile[kk * 65 + (tid & 63)] = v; }
        __syncthreads();
        { const int kc = tid & 7, nn = tid >> 3;
          const float* tp = tile + (kc * 8) * 65 + nn;
          u32x4 o; o.x = pk2(tp[0], tp[65]); o.y = pk2(tp[2 * 65], tp[3 * 65]); o.z = pk2(tp[4 * 65], tp[5 * 65]); o.w = pk2(tp[6 * 65], tp[7 * 65]);
          *(u32x4*)(dst + (size_t)(n0 + nn) * K + k0 + kc * 8) = o; }
        __syncthreads();
    }
    base += ntiles;
}
DI void phase_prep_ff(const Params& p, int l, int which, float* tile, int vbid, int vG) {
    unsigned char* ws = p.ws; int base = 0;
    if (which == 0) {
        tjob<1>(p.ff1_w_in + (size_t)l * DM * 2 * DFF, 2 * DFF, DM, 2 * DFF, (bf16_t*)(ws + O_WFF1IN), nullptr, tile, base, vbid, vG);
        tjob<0>(p.ff1_w_out + (size_t)l * DFF * DM, DM, DFF, DM, (bf16_t*)(ws + O_WFF1OUT), nullptr, tile, base, vbid, vG);
    } else {
        tjob<1>(p.ff2_w_in + (size_t)l * DM * 2 * DFF, 2 * DFF, DM, 2 * DFF, (bf16_t*)(ws + O_WFF2IN), nullptr, tile, base, vbid, vG);
        tjob<0>(p.ff2_w_out + (size_t)l * DFF * DM, DM, DFF, DM, (bf16_t*)(ws + O_WFF2OUT), nullptr, tile, base, vbid, vG);
    }
}
DI void phase_prep(const Params& p, int l, float* tile) {
    unsigned char* ws = p.ws; int base = 0;
    const int vbid = BIDX, vG = gridDim.x;
    const float* modl = (const float*)(ws + O_MOD) + (size_t)l * 5 * NMOD; float* shw = (float*)(ws + O_SHW);
    if (l == 0) phase_prep_ff(p, 0, 0, tile, vbid, vG);
    tjob<2>(p.w_in + (size_t)l * DM * 3744, 3744, DM, NIN, (bf16_t*)(ws + O_WIN), nullptr, tile, base, vbid, vG);
    tjob<0>(p.w_uq + (size_t)l * 384 * 768, 768, 384, 768, (bf16_t*)(ws + O_WUQ), p.q_a_norm + l * 384, tile, base, vbid, vG);
    tjob<3>(p.w_ukv + (size_t)l * 256 * 1024, 1024, 256, 1024, (bf16_t*)(ws + O_WUKV), p.kv_a_norm + l * 256, tile, base, vbid, vG);
    tjob<0>(p.w_o_attn + (size_t)l * 512 * 1024, 1024, 512, 1024, (bf16_t*)(ws + O_WOA), nullptr, tile, base, vbid, vG);
    tjob<0>(p.w_o_lru + (size_t)l * 512 * 1024, 1024, 512, 1024, (bf16_t*)(ws + O_WOL), nullptr, tile, base, vbid, vG);
    tjob<0>(p.w_out + (size_t)l * 1024 * 1024, 1024, 1024, 1024, (bf16_t*)(ws + O_WOUT), nullptr, tile, base, vbid, vG);
    { float* sh = tile; float* red = tile + 5 * DM;
      const int tid = TIDX, nn = tid & 63, ks = tid >> 6;
      for (int it = BIDX; it < 88 + 60 + 88; it += gridDim.x) {
          const int m = it < 88 ? 0 : (it < 148 ? 1 : 2), n0 = (m == 0 ? it : (m == 1 ? it - 88 : it - 148)) * 64;
          const float* W = m == 0 ? p.ff1_w_in + (size_t)l * DM * 2 * DFF : (m == 1 ? p.w_in + (size_t)l * DM * 3744 : p.ff2_w_in + (size_t)l * DM * 2 * DFF);
          const int ld = m == 1 ? 3744 : 2 * DFF, c = m == 1 ? colmap<2>(n0 + nn) : colmap<1>(n0 + nn);
          __syncthreads();
          for (int i = tid; i < 5 * DM; i += 512) sh[i] = modl[(size_t)(i >> 10) * NMOD + m * 3 * DM + (i & 1023)];
          __syncthreads();
          float a0 = 0.f, a1 = 0.f, a2 = 0.f, a3 = 0.f, a4 = 0.f;
          if (c >= 0) {
#pragma unroll 8
              for (int k = ks * 128; k < ks * 128 + 128; ++k) { const float wv = W[(size_t)k * ld + c]; a0 += sh[k] * wv; a1 += sh[DM + k] * wv; a2 += sh[2 * DM + k] * wv; a3 += sh[3 * DM + k] * wv; a4 += sh[4 * DM + k] * wv; }
          }
          red[(ks * 5 + 0) * 64 + nn] = a0; red[(ks * 5 + 1) * 64 + nn] = a1; red[(ks * 5 + 2) * 64 + nn] = a2; red[(ks * 5 + 3) * 64 + nn] = a3; red[(ks * 5 + 4) * 64 + nn] = a4;
          __syncthreads();
          if (tid < 320) { const int r = tid >> 6; float sum = 0.f;
#pragma unroll
              for (int w8 = 0; w8 < 8; ++w8) sum += red[(w8 * 5 + r) * 64 + nn];
              shw[(size_t)(m * 5 + r) * 5632 + n0 + nn] = sum; }
      }
      __syncthreads(); }
    if (BIDX == 0) { float* sp8 = (float*)(ws + O_SP);
        for (int i = TIDX; i < 1024; i += 512) { const float nl = -p.lru_lambda[l * 1024 + i]; sp8[i] = -8.f * (fmaxf(nl, 0.f) + log1pf(__expf(-fabsf(nl)))); } }
    bf16_t* wg = (bf16_t*)(ws + O_WGATE);
    for (int idx = BIDX * 512 + TIDX; idx < 2048 * 256; idx += gridDim.x * 512) {
        const int n = idx >> 8, k = idx & 255, d = n >> 10, cb = (n >> 8) & 3, gt = (n >> 7) & 1, c = n & 127, ch = cb * 128 + c, g = ch >> 6, j = ch & 63, ci = 256 * (cb >> 1) + k, gi = ci >> 6, i = ci & 63;
        float v = 0.f;
        if (gi == g) v = (gt ? p.w_igate : p.w_rgate)[((((size_t)l * 2 + d) * 8 + g) * 64 + i) * 64 + j];
        wg[idx] = f2bf(v);
    }
}

DI void phase_norm0(const Params& p) {
    const int tid = TIDX, lane = tid & 63, gw = BIDX * 8 + (tid >> 6), nw = gridDim.x * 8;
    float* X = (float*)(p.ws + O_X); bf16_t* XS = (bf16_t*)(p.ws + O_XNY); float* SS = (float*)(p.ws + O_SS);
    const float* mod = (const float*)(p.ws + O_MOD);
    for (int row = gw; row < MA; row += nw) {
        const float* src = row < ML ? p.x + (size_t)row * DM : p.ctx + (size_t)(row - ML) * DM;
        f32x4 v[4]; float s = 0.f;
#pragma unroll
        for (int j = 0; j < 4; ++j) { v[j] = *(const f32x4*)(src + 256 * j + 4 * lane); s += (v[j][0] * v[j][0] + v[j][1] * v[j][1]) + (v[j][2] * v[j][2] + v[j][3] * v[j][3]); }
        s = wave_sum(s);
        if (lane < 16) SS[(size_t)row * 16 + lane] = lane == 0 ? s : 0.f;
        const float* mr = mod + (size_t)mod_row(row) * NMOD;
#pragma unroll
        for (int j = 0; j < 4; ++j) {
            const int col = 256 * j + 4 * lane;
            *(f32x4*)(X + (size_t)row * DM + col) = v[j];
            const f32x4 sc = *(const f32x4*)(mr + DM + col);
            st_bf4(XS + (size_t)row * DM + col, v[j] * (1.f + sc));
        }
    }
}

DI void phase_conv(const Params& p, int l) {
    const bf16_t* UXY = (const bf16_t*)(p.ws + O_UXY); const bf16_t* P1 = (const bf16_t*)(p.ws + O_R1);
    bf16_t* xc = (bf16_t*)(p.ws + O_XNY);
    const float* cw = p.conv_w + (size_t)l * 4 * 512; const float* cb = p.conv_b + (size_t)l * 512;
    for (int e = BIDX * 512 + TIDX; e < MA * 64; e += gridDim.x * 512) {
        const int row = e >> 6, ch = (e & 63) * 8;
        int t, T; if (row < ML) { t = row & (SEQ - 1); T = SEQ; } else { t = (row - ML) & 255; T = CTXL; }
        float y[8];
#pragma unroll
        for (int i = 0; i < 8; ++i) y[i] = cb[ch + i];
#pragma unroll
        for (int k = 0; k < 4; ++k) {
            const int tt = t + k - 2;
            if (tt >= 0 && tt < T) {
                const u32x4 uv = *(const u32x4*)(UXY + (size_t)(row + k - 2) * 1024 + ch);
                const f32x4 w0 = *(const f32x4*)(cw + k * 512 + ch), w1 = *(const f32x4*)(cw + k * 512 + ch + 4);
                y[0] += w0[0] * bflo(uv.x); y[1] += w0[1] * bfhi(uv.x); y[2] += w0[2] * bflo(uv.y); y[3] += w0[3] * bfhi(uv.y);
                y[4] += w1[0] * bflo(uv.z); y[5] += w1[1] * bfhi(uv.z); y[6] += w1[2] * bflo(uv.w); y[7] += w1[3] * bfhi(uv.w);
            }
        }
        u32x4 o; o.x = pk2(y[0], y[1]); o.y = pk2(y[2], y[3]); o.z = pk2(y[4], y[5]); o.w = pk2(y[6], y[7]);
        *(u32x4*)(xc + (size_t)row * 512 + ch) = o;
    }
    float* rsq = (float*)(p.ws + O_RSQ); float* rskv = (float*)(p.ws + O_RSKV);
    const int tid2 = TIDX, l16 = tid2 & 15, gq = BIDX * 32 + (tid2 >> 4), nq = gridDim.x * 32;
    for (int row = gq; row < MA; row += nq) {
        const bf16_t* pr = P1 + (size_t)row * 768;
        u32x4 v[5];
#pragma unroll
        for (int i = 0; i < 5; ++i) v[i] = *(const u32x4*)(pr + (l16 + 16 * i) * 8);
        float sq = 0.f, skv = 0.f;
#pragma unroll
        for (int i = 0; i < 5; ++i) {
            const float s2 = bflo(v[i].x) * bflo(v[i].x) + bfhi(v[i].x) * bfhi(v[i].x) + bflo(v[i].y) * bflo(v[i].y) + bfhi(v[i].y) * bfhi(v[i].y)
                           + bflo(v[i].z) * bflo(v[i].z) + bfhi(v[i].z) * bfhi(v[i].z) + bflo(v[i].w) * bflo(v[i].w) + bfhi(v[i].w) * bfhi(v[i].w);
            if (i < 3) sq += s2; else skv += s2;
        }
#pragma unroll
        for (int o = 1; o < 16; o <<= 1) { sq += __shfl_xor(sq, o); skv += __shfl_xor(skv, o); }
        if (l16 == 0) { rsq[row] = rsqrtf(sq * (1.f / 384.f) + EPS); rskv[row] = rsqrtf(skv * (1.f / 256.f) + EPS); }
    }
}

DI int chunk_row0(int b, int pch) { return pch < 4 ? ML + b * CTXL + pch * 64 : b * SEQ + (pch - 4) * 64; }
DI void phase_scan_agg(const Params& p) {
    const bf16_t* OM = (const bf16_t*)(p.ws + O_S); const bf16_t* BB = OM + (size_t)2 * MA * 512;
    f32x4* agg = (f32x4*)(p.ws + O_AGG);
    const int tid = TIDX, lane = tid & 63, gw = (tid >> 6) * gridDim.x + BIDX, nw = gridDim.x * 8;
    for (int it = gw; it < 2 * NB * NCH; it += nw) {
        const int d = it & 1, bp = it >> 1, b = bp / NCH, pch = bp % NCH, row0 = chunk_row0(b, pch);
        const bf16_t* om = OM + ((size_t)d * MA + row0) * 512 + lane * 8; const bf16_t* bb = BB + ((size_t)d * MA + row0) * 512 + lane * 8;
        float h[8], A[8];
#pragma unroll
        for (int i = 0; i < 8; ++i) { h[i] = 0.f; A[i] = 1.f; }
#pragma unroll 8
        for (int t = 0; t < 64; ++t) {
            const int tt = d ? 63 - t : t;
            const u32x4 ov = *(const u32x4*)(om + (size_t)tt * 512), bv = *(const u32x4*)(bb + (size_t)tt * 512);
            const float a[8] = {1.f - bflo(ov.x), 1.f - bfhi(ov.x), 1.f - bflo(ov.y), 1.f - bfhi(ov.y), 1.f - bflo(ov.z), 1.f - bfhi(ov.z), 1.f - bflo(ov.w), 1.f - bfhi(ov.w)};
            const float bq[8] = {bflo(bv.x), bfhi(bv.x), bflo(bv.y), bfhi(bv.y), bflo(bv.z), bfhi(bv.z), bflo(bv.w), bfhi(bv.w)};
#pragma unroll
            for (int i = 0; i < 8; ++i) { h[i] = a[i] * h[i] + bq[i]; A[i] *= a[i]; }
        }
        f32x4* dst = agg + (((size_t)(d * NB + b) * NCH + pch) * 512 + lane * 8) / 2;
#pragma unroll
        for (int i = 0; i < 4; ++i) dst[i] = (f32x4){A[2 * i], h[2 * i], A[2 * i + 1], h[2 * i + 1]};
    }
}
DI float gelu_tanh(float x) { const float u = 0.7978845608028654f * (x + 0.044715f * x * x * x); const float e = __expf(2.f * u); const float th = 1.f - 2.f * __builtin_amdgcn_rcpf(e + 1.f); return 0.5f * x * (1.f + th); }
DI void agg_step(const f32x4* e, float (&h)[8]) {
    const f32x4 e0 = e[0], e1 = e[1], e2 = e[2], e3 = e[3];
    h[0] = e0[0] * h[0] + e0[1]; h[1] = e0[2] * h[1] + e0[3]; h[2] = e1[0] * h[2] + e1[1]; h[3] = e1[2] * h[3] + e1[3];
    h[4] = e2[0] * h[4] + e2[1]; h[5] = e2[2] * h[5] + e2[3]; h[6] = e3[0] * h[6] + e3[1]; h[7] = e3[2] * h[7] + e3[3];
}
DI void phase_scan_apply(const Params& p) {
    const bf16_t* OM = (const bf16_t*)(p.ws + O_S); const bf16_t* BB = OM + (size_t)2 * MA * 512;
    const f32x4* agg = (const f32x4*)(p.ws + O_AGG);
    bf16_t* UXY = (bf16_t*)(p.ws + O_UXY); float* HF = p.out;
    const int tid = TIDX, lane = tid & 63, gw = (tid >> 6) * gridDim.x + BIDX, nw = gridDim.x * 8;
    for (int it = gw; it < NB * NCH; it += nw) {
        const int b = it / NCH, pch = it % NCH, row0 = chunk_row0(b, pch);
        const f32x4* af = agg + (((size_t)(0 * NB + b) * NCH) * 512 + lane * 8) / 2; const f32x4* ab = agg + (((size_t)(1 * NB + b) * NCH) * 512 + lane * 8) / 2;
        float h[8];
#pragma unroll
        for (int i = 0; i < 8; ++i) h[i] = 0.f;
#pragma unroll 4
        for (int q = 0; q < pch; ++q) agg_step(af + (size_t)q * 256, h);
        { const bf16_t* om = OM + ((size_t)row0) * 512 + lane * 8; const bf16_t* bb = BB + ((size_t)row0) * 512 + lane * 8; float* hf = HF + (size_t)row0 * 512 + lane * 8;
#pragma unroll 8
          for (int t = 0; t < 64; ++t) {
              const u32x4 ov = *(const u32x4*)(om + (size_t)t * 512), bv = *(const u32x4*)(bb + (size_t)t * 512);
              h[0] = (1.f - bflo(ov.x)) * h[0] + bflo(bv.x); h[1] = (1.f - bfhi(ov.x)) * h[1] + bfhi(bv.x); h[2] = (1.f - bflo(ov.y)) * h[2] + bflo(bv.y); h[3] = (1.f - bfhi(ov.y)) * h[3] + bfhi(bv.y);
              h[4] = (1.f - bflo(ov.z)) * h[4] + bflo(bv.z); h[5] = (1.f - bfhi(ov.z)) * h[5] + bfhi(bv.z); h[6] = (1.f - bflo(ov.w)) * h[6] + bflo(bv.w); h[7] = (1.f - bfhi(ov.w)) * h[7] + bfhi(bv.w);
              *(f32x4*)(hf + (size_t)t * 512) = (f32x4){h[0], h[1], h[2], h[3]}; *(f32x4*)(hf + (size_t)t * 512 + 4) = (f32x4){h[4], h[5], h[6], h[7]};
          } }
#pragma unroll
        for (int i = 0; i < 8; ++i) h[i] = 0.f;
        if (pch >= 4) {
#pragma unroll
            for (int q = 3; q >= 0; --q) agg_step(ab + (size_t)q * 256, h);
#pragma unroll 4
            for (int q = NCH - 1; q > pch; --q) agg_step(ab + (size_t)q * 256, h);
        } else {
            for (int q = 3; q > pch; --q) agg_step(ab + (size_t)q * 256, h);
        }
        { const bf16_t* om = OM + ((size_t)MA + row0) * 512 + lane * 8; const bf16_t* bb = BB + ((size_t)MA + row0) * 512 + lane * 8; const float* hf = HF + (size_t)row0 * 512 + lane * 8;
#pragma unroll 4
          for (int t = 63; t >= 0; --t) {
              const u32x4 ov = *(const u32x4*)(om + (size_t)t * 512), bv = *(const u32x4*)(bb + (size_t)t * 512);
              const f32x4 f0 = *(const f32x4*)(hf + (size_t)t * 512), f1 = *(const f32x4*)(hf + (size_t)t * 512 + 4);
              const u32x4 uv = *(const u32x4*)(UXY + (size_t)(row0 + t) * 1024 + 512 + lane * 8);
              h[0] = (1.f - bflo(ov.x)) * h[0] + bflo(bv.x); h[1] = (1.f - bfhi(ov.x)) * h[1] + bfhi(bv.x); h[2] = (1.f - bflo(ov.y)) * h[2] + bflo(bv.y); h[3] = (1.f - bfhi(ov.y)) * h[3] + bfhi(bv.y);
              h[4] = (1.f - bflo(ov.z)) * h[4] + bflo(bv.z); h[5] = (1.f - bfhi(ov.z)) * h[5] + bfhi(bv.z); h[6] = (1.f - bflo(ov.w)) * h[6] + bflo(bv.w); h[7] = (1.f - bfhi(ov.w)) * h[7] + bfhi(bv.w);
              u32x4 o;
              o.x = pk2((f0[0] + h[0]) * gelu_tanh(bflo(uv.x)), (f0[1] + h[1]) * gelu_tanh(bfhi(uv.x))); o.y = pk2((f0[2] + h[2]) * gelu_tanh(bflo(uv.y)), (f0[3] + h[3]) * gelu_tanh(bfhi(uv.y)));
              o.z = pk2((f1[0] + h[4]) * gelu_tanh(bflo(uv.z)), (f1[1] + h[5]) * gelu_tanh(bfhi(uv.z))); o.w = pk2((f1[2] + h[6]) * gelu_tanh(bflo(uv.w)), (f1[3] + h[7]) * gelu_tanh(bfhi(uv.w)));
              *(u32x4*)(UXY + (size_t)(row0 + t) * 1024 + lane * 8) = o;
          } }
    }
}

DI void phase_qk(const Params& p, int l) {
    const bf16_t* qraw = (const bf16_t*)p.out; const bf16_t* kn = qraw + (size_t)MA * 768;
    const bf16_t* P1 = (const bf16_t*)(p.ws + O_R1);
    bf16_t* Q = (bf16_t*)(p.ws + O_S); bf16_t* Kb = Q + (size_t)32 * TK * 96;
    const int lane = TIDX & 63, gw = BIDX * 8 + (TIDX >> 6), nw = gridDim.x * 8, h = lane >> 3, j = lane & 7;
    const float* qn = p.q_norm + l * 96; const float* knm = p.k_norm + l * 96;
    float gq[12], gk[12];
#pragma unroll
    for (int i = 0; i < 12; ++i) { gq[i] = qn[8 * i + j] * QSCALE; gk[i] = knm[8 * i + j]; }
    const float freq = exp2f(-(float)j * 1.6609640474436813f);
    for (int row0 = gw; row0 < MA; row0 += nw) {
        float xq[1][12], xk[1][12];
#pragma unroll
        for (int u = 0; u < 1; ++u) {
            const int row = row0 + u * nw;
            if (row < MA) {
#pragma unroll
                for (int i = 0; i < 12; ++i) xq[u][i] = bf2f(qraw[(size_t)row * 768 + h * 96 + 8 * i + j]);
#pragma unroll
                for (int i = 0; i < 8; ++i) xk[u][i] = bf2f(kn[(size_t)row * 512 + h * 64 + 8 * i + j]);
#pragma unroll
                for (int i = 8; i < 12; ++i) xk[u][i] = bf2f(P1[(size_t)row * 768 + 640 + 8 * (i - 8) + j]);
            }
        }
#pragma unroll
        for (int u = 0; u < 1; ++u) {
            const int row = row0 + u * nw;
            if (row < MA) {
                const bool lat = row < ML; int b, pos;
                if (lat) { b = row >> 13; pos = row & (SEQ - 1); } else { const int r = row - ML; b = r >> 8; pos = SEQ + (r & 255); }
                float c0 = 1.f, s0 = 0.f, c1 = 1.f, s1 = 0.f;
                if (lat) { float r0 = (float)(pos >> 6) * freq * 0.15915494309189535f, r1 = (float)(pos & 63) * freq * 0.15915494309189535f;
                    r0 -= floorf(r0); r1 -= floorf(r1);
                    c0 = __builtin_amdgcn_cosf(r0); s0 = __builtin_amdgcn_sinf(r0); c1 = __builtin_amdgcn_cosf(r1); s1 = __builtin_amdgcn_sinf(r1); }
                float sq = 0.f, sk = 0.f;
#pragma unroll
                for (int i = 0; i < 12; ++i) { sq += xq[u][i] * xq[u][i]; sk += xk[u][i] * xk[u][i]; }
                sq += __shfl_xor(sq, 1); sk += __shfl_xor(sk, 1); sq += __shfl_xor(sq, 2); sk += __shfl_xor(sk, 2); sq += __shfl_xor(sq, 4); sk += __shfl_xor(sk, 4);
                const float rq = rsqrtf(sq * (1.f / 96.f) + EPS), rk = rsqrtf(sk * (1.f / 96.f) + EPS);
                float x[12];
#pragma unroll
                for (int i = 0; i < 12; ++i) x[i] = xq[u][i] * (rq * gq[i]);
                { const float y8 = x[8] * c0 - x[9] * s0, y9 = x[8] * s0 + x[9] * c0, y10 = x[10] * c1 - x[11] * s1, y11 = x[10] * s1 + x[11] * c1;
                  x[8] = y8; x[9] = y9; x[10] = y10; x[11] = y11; }
                { bf16_t* dst = Q + ((size_t)(b * NH + h) * TK + pos) * 96 + j;
#pragma unroll
                  for (int i = 0; i < 12; ++i) dst[8 * i] = f2bf(x[i]); }
#pragma unroll
                for (int i = 0; i < 12; ++i) x[i] = xk[u][i] * (rk * gk[i]);
                { const float y8 = x[8] * c0 - x[9] * s0, y9 = x[8] * s0 + x[9] * c0, y10 = x[10] * c1 - x[11] * s1, y11 = x[10] * s1 + x[11] * c1;
                  x[8] = y8; x[9] = y9; x[10] = y10; x[11] = y11; }
                { bf16_t* dst = Kb + ((size_t)(b * NH + h) * TK + pos) * 96 + j;
#pragma unroll
                  for (int i = 0; i < 12; ++i) dst[8 * i] = f2bf(x[i]); }
            }
        }
    }
}

constexpr int KROW = 208, VROW = 144, KBYTES = 64 * KROW, ABUF = KBYTES + 64 * VROW;
DI void attn_item(unsigned char* lds, const bf16_t* Q, const bf16_t* Kb, const bf16_t* Vt, bf16_t* att, int bh, int qposA, int qposB, int kt0, int kt1, int outrowA, int outrowB, bool writeB) {
    const int tid = TIDX, lane = tid & 63, l31 = lane & 31, half = lane >> 5;
    bf16x8 qa[6], qb[6];
    { const bf16_t* qp = Q + ((size_t)bh * TK + qposA + l31) * 96 + 8 * half; const bf16_t* qq = Q + ((size_t)bh * TK + qposB + l31) * 96 + 8 * half;
#pragma unroll
      for (int ks = 0; ks < 6; ++ks) { qa[ks] = *(const bf16x8*)(qp + 16 * ks); qb[ks] = *(const bf16x8*)(qq + 16 * ks); } }
    f32x16 oa0, oa1, ob0, ob1;
#pragma unroll
    for (int i = 0; i < 16; ++i) { oa0[i] = 0.f; oa1[i] = 0.f; ob0[i] = 0.f; ob1[i] = 0.f; }
    float la = 0.f, lb = 0.f;
    const unsigned char* kg = (const unsigned char*)(Kb + (size_t)bh * TK * 96) + (size_t)tid * 16;
    const unsigned char* vg = (const unsigned char*)(Vt + ((size_t)bh * 64 + (tid >> 3)) * TK) + (tid & 7) * 16;
    const int kc1 = 512 + tid;
    const int koff0 = (tid / 12) * KROW + (tid % 12) * 16, koff1 = (kc1 / 12) * KROW + (kc1 % 12) * 16;
    const int voff = KBYTES + (tid >> 3) * VROW + ((tid & 7) >> 1) * 32 + (tid & 1) * 8;
    const int klo = l31 * KROW + 16 * half, vlo = KBYTES + l31 * VROW + 16 * half;
    u32x4 kr0, kr1 = {0u, 0u, 0u, 0u}, vr;
#define AT_GLOAD(kt) do { kr0 = *(const u32x4*)(kg + (size_t)(kt) * 12288); if (tid < 256) kr1 = *(const u32x4*)(kg + (size_t)(kt) * 12288 + 8192); vr = *(const u32x4*)(vg + (size_t)(kt) * 128); } while (0)
#define AT_SSTORE(stg) do { unsigned char* bp_ = lds + (stg) * ABUF; *(u32x4*)(bp_ + koff0) = kr0; if (tid < 256) *(u32x4*)(bp_ + koff1) = kr1; \
        *(u32x2*)(bp_ + voff) = (u32x2){vr.x, vr.y}; *(u32x2*)(bp_ + voff + 16) = (u32x2){vr.z, vr.w}; } while (0)
#define AT_PK(v, o) (u32x4){pk2(v[o], v[o + 1]), pk2(v[o + 2], v[o + 3]), pk2(v[o + 4], v[o + 5]), pk2(v[o + 6], v[o + 7])}
    AT_GLOAD(kt0); AT_SSTORE(0);
    __syncthreads();
    for (int kt = kt0; kt < kt1; ++kt) {
        const int cur = (kt - kt0) & 1;
        const bool more = kt + 1 < kt1;
        if (more) AT_GLOAD(kt + 1);
        const unsigned char* kl = lds + cur * ABUF + klo;
        const unsigned char* vl = lds + cur * ABUF + vlo;
        f32x16 sa0, sa1, sb0, sb1;
        const f32x16 zero16 = {0.f, 0.f, 0.f, 0.f, 0.f, 0.f, 0.f, 0.f, 0.f, 0.f, 0.f, 0.f, 0.f, 0.f, 0.f, 0.f};
#pragma unroll
        for (int ks = 0; ks < 6; ++ks) {
            const bf16x8 a0 = *(const bf16x8*)(kl + 32 * ks), a1 = *(const bf16x8*)(kl + 32 * KROW + 32 * ks);
            sa0 = __builtin_amdgcn_mfma_f32_32x32x16_bf16(a0, qa[ks], ks == 0 ? zero16 : sa0, 0, 0, 0);
            sa1 = __builtin_amdgcn_mfma_f32_32x32x16_bf16(a1, qa[ks], ks == 0 ? zero16 : sa1, 0, 0, 0);
            sb0 = __builtin_amdgcn_mfma_f32_32x32x16_bf16(a0, qb[ks], ks == 0 ? zero16 : sb0, 0, 0, 0);
            sb1 = __builtin_amdgcn_mfma_f32_32x32x16_bf16(a1, qb[ks], ks == 0 ? zero16 : sb1, 0, 0, 0);
        }
        float pa = 0.f, pb = 0.f;
#pragma unroll
        for (int i = 0; i < 16; ++i) { sa0[i] = __builtin_amdgcn_exp2f(sa0[i]); sa1[i] = __builtin_amdgcn_exp2f(sa1[i]); pa += sa0[i] + sa1[i];
                                       sb0[i] = __builtin_amdgcn_exp2f(sb0[i]); sb1[i] = __builtin_amdgcn_exp2f(sb1[i]); pb += sb0[i] + sb1[i]; }
        la += pa; lb += pb;
#pragma unroll
        for (int s = 0; s < 4; ++s) {
            const bf16x8 v0 = *(const bf16x8*)(vl + 32 * s), v1 = *(const bf16x8*)(vl + 32 * VROW + 32 * s);
            const bf16x8 fa = __builtin_bit_cast(bf16x8, s < 2 ? AT_PK(sa0, 8 * (s & 1)) : AT_PK(sa1, 8 * (s & 1)));
            const bf16x8 fb = __builtin_bit_cast(bf16x8, s < 2 ? AT_PK(sb0, 8 * (s & 1)) : AT_PK(sb1, 8 * (s & 1)));
            oa0 = __builtin_amdgcn_mfma_f32_32x32x16_bf16(v0, fa, oa0, 0, 0, 0); oa1 = __builtin_amdgcn_mfma_f32_32x32x16_bf16(v1, fa, oa1, 0, 0, 0);
            ob0 = __builtin_amdgcn_mfma_f32_32x32x16_bf16(v0, fb, ob0, 0, 0, 0); ob1 = __builtin_amdgcn_mfma_f32_32x32x16_bf16(v1, fb, ob1, 0, 0, 0);
        }
        if (more) AT_SSTORE(cur ^ 1);
        __syncthreads();
    }
#undef AT_GLOAD
#undef AT_SSTORE
#undef AT_PK
    { const float lt = la + __shfl_xor(la, 32), inv = 1.f / lt;
      bf16_t* op = att + (size_t)(outrowA + l31) * 512 + (bh & 7) * 64 + 4 * half;
#pragma unroll
      for (int g = 0; g < 4; ++g) {
          st_bf4(op + 8 * g, (f32x4){oa0[4 * g] * inv, oa0[4 * g + 1] * inv, oa0[4 * g + 2] * inv, oa0[4 * g + 3] * inv});
          st_bf4(op + 32 + 8 * g, (f32x4){oa1[4 * g] * inv, oa1[4 * g + 1] * inv, oa1[4 * g + 2] * inv, oa1[4 * g + 3] * inv}); } }
    if (writeB) { const float lt = lb + __shfl_xor(lb, 32), inv = 1.f / lt;
      bf16_t* op = att + (size_t)(outrowB + l31) * 512 + (bh & 7) * 64 + 4 * half;
#pragma unroll
      for (int g = 0; g < 4; ++g) {
          st_bf4(op + 8 * g, (f32x4){ob0[4 * g] * inv, ob0[4 * g + 1] * inv, ob0[4 * g + 2] * inv, ob0[4 * g + 3] * inv});
          st_bf4(op + 32 + 8 * g, (f32x4){ob1[4 * g] * inv, ob1[4 * g + 1] * inv, ob1[4 * g + 2] * inv, ob1[4 * g + 3] * inv}); } }
}
DI void phase_attn(const Params& p, unsigned char* lds, bool with_ctx) {
    const bf16_t* Q = (const bf16_t*)(p.ws + O_S); const bf16_t* Kb = Q + (size_t)32 * TK * 96; const bf16_t* Vt = Kb + (size_t)32 * TK * 96;
    bf16_t* att = (bf16_t*)p.out;
    const int nitems = 512 + (with_ctx ? 32 : 0);
    for (int it = BIDX; it < nitems; it += gridDim.x) {
        const int wave = TIDX >> 6;
        if (it < 512) {
            const int j = (it >> 3) & 31, bh = (it >> 8) * 16 + (it & 7) * 2 + (j >> 4), q0 = (j & 15) * 512 + wave * 64, r0 = (bh >> 3) * SEQ + q0;
            attn_item(lds, Q, Kb, Vt, att, bh, q0, q0 + 32, 0, TK / 64, r0, r0 + 32, true);
        } else {
            const int bh = it - 512, q0 = SEQ + wave * 32, r0 = ML + (bh >> 3) * CTXL + wave * 32;
            attn_item(lds, Q, Kb, Vt, att, bh, q0, q0, SEQ / 64, TK / 64, r0, r0, false);
        }
    }
}

constexpr int PH_PER_LAYER = 15, N_PHASES = 1 + DEPTH * PH_PER_LAYER;
DI int phase_case(int ph) { const int i = (ph - 1) % PH_PER_LAYER; return i < 3 ? i : (i < 13 ? i + 1 : i + 2); }
DI void run_phase(const Params& p, int ph, unsigned char* smem) {
    LAS unsigned char* lds = (LAS unsigned char*)smem;
    unsigned char* ws = p.ws;
    if (ph == 0) { phase_mod(p, (float*)smem); return; }
    const int l = (ph - 1) / PH_PER_LAYER, s = phase_case(ph);
    const bool last = (l == DEPTH - 1);
    const float* mod = (const float*)(ws + O_MOD) + (size_t)l * 5 * NMOD;
    float* X = (float*)(ws + O_X);
    bf16_t* XNY = (bf16_t*)(ws + O_XNY); bf16_t* H = (bf16_t*)(ws + O_R1); bf16_t* P1 = (bf16_t*)(ws + O_R1); bf16_t* GATE = P1 + (size_t)MA * 768;
    bf16_t* UXY = (bf16_t*)(ws + O_UXY);
    float* SS = (float*)(ws + O_SS); const float* shw = (const float*)(ws + O_SHW);
    const int Mtail = last ? ML : MA;
    switch (s) {
    case 0: phase_prep(p, l, (float*)smem); if (l == 0) phase_norm0(p); break;
    case 1: { ESwiglu E{H, SS, shw}; gemm_phase<ESwiglu, false, true>(lds, Gemm{XNY, (const bf16_t*)(ws + O_WFF1IN), MA, 2 * DFF, DM, DM, DM}, E); } break;
    case 2: { EResid<1, true> E{X, X, mod + 2 * DM, mod + 4 * DM, XNY, SS + (size_t)MA * 16}; gemm_phase<EResid<1, true>, false, true>(lds, Gemm{H, (const bf16_t*)(ws + O_WFF1OUT), MA, DM, DFF, DFF, DFF}, E); }
              { const int nthird = (MA / BM) * (DM / BM) - 2 * (int)gridDim.x, vb = (int)BIDX - nthird; if (nthird > 0 && nthird < (int)gridDim.x && vb >= 0) phase_prep_ff(p, l, 1, (float*)smem, vb, (int)gridDim.x - nthird); else if (nthird <= 0 || nthird >= (int)gridDim.x) phase_prep_ff(p, l, 1, (float*)smem, BIDX, gridDim.x); }
              break;
    case 4: { EWin E{P1, UXY, GATE, SS + (size_t)MA * 16, shw + 5 * 5632}; gemm_phase<EWin, false, true>(lds, Gemm{XNY, (const bf16_t*)(ws + O_WIN), MA, NIN, DM, DM, DM}, E); } break;
    case 5: phase_conv(p, l); break;
    case 6: { bf16_t* OM = (bf16_t*)(ws + O_S); EGate E{XNY, OM, OM + (size_t)2 * MA * 512, (const float*)(ws + O_SP), p.b_rgate + l * 1024, p.b_igate + l * 1024};
              gemm_phase<EGate, true, true>(lds, Gemm{XNY, (const bf16_t*)(ws + O_WGATE), MA, 2048, 256, 512, 256}, E); } break;
    case 7: phase_scan_agg(p); break;
    case 8: phase_scan_apply(p); break;
    case 9: { bf16_t* qraw = (bf16_t*)p.out; bf16_t* kn = qraw + (size_t)MA * 768; bf16_t* Vt = (bf16_t*)(ws + O_S) + (size_t)2 * 32 * TK * 96;
              const float* rsq = (const float*)(ws + O_RSQ); const float* rskv = (const float*)(ws + O_RSKV);
              const bf16_t* wukv = (const bf16_t*)(ws + O_WUKV);
              { EpiElem8<FRowScale> E{{qraw, 768, rsq}}; gemm_phase<EpiElem8<FRowScale>, false, true>(lds, Gemm{P1, (const bf16_t*)(ws + O_WUQ), MA, 768, 384, 768, 384}, E); }
              { EpiElem8<FRowScale> E{{kn, 512, rskv}}; gemm_phase<EpiElem8<FRowScale>, false, true>(lds, Gemm{P1 + 384, wukv, MA, 512, 256, 768, 256}, E); }
              { EpiElem8<FVt> E{{Vt, rskv}}; gemm_phase<EpiElem8<FVt>, false, true>(lds, Gemm{wukv + (size_t)512 * 256, P1 + 384, 512, MA, 256, 256, 768}, E); }
              } break;
    case 10: phase_qk(p, l); break;
    case 11: phase_attn(p, smem, !last); break;
    case 12: { { EpiElem8<FMergeA> E{{GATE, XNY}}; gemm_phase<EpiElem8<FMergeA>, false, true>(lds, Gemm{(const bf16_t*)p.out, (const bf16_t*)(ws + O_WOA), Mtail, DM, 512, 512, 512}, E); }
               { EpiElem8<FMergeB> E{{GATE, XNY}}; gemm_phase<EpiElem8<FMergeB>, false, true>(lds, Gemm{UXY, (const bf16_t*)(ws + O_WOL), Mtail, DM, 512, 1024, 512}, E); } } break;
    case 13: { EResid<2, true> E{X, X, mod + 5 * DM, mod + 7 * DM, UXY, SS + (size_t)2 * MA * 16}; gemm_phase<EResid<2, true>, false, true>(lds, Gemm{XNY, (const bf16_t*)(ws + O_WOUT), Mtail, DM, DM, DM, DM}, E); } break;
    case 15: { ESwiglu E{H, SS + (size_t)2 * MA * 16, shw + 2 * 5 * 5632}; gemm_phase<ESwiglu, false, true>(lds, Gemm{UXY, (const bf16_t*)(ws + O_WFF2IN), Mtail, 2 * DFF, DM, DM, DM}, E); } break;
    case 16: if (last) { EResid<1, false> E{X, p.out, mod + 8 * DM, nullptr, nullptr, nullptr}; gemm_phase<EResid<1, false>, false, true>(lds, Gemm{H, (const bf16_t*)(ws + O_WFF2OUT), Mtail, DM, DFF, DFF, DFF}, E); }
             else { EResid<1, true> E{X, X, mod + 8 * DM, mod + 5 * NMOD + DM, XNY, SS}; gemm_phase<EResid<1, true>, false, true>(lds, Gemm{H, (const bf16_t*)(ws + O_WFF2OUT), Mtail, DM, DFF, DFF, DFF}, E); }
             if (!last) { const int nthird = (MA / BM) * (DM / BM) - 2 * (int)gridDim.x, vb = (int)BIDX - nthird; if (nthird > 0 && nthird < (int)gridDim.x && vb >= 0) phase_prep_ff(p, l + 1, 0, (float*)smem, vb, (int)gridDim.x - nthird); else if (nthird <= 0 || nthird >= (int)gridDim.x) phase_prep_ff(p, l + 1, 0, (float*)smem, BIDX, gridDim.x); }
             break;
    }
}

#ifndef PROBE_MASK
#define PROBE_MASK 0u
#endif
#define XB_TMO      128
#define XB_XCNT(j)  (256  + 64 * (j))
#define XB_XSUB(j)  (1280 + 64 * (j))
#define XB_XGEN(j)  (2304 + 64 * (j))
#define XB_TOP      3328
#define XB_TOPGEN   3392
#define XCD_BAR_WORDS 3456
#define XB_SPIN_CAP (1u << 18)
DI unsigned xb_ld(unsigned* p)              { return __hip_atomic_load(p, __ATOMIC_RELAXED, __HIP_MEMORY_SCOPE_AGENT); }
DI unsigned xb_add(unsigned* p, unsigned v) { return __hip_atomic_fetch_add(p, v, __ATOMIC_RELAXED, __HIP_MEMORY_SCOPE_AGENT); }
DI unsigned xb_xcc_id() { return (unsigned)__builtin_amdgcn_s_getreg((3 << 11) | 20) & 0xFu; }
#define XB_SPIN(cond, bar) do { unsigned _sp = 0; while (cond) { __builtin_amdgcn_s_sleep(1); \
    if ((++_sp & 255u) == 0u) { if (xb_ld(&(bar)[XB_TMO])) break; if (_sp > XB_SPIN_CAP) { atomicAdd(&(bar)[XB_TMO], 1u); break; } } } } while (0)
struct XcdBarrier { unsigned* bar; unsigned x; volatile LAS unsigned* st; };
DI XcdBarrier xcd_barrier_post(unsigned* bar, volatile LAS unsigned* st) {
    XcdBarrier b; b.bar = bar; b.x = xb_xcc_id(); b.st = st;
    if (threadIdx.x == 0) (void)xb_add(&bar[XB_XCNT(b.x)], 1u);
    return b;
}
DI void xcd_barrier_complete(unsigned* bar, unsigned x, unsigned& nloc, unsigned& nx) {
    const unsigned G = gridDim.x * gridDim.y * gridDim.z;
    unsigned sum, cnt, mine, sp = 0u;
    for (;;) {
        sum = 0u; cnt = 0u; mine = 0u;
#pragma unroll
        for (unsigned j = 0; j < 16; ++j) { const unsigned c = xb_ld(&bar[XB_XCNT(j)]); sum += c; cnt += (c > 0u) ? 1u : 0u; mine = (j == x) ? c : mine; }
        if (sum == G) break;
        __builtin_amdgcn_s_sleep(1);
        if ((++sp & 255u) == 0u) { if (xb_ld(&bar[XB_TMO])) break; if (sp > XB_SPIN_CAP) { atomicAdd(&bar[XB_TMO], 1u); break; } }
    }
    nloc = mine > 0u ? mine : 1u; nx = cnt > 0u ? cnt : 1u;
}
DI void xcd_barrier(const XcdBarrier& b) {
    asm volatile("s_waitcnt vmcnt(0)" ::: "memory");
    __syncthreads();
    if (threadIdx.x == 0) {
        unsigned* bar = b.bar;
        __builtin_amdgcn_s_waitcnt(0);
        unsigned nloc = b.st[0], nx = b.st[1];
        if (nloc == 0u) { xcd_barrier_complete(bar, b.x, nloc, nx); b.st[0] = nloc; b.st[1] = nx; }
        const unsigned old = xb_add(&bar[XB_XSUB(b.x)], 1u);
        const unsigned gen = old / nloc;
        if (old + 1u == (gen + 1u) * nloc) {
            __builtin_amdgcn_fence(__ATOMIC_RELEASE, "agent");
            asm volatile("s_waitcnt vmcnt(0)" ::: "memory");
            const unsigned og = xb_add(&bar[XB_TOP], 1u);
            const unsigned tg = og / nx;
            if (og + 1u == (tg + 1u) * nx) xb_add(&bar[XB_TOPGEN], 1u);
            else XB_SPIN(xb_ld(&bar[XB_TOPGEN]) == tg, bar);
            __builtin_amdgcn_fence(__ATOMIC_ACQUIRE, "agent");
            xb_add(&bar[XB_XGEN(b.x)], 1u);
            asm volatile("s_waitcnt vmcnt(0)" ::: "memory");
        } else {
            XB_SPIN(xb_ld(&bar[XB_XGEN(b.x)]) == gen, bar);
            __builtin_amdgcn_fence(__ATOMIC_ACQUIRE, "agent");
            asm volatile("s_waitcnt vmcnt(0)" ::: "memory");
        }
    }
    __syncthreads();
}
__global__ void __launch_bounds__(512) mega(Params p) {
    extern __shared__ __attribute__((aligned(16))) unsigned char smem[];
    __shared__ uint4 xb_words;
    cg::grid_group grid = cg::this_grid();
    if (threadIdx.x == 0) xb_words = make_uint4(0u, 0u, 0u, 0u);
    __syncthreads();
    const XcdBarrier xb = xcd_barrier_post((unsigned*)(p.ws + O_BAR), (volatile LAS unsigned*)&xb_words);
    unsigned long long tsel = 0;
    for (int ph = p.ph_lo; ph < p.ph_hi; ++ph) {
        const unsigned long long t0 = PROBE_MASK ? wall_clock64() : 0ull;
        run_phase(p, ph, smem);
        if (p.coop && ph + 1 < p.ph_hi) { if (ph == 0) grid.sync(); else xcd_barrier(xb); }
        if (PROBE_MASK) { const int sidx = ph == 0 ? 17 : phase_case(ph); if ((PROBE_MASK >> sidx) & 1u) tsel += wall_clock64() - t0; }
    }
    if (PROBE_MASK && blockIdx.x == 0) { const unsigned long long t0 = wall_clock64(); while (wall_clock64() - t0 < tsel) __builtin_amdgcn_s_sleep(64); }
}

extern "C" void kernel_launch(void* const* d_in, const int* in_sizes, int n_in, void* d_out, int out_size, void* d_ws, size_t ws_size, hipStream_t stream) {
    static int grid = 0;
    if (grid == 0) {
        if (n_in != 27 || ws_size < WS_END) { fprintf(stderr, "kernel_launch: need 27 inputs and %zu bytes of workspace; got %d, %zu\n", (size_t)WS_END, n_in, ws_size); grid = -1; return; }
        int dev = 0, cus = 0, per_cu = 0;
        hipGetDevice(&dev); hipDeviceGetAttribute(&cus, hipDeviceAttributeMultiprocessorCount, dev);
        if (hipFuncSetAttribute((const void*)mega, hipFuncAttributeMaxDynamicSharedMemorySize, LDS_BYTES) != hipSuccess) { fprintf(stderr, "kernel_launch: hipFuncSetAttribute failed\n"); grid = -1; return; }
        if (hipOccupancyMaxActiveBlocksPerMultiprocessor(&per_cu, (const void*)mega, 512, LDS_BYTES) != hipSuccess || per_cu < 1) { fprintf(stderr, "kernel_launch: occupancy query gave %d\n", per_cu); per_cu = 1; }
        (void)hipGetLastError();
        grid = cus;
    }
    if (grid < 0) return;
    Params p{};
    const float** pp = (const float**)&p;
    for (int i = 0; i < 27; ++i) pp[i] = (const float*)d_in[i];
    p.out = (float*)d_out; p.ws = (unsigned char*)d_ws; p.ph_lo = 0; p.ph_hi = N_PHASES; p.coop = 1; p.pad = 0;
    (void)hipMemsetAsync((unsigned char*)d_ws + O_BAR, 0, XCD_BAR_WORDS * 4, stream);
    void* args[] = {&p};
    hipError_t e = hipLaunchCooperativeKernel((const void*)mega, dim3(grid), dim3(512), args, LDS_BYTES, stream);
    if (e != hipSuccess) {
        fprintf(stderr, "cooperative launch failed: %s (grid %d); falling back to one launch per phase\n", hipGetErrorString(e), grid);
        (void)hipGetLastError();
        p.coop = 0;
        for (int ph = 0; ph < N_PHASES; ++ph) { p.ph_lo = ph; p.ph_hi = ph + 1; hipLaunchKernelGGL(mega, dim3(grid), dim3(512), LDS_BYTES, stream, p); }
    }
}
```

```cpp
#include <hip/hip_runtime.h>
#include <hip/hip_cooperative_groups.h>
#include <cstdio>
namespace cg = cooperative_groups;

#define DI __device__ __forceinline__
#define LAS __attribute__((address_space(3)))
typedef unsigned short bf16_t;
typedef short bf16x8 __attribute__((ext_vector_type(8)));
typedef float f32x2 __attribute__((ext_vector_type(2)));
typedef float f32x4 __attribute__((ext_vector_type(4)));
typedef float f32x16 __attribute__((ext_vector_type(16)));
typedef unsigned u32x2 __attribute__((ext_vector_type(2)));
typedef unsigned u32x4 __attribute__((ext_vector_type(4)));
typedef __bf16 bfv2 __attribute__((ext_vector_type(2)));

constexpr int DM = 1024, NB = 4, SEQ = 8192, CTXL = 256, DEPTH = 4;
constexpr int ML = NB * SEQ, MC = NB * CTXL, MA = ML + MC;
constexpr int DFF = 2816, NH = 8, TK = SEQ + CTXL;
constexpr int NIN = 3840;
constexpr int NMOD = 9 * DM;
constexpr float EPS = 1e-6f;
constexpr float QSCALE = 0.10206207261596577f * 1.4426950408889634f;
constexpr int NCH = 132;

constexpr size_t SZ_FFIN = (size_t)2 * DFF * DM * 2, SZ_FFOUT = (size_t)DM * DFF * 2;
constexpr size_t O_WFF1IN = 0;
constexpr size_t O_WFF1OUT = O_WFF1IN + SZ_FFIN;
constexpr size_t O_WFF2IN = O_WFF1OUT + SZ_FFOUT;
constexpr size_t O_WFF2OUT = O_WFF2IN + SZ_FFIN;
constexpr size_t O_WIN = O_WFF2OUT + SZ_FFOUT;
constexpr size_t O_WUQ = O_WIN + (size_t)NIN * DM * 2;
constexpr size_t O_WUKV = O_WUQ + (size_t)768 * 384 * 2;
constexpr size_t O_WOA = O_WUKV + (size_t)1024 * 256 * 2;
constexpr size_t O_WOL = O_WOA + (size_t)1024 * 512 * 2;
constexpr size_t O_WOUT = O_WOL + (size_t)1024 * 512 * 2;
constexpr size_t O_WGATE = O_WOUT + (size_t)1024 * 1024 * 2;
constexpr size_t O_MOD = O_WGATE + (size_t)2048 * 256 * 2;
constexpr size_t O_RSQ = O_MOD + (size_t)DEPTH * 5 * NMOD * 4;
constexpr size_t O_RSKV = O_RSQ + (size_t)MA * 4;
constexpr size_t O_AGG = O_RSKV + (size_t)MA * 4;
constexpr size_t O_SP = O_AGG + (size_t)2 * NB * NCH * 512 * 8;
constexpr size_t O_BAR = O_SP + 4096;
constexpr size_t O_SS = O_BAR + 16384;
constexpr size_t O_SHW = O_SS + (size_t)3 * MA * 16 * 4;
constexpr size_t O_X = O_SHW + (size_t)3 * 5 * 5632 * 4;
constexpr size_t O_R1 = O_X + (size_t)MA * DM * 4;
constexpr size_t O_UXY = O_R1 + (size_t)MA * DFF * 2;
constexpr size_t O_XNY = O_UXY + (size_t)MA * 1024 * 2;
constexpr size_t O_S = O_XNY + (size_t)MA * 1024 * 2;
constexpr size_t WS_END = O_S + (size_t)MA * 1024 * 4;
constexpr int LDS_BYTES = 131072;

struct Params {
    const float *x, *c, *ctx, *c_ctx, *w_ada, *b_ada, *ff1_w_in, *ff1_w_out, *ff2_w_in, *ff2_w_out, *w_in, *q_a_norm, *w_uq, *kv_a_norm, *w_ukv, *q_norm, *k_norm,
        *conv_w, *conv_b, *lru_lambda, *w_rgate, *b_rgate, *w_igate, *b_igate, *w_o_attn, *w_o_lru, *w_out;
    float* out; unsigned char* ws;
    int ph_lo, ph_hi, coop, pad;
};

DI int tidx_() { int t = threadIdx.x; asm volatile("" : "+v"(t)); return t; }
DI int bidx_() { int t = blockIdx.x; asm volatile("" : "+s"(t)); return t; }
#define TIDX tidx_()
#define BIDX bidx_()
DI unsigned pk2(float lo, float hi) { f32x2 v = {lo, hi}; bfv2 r = __builtin_convertvector(v, bfv2); return __builtin_bit_cast(unsigned, r); }
DI bf16_t f2bf(float x) { return (bf16_t)(pk2(x, 0.f) & 0xffffu); }
DI float bf2f(bf16_t v) { return __uint_as_float((unsigned)v << 16); }
DI float bflo(unsigned v) { return __uint_as_float(v << 16); }
DI float bfhi(unsigned v) { return __uint_as_float(v & 0xffff0000u); }
DI float wave_sum(float v) {
#pragma unroll
    for (int o = 1; o < 64; o <<= 1) v += __shfl_xor(v, o);
    return v;
}
DI float sigmoidf_(float x) { return __builtin_amdgcn_rcpf(1.f + __expf(-x)); }
DI int mod_row(int row) { return row < ML ? (row >> 13) : 4; }
DI float row_rstd(const float* SSP, int row) {
    const f32x4* q = (const f32x4*)(SSP + (size_t)row * 16); const f32x4 a = q[0], b = q[1], c = q[2], d = q[3];
    const float s = ((a[0] + a[1]) + (a[2] + a[3])) + ((b[0] + b[1]) + (b[2] + b[3])) + ((c[0] + c[1]) + (c[2] + c[3])) + ((d[0] + d[1]) + (d[2] + d[3]));
    return __builtin_amdgcn_rsqf(s * (1.f / DM) + EPS);
}

constexpr int BM = 256, BK = 64, HALF = 128, HTB = HALF * BK * 2, NXCD = 8, WGM = 8;
DI int lds_byte(int r, int c) { const int st = (r >> 4) * 2 + (c >> 5), rr = r & 15, cc = c & 31, ob = rr * 64 + cc * 2; return st * 1024 + (ob ^ (((ob >> 9) & 1) << 5)); }
DI void stage_rc(int b, int& R, int& C) { const int st = b / 1024, sb = b % 1024, swz = sb ^ (((sb >> 9) & 1) << 5); R = (st >> 1) * 16 + swz / 64; C = (st & 1) * 32 + (swz % 64) / 2; }
struct Unit { int pm, pn; };
struct Gemm { const bf16_t* A; const bf16_t* Bt; int M, N, K, lda, ldb; };
struct StaticOrder {
    int nM, nN, nwg, G, c;
    DI void init(int M, int N, int G_, int c_) { nM = M / BM; nN = N / BM; nwg = nM * nN; G = G_; c = c_; }
    DI bool next(int i, Unit& u) const {
        const long L = (long)i * G + c; if (L >= nwg) return false;
        int wgid = (int)L; { const int q = nwg / NXCD, r = nwg % NXCD, xcd = wgid % NXCD, off = wgid / NXCD; wgid = (xcd < r ? xcd * (q + 1) : r * (q + 1) + (xcd - r) * q) + off; }
        const int nig = WGM * nN, gid = wgid / nig, fm = gid * WGM, gsz = (nM - fm) < WGM ? (nM - fm) : WGM;
        u.pm = fm + ((wgid % nig) % gsz); u.pn = (wgid % nig) / gsz; return true;
    }
};

DI int perm32(int rho) { const int n = rho >> 4, i = rho & 15; return 8 * (i >> 2) + 4 * n + (i & 3); }
template <class Epi, bool GATE_A, bool PERM = false>
DI void gemm_phase(LAS unsigned char* lds, const Gemm g, const Epi& E) {
    const int tid = TIDX, wid = __builtin_amdgcn_readfirstlane(tid >> 6), lane = tid & 63, wr = wid >> 2, wc = wid & 3, fr = lane & 15, fq = lane >> 4;
    const int K = g.K, nt = K / BK;
    StaticOrder S; S.init(g.M, g.N, gridDim.x, BIDX);
    unsigned voffA[2], voffB[2];
#pragma unroll
    for (int i = 0; i < 2; ++i) { int R, C; stage_rc(tid * 16 + i * 8192, R, C); const int Rb = PERM ? ((R & ~31) + perm32(R & 31)) : R; voffA[i] = (unsigned)(R * g.lda + C) * 2u; voffB[i] = (unsigned)(Rb * g.ldb + C) * 2u; }
#pragma unroll
    for (int i = 0; i < 2; ++i) { asm volatile("" : "+v"(voffA[i])); asm volatile("" : "+v"(voffB[i])); }
    const size_t kstep = (size_t)(BK * 2);
    const size_t hstepA = (size_t)HALF * g.lda * 2, hstepB = (size_t)HALF * g.ldb * 2;
    const size_t tstepA = 2 * hstepA, tstepB = 2 * hstepB;
    const unsigned ldsw = (unsigned)wid * 1024u;
    const int aoff = lds_byte(wr * 64 + fr, fq * 8), boff = lds_byte(wc * 32 + fr, fq * 8);
#define PG8_SA(b, h) (((b) * 2 + (h)) * HTB)
#define PG8_SB(b, h) ((4 + (b) * 2 + (h)) * HTB)
#define PG8_STAGE(bufoff, gbase, voff) do { _Pragma("unroll") for (int _i = 0; _i < 2; ++_i) \
        __builtin_amdgcn_global_load_lds((const unsigned*)((const char*)(gbase) + (voff)[_i]), (LAS unsigned*)(lds + (bufoff) + ldsw + _i * 8192), 16, 0, 0); } while (0)
#define PG8_LDA(dst, b, h) do { _Pragma("unroll") for (int m = 0; m < 4; ++m) _Pragma("unroll") for (int k = 0; k < 2; ++k) dst[m][k] = *(const LAS bf16x8*)(lds + PG8_SA(b, h) + aoff + m * 2048 + k * 1024); } while (0)
#define PG8_LDB(dst, b, h) do { _Pragma("unroll") for (int n = 0; n < 2; ++n) _Pragma("unroll") for (int k = 0; k < 2; ++k) dst[n][k] = *(const LAS bf16x8*)(lds + PG8_SB(b, h) + boff + n * 2048 + k * 1024); } while (0)
#define PG8_MMA(ai, bj, At, Bt) do { __builtin_amdgcn_s_setprio(1); _Pragma("unroll") for (int m = 0; m < 4; ++m) _Pragma("unroll") for (int n = 0; n < 2; ++n) _Pragma("unroll") for (int k = 0; k < 2; ++k) \
        acc[ai][bj][m][n] = __builtin_amdgcn_mfma_f32_16x16x32_bf16(Bt[n][k], At[m][k], acc[ai][bj][m][n], 0, 0, 0); __builtin_amdgcn_s_setprio(0); } while (0)
#define PG8_WAIT_V(n) asm volatile("s_waitcnt vmcnt(" #n ")" ::: "memory")
#define PG8_WAIT_L(n) asm volatile("s_waitcnt lgkmcnt(" #n ")" ::: "memory")
#define PG8_BAR __builtin_amdgcn_s_barrier()
#define PG8_SCHED __builtin_amdgcn_sched_barrier(0)
#define PG8_ABASE(u) ((const char*)g.A + (size_t)(u).pm * tstepA + (GATE_A ? (size_t)((((u).pn & 3) >> 1) * 512) : (size_t)0))
    Unit cur, nxt; int ui = 0;
    if (!S.next(0, cur)) return;
    f32x4 acc[2][2][4][2];
#pragma unroll
    for (int a = 0; a < 2; ++a)
#pragma unroll
        for (int b = 0; b < 2; ++b)
#pragma unroll
            for (int m = 0; m < 4; ++m)
#pragma unroll
                for (int n = 0; n < 2; ++n) acc[a][b][m][n] = (f32x4){0.f, 0.f, 0.f, 0.f};
    bf16x8 At[4][2], B0[2][2], B1[2][2];
    const char* cA = PG8_ABASE(cur); const char* cB = (const char*)g.Bt + (size_t)cur.pn * tstepB;
    PG8_STAGE(PG8_SB(0, 0), cB, voffB); PG8_STAGE(PG8_SA(0, 0), cA, voffA); PG8_STAGE(PG8_SB(0, 1), cB + hstepB, voffB); PG8_STAGE(PG8_SA(0, 1), cA + hstepA, voffA);
    if (wr == 1) PG8_BAR;
    PG8_WAIT_V(4); PG8_BAR;
    PG8_STAGE(PG8_SB(1, 0), cB + kstep, voffB); PG8_STAGE(PG8_SA(1, 0), cA + kstep, voffA); PG8_STAGE(PG8_SB(1, 1), cB + hstepB + kstep, voffB);
    PG8_WAIT_V(6); PG8_BAR;
    for (;;) {
        const bool has_next = S.next(ui + 1, nxt);
        const char* nA = has_next ? PG8_ABASE(nxt) : cA; const char* nB = has_next ? (const char*)g.Bt + (size_t)nxt.pn * tstepB : cB;
#pragma nounroll
        for (int t = 0; t < nt; t += 2) {
            const bool last = (t == nt - 2);
            const char* a1 = cA + (size_t)(t + 1) * kstep;
            const char* a2 = last ? nA : cA + (size_t)(t + 2) * kstep; const char* b2 = last ? nB : cB + (size_t)(t + 2) * kstep;
            const char* a3 = a2 + kstep; const char* b3 = b2 + kstep;
            PG8_LDB(B0, 0, 0); PG8_SCHED; PG8_LDA(At, 0, 0); PG8_STAGE(PG8_SA(1, 1), a1 + hstepA, voffA);
            PG8_WAIT_L(8); PG8_BAR; PG8_WAIT_L(0); PG8_MMA(0, 0, At, B0); PG8_BAR; PG8_SCHED;
            PG8_LDB(B1, 0, 1); PG8_STAGE(PG8_SB(0, 0), b2, voffB);
            PG8_BAR; PG8_WAIT_L(0); PG8_MMA(0, 1, At, B1); PG8_BAR;
            PG8_LDA(At, 0, 1); PG8_STAGE(PG8_SA(0, 0), a2, voffA);
            PG8_BAR; PG8_WAIT_L(0); PG8_MMA(1, 0, At, B0); PG8_BAR; PG8_SCHED;
            PG8_STAGE(PG8_SB(0, 1), b2 + hstepB, voffB);
            PG8_WAIT_V(6); PG8_BAR; PG8_MMA(1, 1, At, B1); PG8_BAR;
            PG8_LDB(B0, 1, 0); PG8_SCHED; PG8_LDA(At, 1, 0); PG8_STAGE(PG8_SA(0, 1), a2 + hstepA, voffA);
            PG8_WAIT_L(8); PG8_BAR; PG8_WAIT_L(0); PG8_MMA(0, 0, At, B0); PG8_BAR; PG8_SCHED;
            PG8_LDB(B1, 1, 1); PG8_STAGE(PG8_SB(1, 0), b3, voffB);
            PG8_BAR; PG8_WAIT_L(0); PG8_MMA(0, 1, At, B1); PG8_BAR;
            PG8_LDA(At, 1, 1); PG8_STAGE(PG8_SA(1, 0), a3, voffA);
            PG8_BAR; PG8_WAIT_L(0); PG8_MMA(1, 0, At, B0); PG8_BAR; PG8_SCHED;
            PG8_STAGE(PG8_SB(1, 1), b3 + hstepB, voffB);
            PG8_WAIT_V(6); PG8_BAR; PG8_MMA(1, 1, At, B1); PG8_BAR;
        }
        E(acc, cur, wr, wc, fr, fq);
        if (!has_next) break;
#pragma unroll
        for (int a = 0; a < 2; ++a)
#pragma unroll
            for (int b = 0; b < 2; ++b)
#pragma unroll
                for (int m = 0; m < 4; ++m)
#pragma unroll
                    for (int n = 0; n < 2; ++n) acc[a][b][m][n] = (f32x4){0.f, 0.f, 0.f, 0.f};
        cur = nxt; cA = nA; cB = nB; ++ui;
    }
    PG8_WAIT_V(0);
    if (wr == 0) PG8_BAR;
    PG8_BAR;
#undef PG8_SA
#undef PG8_SB
#undef PG8_STAGE
#undef PG8_LDA
#undef PG8_LDB
#undef PG8_MMA
#undef PG8_WAIT_V
#undef PG8_WAIT_L
#undef PG8_BAR
#undef PG8_SCHED
#undef PG8_ABASE
}

template <class F> struct EpiElem {
    F f;
    DI void operator()(const f32x4 (&acc)[2][2][4][2], const Unit& u, int wr, int wc, int fr, int fq) const {
        const int row0 = u.pm * BM + wr * 64 + fr, col0 = u.pn * BM + wc * 32 + 4 * fq;
#pragma unroll
        for (int ai = 0; ai < 2; ++ai)
#pragma unroll
            for (int m = 0; m < 4; ++m)
#pragma unroll
                for (int bj = 0; bj < 2; ++bj)
#pragma unroll
                    for (int n = 0; n < 2; ++n) { f(row0 + ai * HALF + m * 16, col0 + bj * HALF + n * 16, acc[ai][bj][m][n]); }
    }
};
template <class F> struct EpiElemRow {
    F f;
    DI void operator()(const f32x4 (&acc)[2][2][4][2], const Unit& u, int wr, int wc, int fr, int fq) const {
        const int row0 = u.pm * BM + wr * 64 + fr, col0 = u.pn * BM + wc * 32 + 4 * fq;
#pragma unroll
        for (int ai = 0; ai < 2; ++ai)
#pragma unroll
            for (int m = 0; m < 4; ++m) {
                float ssq = 0.f;
#pragma unroll
                for (int bj = 0; bj < 2; ++bj)
#pragma unroll
                    for (int n = 0; n < 2; ++n) { ssq += f(row0 + ai * HALF + m * 16, col0 + bj * HALF + n * 16, acc[ai][bj][m][n]); }
                ssq += __shfl_xor(ssq, 16); ssq += __shfl_xor(ssq, 32);
                if (fq == 0) f.row(row0 + ai * HALF + m * 16, (u.pn & 3) * 4 + wc, ssq);
            }
    }
};
template <class F> struct EpiElemRS {
    F f;
    DI void operator()(const f32x4 (&acc)[2][2][4][2], const Unit& u, int wr, int wc, int fr, int fq) const {
        const int row0 = u.pm * BM + wr * 64 + fr, col0 = u.pn * BM + wc * 32 + 4 * fq;
#pragma unroll
        for (int ai = 0; ai < 2; ++ai)
#pragma unroll
            for (int m = 0; m < 4; ++m) {
                const float rs = f.rs(row0 + ai * HALF + m * 16);
#pragma unroll
                for (int bj = 0; bj < 2; ++bj)
#pragma unroll
                    for (int n = 0; n < 2; ++n) { f(row0 + ai * HALF + m * 16, col0 + bj * HALF + n * 16, acc[ai][bj][m][n], rs); }
            }
    }
};
template <class F> struct EpiPairRS {
    F f;
    DI void operator()(const f32x4 (&acc)[2][2][4][2], const Unit& u, int wr, int wc, int fr, int fq) const {
        const int row0 = u.pm * BM + wr * 64 + fr, c0 = wc * 32 + 4 * fq;
#pragma unroll
        for (int ai = 0; ai < 2; ++ai)
#pragma unroll
            for (int m = 0; m < 4; ++m) {
                const float rs = f.rs(row0 + ai * HALF + m * 16);
#pragma unroll
                for (int n = 0; n < 2; ++n) { f(row0 + ai * HALF + m * 16, u.pn, c0 + n * 16, acc[ai][0][m][n], acc[ai][1][m][n], rs); }
            }
    }
};
template <class F> struct EpiElem2 {
    F f;
    DI void operator()(const f32x4 (&acc)[2][2][4][2], const Unit& u, int wr, int wc, int fr, int fq) const {
        const int row0 = u.pm * BM + wr * 64 + fr, col0 = u.pn * BM + wc * 32 + 4 * fq;
        typename F::L cur[2][2], nxt[2][2];
#pragma unroll
        for (int bj = 0; bj < 2; ++bj)
#pragma unroll
            for (int n = 0; n < 2; ++n) cur[bj][n] = f.load(row0, col0 + bj * HALF + n * 16);
#pragma unroll
        for (int i = 0; i < 8; ++i) {
            const int row = row0 + (i >> 2) * HALF + (i & 3) * 16;
            if (i < 7) { const int rown = row0 + ((i + 1) >> 2) * HALF + ((i + 1) & 3) * 16;
#pragma unroll
                for (int bj = 0; bj < 2; ++bj)
#pragma unroll
                    for (int n = 0; n < 2; ++n) nxt[bj][n] = f.load(rown, col0 + bj * HALF + n * 16); }
#pragma unroll
            for (int bj = 0; bj < 2; ++bj)
#pragma unroll
                for (int n = 0; n < 2; ++n) f.apply(row, col0 + bj * HALF + n * 16, acc[i >> 2][bj][i & 3][n], cur[bj][n]);
#pragma unroll
            for (int bj = 0; bj < 2; ++bj)
#pragma unroll
                for (int n = 0; n < 2; ++n) cur[bj][n] = nxt[bj][n];
        }
    }
};
template <class F> struct EpiElem8 {
    F f;
    DI void operator()(const f32x4 (&acc)[2][2][4][2], const Unit& u, int wr, int wc, int fr, int fq) const {
        const int row0 = u.pm * BM + wr * 64 + fr, col0 = u.pn * BM + wc * 32 + 8 * fq;
        typename F::L cur[2], nxt[2];
#pragma unroll
        for (int bj = 0; bj < 2; ++bj) cur[bj] = f.load(row0, col0 + bj * HALF);
#pragma unroll
        for (int i = 0; i < 8; ++i) {
            const int row = row0 + (i >> 2) * HALF + (i & 3) * 16;
            if (i < 7) { const int rown = row0 + ((i + 1) >> 2) * HALF + ((i + 1) & 3) * 16;
#pragma unroll
                for (int bj = 0; bj < 2; ++bj) nxt[bj] = f.load(rown, col0 + bj * HALF); }
#pragma unroll
            for (int bj = 0; bj < 2; ++bj) f.apply(row, col0 + bj * HALF, acc[i >> 2][bj][i & 3][0], acc[i >> 2][bj][i & 3][1], cur[bj]);
#pragma unroll
            for (int bj = 0; bj < 2; ++bj) cur[bj] = nxt[bj];
        }
    }
};
template <class F> struct EpiPair {
    F f;
    DI void operator()(const f32x4 (&acc)[2][2][4][2], const Unit& u, int wr, int wc, int fr, int fq) const {
        const int row0 = u.pm * BM + wr * 64 + fr, c0 = wc * 32 + 4 * fq;
#pragma unroll
        for (int ai = 0; ai < 2; ++ai)
#pragma unroll
            for (int m = 0; m < 4; ++m)
#pragma unroll
                for (int n = 0; n < 2; ++n) { f(row0 + ai * HALF + m * 16, u.pn, c0 + n * 16, acc[ai][0][m][n], acc[ai][1][m][n]); }
    }
};
DI void st_bf4(bf16_t* p, f32x4 v) { u32x2 o; o.x = pk2(v[0], v[1]); o.y = pk2(v[2], v[3]); *(u32x2*)p = o; }
DI void st_bf8(bf16_t* p, f32x4 lo, f32x4 hi) { u32x4 o; o.x = pk2(lo[0], lo[1]); o.y = pk2(lo[2], lo[3]); o.z = pk2(hi[0], hi[1]); o.w = pk2(hi[2], hi[3]); *(u32x4*)p = o; }

struct FSwiglu { bf16_t* H; const float* SS; const float* shw;
    DI float rs(int row) const { return row_rstd(SS, row); }
    DI void operator()(int row, int pn, int c, f32x4 g, f32x4 u, float rs) const {
        const float* sw = shw + mod_row(row) * 5632 + pn * 256 + c;
        g = g * rs + *(const f32x4*)sw; u = u * rs + *(const f32x4*)(sw + 128);
        f32x4 h;
#pragma unroll
        for (int e = 0; e < 4; ++e) h[e] = g[e] * sigmoidf_(g[e]) * u[e];
        st_bf4(H + (size_t)row * DFF + pn * 128 + c, h);
    } };
struct FResid { const float* src; float* dst; const float* mod; float coef;
    DI void operator()(int row, int col, f32x4 v) const {
        const f32x4 g = *(const f32x4*)(mod + mod_row(row) * NMOD + col);
        const f32x4 x = *(const f32x4*)(src + (size_t)row * DM + col);
        *(f32x4*)(dst + (size_t)row * DM + col) = x + coef * g * v;
    } };
template <int COEF2> struct FResidN { const float* src; float* dst; const float* mod; const float* scn; bf16_t* XS; float* SS;
    DI float operator()(int row, int col, f32x4 v) const {
        const int r = mod_row(row);
        const f32x4 g = *(const f32x4*)(mod + r * NMOD + col);
        const f32x4 x = *(const f32x4*)(src + (size_t)row * DM + col);
        const f32x4 xn = x + (0.5f * COEF2) * g * v;
        *(f32x4*)(dst + (size_t)row * DM + col) = xn;
        const f32x4 sc = *(const f32x4*)(scn + r * NMOD + col);
        st_bf4(XS + (size_t)row * DM + col, xn * (1.f + sc));
        return (xn[0] * xn[0] + xn[1] * xn[1]) + (xn[2] * xn[2] + xn[3] * xn[3]);
    }
    DI void row(int row, int slot, float ssq) const { SS[(size_t)row * 16 + slot] = ssq; } };
struct FWin { bf16_t *P1, *UXY, *GATE; const float* SS; const float* shw;
    DI float rs(int row) const { return row_rstd(SS, row); }
    DI void operator()(int row, int col, f32x4 v, float rs) const {
        v = v * rs + *(const f32x4*)(shw + mod_row(row) * 5632 + col);
        bf16_t* p = col < 768 ? P1 + (size_t)row * 768 + col : (col < 1792 ? UXY + (size_t)row * 1024 + (col - 768) : GATE + (size_t)row * 2048 + (col - 1792));
        st_bf4(p, v);
    } };
struct FRowScale { bf16_t* dst; int ld; const float* rs;
    typedef float L;
    DI L load(int row, int) const { return rs[row]; }
    DI void apply(int row, int col, f32x4 v0, f32x4 v1, L sc) const { st_bf8(dst + (size_t)row * ld + col, v0 * sc, v1 * sc); } };
struct FVt { bf16_t* Vt; const float* rs;
    struct L { f32x4 a, b; };
    DI L load(int, int col) const { return L{*(const f32x4*)(rs + col), *(const f32x4*)(rs + col + 4)}; }
    DI void apply(int row, int col, f32x4 v0, f32x4 v1, L sc) const {
        int b, kpos; if (col < ML) { b = col >> 13; kpos = col & (SEQ - 1); } else { const int r = col - ML; b = r >> 8; kpos = SEQ + (r & 255); }
        st_bf8(Vt + ((size_t)(b * NH + (row >> 6)) * 64 + (row & 63)) * TK + kpos, v0 * sc.a, v1 * sc.b);
    } };
struct EGate { const bf16_t* xc; bf16_t *OM, *BB; const float *sp8, *br, *bi;
    DI void operator()(const f32x4 (&acc)[2][2][4][2], const Unit& u, int wr, int wc, int fr, int fq) const {
        const int row0 = u.pm * BM + wr * 64 + fr, d = u.pn >> 2, ch0 = (u.pn & 3) * 128 + wc * 32 + 8 * fq;
        f32x4 s4[2], br4[2], bi4[2]; u32x4 xcur, xnxt;
#pragma unroll
        for (int n = 0; n < 2; ++n) { s4[n] = *(const f32x4*)(sp8 + d * 512 + ch0 + 4 * n); br4[n] = *(const f32x4*)(br + d * 512 + ch0 + 4 * n); bi4[n] = *(const f32x4*)(bi + d * 512 + ch0 + 4 * n); }
        xcur = *(const u32x4*)(xc + (size_t)row0 * 512 + ch0);
#pragma unroll
        for (int i = 0; i < 8; ++i) {
            const int row = row0 + (i >> 2) * HALF + (i & 3) * 16;
            if (i < 7) { const int rown = row0 + ((i + 1) >> 2) * HALF + ((i + 1) & 3) * 16; xnxt = *(const u32x4*)(xc + (size_t)rown * 512 + ch0); }
            f32x4 om[2], bb[2];
#pragma unroll
            for (int n = 0; n < 2; ++n) {
                const f32x4 r4 = acc[i >> 2][0][i & 3][n], i4 = acc[i >> 2][1][i & 3][n];
                const unsigned w0 = n == 0 ? xcur.x : xcur.z, w1 = n == 0 ? xcur.y : xcur.w;
                const f32x4 xf = {bflo(w0), bfhi(w0), bflo(w1), bfhi(w1)};
#pragma unroll
                for (int e = 0; e < 4; ++e) {
                    const float r = sigmoidf_(r4[e] + br4[n][e]), ig = sigmoidf_(i4[e] + bi4[n][e]);
                    const float a = __expf(s4[n][e] * r);
                    om[n][e] = 1.f - a; bb[n][e] = __fsqrt_rn(fmaxf(1.f - a * a, 0.f)) * (ig * xf[e]);
                }
            }
            const size_t o = ((size_t)d * MA + row) * 512 + ch0;
            st_bf8(OM + o, om[0], om[1]); st_bf8(BB + o, bb[0], bb[1]);
            xcur = xnxt;
        }
    } };
DI f32x4 sig_lo(u32x4 g) { return (f32x4){sigmoidf_(bflo(g.x)), sigmoidf_(bfhi(g.x)), sigmoidf_(bflo(g.y)), sigmoidf_(bfhi(g.y))}; }
DI f32x4 sig_hi(u32x4 g) { return (f32x4){sigmoidf_(bflo(g.z)), sigmoidf_(bfhi(g.z)), sigmoidf_(bflo(g.w)), sigmoidf_(bfhi(g.w))}; }
struct FMergeA { const bf16_t* GATE; bf16_t* Y;
    typedef u32x4 L;
    DI L load(int row, int col) const { return *(const u32x4*)(GATE + (size_t)row * 2048 + col); }
    DI void apply(int row, int col, f32x4 v0, f32x4 v1, L gv) const { st_bf8(Y + (size_t)row * DM + col, sig_lo(gv) * v0, sig_hi(gv) * v1); } };
struct FMergeB { const bf16_t* GATE; bf16_t* Y;
    struct L { u32x4 g, y; };
    DI L load(int row, int col) const { return L{*(const u32x4*)(GATE + (size_t)row * 2048 + 1024 + col), *(const u32x4*)(Y + (size_t)row * DM + col)}; }
    DI void apply(int row, int col, f32x4 v0, f32x4 v1, L q) const {
        const f32x4 y0 = {bflo(q.y.x), bfhi(q.y.x), bflo(q.y.y), bfhi(q.y.y)}, y1 = {bflo(q.y.z), bfhi(q.y.z), bflo(q.y.w), bfhi(q.y.w)};
        st_bf8(Y + (size_t)row * DM + col, y0 + sig_lo(q.g) * v0, y1 + sig_hi(q.g) * v1);
    } };

struct ESwiglu { bf16_t* H; const float* SS; const float* shw;
    DI void operator()(const f32x4 (&acc)[2][2][4][2], const Unit& u, int wr, int wc, int fr, int fq) const {
        const int row0 = u.pm * BM + wr * 64 + fr, c0 = wc * 32 + 8 * fq;
        const float* sw = shw + mod_row(u.pm * BM) * 5632 + u.pn * 256 + c0;
        f32x4 sg[2], su[2]; float rs[8];
#pragma unroll
        for (int n = 0; n < 2; ++n) { sg[n] = *(const f32x4*)(sw + 4 * n); su[n] = *(const f32x4*)(sw + 128 + 4 * n); }
#pragma unroll
        for (int i = 0; i < 8; ++i) rs[i] = row_rstd(SS, row0 + (i >> 2) * HALF + (i & 3) * 16);
#pragma unroll
        for (int ai = 0; ai < 2; ++ai)
#pragma unroll
            for (int m = 0; m < 4; ++m) {
                f32x4 h[2];
#pragma unroll
                for (int n = 0; n < 2; ++n) {
                    const f32x4 g = acc[ai][0][m][n] * rs[ai * 4 + m] + sg[n], uu = acc[ai][1][m][n] * rs[ai * 4 + m] + su[n];
#pragma unroll
                    for (int e = 0; e < 4; ++e) h[n][e] = g[e] * sigmoidf_(g[e]) * uu[e];
                }
                st_bf8(H + (size_t)(row0 + ai * HALF + m * 16) * DFF + u.pn * 128 + c0, h[0], h[1]);
            }
    } };
struct EWin { bf16_t *P1, *UXY, *GATE; const float* SS; const float* shw;
    template <int LD> DI void body(const f32x4 (&acc)[2][2][4][2], bf16_t* dst, const f32x4 (&sh)[2][2], const float (&rs)[8]) const {
#pragma unroll
        for (int ai = 0; ai < 2; ++ai)
#pragma unroll
            for (int m = 0; m < 4; ++m)
#pragma unroll
                for (int bj = 0; bj < 2; ++bj)
                    st_bf8(dst + (size_t)(ai * HALF + m * 16) * LD + 128 * bj, acc[ai][bj][m][0] * rs[ai * 4 + m] + sh[bj][0], acc[ai][bj][m][1] * rs[ai * 4 + m] + sh[bj][1]);
    }
    DI void operator()(const f32x4 (&acc)[2][2][4][2], const Unit& u, int wr, int wc, int fr, int fq) const {
        const int row0 = u.pm * BM + wr * 64 + fr, c0 = wc * 32 + 8 * fq;
        const float* sw = shw + mod_row(u.pm * BM) * 5632 + u.pn * 256 + c0;
        f32x4 sh[2][2]; float rs[8];
#pragma unroll
        for (int bj = 0; bj < 2; ++bj)
#pragma unroll
            for (int n = 0; n < 2; ++n) sh[bj][n] = *(const f32x4*)(sw + 128 * bj + 4 * n);
#pragma unroll
        for (int i = 0; i < 8; ++i) { rs[i] = row_rstd(SS, row0 + (i >> 2) * HALF + (i & 3) * 16); if ((i & 1) == 1) __builtin_amdgcn_sched_barrier(0); }
        if (u.pn < 3) body<768>(acc, P1 + (size_t)row0 * 768 + u.pn * 256 + c0, sh, rs);
        else if (u.pn < 7) body<1024>(acc, UXY + (size_t)row0 * 1024 + (u.pn - 3) * 256 + c0, sh, rs);
        else body<2048>(acc, GATE + (size_t)row0 * 2048 + (u.pn - 7) * 256 + c0, sh, rs);
    } };
template <int COEF2, bool NORM> struct EResid { const float* src; float* dst; const float* mod; const float* scn; bf16_t* XS; float* SS;
    DI void operator()(const f32x4 (&acc)[2][2][4][2], const Unit& u, int wr, int wc, int fr, int fq) const {
        const int row0 = u.pm * BM + wr * 64 + fr, col0 = u.pn * BM + wc * 32 + 8 * fq, r = mod_row(u.pm * BM);
        f32x4 g[2][2], sc[2][2];
#pragma unroll
        for (int bj = 0; bj < 2; ++bj)
#pragma unroll
            for (int n = 0; n < 2; ++n) { g[bj][n] = *(const f32x4*)(mod + r * NMOD + col0 + 128 * bj + 4 * n) * (0.5f * COEF2);
                if (NORM) sc[bj][n] = *(const f32x4*)(scn + r * NMOD + col0 + 128 * bj + 4 * n) + 1.f; }
        f32x4 xc[2][2], xn_[2][2];
#pragma unroll
        for (int bj = 0; bj < 2; ++bj)
#pragma unroll
            for (int n = 0; n < 2; ++n) xc[bj][n] = *(const f32x4*)(src + (size_t)row0 * DM + col0 + 128 * bj + 4 * n);
#pragma unroll
        for (int i = 0; i < 8; ++i) {
            const int row = row0 + (i >> 2) * HALF + (i & 3) * 16;
            if (i < 7) { const int rown = row0 + ((i + 1) >> 2) * HALF + ((i + 1) & 3) * 16;
#pragma unroll
                for (int bj = 0; bj < 2; ++bj)
#pragma unroll
                    for (int n = 0; n < 2; ++n) xn_[bj][n] = *(const f32x4*)(src + (size_t)rown * DM + col0 + 128 * bj + 4 * n); }
            float ssq = 0.f;
#pragma unroll
            for (int bj = 0; bj < 2; ++bj) {
                f32x4 y[2];
#pragma unroll
                for (int n = 0; n < 2; ++n) {
                    y[n] = xc[bj][n] + g[bj][n] * acc[i >> 2][bj][i & 3][n];
                    *(f32x4*)(dst + (size_t)row * DM + col0 + 128 * bj + 4 * n) = y[n];
                    if (NORM) ssq += (y[n][0] * y[n][0] + y[n][1] * y[n][1]) + (y[n][2] * y[n][2] + y[n][3] * y[n][3]);
                }
                if (NORM) st_bf8(XS + (size_t)row * DM + col0 + 128 * bj, y[0] * sc[bj][0], y[1] * sc[bj][1]);
            }
            if (NORM) { ssq += __shfl_xor(ssq, 16); ssq += __shfl_xor(ssq, 32); if (fq == 0) SS[(size_t)row * 16 + (u.pn & 3) * 4 + wc] = ssq; }
#pragma unroll
            for (int bj = 0; bj < 2; ++bj)
#pragma unroll
                for (int n = 0; n < 2; ++n) xc[bj][n] = xn_[bj][n];
        }
    } };

DI void phase_mod(const Params& p, float* lds) {
    float* sc = lds;
    float* red = lds + 5 * DM;
    const int tid = TIDX, lane = tid & 63, wave = tid >> 6;
    for (int i = tid; i < 5 * DM; i += 512) { const float v = i < 4 * DM ? p.c[i] : p.c_ctx[i - 4 * DM]; sc[i] = v * sigmoidf_(v); }
    __syncthreads();
    float* mod = (float*)(p.ws + O_MOD);
    for (int it = BIDX; it < DEPTH * (NMOD / 64); it += gridDim.x) {
        const int l = it / (NMOD / 64), n = (it % (NMOD / 64)) * 64 + lane;
        const float* w = p.w_ada + ((size_t)l * DM + wave * 128) * NMOD + n;
        float a0 = 0.f, a1 = 0.f, a2 = 0.f, a3 = 0.f, a4 = 0.f;
#pragma unroll 8
        for (int k = 0; k < 128; ++k) { const float wv = w[(size_t)k * NMOD]; const int kk = wave * 128 + k;
            a0 += sc[kk] * wv; a1 += sc[DM + kk] * wv; a2 += sc[2 * DM + kk] * wv; a3 += sc[3 * DM + kk] * wv; a4 += sc[4 * DM + kk] * wv; }
        red[(wave * 5 + 0) * 64 + lane] = a0; red[(wave * 5 + 1) * 64 + lane] = a1; red[(wave * 5 + 2) * 64 + lane] = a2; red[(wave * 5 + 3) * 64 + lane] = a3; red[(wave * 5 + 4) * 64 + lane] = a4;
        __syncthreads();
        if (tid < 320) { const int r = tid >> 6; float s = p.b_ada[(size_t)l * NMOD + n];
#pragma unroll
            for (int w8 = 0; w8 < 8; ++w8) s += red[(w8 * 5 + r) * 64 + lane];
            mod[((size_t)l * 5 + r) * NMOD + n] = s; }
        __syncthreads();
    }
}

template <int MAP> DI int colmap(int n) {
    if (MAP == 0) return n;
    if (MAP == 1) { const int pn = n >> 8, bj = (n >> 7) & 1, c = n & 127; return bj * DFF + pn * 128 + c; }
    if (MAP == 2) return n < 672 ? n : (n < 768 ? -1 : n - 96);
    { const int m = n & 511, h = m >> 6, d = m & 63; return h * 128 + (n >> 9) * 64 + d; }
}
template <int MAP> DI void tjob(const float* src, int ld, int K, int N, bf16_t* dst, const float* kscale, float* tile, int& base, int vbid, int G) {
    const int tid = TIDX, ntn = N / 64, ntiles = ntn * (K / 64);
    int first = (vbid - base % G + G) % G;
    for (int t = first; t < ntiles; t += G) {
        const int n0 = (t % ntn) * 64, k0 = (t / ntn) * 64;
        const int c = colmap<MAP>(n0 + (tid & 63));
#pragma unroll
        for (int i = 0; i < 8; ++i) { const int kk = (tid >> 6) + 8 * i; float v = c >= 0 ? src[(size_t)(k0 + kk) * ld + c] : 0.f; if (kscale) v *= kscale[k0 + kk]; tile[kk * 65 + (tid & 63)] = v; }
        __syncthreads();
        { const int kc = tid & 7, nn = tid >> 3;
          const float* tp = tile + (kc * 8) * 65 + nn;
          u32x4 o; o.x = pk2(tp[0], tp[65]); o.y = pk2(tp[2 * 65], tp[3 * 65]); o.z = pk2(tp[4 * 65], tp[5 * 65]); o.w = pk2(tp[6 * 65], tp[7 * 65]);
          *(u32x4*)(dst + (size_t)(n0 + nn) * K + k0 + kc * 8) = o; }
        __syncthreads();
    }
    base += ntiles;
}
DI void phase_prep_ff(const Params& p, int l, int which, float* tile, int vbid, int vG) {
    unsigned char* ws = p.ws; int base = 0;
    if (which == 0) {
        tjob<1>(p.ff1_w_in + (size_t)l * DM * 2 * DFF, 2 * DFF, DM, 2 * DFF, (bf16_t*)(ws + O_WFF1IN), nullptr, tile, base, vbid, vG);
        tjob<0>(p.ff1_w_out + (size_t)l * DFF * DM, DM, DFF, DM, (bf16_t*)(ws + O_WFF1OUT), nullptr, tile, base, vbid, vG);
    } else {
        tjob<1>(p.ff2_w_in + (size_t)l * DM * 2 * DFF, 2 * DFF, DM, 2 * DFF, (bf16_t*)(ws + O_WFF2IN), nullptr, tile, base, vbid, vG);
        tjob<0>(p.ff2_w_out + (size_t)l * DFF * DM, DM, DFF, DM, (bf16_t*)(ws + O_WFF2OUT), nullptr, tile, base, vbid, vG);
    }
}
DI void phase_prep(const Params& p, int l, float* tile) {
    unsigned char* ws = p.ws; int base = 0;
    const int vbid = BIDX, vG = gridDim.x;
    const float* modl = (const float*)(ws + O_MOD) + (size_t)l * 5 * NMOD; float* shw = (float*)(ws + O_SHW);
    if (l == 0) phase_prep_ff(p, 0, 0, tile, vbid, vG);
    tjob<2>(p.w_in + (size_t)l * DM * 3744, 3744, DM, NIN, (bf16_t*)(ws + O_WIN), nullptr, tile, base, vbid, vG);
    tjob<0>(p.w_uq + (size_t)l * 384 * 768, 768, 384, 768, (bf16_t*)(ws + O_WUQ), p.q_a_norm + l * 384, tile, base, vbid, vG);
    tjob<3>(p.w_ukv + (size_t)l * 256 * 1024, 1024, 256, 1024, (bf16_t*)(ws + O_WUKV), p.kv_a_norm + l * 256, tile, base, vbid, vG);
    tjob<0>(p.w_o_attn + (size_t)l * 512 * 1024, 1024, 512, 1024, (bf16_t*)(ws + O_WOA), nullptr, tile, base, vbid, vG);
    tjob<0>(p.w_o_lru + (size_t)l * 512 * 1024, 1024, 512, 1024, (bf16_t*)(ws + O_WOL), nullptr, tile, base, vbid, vG);
    tjob<0>(p.w_out + (size_t)l * 1024 * 1024, 1024, 1024, 1024, (bf16_t*)(ws + O_WOUT), nullptr, tile, base, vbid, vG);
    { float* sh = tile; float* red = tile + 5 * DM;
      const int tid = TIDX, nn = tid & 63, ks = tid >> 6;
      for (int it = BIDX; it < 88 + 60 + 88; it += gridDim.x) {
          const int m = it < 88 ? 0 : (it < 148 ? 1 : 2), n0 = (m == 0 ? it : (m == 1 ? it - 88 : it - 148)) * 64;
          const float* W = m == 0 ? p.ff1_w_in + (size_t)l * DM * 2 * DFF : (m == 1 ? p.w_in + (size_t)l * DM * 3744 : p.ff2_w_in + (size_t)l * DM * 2 * DFF);
          const int ld = m == 1 ? 3744 : 2 * DFF, c = m == 1 ? colmap<2>(n0 + nn) : colmap<1>(n0 + nn);
          __syncthreads();
          for (int i = tid; i < 5 * DM; i += 512) sh[i] = modl[(size_t)(i >> 10) * NMOD + m * 3 * DM + (i & 1023)];
          __syncthreads();
          float a0 = 0.f, a1 = 0.f, a2 = 0.f, a3 = 0.f, a4 = 0.f;
          if (c >= 0) {
#pragma unroll 8
              for (int k = ks * 128; k < ks * 128 + 128; ++k) { const float wv = W[(size_t)k * ld + c]; a0 += sh[k] * wv; a1 += sh[DM + k] * wv; a2 += sh[2 * DM + k] * wv; a3 += sh[3 * DM + k] * wv; a4 += sh[4 * DM + k] * wv; }
          }
          red[(ks * 5 + 0) * 64 + nn] = a0; red[(ks * 5 + 1) * 64 + nn] = a1; red[(ks * 5 + 2) * 64 + nn] = a2; red[(ks * 5 + 3) * 64 + nn] = a3; red[(ks * 5 + 4) * 64 + nn] = a4;
          __syncthreads();
          if (tid < 320) { const int r = tid >> 6; float sum = 0.f;
#pragma unroll
              for (int w8 = 0; w8 < 8; ++w8) sum += red[(w8 * 5 + r) * 64 + nn];
              shw[(size_t)(m * 5 + r) * 5632 + n0 + nn] = sum; }
      }
      __syncthreads(); }
    if (BIDX == 0) { float* sp8 = (float*)(ws + O_SP);
        for (int i = TIDX; i < 1024; i += 512) { const float nl = -p.lru_lambda[l * 1024 + i]; sp8[i] = -8.f * (fmaxf(nl, 0.f) + log1pf(__expf(-fabsf(nl)))); } }
    bf16_t* wg = (bf16_t*)(ws + O_WGATE);
    for (int idx = BIDX * 512 + TIDX; idx < 2048 * 256; idx += gridDim.x * 512) {
        const int n = idx >> 8, k = idx & 255, d = n >> 10, cb = (n >> 8) & 3, gt = (n >> 7) & 1, c = n & 127, ch = cb * 128 + c, g = ch >> 6, j = ch & 63, ci = 256 * (cb >> 1) + k, gi = ci >> 6, i = ci & 63;
        float v = 0.f;
        if (gi == g) v = (gt ? p.w_igate : p.w_rgate)[((((size_t)l * 2 + d) * 8 + g) * 64 + i) * 64 + j];
        wg[idx] = f2bf(v);
    }
}

DI void phase_norm0(const Params& p) {
    const int tid = TIDX, lane = tid & 63, gw = BIDX * 8 + (tid >> 6), nw = gridDim.x * 8;
    float* X = (float*)(p.ws + O_X); bf16_t* XS = (bf16_t*)(p.ws + O_XNY); float* SS = (float*)(p.ws + O_SS);
    const float* mod = (const float*)(p.ws + O_MOD);
    for (int row = gw; row < MA; row += nw) {
        const float* src = row < ML ? p.x + (size_t)row * DM : p.ctx + (size_t)(row - ML) * DM;
        f32x4 v[4]; float s = 0.f;
#pragma unroll
        for (int j = 0; j < 4; ++j) { v[j] = *(const f32x4*)(src + 256 * j + 4 * lane); s += (v[j][0] * v[j][0] + v[j][1] * v[j][1]) + (v[j][2] * v[j][2] + v[j][3] * v[j][3]); }
        s = wave_sum(s);
        if (lane < 16) SS[(size_t)row * 16 + lane] = lane == 0 ? s : 0.f;
        const float* mr = mod + (size_t)mod_row(row) * NMOD;
#pragma unroll
        for (int j = 0; j < 4; ++j) {
            const int col = 256 * j + 4 * lane;
            *(f32x4*)(X + (size_t)row * DM + col) = v[j];
            const f32x4 sc = *(const f32x4*)(mr + DM + col);
            st_bf4(XS + (size_t)row * DM + col, v[j] * (1.f + sc));
        }
    }
}

DI void phase_conv(const Params& p, int l) {
    const bf16_t* UXY = (const bf16_t*)(p.ws + O_UXY); const bf16_t* P1 = (const bf16_t*)(p.ws + O_R1);
    bf16_t* xc = (bf16_t*)(p.ws + O_XNY);
    const float* cw = p.conv_w + (size_t)l * 4 * 512; const float* cb = p.conv_b + (size_t)l * 512;
    for (int e = BIDX * 512 + TIDX; e < MA * 64; e += gridDim.x * 512) {
        const int row = e >> 6, ch = (e & 63) * 8;
        int t, T; if (row < ML) { t = row & (SEQ - 1); T = SEQ; } else { t = (row - ML) & 255; T = CTXL; }
        float y[8];
#pragma unroll
        for (int i = 0; i < 8; ++i) y[i] = cb[ch + i];
#pragma unroll
        for (int k = 0; k < 4; ++k) {
            const int tt = t + k - 2;
            if (tt >= 0 && tt < T) {
                const u32x4 uv = *(const u32x4*)(UXY + (size_t)(row + k - 2) * 1024 + ch);
                const f32x4 w0 = *(const f32x4*)(cw + k * 512 + ch), w1 = *(const f32x4*)(cw + k * 512 + ch + 4);
                y[0] += w0[0] * bflo(uv.x); y[1] += w0[1] * bfhi(uv.x); y[2] += w0[2] * bflo(uv.y); y[3] += w0[3] * bfhi(uv.y);
                y[4] += w1[0] * bflo(uv.z); y[5] += w1[1] * bfhi(uv.z); y[6] += w1[2] * bflo(uv.w); y[7] += w1[3] * bfhi(uv.w);
            }
        }
        u32x4 o; o.x = pk2(y[0], y[1]); o.y = pk2(y[2], y[3]); o.z = pk2(y[4], y[5]); o.w = pk2(y[6], y[7]);
        *(u32x4*)(xc + (size_t)row * 512 + ch) = o;
    }
    float* rsq = (float*)(p.ws + O_RSQ); float* rskv = (float*)(p.ws + O_RSKV);
    const int tid2 = TIDX, l16 = tid2 & 15, gq = BIDX * 32 + (tid2 >> 4), nq = gridDim.x * 32;
    for (int row = gq; row < MA; row += nq) {
        const bf16_t* pr = P1 + (size_t)row * 768;
        u32x4 v[5];
#pragma unroll
        for (int i = 0; i < 5; ++i) v[i] = *(const u32x4*)(pr + (l16 + 16 * i) * 8);
        float sq = 0.f, skv = 0.f;
#pragma unroll
        for (int i = 0; i < 5; ++i) {
            const float s2 = bflo(v[i].x) * bflo(v[i].x) + bfhi(v[i].x) * bfhi(v[i].x) + bflo(v[i].y) * bflo(v[i].y) + bfhi(v[i].y) * bfhi(v[i].y)
                           + bflo(v[i].z) * bflo(v[i].z) + bfhi(v[i].z) * bfhi(v[i].z) + bflo(v[i].w) * bflo(v[i].w) + bfhi(v[i].w) * bfhi(v[i].w);
            if (i < 3) sq += s2; else skv += s2;
        }
#pragma unroll
        for (int o = 1; o < 16; o <<= 1) { sq += __shfl_xor(sq, o); skv += __shfl_xor(skv, o); }
        if (l16 == 0) { rsq[row] = rsqrtf(sq * (1.f / 384.f) + EPS); rskv[row] = rsqrtf(skv * (1.f / 256.f) + EPS); }
    }
}

DI int chunk_row0(int b, int pch) { return pch < 4 ? ML + b * CTXL + pch * 64 : b * SEQ + (pch - 4) * 64; }
DI void phase_scan_agg(const Params& p) {
    const bf16_t* OM = (const bf16_t*)(p.ws + O_S); const bf16_t* BB = OM + (size_t)2 * MA * 512;
    f32x4* agg = (f32x4*)(p.ws + O_AGG);
    const int tid = TIDX, lane = tid & 63, gw = (tid >> 6) * gridDim.x + BIDX, nw = gridDim.x * 8;
    for (int it = gw; it < 2 * NB * NCH; it += nw) {
        const int d = it & 1, bp = it >> 1, b = bp / NCH, pch = bp % NCH, row0 = chunk_row0(b, pch);
        const bf16_t* om = OM + ((size_t)d * MA + row0) * 512 + lane * 8; const bf16_t* bb = BB + ((size_t)d * MA + row0) * 512 + lane * 8;
        float h[8], A[8];
#pragma unroll
        for (int i = 0; i < 8; ++i) { h[i] = 0.f; A[i] = 1.f; }
#pragma unroll 8
        for (int t = 0; t < 64; ++t) {
            const int tt = d ? 63 - t : t;
            const u32x4 ov = *(const u32x4*)(om + (size_t)tt * 512), bv = *(const u32x4*)(bb + (size_t)tt * 512);
            const float a[8] = {1.f - bflo(ov.x), 1.f - bfhi(ov.x), 1.f - bflo(ov.y), 1.f - bfhi(ov.y), 1.f - bflo(ov.z), 1.f - bfhi(ov.z), 1.f - bflo(ov.w), 1.f - bfhi(ov.w)};
            const float bq[8] = {bflo(bv.x), bfhi(bv.x), bflo(bv.y), bfhi(bv.y), bflo(bv.z), bfhi(bv.z), bflo(bv.w), bfhi(bv.w)};
#pragma unroll
            for (int i = 0; i < 8; ++i) { h[i] = a[i] * h[i] + bq[i]; A[i] *= a[i]; }
        }
        f32x4* dst = agg + (((size_t)(d * NB + b) * NCH + pch) * 512 + lane * 8) / 2;
#pragma unroll
        for (int i = 0; i < 4; ++i) dst[i] = (f32x4){A[2 * i], h[2 * i], A[2 * i + 1], h[2 * i + 1]};
    }
}
DI float gelu_tanh(float x) { const float u = 0.7978845608028654f * (x + 0.044715f * x * x * x); const float e = __expf(2.f * u); const float th = 1.f - 2.f * __builtin_amdgcn_rcpf(e + 1.f); return 0.5f * x * (1.f + th); }
DI void agg_step(const f32x4* e, float (&h)[8]) {
    const f32x4 e0 = e[0], e1 = e[1], e2 = e[2], e3 = e[3];
    h[0] = e0[0] * h[0] + e0[1]; h[1] = e0[2] * h[1] + e0[3]; h[2] = e1[0] * h[2] + e1[1]; h[3] = e1[2] * h[3] + e1[3];
    h[4] = e2[0] * h[4] + e2[1]; h[5] = e2[2] * h[5] + e2[3]; h[6] = e3[0] * h[6] + e3[1]; h[7] = e3[2] * h[7] + e3[3];
}
DI void phase_scan_apply(const Params& p) {
    const bf16_t* OM = (const bf16_t*)(p.ws + O_S); const bf16_t* BB = OM + (size_t)2 * MA * 512;
    const f32x4* agg = (const f32x4*)(p.ws + O_AGG);
    bf16_t* UXY = (bf16_t*)(p.ws + O_UXY); float* HF = p.out;
    const int tid = TIDX, lane = tid & 63, gw = (tid >> 6) * gridDim.x + BIDX, nw = gridDim.x * 8;
    for (int it = gw; it < NB * NCH; it += nw) {
        const int b = it / NCH, pch = it % NCH, row0 = chunk_row0(b, pch);
        const f32x4* af = agg + (((size_t)(0 * NB + b) * NCH) * 512 + lane * 8) / 2; const f32x4* ab = agg + (((size_t)(1 * NB + b) * NCH) * 512 + lane * 8) / 2;
        float h[8];
#pragma unroll
        for (int i = 0; i < 8; ++i) h[i] = 0.f;
#pragma unroll 4
        for (int q = 0; q < pch; ++q) agg_step(af + (size_t)q * 256, h);
        { const bf16_t* om = OM + ((size_t)row0) * 512 + lane * 8; const bf16_t* bb = BB + ((size_t)row0) * 512 + lane * 8; float* hf = HF + (size_t)row0 * 512 + lane * 8;
#pragma unroll 8
          for (int t = 0; t < 64; ++t) {
              const u32x4 ov = *(const u32x4*)(om + (size_t)t * 512), bv = *(const u32x4*)(bb + (size_t)t * 512);
              h[0] = (1.f - bflo(ov.x)) * h[0] + bflo(bv.x); h[1] = (1.f - bfhi(ov.x)) * h[1] + bfhi(bv.x); h[2] = (1.f - bflo(ov.y)) * h[2] + bflo(bv.y); h[3] = (1.f - bfhi(ov.y)) * h[3] + bfhi(bv.y);
              h[4] = (1.f - bflo(ov.z)) * h[4] + bflo(bv.z); h[5] = (1.f - bfhi(ov.z)) * h[5] + bfhi(bv.z); h[6] = (1.f - bflo(ov.w)) * h[6] + bflo(bv.w); h[7] = (1.f - bfhi(ov.w)) * h[7] + bfhi(bv.w);
              *(f32x4*)(hf + (size_t)t * 512) = (f32x4){h[0], h[1], h[2], h[3]}; *(f32x4*)(hf + (size_t)t * 512 + 4) = (f32x4){h[4], h[5], h[6], h[7]};
          } }
#pragma unroll
        for (int i = 0; i < 8; ++i) h[i] = 0.f;
        if (pch >= 4) {
#pragma unroll
            for (int q = 3; q >= 0; --q) agg_step(ab + (size_t)q * 256, h);
#pragma unroll 4
            for (int q = NCH - 1; q > pch; --q) agg_step(ab + (size_t)q * 256, h);
        } else {
            for (int q = 3; q > pch; --q) agg_step(ab + (size_t)q * 256, h);
        }
        { const bf16_t* om = OM + ((size_t)MA + row0) * 512 + lane * 8; const bf16_t* bb = BB + ((size_t)MA + row0) * 512 + lane * 8; const float* hf = HF + (size_t)row0 * 512 + lane * 8;
#pragma unroll 4
          for (int t = 63; t >= 0; --t) {
              const u32x4 ov = *(const u32x4*)(om + (size_t)t * 512), bv = *(const u32x4*)(bb + (size_t)t * 512);
              const f32x4 f0 = *(const f32x4*)(hf + (size_t)t * 512), f1 = *(const f32x4*)(hf + (size_t)t * 512 + 4);
              const u32x4 uv = *(const u32x4*)(UXY + (size_t)(row0 + t) * 1024 + 512 + lane * 8);
              h[0] = (1.f - bflo(ov.x)) * h[0] + bflo(bv.x); h[1] = (1.f - bfhi(ov.x)) * h[1] + bfhi(bv.x); h[2] = (1.f - bflo(ov.y)) * h[2] + bflo(bv.y); h[3] = (1.f - bfhi(ov.y)) * h[3] + bfhi(bv.y);
              h[4] = (1.f - bflo(ov.z)) * h[4] + bflo(bv.z); h[5] = (1.f - bfhi(ov.z)) * h[5] + bfhi(bv.z); h[6] = (1.f - bflo(ov.w)) * h[6] + bflo(bv.w); h[7] = (1.f - bfhi(ov.w)) * h[7] + bfhi(bv.w);
              u32x4 o;
              o.x = pk2((f0[0] + h[0]) * gelu_tanh(bflo(uv.x)), (f0[1] + h[1]) * gelu_tanh(bfhi(uv.x))); o.y = pk2((f0[2] + h[2]) * gelu_tanh(bflo(uv.y)), (f0[3] + h[3]) * gelu_tanh(bfhi(uv.y)));
              o.z = pk2((f1[0] + h[4]) * gelu_tanh(bflo(uv.z)), (f1[1] + h[5]) * gelu_tanh(bfhi(uv.z))); o.w = pk2((f1[2] + h[6]) * gelu_tanh(bflo(uv.w)), (f1[3] + h[7]) * gelu_tanh(bfhi(uv.w)));
              *(u32x4*)(UXY + (size_t)(row0 + t) * 1024 + lane * 8) = o;
          } }
    }
}

DI void phase_qk(const Params& p, int l, unsigned char* smem) {
    const bf16_t* qraw = (const bf16_t*)p.out; const bf16_t* kn = qraw + (size_t)MA * 768;
    const bf16_t* P1 = (const bf16_t*)(p.ws + O_R1);
    bf16_t* Q = (bf16_t*)(p.ws + O_S); bf16_t* Kb = Q + (size_t)32 * TK * 96;
    const int tid = TIDX, lane = tid & 63, wave = tid >> 6, gw = BIDX * 8 + wave, nw = gridDim.x * 8, h = lane >> 3, j = lane & 7;
    unsigned char* wq = smem + wave * 4096; unsigned char* wk = wq + 1536;
    const float* qn = p.q_norm + l * 96; const float* knm = p.k_norm + l * 96;
    float gq[12], gk[12];
#pragma unroll
    for (int i = 0; i < 12; ++i) { gq[i] = qn[8 * i + j] * QSCALE; gk[i] = knm[8 * i + j]; }
    const float freq = exp2f(-(float)j * 1.6609640474436813f);
    for (int row = gw; row < MA; row += nw) {
        { const u32x4 q0 = *(const u32x4*)(qraw + (size_t)row * 768 + lane * 8);
          u32x4 q1 = {0u, 0u, 0u, 0u}, k1 = {0u, 0u, 0u, 0u};
          if (lane < 32) q1 = *(const u32x4*)(qraw + (size_t)row * 768 + 512 + lane * 8);
          const u32x4 k0 = *(const u32x4*)(kn + (size_t)row * 512 + lane * 8);
          if (lane < 4) k1 = *(const u32x4*)(P1 + (size_t)row * 768 + 640 + lane * 8);
          *(u32x4*)(wq + lane * 16) = q0; if (lane < 32) *(u32x4*)(wq + 1024 + lane * 16) = q1;
          *(u32x4*)(wk + lane * 16) = k0; if (lane < 4) *(u32x4*)(wk + 1024 + lane * 16) = k1; }
        __builtin_amdgcn_fence(__ATOMIC_RELEASE, "wavefront"); __builtin_amdgcn_wave_barrier(); __builtin_amdgcn_fence(__ATOMIC_ACQUIRE, "wavefront");
        float xq[12], xk[12];
#pragma unroll
        for (int i = 0; i < 12; ++i) xq[i] = bf2f(*(const bf16_t*)(wq + (h * 96 + 8 * i + j) * 2));
#pragma unroll
        for (int i = 0; i < 8; ++i) xk[i] = bf2f(*(const bf16_t*)(wk + (h * 64 + 8 * i + j) * 2));
#pragma unroll
        for (int i = 8; i < 12; ++i) xk[i] = bf2f(*(const bf16_t*)(wk + 1024 + (8 * (i - 8) + j) * 2));
        __builtin_amdgcn_fence(__ATOMIC_RELEASE, "wavefront"); __builtin_amdgcn_wave_barrier(); __builtin_amdgcn_fence(__ATOMIC_ACQUIRE, "wavefront");
        const bool lat = row < ML; int b, pos;
        if (lat) { b = row >> 13; pos = row & (SEQ - 1); } else { const int r = row - ML; b = r >> 8; pos = SEQ + (r & 255); }
        float c0 = 1.f, s0 = 0.f, c1 = 1.f, s1 = 0.f;
        if (lat) { float r0 = (float)(pos >> 6) * freq * 0.15915494309189535f, r1 = (float)(pos & 63) * freq * 0.15915494309189535f;
            r0 -= floorf(r0); r1 -= floorf(r1);
            c0 = __builtin_amdgcn_cosf(r0); s0 = __builtin_amdgcn_sinf(r0); c1 = __builtin_amdgcn_cosf(r1); s1 = __builtin_amdgcn_sinf(r1); }
        float sq = 0.f, sk = 0.f;
#pragma unroll
        for (int i = 0; i < 12; ++i) { sq += xq[i] * xq[i]; sk += xk[i] * xk[i]; }
        sq += __shfl_xor(sq, 1); sk += __shfl_xor(sk, 1); sq += __shfl_xor(sq, 2); sk += __shfl_xor(sk, 2); sq += __shfl_xor(sq, 4); sk += __shfl_xor(sk, 4);
        const float rq = rsqrtf(sq * (1.f / 96.f) + EPS), rk = rsqrtf(sk * (1.f / 96.f) + EPS);
#pragma unroll
        for (int i = 0; i < 12; ++i) { xq[i] *= rq * gq[i]; xk[i] *= rk * gk[i]; }
        { const float y8 = xq[8] * c0 - xq[9] * s0, y9 = xq[8] * s0 + xq[9] * c0, y10 = xq[10] * c1 - xq[11] * s1, y11 = xq[10] * s1 + xq[11] * c1;
          xq[8] = y8; xq[9] = y9; xq[10] = y10; xq[11] = y11; }
        { const float y8 = xk[8] * c0 - xk[9] * s0, y9 = xk[8] * s0 + xk[9] * c0, y10 = xk[10] * c1 - xk[11] * s1, y11 = xk[10] * s1 + xk[11] * c1;
          xk[8] = y8; xk[9] = y9; xk[10] = y10; xk[11] = y11; }
#pragma unroll
        for (int i = 0; i < 12; ++i) { *(bf16_t*)(wq + (h * 96 + 8 * i + j) * 2) = f2bf(xq[i]); *(bf16_t*)(wk + (h * 96 + 8 * i + j) * 2) = f2bf(xk[i]); }
        __builtin_amdgcn_fence(__ATOMIC_RELEASE, "wavefront"); __builtin_amdgcn_wave_barrier(); __builtin_amdgcn_fence(__ATOMIC_ACQUIRE, "wavefront");
        { const int c0i = lane, c1i = 64 + lane;
          const u32x4 oq0 = *(const u32x4*)(wq + c0i * 16), ok0 = *(const u32x4*)(wk + c0i * 16);
          const size_t d0 = ((size_t)(b * NH + c0i / 12) * TK + pos) * 96 + (c0i % 12) * 8;
          *(u32x4*)(Q + d0) = oq0; *(u32x4*)(Kb + d0) = ok0;
          if (lane < 32) { const u32x4 oq1 = *(const u32x4*)(wq + c1i * 16), ok1 = *(const u32x4*)(wk + c1i * 16);
              const size_t d1 = ((size_t)(b * NH + c1i / 12) * TK + pos) * 96 + (c1i % 12) * 8;
              *(u32x4*)(Q + d1) = oq1; *(u32x4*)(Kb + d1) = ok1; } }
        __builtin_amdgcn_fence(__ATOMIC_RELEASE, "wavefront"); __builtin_amdgcn_wave_barrier(); __builtin_amdgcn_fence(__ATOMIC_ACQUIRE, "wavefront");
    }
}

constexpr int KROW = 208, VROW = 144, KBYTES = 64 * KROW, ABUF = KBYTES + 64 * VROW;
DI void attn_item(unsigned char* lds, const bf16_t* Q, const bf16_t* Kb, const bf16_t* Vt, bf16_t* att, int bh, int qposA, int qposB, int kt0, int kt1, int outrowA, int outrowB, bool writeB) {
    const int tid = TIDX, lane = tid & 63, l31 = lane & 31, half = lane >> 5;
    bf16x8 qa[6], qb[6];
    { const bf16_t* qp = Q + ((size_t)bh * TK + qposA + l31) * 96 + 8 * half; const bf16_t* qq = Q + ((size_t)bh * TK + qposB + l31) * 96 + 8 * half;
#pragma unroll
      for (int ks = 0; ks < 6; ++ks) { qa[ks] = *(const bf16x8*)(qp + 16 * ks); qb[ks] = *(const bf16x8*)(qq + 16 * ks); } }
    f32x16 oa0, oa1, ob0, ob1;
#pragma unroll
    for (int i = 0; i < 16; ++i) { oa0[i] = 0.f; oa1[i] = 0.f; ob0[i] = 0.f; ob1[i] = 0.f; }
    float la = 0.f, lb = 0.f;
    const unsigned char* kg = (const unsigned char*)(Kb + (size_t)bh * TK * 96) + (size_t)tid * 16;
    const unsigned char* vg = (const unsigned char*)(Vt + ((size_t)bh * 64 + (tid >> 3)) * TK) + (tid & 7) * 16;
    const int kc1 = 512 + tid;
    const int koff0 = (tid / 12) * KROW + (tid % 12) * 16, koff1 = (kc1 / 12) * KROW + (kc1 % 12) * 16;
    const int voff = KBYTES + (tid >> 3) * VROW + ((tid & 7) >> 1) * 32 + (tid & 1) * 8;
    const int klo = l31 * KROW + 16 * half, vlo = KBYTES + l31 * VROW + 16 * half;
    u32x4 kr0, kr1 = {0u, 0u, 0u, 0u}, vr;
#define AT_GLOAD(kt) do { kr0 = *(const u32x4*)(kg + (size_t)(kt) * 12288); if (tid < 256) kr1 = *(const u32x4*)(kg + (size_t)(kt) * 12288 + 8192); vr = *(const u32x4*)(vg + (size_t)(kt) * 128); } while (0)
#define AT_SSTORE(stg) do { unsigned char* bp_ = lds + (stg) * ABUF; *(u32x4*)(bp_ + koff0) = kr0; if (tid < 256) *(u32x4*)(bp_ + koff1) = kr1; \
        *(u32x2*)(bp_ + voff) = (u32x2){vr.x, vr.y}; *(u32x2*)(bp_ + voff + 16) = (u32x2){vr.z, vr.w}; } while (0)
#define AT_PK(v, o) (u32x4){pk2(v[o], v[o + 1]), pk2(v[o + 2], v[o + 3]), pk2(v[o + 4], v[o + 5]), pk2(v[o + 6], v[o + 7])}
    AT_GLOAD(kt0); AT_SSTORE(0);
    __syncthreads();
    for (int kt = kt0; kt < kt1; ++kt) {
        const int cur = (kt - kt0) & 1;
        const bool more = kt + 1 < kt1;
        if (more) AT_GLOAD(kt + 1);
        const unsigned char* kl = lds + cur * ABUF + klo;
        const unsigned char* vl = lds + cur * ABUF + vlo;
        f32x16 sa0, sa1, sb0, sb1;
        const f32x16 zero16 = {0.f, 0.f, 0.f, 0.f, 0.f, 0.f, 0.f, 0.f, 0.f, 0.f, 0.f, 0.f, 0.f, 0.f, 0.f, 0.f};
#pragma unroll
        for (int ks = 0; ks < 6; ++ks) {
            const bf16x8 a0 = *(const bf16x8*)(kl + 32 * ks), a1 = *(const bf16x8*)(kl + 32 * KROW + 32 * ks);
            sa0 = __builtin_amdgcn_mfma_f32_32x32x16_bf16(a0, qa[ks], ks == 0 ? zero16 : sa0, 0, 0, 0);
            sa1 = __builtin_amdgcn_mfma_f32_32x32x16_bf16(a1, qa[ks], ks == 0 ? zero16 : sa1, 0, 0, 0);
            sb0 = __builtin_amdgcn_mfma_f32_32x32x16_bf16(a0, qb[ks], ks == 0 ? zero16 : sb0, 0, 0, 0);
            sb1 = __builtin_amdgcn_mfma_f32_32x32x16_bf16(a1, qb[ks], ks == 0 ? zero16 : sb1, 0, 0, 0);
        }
        float pa = 0.f, pb = 0.f;
#pragma unroll
        for (int i = 0; i < 16; ++i) { sa0[i] = __builtin_amdgcn_exp2f(sa0[i]); sa1[i] = __builtin_amdgcn_exp2f(sa1[i]); pa += sa0[i] + sa1[i];
                                       sb0[i] = __builtin_amdgcn_exp2f(sb0[i]); sb1[i] = __builtin_amdgcn_exp2f(sb1[i]); pb += sb0[i] + sb1[i]; }
        la += pa; lb += pb;
#pragma unroll
        for (int s = 0; s < 4; ++s) {
            const bf16x8 v0 = *(const bf16x8*)(vl + 32 * s), v1 = *(const bf16x8*)(vl + 32 * VROW + 32 * s);
            const bf16x8 fa = __builtin_bit_cast(bf16x8, s < 2 ? AT_PK(sa0, 8 * (s & 1)) : AT_PK(sa1, 8 * (s & 1)));
            const bf16x8 fb = __builtin_bit_cast(bf16x8, s < 2 ? AT_PK(sb0, 8 * (s & 1)) : AT_PK(sb1, 8 * (s & 1)));
            oa0 = __builtin_amdgcn_mfma_f32_32x32x16_bf16(v0, fa, oa0, 0, 0, 0); oa1 = __builtin_amdgcn_mfma_f32_32x32x16_bf16(v1, fa, oa1, 0, 0, 0);
            ob0 = __builtin_amdgcn_mfma_f32_32x32x16_bf16(v0, fb, ob0, 0, 0, 0); ob1 = __builtin_amdgcn_mfma_f32_32x32x16_bf16(v1, fb, ob1, 0, 0, 0);
        }
        if (more) AT_SSTORE(cur ^ 1);
        __syncthreads();
    }
#undef AT_GLOAD
#undef AT_SSTORE
#undef AT_PK
    { const float lt = la + __shfl_xor(la, 32), inv = 1.f / lt;
      bf16_t* op = att + (size_t)(outrowA + l31) * 512 + (bh & 7) * 64 + 4 * half;
#pragma unroll
      for (int g = 0; g < 4; ++g) {
          st_bf4(op + 8 * g, (f32x4){oa0[4 * g] * inv, oa0[4 * g + 1] * inv, oa0[4 * g + 2] * inv, oa0[4 * g + 3] * inv});
          st_bf4(op + 32 + 8 * g, (f32x4){oa1[4 * g] * inv, oa1[4 * g + 1] * inv, oa1[4 * g + 2] * inv, oa1[4 * g + 3] * inv}); } }
    if (writeB) { const float lt = lb + __shfl_xor(lb, 32), inv = 1.f / lt;
      bf16_t* op = att + (size_t)(outrowB + l31) * 512 + (bh & 7) * 64 + 4 * half;
#pragma unroll
      for (int g = 0; g < 4; ++g) {
          st_bf4(op + 8 * g, (f32x4){ob0[4 * g] * inv, ob0[4 * g + 1] * inv, ob0[4 * g + 2] * inv, ob0[4 * g + 3] * inv});
          st_bf4(op + 32 + 8 * g, (f32x4){ob1[4 * g] * inv, ob1[4 * g + 1] * inv, ob1[4 * g + 2] * inv, ob1[4 * g + 3] * inv}); } }
}
DI void phase_attn(const Params& p, unsigned char* lds, bool with_ctx) {
    const bf16_t* Q = (const bf16_t*)(p.ws + O_S); const bf16_t* Kb = Q + (size_t)32 * TK * 96; const bf16_t* Vt = Kb + (size_t)32 * TK * 96;
    bf16_t* att = (bf16_t*)p.out;
    const int nitems = 512 + (with_ctx ? 32 : 0);
    for (int it = BIDX; it < nitems; it += gridDim.x) {
        const int wave = TIDX >> 6;
        if (it < 512) {
            const int j = (it >> 3) & 31, bh = (it >> 8) * 16 + (it & 7) * 2 + (j >> 4), q0 = (j & 15) * 512 + wave * 64, r0 = (bh >> 3) * SEQ + q0;
            attn_item(lds, Q, Kb, Vt, att, bh, q0, q0 + 32, 0, TK / 64, r0, r0 + 32, true);
        } else {
            const int bh = it - 512, q0 = SEQ + wave * 32, r0 = ML + (bh >> 3) * CTXL + wave * 32;
            attn_item(lds, Q, Kb, Vt, att, bh, q0, q0, SEQ / 64, TK / 64, r0, r0, false);
        }
    }
}

constexpr int PH_PER_LAYER = 15, N_PHASES = 1 + DEPTH * PH_PER_LAYER;
DI int phase_case(int ph) { const int i = (ph - 1) % PH_PER_LAYER; return i < 3 ? i : (i < 13 ? i + 1 : i + 2); }
DI void run_phase(const Params& p, int ph, unsigned char* smem) {
    LAS unsigned char* lds = (LAS unsigned char*)smem;
    unsigned char* ws = p.ws;
    if (ph == 0) { phase_mod(p, (float*)smem); return; }
    const int l = (ph - 1) / PH_PER_LAYER, s = phase_case(ph);
    const bool last = (l == DEPTH - 1);
    const float* mod = (const float*)(ws + O_MOD) + (size_t)l * 5 * NMOD;
    float* X = (float*)(ws + O_X);
    bf16_t* XNY = (bf16_t*)(ws + O_XNY); bf16_t* H = (bf16_t*)(ws + O_R1); bf16_t* P1 = (bf16_t*)(ws + O_R1); bf16_t* GATE = P1 + (size_t)MA * 768;
    bf16_t* UXY = (bf16_t*)(ws + O_UXY);
    float* SS = (float*)(ws + O_SS); const float* shw = (const float*)(ws + O_SHW);
    const int Mtail = last ? ML : MA;
    switch (s) {
    case 0: phase_prep(p, l, (float*)smem); if (l == 0) phase_norm0(p); break;
    case 1: { ESwiglu E{H, SS, shw}; gemm_phase<ESwiglu, false, true>(lds, Gemm{XNY, (const bf16_t*)(ws + O_WFF1IN), MA, 2 * DFF, DM, DM, DM}, E); } break;
    case 2: { EResid<1, true> E{X, X, mod + 2 * DM, mod + 4 * DM, XNY, SS + (size_t)MA * 16}; gemm_phase<EResid<1, true>, false, true>(lds, Gemm{H, (const bf16_t*)(ws + O_WFF1OUT), MA, DM, DFF, DFF, DFF}, E); }
              { const int nthird = (MA / BM) * (DM / BM) - 2 * (int)gridDim.x, vb = (int)BIDX - nthird; if (nthird > 0 && nthird < (int)gridDim.x && vb >= 0) phase_prep_ff(p, l, 1, (float*)smem, vb, (int)gridDim.x - nthird); else if (nthird <= 0 || nthird >= (int)gridDim.x) phase_prep_ff(p, l, 1, (float*)smem, BIDX, gridDim.x); }
              break;
    case 4: { EWin E{P1, UXY, GATE, SS + (size_t)MA * 16, shw + 5 * 5632}; gemm_phase<EWin, false, true>(lds, Gemm{XNY, (const bf16_t*)(ws + O_WIN), MA, NIN, DM, DM, DM}, E); } break;
    case 5: phase_conv(p, l); break;
    case 6: { bf16_t* OM = (bf16_t*)(ws + O_S); EGate E{XNY, OM, OM + (size_t)2 * MA * 512, (const float*)(ws + O_SP), p.b_rgate + l * 1024, p.b_igate + l * 1024};
              gemm_phase<EGate, true, true>(lds, Gemm{XNY, (const bf16_t*)(ws + O_WGATE), MA, 2048, 256, 512, 256}, E); } break;
    case 7: phase_scan_agg(p); break;
    case 8: phase_scan_apply(p); break;
    case 9: { bf16_t* qraw = (bf16_t*)p.out; bf16_t* kn = qraw + (size_t)MA * 768; bf16_t* Vt = (bf16_t*)(ws + O_S) + (size_t)2 * 32 * TK * 96;
              const float* rsq = (const float*)(ws + O_RSQ); const float* rskv = (const float*)(ws + O_RSKV);
              const bf16_t* wukv = (const bf16_t*)(ws + O_WUKV);
              { EpiElem8<FRowScale> E{{qraw, 768, rsq}}; gemm_phase<EpiElem8<FRowScale>, false, true>(lds, Gemm{P1, (const bf16_t*)(ws + O_WUQ), MA, 768, 384, 768, 384}, E); }
              { EpiElem8<FRowScale> E{{kn, 512, rskv}}; gemm_phase<EpiElem8<FRowScale>, false, true>(lds, Gemm{P1 + 384, wukv, MA, 512, 256, 768, 256}, E); }
              { EpiElem8<FVt> E{{Vt, rskv}}; gemm_phase<EpiElem8<FVt>, false, true>(lds, Gemm{wukv + (size_t)512 * 256, P1 + 384, 512, MA, 256, 256, 768}, E); }
              } break;
    case 10: phase_qk(p, l, smem); break;
    case 11: phase_attn(p, smem, !last); break;
    case 12: { { EpiElem8<FMergeA> E{{GATE, XNY}}; gemm_phase<EpiElem8<FMergeA>, false, true>(lds, Gemm{(const bf16_t*)p.out, (const bf16_t*)(ws + O_WOA), Mtail, DM, 512, 512, 512}, E); }
               { EpiElem8<FMergeB> E{{GATE, XNY}}; gemm_phase<EpiElem8<FMergeB>, false, true>(lds, Gemm{UXY, (const bf16_t*)(ws + O_WOL), Mtail, DM, 512, 1024, 512}, E); } } break;
    case 13: { EResid<2, true> E{X, X, mod + 5 * DM, mod + 7 * DM, UXY, SS + (size_t)2 * MA * 16}; gemm_phase<EResid<2, true>, false, true>(lds, Gemm{XNY, (const bf16_t*)(ws + O_WOUT), Mtail, DM, DM, DM, DM}, E); } break;
    case 15: { ESwiglu E{H, SS + (size_t)2 * MA * 16, shw + 2 * 5 * 5632}; gemm_phase<ESwiglu, false, true>(lds, Gemm{UXY, (const bf16_t*)(ws + O_WFF2IN), Mtail, 2 * DFF, DM, DM, DM}, E); } break;
    case 16: if (last) { EResid<1, false> E{X, p.out, mod + 8 * DM, nullptr, nullptr, nullptr}; gemm_phase<EResid<1, false>, false, true>(lds, Gemm{H, (const bf16_t*)(ws + O_WFF2OUT), Mtail, DM, DFF, DFF, DFF}, E); }
             else { EResid<1, true> E{X, X, mod + 8 * DM, mod + 5 * NMOD + DM, XNY, SS}; gemm_phase<EResid<1, true>, false, true>(lds, Gemm{H, (const bf16_t*)(ws + O_WFF2OUT), Mtail, DM, DFF, DFF, DFF}, E); }
             if (!last) { const int nthird = (MA / BM) * (DM / BM) - 2 * (int)gridDim.x, vb = (int)BIDX - nthird; if (nthird > 0 && nthird < (int)gridDim.x && vb >= 0) phase_prep_ff(p, l + 1, 0, (float*)smem, vb, (int)gridDim.x - nthird); else if (nthird <= 0 || nthird >= (int)gridDim.x) phase_prep_ff(p, l + 1, 0, (float*)smem, BIDX, gridDim.x); }
             break;
    }
}

#ifndef PROBE_MASK
#define PROBE_MASK 0u
#endif
#define XB_TMO      128
#define XB_XCNT(j)  (256  + 64 * (j))
#define XB_XSUB(j)  (1280 + 64 * (j))
#define XB_XGEN(j)  (2304 + 64 * (j))
#define XB_TOP      3328
#define XB_TOPGEN   3392
#define XCD_BAR_WORDS 3456
#define XB_SPIN_CAP (1u << 18)
DI unsigned xb_ld(unsigned* p)              { return __hip_atomic_load(p, __ATOMIC_RELAXED, __HIP_MEMORY_SCOPE_AGENT); }
DI unsigned xb_add(unsigned* p, unsigned v) { return __hip_atomic_fetch_add(p, v, __ATOMIC_RELAXED, __HIP_MEMORY_SCOPE_AGENT); }
DI unsigned xb_xcc_id() { return (unsigned)__builtin_amdgcn_s_getreg((3 << 11) | 20) & 0xFu; }
#define XB_SPIN(cond, bar) do { unsigned _sp = 0; while (cond) { __builtin_amdgcn_s_sleep(1); \
    if ((++_sp & 255u) == 0u) { if (xb_ld(&(bar)[XB_TMO])) break; if (_sp > XB_SPIN_CAP) { atomicAdd(&(bar)[XB_TMO], 1u); break; } } } } while (0)
struct XcdBarrier { unsigned* bar; unsigned x; volatile LAS unsigned* st; };
DI XcdBarrier xcd_barrier_post(unsigned* bar, volatile LAS unsigned* st) {
    XcdBarrier b; b.bar = bar; b.x = xb_xcc_id(); b.st = st;
    if (threadIdx.x == 0) (void)xb_add(&bar[XB_XCNT(b.x)], 1u);
    return b;
}
DI void xcd_barrier_complete(unsigned* bar, unsigned x, unsigned& nloc, unsigned& nx) {
    const unsigned G = gridDim.x * gridDim.y * gridDim.z;
    unsigned sum, cnt, mine, sp = 0u;
    for (;;) {
        sum = 0u; cnt = 0u; mine = 0u;
#pragma unroll
        for (unsigned j = 0; j < 16; ++j) { const unsigned c = xb_ld(&bar[XB_XCNT(j)]); sum += c; cnt += (c > 0u) ? 1u : 0u; mine = (j == x) ? c : mine; }
        if (sum == G) break;
        __builtin_amdgcn_s_sleep(1);
        if ((++sp & 255u) == 0u) { if (xb_ld(&bar[XB_TMO])) break; if (sp > XB_SPIN_CAP) { atomicAdd(&bar[XB_TMO], 1u); break; } }
    }
    nloc = mine > 0u ? mine : 1u; nx = cnt > 0u ? cnt : 1u;
}
DI void xcd_barrier(const XcdBarrier& b) {
    asm volatile("s_waitcnt vmcnt(0)" ::: "memory");
    __syncthreads();
    if (threadIdx.x == 0) {
        unsigned* bar = b.bar;
        __builtin_amdgcn_s_waitcnt(0);
        unsigned nloc = b.st[0], nx = b.st[1];
        if (nloc == 0u) { xcd_barrier_complete(bar, b.x, nloc, nx); b.st[0] = nloc; b.st[1] = nx; }
        const unsigned old = xb_add(&bar[XB_XSUB(b.x)], 1u);
        const unsigned gen = old / nloc;
        if (old + 1u == (gen + 1u) * nloc) {
            __builtin_amdgcn_fence(__ATOMIC_RELEASE, "agent");
            asm volatile("s_waitcnt vmcnt(0)" ::: "memory");
            const unsigned og = xb_add(&bar[XB_TOP], 1u);
            const unsigned tg = og / nx;
            if (og + 1u == (tg + 1u) * nx) xb_add(&bar[XB_TOPGEN], 1u);
            else XB_SPIN(xb_ld(&bar[XB_TOPGEN]) == tg, bar);
            __builtin_amdgcn_fence(__ATOMIC_ACQUIRE, "agent");
            xb_add(&bar[XB_XGEN(b.x)], 1u);
            asm volatile("s_waitcnt vmcnt(0)" ::: "memory");
        } else {
            XB_SPIN(xb_ld(&bar[XB_XGEN(b.x)]) == gen, bar);
            __builtin_amdgcn_fence(__ATOMIC_ACQUIRE, "agent");
            asm volatile("s_waitcnt vmcnt(0)" ::: "memory");
        }
    }
    __syncthreads();
}
__global__ void __launch_bounds__(512) mega(Params p) {
    extern __shared__ __attribute__((aligned(16))) unsigned char smem[];
    __shared__ uint4 xb_words;
    cg::grid_group grid = cg::this_grid();
    if (threadIdx.x == 0) xb_words = make_uint4(0u, 0u, 0u, 0u);
    __syncthreads();
    const XcdBarrier xb = xcd_barrier_post((unsigned*)(p.ws + O_BAR), (volatile LAS unsigned*)&xb_words);
    unsigned long long tsel = 0;
    for (int ph = p.ph_lo; ph < p.ph_hi; ++ph) {
        const unsigned long long t0 = PROBE_MASK ? wall_clock64() : 0ull;
        run_phase(p, ph, smem);
        if (p.coop && ph + 1 < p.ph_hi) { if (ph == 0) grid.sync(); else xcd_barrier(xb); }
        if (PROBE_MASK) { const int sidx = ph == 0 ? 17 : phase_case(ph); if ((PROBE_MASK >> sidx) & 1u) tsel += wall_clock64() - t0; }
    }
    if (PROBE_MASK && blockIdx.x == 0) { const unsigned long long t0 = wall_clock64(); while (wall_clock64() - t0 < tsel) __builtin_amdgcn_s_sleep(64); }
}

extern "C" void kernel_launch(void* const* d_in, const int* in_sizes, int n_in, void* d_out, int out_size, void* d_ws, size_t ws_size, hipStream_t stream) {
    static int grid = 0;
    if (grid == 0) {
        if (n_in != 27 || ws_size < WS_END) { fprintf(stderr, "kernel_launch: need 27 inputs and %zu bytes of workspace; got %d, %zu\n", (size_t)WS_END, n_in, ws_size); grid = -1; return; }
        int dev = 0, cus = 0, per_cu = 0;
        hipGetDevice(&dev); hipDeviceGetAttribute(&cus, hipDeviceAttributeMultiprocessorCount, dev);
        if (hipFuncSetAttribute((const void*)mega, hipFuncAttributeMaxDynamicSharedMemorySize, LDS_BYTES) != hipSuccess) { fprintf(stderr, "kernel_launch: hipFuncSetAttribute failed\n"); grid = -1; return; }
        if (hipOccupancyMaxActiveBlocksPerMultiprocessor(&per_cu, (const void*)mega, 512, LDS_BYTES) != hipSuccess || per_cu < 1) { fprintf(stderr, "kernel_launch: occupancy query gave %d\n", per_cu); per_cu = 1; }
        (void)hipGetLastError();
        grid = cus;
    }
    if (grid < 0) return;
    Params p{};
    const float** pp = (const float**)&p;
    for (int i = 0; i < 27; ++i) pp[i] = (const float*)d_in[i];
    p.out = (float*)d_out; p.ws = (unsigned char*)d_ws; p.ph_lo = 0; p.ph_hi = N_PHASES; p.coop = 1; p.pad = 0;
    (void)hipMemsetAsync((unsigned char*)d_ws + O_BAR, 0, XCD_BAR_WORDS * 4, stream);
    void* args[] = {&p};
    hipError_t e = hipLaunchCooperativeKernel((const void*)mega, dim3(grid), dim3(512), args, LDS_BYTES, stream);
    if (e != hipSuccess) {
        fprintf(stderr, "cooperative launch failed: %s (grid %d); falling back to one launch per phase\n", hipGetErrorString(e), grid);
        (void)hipGetLastError();
        p.coop = 0;
        for (int ph = 0; ph < N_PHASES; ++ph) { p.ph_lo = ph; p.ph_hi = ph + 1; hipLaunchKernelGGL(mega, dim3(grid), dim3(512), LDS_BYTES, stream, p); }
    }
}
```

```cpp
#include <hip/hip_runtime.h>
#include <hip/hip_cooperative_groups.h>
#include <cstdio>
namespace cg = cooperative_groups;

#define DI __device__ __forceinline__
#define LAS __attribute__((address_space(3)))
typedef unsigned short bf16_t;
typedef short bf16x8 __attribute__((ext_vector_type(8)));
typedef float f32x2 __attribute__((ext_vector_type(2)));
typedef float f32x4 __attribute__((ext_vector_type(4)));
typedef float f32x16 __attribute__((ext_vector_type(16)));
typedef unsigned u32x2 __attribute__((ext_vector_type(2)));
typedef unsigned u32x4 __attribute__((ext_vector_type(4)));
typedef __bf16 bfv2 __attribute__((ext_vector_type(2)));

constexpr int DM = 1024, NB = 4, SEQ = 8192, CTXL = 256, DEPTH = 4;
constexpr int ML = NB * SEQ, MC = NB * CTXL, MA = ML + MC;
constexpr int DFF = 2816, NH = 8, TK = SEQ + CTXL;
constexpr int NIN = 3840;
constexpr int NMOD = 9 * DM;
constexpr float EPS = 1e-6f;
constexpr float QSCALE = 0.10206207261596577f * 1.4426950408889634f;
constexpr int NCH = 132;

constexpr size_t SZ_FFIN = (size_t)2 * DFF * DM * 2, SZ_FFOUT = (size_t)DM * DFF * 2;
constexpr size_t O_WFF1IN = 0;
constexpr size_t O_WFF1OUT = O_WFF1IN + SZ_FFIN;
constexpr size_t O_WFF2IN = O_WFF1OUT + SZ_FFOUT;
constexpr size_t O_WFF2OUT = O_WFF2IN + SZ_FFIN;
constexpr size_t O_WIN = O_WFF2OUT + SZ_FFOUT;
constexpr size_t O_WUQ = O_WIN + (size_t)NIN * DM * 2;
constexpr size_t O_WUKV = O_WUQ + (size_t)768 * 384 * 2;
constexpr size_t O_WOA = O_WUKV + (size_t)1024 * 256 * 2;
constexpr size_t O_WOL = O_WOA + (size_t)1024 * 512 * 2;
constexpr size_t O_WOUT = O_WOL + (size_t)1024 * 512 * 2;
constexpr size_t O_WGATE = O_WOUT + (size_t)1024 * 1024 * 2;
constexpr size_t O_MOD = O_WGATE + (size_t)2048 * 256 * 2;
constexpr size_t O_RSQ = O_MOD + (size_t)DEPTH * 5 * NMOD * 4;
constexpr size_t O_RSKV = O_RSQ + (size_t)MA * 4;
constexpr size_t O_AGG = O_RSKV + (size_t)MA * 4;
constexpr size_t O_SP = O_AGG + (size_t)2 * NB * NCH * 512 * 8;
constexpr size_t O_BAR = O_SP + 4096;
constexpr size_t O_SS = O_BAR + 16384;
constexpr size_t O_SHW = O_SS + (size_t)3 * MA * 16 * 4;
constexpr size_t O_X = O_SHW + (size_t)3 * 5 * 5632 * 4;
constexpr size_t O_R1 = O_X + (size_t)MA * DM * 4;
constexpr size_t O_UXY = O_R1 + (size_t)MA * DFF * 2;
constexpr size_t O_XNY = O_UXY + (size_t)MA * 1024 * 2;
constexpr size_t O_S = O_XNY + (size_t)MA * 1024 * 2;
constexpr size_t WS_END = O_S + (size_t)MA * 1024 * 4;
constexpr int LDS_BYTES = 131072;

struct Params {
    const float *x, *c, *ctx, *c_ctx, *w_ada, *b_ada, *ff1_w_in, *ff1_w_out, *ff2_w_in, *ff2_w_out, *w_in, *q_a_norm, *w_uq, *kv_a_norm, *w_ukv, *q_norm, *k_norm,
        *conv_w, *conv_b, *lru_lambda, *w_rgate, *b_rgate, *w_igate, *b_igate, *w_o_attn, *w_o_lru, *w_out;
    float* out; unsigned char* ws;
    int ph_lo, ph_hi, coop, pad;
};

DI int tidx_() { int t = threadIdx.x; asm volatile("" : "+v"(t)); return t; }
DI int bidx_() { int t = blockIdx.x; asm volatile("" : "+s"(t)); return t; }
#define TIDX tidx_()
#define BIDX bidx_()
DI unsigned pk2(float lo, float hi) { f32x2 v = {lo, hi}; bfv2 r = __builtin_convertvector(v, bfv2); return __builtin_bit_cast(unsigned, r); }
DI bf16_t f2bf(float x) { return (bf16_t)(pk2(x, 0.f) & 0xffffu); }
DI float bf2f(bf16_t v) { return __uint_as_float((unsigned)v << 16); }
DI float bflo(unsigned v) { return __uint_as_float(v << 16); }
DI float bfhi(unsigned v) { return __uint_as_float(v & 0xffff0000u); }
DI float wave_sum(float v) {
#pragma unroll
    for (int o = 1; o < 64; o <<= 1) v += __shfl_xor(v, o);
    return v;
}
DI float sigmoidf_(float x) { return __builtin_amdgcn_rcpf(1.f + __expf(-x)); }
DI int mod_row(int row) { return row < ML ? (row >> 13) : 4; }
DI float row_rstd(const float* SSP, int row) {
    const f32x4* q = (const f32x4*)(SSP + (size_t)row * 16); const f32x4 a = q[0], b = q[1], c = q[2], d = q[3];
    const float s = ((a[0] + a[1]) + (a[2] + a[3])) + ((b[0] + b[1]) + (b[2] + b[3])) + ((c[0] + c[1]) + (c[2] + c[3])) + ((d[0] + d[1]) + (d[2] + d[3]));
    return __builtin_amdgcn_rsqf(s * (1.f / DM) + EPS);
}

constexpr int BM = 256, BK = 64, HALF = 128, HTB = HALF * BK * 2, NXCD = 8, WGM = 8;
DI int lds_byte(int r, int c) { const int st = (r >> 4) * 2 + (c >> 5), rr = r & 15, cc = c & 31, ob = rr * 64 + cc * 2; return st * 1024 + (ob ^ (((ob >> 9) & 1) << 5)); }
DI void stage_rc(int b, int& R, int& C) { const int st = b / 1024, sb = b % 1024, swz = sb ^ (((sb >> 9) & 1) << 5); R = (st >> 1) * 16 + swz / 64; C = (st & 1) * 32 + (swz % 64) / 2; }
struct Unit { int pm, pn; };
struct Gemm { const bf16_t* A; const bf16_t* Bt; int M, N, K, lda, ldb; int rot = 0; };
struct StaticOrder {
    int nM, nN, nwg, G, c;
    DI void init(int M, int N, int G_, int c_) { nM = M / BM; nN = N / BM; nwg = nM * nN; G = G_; c = c_; }
    DI bool next(int i, Unit& u) const {
        const long L = (long)i * G + c; if (L >= nwg) return false;
        int wgid = (int)L; { const int q = nwg / NXCD, r = nwg % NXCD, xcd = wgid % NXCD, off = wgid / NXCD; wgid = (xcd < r ? xcd * (q + 1) : r * (q + 1) + (xcd - r) * q) + off; }
        const int nig = WGM * nN, gid = wgid / nig, fm = gid * WGM, gsz = (nM - fm) < WGM ? (nM - fm) : WGM;
        u.pm = fm + ((wgid % nig) % gsz); u.pn = (wgid % nig) / gsz; return true;
    }
};

DI int perm32(int rho) { const int n = rho >> 4, i = rho & 15; return 8 * (i >> 2) + 4 * n + (i & 3); }
template <class Epi, bool GATE_A, bool PERM = false>
DI void gemm_phase(LAS unsigned char* lds, const Gemm g, const Epi& E) {
    const int tid = TIDX, wid = __builtin_amdgcn_readfirstlane(tid >> 6), lane = tid & 63, wr = wid >> 2, wc = wid & 3, fr = lane & 15, fq = lane >> 4;
    const int K = g.K, nt = K / BK;
    StaticOrder S; S.init(g.M, g.N, gridDim.x, (BIDX - g.rot + (int)gridDim.x) % (int)gridDim.x);
    unsigned voffA[2], voffB[2];
#pragma unroll
    for (int i = 0; i < 2; ++i) { int R, C; stage_rc(tid * 16 + i * 8192, R, C); const int Rb = PERM ? ((R & ~31) + perm32(R & 31)) : R; voffA[i] = (unsigned)(R * g.lda + C) * 2u; voffB[i] = (unsigned)(Rb * g.ldb + C) * 2u; }
#pragma unroll
    for (int i = 0; i < 2; ++i) { asm volatile("" : "+v"(voffA[i])); asm volatile("" : "+v"(voffB[i])); }
    const size_t kstep = (size_t)(BK * 2);
    const size_t hstepA = (size_t)HALF * g.lda * 2, hstepB = (size_t)HALF * g.ldb * 2;
    const size_t tstepA = 2 * hstepA, tstepB = 2 * hstepB;
    const unsigned ldsw = (unsigned)wid * 1024u;
    const int aoff = lds_byte(wr * 64 + fr, fq * 8), boff = lds_byte(wc * 32 + fr, fq * 8);
#define PG8_SA(b, h) (((b) * 2 + (h)) * HTB)
#define PG8_SB(b, h) ((4 + (b) * 2 + (h)) * HTB)
#define PG8_STAGE(bufoff, gbase, voff) do { _Pragma("unroll") for (int _i = 0; _i < 2; ++_i) \
        __builtin_amdgcn_global_load_lds((const unsigned*)((const char*)(gbase) + (voff)[_i]), (LAS unsigned*)(lds + (bufoff) + ldsw + _i * 8192), 16, 0, 0); } while (0)
#define PG8_LDA(dst, b, h) do { _Pragma("unroll") for (int m = 0; m < 4; ++m) _Pragma("unroll") for (int k = 0; k < 2; ++k) dst[m][k] = *(const LAS bf16x8*)(lds + PG8_SA(b, h) + aoff + m * 2048 + k * 1024); } while (0)
#define PG8_LDB(dst, b, h) do { _Pragma("unroll") for (int n = 0; n < 2; ++n) _Pragma("unroll") for (int k = 0; k < 2; ++k) dst[n][k] = *(const LAS bf16x8*)(lds + PG8_SB(b, h) + boff + n * 2048 + k * 1024); } while (0)
#define PG8_MMA(ai, bj, At, Bt) do { __builtin_amdgcn_s_setprio(1); _Pragma("unroll") for (int m = 0; m < 4; ++m) _Pragma("unroll") for (int n = 0; n < 2; ++n) _Pragma("unroll") for (int k = 0; k < 2; ++k) \
        acc[ai][bj][m][n] = __builtin_amdgcn_mfma_f32_16x16x32_bf16(Bt[n][k], At[m][k], acc[ai][bj][m][n], 0, 0, 0); __builtin_amdgcn_s_setprio(0); } while (0)
#define PG8_WAIT_V(n) asm volatile("s_waitcnt vmcnt(" #n ")" ::: "memory")
#define PG8_WAIT_L(n) asm volatile("s_waitcnt lgkmcnt(" #n ")" ::: "memory")
#define PG8_BAR __builtin_amdgcn_s_barrier()
#define PG8_SCHED __builtin_amdgcn_sched_barrier(0)
#define PG8_ABASE(u) ((const char*)g.A + (size_t)(u).pm * tstepA + (GATE_A ? (size_t)((((u).pn & 3) >> 1) * 512) : (size_t)0))
    Unit cur, nxt; int ui = 0;
    if (!S.next(0, cur)) return;
    f32x4 acc[2][2][4][2];
#pragma unroll
    for (int a = 0; a < 2; ++a)
#pragma unroll
        for (int b = 0; b < 2; ++b)
#pragma unroll
            for (int m = 0; m < 4; ++m)
#pragma unroll
                for (int n = 0; n < 2; ++n) acc[a][b][m][n] = (f32x4){0.f, 0.f, 0.f, 0.f};
    bf16x8 At[4][2], B0[2][2], B1[2][2];
    const char* cA = PG8_ABASE(cur); const char* cB = (const char*)g.Bt + (size_t)cur.pn * tstepB;
    PG8_STAGE(PG8_SB(0, 0), cB, voffB); PG8_STAGE(PG8_SA(0, 0), cA, voffA); PG8_STAGE(PG8_SB(0, 1), cB + hstepB, voffB); PG8_STAGE(PG8_SA(0, 1), cA + hstepA, voffA);
    if (wr == 1) PG8_BAR;
    PG8_WAIT_V(4); PG8_BAR;
    PG8_STAGE(PG8_SB(1, 0), cB + kstep, voffB); PG8_STAGE(PG8_SA(1, 0), cA + kstep, voffA); PG8_STAGE(PG8_SB(1, 1), cB + hstepB + kstep, voffB);
    PG8_WAIT_V(6); PG8_BAR;
    for (;;) {
        const bool has_next = S.next(ui + 1, nxt);
        const char* nA = has_next ? PG8_ABASE(nxt) : cA; const char* nB = has_next ? (const char*)g.Bt + (size_t)nxt.pn * tstepB : cB;
#pragma nounroll
        for (int t = 0; t < nt; t += 2) {
            const bool last = (t == nt - 2);
            const char* a1 = cA + (size_t)(t + 1) * kstep;
            const char* a2 = last ? nA : cA + (size_t)(t + 2) * kstep; const char* b2 = last ? nB : cB + (size_t)(t + 2) * kstep;
            const char* a3 = a2 + kstep; const char* b3 = b2 + kstep;
            PG8_LDB(B0, 0, 0); PG8_SCHED; PG8_LDA(At, 0, 0); PG8_STAGE(PG8_SA(1, 1), a1 + hstepA, voffA);
            PG8_WAIT_L(8); PG8_BAR; PG8_WAIT_L(0); PG8_MMA(0, 0, At, B0); PG8_BAR; PG8_SCHED;
            PG8_LDB(B1, 0, 1); PG8_STAGE(PG8_SB(0, 0), b2, voffB);
            PG8_BAR; PG8_WAIT_L(0); PG8_MMA(0, 1, At, B1); PG8_BAR;
            PG8_LDA(At, 0, 1); PG8_STAGE(PG8_SA(0, 0), a2, voffA);
            PG8_BAR; PG8_WAIT_L(0); PG8_MMA(1, 0, At, B0); PG8_BAR; PG8_SCHED;
            PG8_STAGE(PG8_SB(0, 1), b2 + hstepB, voffB);
            PG8_WAIT_V(6); PG8_BAR; PG8_MMA(1, 1, At, B1); PG8_BAR;
            PG8_LDB(B0, 1, 0); PG8_SCHED; PG8_LDA(At, 1, 0); PG8_STAGE(PG8_SA(0, 1), a2 + hstepA, voffA);
            PG8_WAIT_L(8); PG8_BAR; PG8_WAIT_L(0); PG8_MMA(0, 0, At, B0); PG8_BAR; PG8_SCHED;
            PG8_LDB(B1, 1, 1); PG8_STAGE(PG8_SB(1, 0), b3, voffB);
            PG8_BAR; PG8_WAIT_L(0); PG8_MMA(0, 1, At, B1); PG8_BAR;
            PG8_LDA(At, 1, 1); PG8_STAGE(PG8_SA(1, 0), a3, voffA);
            PG8_BAR; PG8_WAIT_L(0); PG8_MMA(1, 0, At, B0); PG8_BAR; PG8_SCHED;
            PG8_STAGE(PG8_SB(1, 1), b3 + hstepB, voffB);
            PG8_WAIT_V(6); PG8_BAR; PG8_MMA(1, 1, At, B1); PG8_BAR;
        }
        E(acc, cur, wr, wc, fr, fq);
        if (!has_next) break;
#pragma unroll
        for (int a = 0; a < 2; ++a)
#pragma unroll
            for (int b = 0; b < 2; ++b)
#pragma unroll
                for (int m = 0; m < 4; ++m)
#pragma unroll
                    for (int n = 0; n < 2; ++n) acc[a][b][m][n] = (f32x4){0.f, 0.f, 0.f, 0.f};
        cur = nxt; cA = nA; cB = nB; ++ui;
    }
    PG8_WAIT_V(0);
    if (wr == 0) PG8_BAR;
    PG8_BAR;
#undef PG8_SA
#undef PG8_SB
#undef PG8_STAGE
#undef PG8_LDA
#undef PG8_LDB
#undef PG8_MMA
#undef PG8_WAIT_V
#undef PG8_WAIT_L
#undef PG8_BAR
#undef PG8_SCHED
#undef PG8_ABASE
}

template <class F> struct EpiElem {
    F f;
    DI void operator()(const f32x4 (&acc)[2][2][4][2], const Unit& u, int wr, int wc, int fr, int fq) const {
        const int row0 = u.pm * BM + wr * 64 + fr, col0 = u.pn * BM + wc * 32 + 4 * fq;
#pragma unroll
        for (int ai = 0; ai < 2; ++ai)
#pragma unroll
            for (int m = 0; m < 4; ++m)
#pragma unroll
                for (int bj = 0; bj < 2; ++bj)
#pragma unroll
                    for (int n = 0; n < 2; ++n) { f(row0 + ai * HALF + m * 16, col0 + bj * HALF + n * 16, acc[ai][bj][m][n]); }
    }
};
template <class F> struct EpiElemRow {
    F f;
    DI void operator()(const f32x4 (&acc)[2][2][4][2], const Unit& u, int wr, int wc, int fr, int fq) const {
        const int row0 = u.pm * BM + wr * 64 + fr, col0 = u.pn * BM + wc * 32 + 4 * fq;
#pragma unroll
        for (int ai = 0; ai < 2; ++ai)
#pragma unroll
            for (int m = 0; m < 4; ++m) {
                float ssq = 0.f;
#pragma unroll
                for (int bj = 0; bj < 2; ++bj)
#pragma unroll
                    for (int n = 0; n < 2; ++n) { ssq += f(row0 + ai * HALF + m * 16, col0 + bj * HALF + n * 16, acc[ai][bj][m][n]); }
                ssq += __shfl_xor(ssq, 16); ssq += __shfl_xor(ssq, 32);
                if (fq == 0) f.row(row0 + ai * HALF + m * 16, (u.pn & 3) * 4 + wc, ssq);
            }
    }
};
template <class F> struct EpiElemRS {
    F f;
    DI void operator()(const f32x4 (&acc)[2][2][4][2], const Unit& u, int wr, int wc, int fr, int fq) const {
        const int row0 = u.pm * BM + wr * 64 + fr, col0 = u.pn * BM + wc * 32 + 4 * fq;
#pragma unroll
        for (int ai = 0; ai < 2; ++ai)
#pragma unroll
            for (int m = 0; m < 4; ++m) {
                const float rs = f.rs(row0 + ai * HALF + m * 16);
#pragma unroll
                for (int bj = 0; bj < 2; ++bj)
#pragma unroll
                    for (int n = 0; n < 2; ++n) { f(row0 + ai * HALF + m * 16, col0 + bj * HALF + n * 16, acc[ai][bj][m][n], rs); }
            }
    }
};
template <class F> struct EpiPairRS {
    F f;
    DI void operator()(const f32x4 (&acc)[2][2][4][2], const Unit& u, int wr, int wc, int fr, int fq) const {
        const int row0 = u.pm * BM + wr * 64 + fr, c0 = wc * 32 + 4 * fq;
#pragma unroll
        for (int ai = 0; ai < 2; ++ai)
#pragma unroll
            for (int m = 0; m < 4; ++m) {
                const float rs = f.rs(row0 + ai * HALF + m * 16);
#pragma unroll
                for (int n = 0; n < 2; ++n) { f(row0 + ai * HALF + m * 16, u.pn, c0 + n * 16, acc[ai][0][m][n], acc[ai][1][m][n], rs); }
            }
    }
};
template <class F> struct EpiElem2 {
    F f;
    DI void operator()(const f32x4 (&acc)[2][2][4][2], const Unit& u, int wr, int wc, int fr, int fq) const {
        const int row0 = u.pm * BM + wr * 64 + fr, col0 = u.pn * BM + wc * 32 + 4 * fq;
        typename F::L cur[2][2], nxt[2][2];
#pragma unroll
        for (int bj = 0; bj < 2; ++bj)
#pragma unroll
            for (int n = 0; n < 2; ++n) cur[bj][n] = f.load(row0, col0 + bj * HALF + n * 16);
#pragma unroll
        for (int i = 0; i < 8; ++i) {
            const int row = row0 + (i >> 2) * HALF + (i & 3) * 16;
            if (i < 7) { const int rown = row0 + ((i + 1) >> 2) * HALF + ((i + 1) & 3) * 16;
#pragma unroll
                for (int bj = 0; bj < 2; ++bj)
#pragma unroll
                    for (int n = 0; n < 2; ++n) nxt[bj][n] = f.load(rown, col0 + bj * HALF + n * 16); }
#pragma unroll
            for (int bj = 0; bj < 2; ++bj)
#pragma unroll
                for (int n = 0; n < 2; ++n) f.apply(row, col0 + bj * HALF + n * 16, acc[i >> 2][bj][i & 3][n], cur[bj][n]);
#pragma unroll
            for (int bj = 0; bj < 2; ++bj)
#pragma unroll
                for (int n = 0; n < 2; ++n) cur[bj][n] = nxt[bj][n];
        }
    }
};
template <class F> struct EpiElem8 {
    F f;
    DI void operator()(const f32x4 (&acc)[2][2][4][2], const Unit& u, int wr, int wc, int fr, int fq) const {
        const int row0 = u.pm * BM + wr * 64 + fr, col0 = u.pn * BM + wc * 32 + 8 * fq;
        typename F::L cur[2], nxt[2];
#pragma unroll
        for (int bj = 0; bj < 2; ++bj) cur[bj] = f.load(row0, col0 + bj * HALF);
#pragma unroll
        for (int i = 0; i < 8; ++i) {
            const int row = row0 + (i >> 2) * HALF + (i & 3) * 16;
            if (i < 7) { const int rown = row0 + ((i + 1) >> 2) * HALF + ((i + 1) & 3) * 16;
#pragma unroll
                for (int bj = 0; bj < 2; ++bj) nxt[bj] = f.load(rown, col0 + bj * HALF); }
#pragma unroll
            for (int bj = 0; bj < 2; ++bj) f.apply(row, col0 + bj * HALF, acc[i >> 2][bj][i & 3][0], acc[i >> 2][bj][i & 3][1], cur[bj]);
#pragma unroll
            for (int bj = 0; bj < 2; ++bj) cur[bj] = nxt[bj];
        }
    }
};
template <class F> struct EpiPair {
    F f;
    DI void operator()(const f32x4 (&acc)[2][2][4][2], const Unit& u, int wr, int wc, int fr, int fq) const {
        const int row0 = u.pm * BM + wr * 64 + fr, c0 = wc * 32 + 4 * fq;
#pragma unroll
        for (int ai = 0; ai < 2; ++ai)
#pragma unroll
            for (int m = 0; m < 4; ++m)
#pragma unroll
                for (int n = 0; n < 2; ++n) { f(row0 + ai * HALF + m * 16, u.pn, c0 + n * 16, acc[ai][0][m][n], acc[ai][1][m][n]); }
    }
};
DI void st_bf4(bf16_t* p, f32x4 v) { u32x2 o; o.x = pk2(v[0], v[1]); o.y = pk2(v[2], v[3]); *(u32x2*)p = o; }
DI void st_bf8(bf16_t* p, f32x4 lo, f32x4 hi) { u32x4 o; o.x = pk2(lo[0], lo[1]); o.y = pk2(lo[2], lo[3]); o.z = pk2(hi[0], hi[1]); o.w = pk2(hi[2], hi[3]); *(u32x4*)p = o; }

struct FSwiglu { bf16_t* H; const float* SS; const float* shw;
    DI float rs(int row) const { return row_rstd(SS, row); }
    DI void operator()(int row, int pn, int c, f32x4 g, f32x4 u, float rs) const {
        const float* sw = shw + mod_row(row) * 5632 + pn * 256 + c;
        g = g * rs + *(const f32x4*)sw; u = u * rs + *(const f32x4*)(sw + 128);
        f32x4 h;
#pragma unroll
        for (int e = 0; e < 4; ++e) h[e] = g[e] * sigmoidf_(g[e]) * u[e];
        st_bf4(H + (size_t)row * DFF + pn * 128 + c, h);
    } };
struct FResid { const float* src; float* dst; const float* mod; float coef;
    DI void operator()(int row, int col, f32x4 v) const {
        const f32x4 g = *(const f32x4*)(mod + mod_row(row) * NMOD + col);
        const f32x4 x = *(const f32x4*)(src + (size_t)row * DM + col);
        *(f32x4*)(dst + (size_t)row * DM + col) = x + coef * g * v;
    } };
template <int COEF2> struct FResidN { const float* src; float* dst; const float* mod; const float* scn; bf16_t* XS; float* SS;
    DI float operator()(int row, int col, f32x4 v) const {
        const int r = mod_row(row);
        const f32x4 g = *(const f32x4*)(mod + r * NMOD + col);
        const f32x4 x = *(const f32x4*)(src + (size_t)row * DM + col);
        const f32x4 xn = x + (0.5f * COEF2) * g * v;
        *(f32x4*)(dst + (size_t)row * DM + col) = xn;
        const f32x4 sc = *(const f32x4*)(scn + r * NMOD + col);
        st_bf4(XS + (size_t)row * DM + col, xn * (1.f + sc));
        return (xn[0] * xn[0] + xn[1] * xn[1]) + (xn[2] * xn[2] + xn[3] * xn[3]);
    }
    DI void row(int row, int slot, float ssq) const { SS[(size_t)row * 16 + slot] = ssq; } };
struct FWin { bf16_t *P1, *UXY, *GATE; const float* SS; const float* shw;
    DI float rs(int row) const { return row_rstd(SS, row); }
    DI void operator()(int row, int col, f32x4 v, float rs) const {
        v = v * rs + *(const f32x4*)(shw + mod_row(row) * 5632 + col);
        bf16_t* p = col < 768 ? P1 + (size_t)row * 768 + col : (col < 1792 ? UXY + (size_t)row * 1024 + (col - 768) : GATE + (size_t)row * 2048 + (col - 1792));
        st_bf4(p, v);
    } };
struct FRowScale { bf16_t* dst; int ld; const float* rs;
    typedef float L;
    DI L load(int row, int) const { return rs[row]; }
    DI void apply(int row, int col, f32x4 v0, f32x4 v1, L sc) const { st_bf8(dst + (size_t)row * ld + col, v0 * sc, v1 * sc); } };
struct FVt { bf16_t* Vt; const float* rs;
    struct L { f32x4 a, b; };
    DI L load(int, int col) const { return L{*(const f32x4*)(rs + col), *(const f32x4*)(rs + col + 4)}; }
    DI void apply(int row, int col, f32x4 v0, f32x4 v1, L sc) const {
        int b, kpos; if (col < ML) { b = col >> 13; kpos = col & (SEQ - 1); } else { const int r = col - ML; b = r >> 8; kpos = SEQ + (r & 255); }
        st_bf8(Vt + ((size_t)(b * NH + (row >> 6)) * 64 + (row & 63)) * TK + kpos, v0 * sc.a, v1 * sc.b);
    } };
struct EGate { const bf16_t* xc; bf16_t *OM, *BB; const float *sp8, *br, *bi;
    DI void operator()(const f32x4 (&acc)[2][2][4][2], const Unit& u, int wr, int wc, int fr, int fq) const {
        const int row0 = u.pm * BM + wr * 64 + fr, d = u.pn >> 2, ch0 = (u.pn & 3) * 128 + wc * 32 + 8 * fq;
        f32x4 s4[2], br4[2], bi4[2]; u32x4 xcur, xnxt;
#pragma unroll
        for (int n = 0; n < 2; ++n) { s4[n] = *(const f32x4*)(sp8 + d * 512 + ch0 + 4 * n); br4[n] = *(const f32x4*)(br + d * 512 + ch0 + 4 * n); bi4[n] = *(const f32x4*)(bi + d * 512 + ch0 + 4 * n); }
        xcur = *(const u32x4*)(xc + (size_t)row0 * 512 + ch0);
#pragma unroll
        for (int i = 0; i < 8; ++i) {
            const int row = row0 + (i >> 2) * HALF + (i & 3) * 16;
            if (i < 7) { const int rown = row0 + ((i + 1) >> 2) * HALF + ((i + 1) & 3) * 16; xnxt = *(const u32x4*)(xc + (size_t)rown * 512 + ch0); }
            f32x4 om[2], bb[2];
#pragma unroll
            for (int n = 0; n < 2; ++n) {
                const f32x4 r4 = acc[i >> 2][0][i & 3][n], i4 = acc[i >> 2][1][i & 3][n];
                const unsigned w0 = n == 0 ? xcur.x : xcur.z, w1 = n == 0 ? xcur.y : xcur.w;
                const f32x4 xf = {bflo(w0), bfhi(w0), bflo(w1), bfhi(w1)};
#pragma unroll
                for (int e = 0; e < 4; ++e) {
                    const float r = sigmoidf_(r4[e] + br4[n][e]), ig = sigmoidf_(i4[e] + bi4[n][e]);
                    const float a = __expf(s4[n][e] * r);
                    om[n][e] = 1.f - a; bb[n][e] = __fsqrt_rn(fmaxf(1.f - a * a, 0.f)) * (ig * xf[e]);
                }
            }
            const size_t o = ((size_t)d * MA + row) * 512 + ch0;
            st_bf8(OM + o, om[0], om[1]); st_bf8(BB + o, bb[0], bb[1]);
            xcur = xnxt;
        }
    } };
DI f32x4 sig_lo(u32x4 g) { return (f32x4){sigmoidf_(bflo(g.x)), sigmoidf_(bfhi(g.x)), sigmoidf_(bflo(g.y)), sigmoidf_(bfhi(g.y))}; }
DI f32x4 sig_hi(u32x4 g) { return (f32x4){sigmoidf_(bflo(g.z)), sigmoidf_(bfhi(g.z)), sigmoidf_(bflo(g.w)), sigmoidf_(bfhi(g.w))}; }
struct FMergeA { const bf16_t* GATE; bf16_t* Y;
    typedef u32x4 L;
    DI L load(int row, int col) const { return *(const u32x4*)(GATE + (size_t)row * 2048 + col); }
    DI void apply(int row, int col, f32x4 v0, f32x4 v1, L gv) const { st_bf8(Y + (size_t)row * DM + col, sig_lo(gv) * v0, sig_hi(gv) * v1); } };
struct FMergeB { const bf16_t* GATE; bf16_t* Y;
    struct L { u32x4 g, y; };
    DI L load(int row, int col) const { return L{*(const u32x4*)(GATE + (size_t)row * 2048 + 1024 + col), *(const u32x4*)(Y + (size_t)row * DM + col)}; }
    DI void apply(int row, int col, f32x4 v0, f32x4 v1, L q) const {
        const f32x4 y0 = {bflo(q.y.x), bfhi(q.y.x), bflo(q.y.y), bfhi(q.y.y)}, y1 = {bflo(q.y.z), bfhi(q.y.z), bflo(q.y.w), bfhi(q.y.w)};
        st_bf8(Y + (size_t)row * DM + col, y0 + sig_lo(q.g) * v0, y1 + sig_hi(q.g) * v1);
    } };

struct ESwiglu { bf16_t* H; const float* SS; const float* shw;
    DI void operator()(const f32x4 (&acc)[2][2][4][2], const Unit& u, int wr, int wc, int fr, int fq) const {
        const int row0 = u.pm * BM + wr * 64 + fr, c0 = wc * 32 + 8 * fq;
        const float* sw = shw + mod_row(u.pm * BM) * 5632 + u.pn * 256 + c0;
        f32x4 sg[2], su[2]; float rs[8];
#pragma unroll
        for (int n = 0; n < 2; ++n) { sg[n] = *(const f32x4*)(sw + 4 * n); su[n] = *(const f32x4*)(sw + 128 + 4 * n); }
#pragma unroll
        for (int i = 0; i < 8; ++i) rs[i] = row_rstd(SS, row0 + (i >> 2) * HALF + (i & 3) * 16);
#pragma unroll
        for (int ai = 0; ai < 2; ++ai)
#pragma unroll
            for (int m = 0; m < 4; ++m) {
                f32x4 h[2];
#pragma unroll
                for (int n = 0; n < 2; ++n) {
                    const f32x4 g = acc[ai][0][m][n] * rs[ai * 4 + m] + sg[n], uu = acc[ai][1][m][n] * rs[ai * 4 + m] + su[n];
#pragma unroll
                    for (int e = 0; e < 4; ++e) h[n][e] = g[e] * sigmoidf_(g[e]) * uu[e];
                }
                st_bf8(H + (size_t)(row0 + ai * HALF + m * 16) * DFF + u.pn * 128 + c0, h[0], h[1]);
            }
    } };
struct EWin { bf16_t *P1, *UXY, *GATE; const float* SS; const float* shw;
    template <int LD> DI void body(const f32x4 (&acc)[2][2][4][2], bf16_t* dst, const f32x4 (&sh)[2][2], const float (&rs)[8]) const {
#pragma unroll
        for (int ai = 0; ai < 2; ++ai)
#pragma unroll
            for (int m = 0; m < 4; ++m)
#pragma unroll
                for (int bj = 0; bj < 2; ++bj)
                    st_bf8(dst + (size_t)(ai * HALF + m * 16) * LD + 128 * bj, acc[ai][bj][m][0] * rs[ai * 4 + m] + sh[bj][0], acc[ai][bj][m][1] * rs[ai * 4 + m] + sh[bj][1]);
    }
    DI void operator()(const f32x4 (&acc)[2][2][4][2], const Unit& u, int wr, int wc, int fr, int fq) const {
        const int row0 = u.pm * BM + wr * 64 + fr, c0 = wc * 32 + 8 * fq;
        const float* sw = shw + mod_row(u.pm * BM) * 5632 + u.pn * 256 + c0;
        f32x4 sh[2][2]; float rs[8];
#pragma unroll
        for (int bj = 0; bj < 2; ++bj)
#pragma unroll
            for (int n = 0; n < 2; ++n) sh[bj][n] = *(const f32x4*)(sw + 128 * bj + 4 * n);
#pragma unroll
        for (int i = 0; i < 8; ++i) { rs[i] = row_rstd(SS, row0 + (i >> 2) * HALF + (i & 3) * 16); if ((i & 1) == 1) __builtin_amdgcn_sched_barrier(0); }
        if (u.pn < 3) body<768>(acc, P1 + (size_t)row0 * 768 + u.pn * 256 + c0, sh, rs);
        else if (u.pn < 7) body<1024>(acc, UXY + (size_t)row0 * 1024 + (u.pn - 3) * 256 + c0, sh, rs);
        else body<2048>(acc, GATE + (size_t)row0 * 2048 + (u.pn - 7) * 256 + c0, sh, rs);
    } };
template <int COEF2, bool NORM> struct EResid { const float* src; float* dst; const float* mod; const float* scn; bf16_t* XS; float* SS;
    DI void operator()(const f32x4 (&acc)[2][2][4][2], const Unit& u, int wr, int wc, int fr, int fq) const {
        const int row0 = u.pm * BM + wr * 64 + fr, col0 = u.pn * BM + wc * 32 + 8 * fq, r = mod_row(u.pm * BM);
        f32x4 g[2][2], sc[2][2];
#pragma unroll
        for (int bj = 0; bj < 2; ++bj)
#pragma unroll
            for (int n = 0; n < 2; ++n) { g[bj][n] = *(const f32x4*)(mod + r * NMOD + col0 + 128 * bj + 4 * n) * (0.5f * COEF2);
                if (NORM) sc[bj][n] = *(const f32x4*)(scn + r * NMOD + col0 + 128 * bj + 4 * n) + 1.f; }
        f32x4 xc[2][2], xn_[2][2];
#pragma unroll
        for (int bj = 0; bj < 2; ++bj)
#pragma unroll
            for (int n = 0; n < 2; ++n) xc[bj][n] = *(const f32x4*)(src + (size_t)row0 * DM + col0 + 128 * bj + 4 * n);
#pragma unroll
        for (int i = 0; i < 8; ++i) {
            const int row = row0 + (i >> 2) * HALF + (i & 3) * 16;
            if (i < 7) { const int rown = row0 + ((i + 1) >> 2) * HALF + ((i + 1) & 3) * 16;
#pragma unroll
                for (int bj = 0; bj < 2; ++bj)
#pragma unroll
                    for (int n = 0; n < 2; ++n) xn_[bj][n] = *(const f32x4*)(src + (size_t)rown * DM + col0 + 128 * bj + 4 * n); }
            float ssq = 0.f;
#pragma unroll
            for (int bj = 0; bj < 2; ++bj) {
                f32x4 y[2];
#pragma unroll
                for (int n = 0; n < 2; ++n) {
                    y[n] = xc[bj][n] + g[bj][n] * acc[i >> 2][bj][i & 3][n];
                    *(f32x4*)(dst + (size_t)row * DM + col0 + 128 * bj + 4 * n) = y[n];
                    if (NORM) ssq += (y[n][0] * y[n][0] + y[n][1] * y[n][1]) + (y[n][2] * y[n][2] + y[n][3] * y[n][3]);
                }
                if (NORM) st_bf8(XS + (size_t)row * DM + col0 + 128 * bj, y[0] * sc[bj][0], y[1] * sc[bj][1]);
            }
            if (NORM) { ssq += __shfl_xor(ssq, 16); ssq += __shfl_xor(ssq, 32); if (fq == 0) SS[(size_t)row * 16 + (u.pn & 3) * 4 + wc] = ssq; }
#pragma unroll
            for (int bj = 0; bj < 2; ++bj)
#pragma unroll
                for (int n = 0; n < 2; ++n) xc[bj][n] = xn_[bj][n];
        }
    } };

DI void phase_mod(const Params& p, float* lds) {
    float* sc = lds;
    float* red = lds + 5 * DM;
    const int tid = TIDX, lane = tid & 63, wave = tid >> 6;
    for (int i = tid; i < 5 * DM; i += 512) { const float v = i < 4 * DM ? p.c[i] : p.c_ctx[i - 4 * DM]; sc[i] = v * sigmoidf_(v); }
    __syncthreads();
    float* mod = (float*)(p.ws + O_MOD);
    for (int it = BIDX; it < DEPTH * (NMOD / 64); it += gridDim.x) {
        const int l = it / (NMOD / 64), n = (it % (NMOD / 64)) * 64 + lane;
        const float* w = p.w_ada + ((size_t)l * DM + wave * 128) * NMOD + n;
        float a0 = 0.f, a1 = 0.f, a2 = 0.f, a3 = 0.f, a4 = 0.f;
#pragma unroll 8
        for (int k = 0; k < 128; ++k) { const float wv = w[(size_t)k * NMOD]; const int kk = wave * 128 + k;
            a0 += sc[kk] * wv; a1 += sc[DM + kk] * wv; a2 += sc[2 * DM + kk] * wv; a3 += sc[3 * DM + kk] * wv; a4 += sc[4 * DM + kk] * wv; }
        red[(wave * 5 + 0) * 64 + lane] = a0; red[(wave * 5 + 1) * 64 + lane] = a1; red[(wave * 5 + 2) * 64 + lane] = a2; red[(wave * 5 + 3) * 64 + lane] = a3; red[(wave * 5 + 4) * 64 + lane] = a4;
        __syncthreads();
        if (tid < 320) { const int r = tid >> 6; float s = p.b_ada[(size_t)l * NMOD + n];
#pragma unroll
            for (int w8 = 0; w8 < 8; ++w8) s += red[(w8 * 5 + r) * 64 + lane];
            mod[((size_t)l * 5 + r) * NMOD + n] = s; }
        __syncthreads();
    }
}

template <int MAP> DI int colmap(int n) {
    if (MAP == 0) return n;
    if (MAP == 1) { const int pn = n >> 8, bj = (n >> 7) & 1, c = n & 127; return bj * DFF + pn * 128 + c; }
    if (MAP == 2) return n < 672 ? n : (n < 768 ? -1 : n - 96);
    { const int m = n & 511, h = m >> 6, d = m & 63; return h * 128 + (n >> 9) * 64 + d; }
}
template <int MAP> DI void tjob(const float* src, int ld, int K, int N, bf16_t* dst, const float* kscale, float* tile, int& base, int vbid, int G) {
    const int tid = TIDX, ntn = N / 64, ntiles = ntn * (K / 64);
    int first = (vbid - base % G + G) % G;
    for (int t = first; t < ntiles; t += G) {
        const int n0 = (t % ntn) * 64, k0 = (t / ntn) * 64;
        const int c = colmap<MAP>(n0 + (tid & 63));
#pragma unroll
        for (int i = 0; i < 8; ++i) { const int kk = (tid >> 6) + 8 * i; float v = c >= 0 ? src[(size_t)(k0 + kk) * ld + c] : 0.f; if (kscale) v *= kscale[k0 + kk]; tile[kk * 65 + (tid & 63)] = v; }
        __syncthreads();
        { const int kc = tid & 7, nn = tid >> 3;
          const float* tp = tile + (kc * 8) * 65 + nn;
          u32x4 o; o.x = pk2(tp[0], tp[65]); o.y = pk2(tp[2 * 65], tp[3 * 65]); o.z = pk2(tp[4 * 65], tp[5 * 65]); o.w = pk2(tp[6 * 65], tp[7 * 65]);
          *(u32x4*)(dst + (size_t)(n0 + nn) * K + k0 + kc * 8) = o; }
        __syncthreads();
    }
    base += ntiles;
}
DI void phase_prep_ff(const Params& p, int l, int which, float* tile, int vbid, int vG) {
    unsigned char* ws = p.ws; int base = 0;
    if (which == 0) {
        tjob<1>(p.ff1_w_in + (size_t)l * DM * 2 * DFF, 2 * DFF, DM, 2 * DFF, (bf16_t*)(ws + O_WFF1IN), nullptr, tile, base, vbid, vG);
        tjob<0>(p.ff1_w_out + (size_t)l * DFF * DM, DM, DFF, DM, (bf16_t*)(ws + O_WFF1OUT), nullptr, tile, base, vbid, vG);
    } else {
        tjob<1>(p.ff2_w_in + (size_t)l * DM * 2 * DFF, 2 * DFF, DM, 2 * DFF, (bf16_t*)(ws + O_WFF2IN), nullptr, tile, base, vbid, vG);
        tjob<0>(p.ff2_w_out + (size_t)l * DFF * DM, DM, DFF, DM, (bf16_t*)(ws + O_WFF2OUT), nullptr, tile, base, vbid, vG);
    }
}
DI void phase_prep(const Params& p, int l, float* tile) {
    unsigned char* ws = p.ws; int base = 0;
    const int vbid = BIDX, vG = gridDim.x;
    const float* modl = (const float*)(ws + O_MOD) + (size_t)l * 5 * NMOD; float* shw = (float*)(ws + O_SHW);
    if (l == 0) phase_prep_ff(p, 0, 0, tile, vbid, vG);
    tjob<2>(p.w_in + (size_t)l * DM * 3744, 3744, DM, NIN, (bf16_t*)(ws + O_WIN), nullptr, tile, base, vbid, vG);
    tjob<0>(p.w_uq + (size_t)l * 384 * 768, 768, 384, 768, (bf16_t*)(ws + O_WUQ), p.q_a_norm + l * 384, tile, base, vbid, vG);
    tjob<3>(p.w_ukv + (size_t)l * 256 * 1024, 1024, 256, 1024, (bf16_t*)(ws + O_WUKV), p.kv_a_norm + l * 256, tile, base, vbid, vG);
    tjob<0>(p.w_o_attn + (size_t)l * 512 * 1024, 1024, 512, 1024, (bf16_t*)(ws + O_WOA), nullptr, tile, base, vbid, vG);
    tjob<0>(p.w_o_lru + (size_t)l * 512 * 1024, 1024, 512, 1024, (bf16_t*)(ws + O_WOL), nullptr, tile, base, vbid, vG);
    tjob<0>(p.w_out + (size_t)l * 1024 * 1024, 1024, 1024, 1024, (bf16_t*)(ws + O_WOUT), nullptr, tile, base, vbid, vG);
    { float* sh = tile; float* red = tile + 5 * DM;
      const int tid = TIDX, nn = tid & 63, ks = tid >> 6;
      for (int it = BIDX; it < 88 + 60 + 88; it += gridDim.x) {
          const int m = it < 88 ? 0 : (it < 148 ? 1 : 2), n0 = (m == 0 ? it : (m == 1 ? it - 88 : it - 148)) * 64;
          const float* W = m == 0 ? p.ff1_w_in + (size_t)l * DM * 2 * DFF : (m == 1 ? p.w_in + (size_t)l * DM * 3744 : p.ff2_w_in + (size_t)l * DM * 2 * DFF);
          const int ld = m == 1 ? 3744 : 2 * DFF, c = m == 1 ? colmap<2>(n0 + nn) : colmap<1>(n0 + nn);
          __syncthreads();
          for (int i = tid; i < 5 * DM; i += 512) sh[i] = modl[(size_t)(i >> 10) * NMOD + m * 3 * DM + (i & 1023)];
          __syncthreads();
          float a0 = 0.f, a1 = 0.f, a2 = 0.f, a3 = 0.f, a4 = 0.f;
          if (c >= 0) {
#pragma unroll 8
              for (int k = ks * 128; k < ks * 128 + 128; ++k) { const float wv = W[(size_t)k * ld + c]; a0 += sh[k] * wv; a1 += sh[DM + k] * wv; a2 += sh[2 * DM + k] * wv; a3 += sh[3 * DM + k] * wv; a4 += sh[4 * DM + k] * wv; }
          }
          red[(ks * 5 + 0) * 64 + nn] = a0; red[(ks * 5 + 1) * 64 + nn] = a1; red[(ks * 5 + 2) * 64 + nn] = a2; red[(ks * 5 + 3) * 64 + nn] = a3; red[(ks * 5 + 4) * 64 + nn] = a4;
          __syncthreads();
          if (tid < 320) { const int r = tid >> 6; float sum = 0.f;
#pragma unroll
              for (int w8 = 0; w8 < 8; ++w8) sum += red[(w8 * 5 + r) * 64 + nn];
              shw[(size_t)(m * 5 + r) * 5632 + n0 + nn] = sum; }
      }
      __syncthreads(); }
    if (BIDX == 0) { float* sp8 = (float*)(ws + O_SP);
        for (int i = TIDX; i < 1024; i += 512) { const float nl = -p.lru_lambda[l * 1024 + i]; sp8[i] = -8.f * (fmaxf(nl, 0.f) + log1pf(__expf(-fabsf(nl)))); } }
    bf16_t* wg = (bf16_t*)(ws + O_WGATE);
    for (int idx = BIDX * 512 + TIDX; idx < 2048 * 256; idx += gridDim.x * 512) {
        const int n = idx >> 8, k = idx & 255, d = n >> 10, cb = (n >> 8) & 3, gt = (n >> 7) & 1, c = n & 127, ch = cb * 128 + c, g = ch >> 6, j = ch & 63, ci = 256 * (cb >> 1) + k, gi = ci >> 6, i = ci & 63;
        float v = 0.f;
        if (gi == g) v = (gt ? p.w_igate : p.w_rgate)[((((size_t)l * 2 + d) * 8 + g) * 64 + i) * 64 + j];
        wg[idx] = f2bf(v);
    }
}

DI void phase_norm0(const Params& p) {
    const int tid = TIDX, lane = tid & 63, gw = BIDX * 8 + (tid >> 6), nw = gridDim.x * 8;
    float* X = (float*)(p.ws + O_X); bf16_t* XS = (bf16_t*)(p.ws + O_XNY); float* SS = (float*)(p.ws + O_SS);
    const float* mod = (const float*)(p.ws + O_MOD);
    for (int row = gw; row < MA; row += nw) {
        const float* src = row < ML ? p.x + (size_t)row * DM : p.ctx + (size_t)(row - ML) * DM;
        f32x4 v[4]; float s = 0.f;
#pragma unroll
        for (int j = 0; j < 4; ++j) { v[j] = *(const f32x4*)(src + 256 * j + 4 * lane); s += (v[j][0] * v[j][0] + v[j][1] * v[j][1]) + (v[j][2] * v[j][2] + v[j][3] * v[j][3]); }
        s = wave_sum(s);
        if (lane < 16) SS[(size_t)row * 16 + lane] = lane == 0 ? s : 0.f;
        const float* mr = mod + (size_t)mod_row(row) * NMOD;
#pragma unroll
        for (int j = 0; j < 4; ++j) {
            const int col = 256 * j + 4 * lane;
            *(f32x4*)(X + (size_t)row * DM + col) = v[j];
            const f32x4 sc = *(const f32x4*)(mr + DM + col);
            st_bf4(XS + (size_t)row * DM + col, v[j] * (1.f + sc));
        }
    }
}

DI void phase_conv(const Params& p, int l) {
    const bf16_t* UXY = (const bf16_t*)(p.ws + O_UXY); const bf16_t* P1 = (const bf16_t*)(p.ws + O_R1);
    bf16_t* xc = (bf16_t*)(p.ws + O_XNY);
    const float* cw = p.conv_w + (size_t)l * 4 * 512; const float* cb = p.conv_b + (size_t)l * 512;
    for (int e = BIDX * 512 + TIDX; e < MA * 64; e += gridDim.x * 512) {
        const int row = e >> 6, ch = (e & 63) * 8;
        int t, T; if (row < ML) { t = row & (SEQ - 1); T = SEQ; } else { t = (row - ML) & 255; T = CTXL; }
        float y[8];
#pragma unroll
        for (int i = 0; i < 8; ++i) y[i] = cb[ch + i];
#pragma unroll
        for (int k = 0; k < 4; ++k) {
            const int tt = t + k - 2;
            if (tt >= 0 && tt < T) {
                const u32x4 uv = *(const u32x4*)(UXY + (size_t)(row + k - 2) * 1024 + ch);
                const f32x4 w0 = *(const f32x4*)(cw + k * 512 + ch), w1 = *(const f32x4*)(cw + k * 512 + ch + 4);
                y[0] += w0[0] * bflo(uv.x); y[1] += w0[1] * bfhi(uv.x); y[2] += w0[2] * bflo(uv.y); y[3] += w0[3] * bfhi(uv.y);
                y[4] += w1[0] * bflo(uv.z); y[5] += w1[1] * bfhi(uv.z); y[6] += w1[2] * bflo(uv.w); y[7] += w1[3] * bfhi(uv.w);
            }
        }
        u32x4 o; o.x = pk2(y[0], y[1]); o.y = pk2(y[2], y[3]); o.z = pk2(y[4], y[5]); o.w = pk2(y[6], y[7]);
        *(u32x4*)(xc + (size_t)row * 512 + ch) = o;
    }
    float* rsq = (float*)(p.ws + O_RSQ); float* rskv = (float*)(p.ws + O_RSKV);
    const int tid2 = TIDX, l16 = tid2 & 15, gq = BIDX * 32 + (tid2 >> 4), nq = gridDim.x * 32;
    for (int row = gq; row < MA; row += nq) {
        const bf16_t* pr = P1 + (size_t)row * 768;
        u32x4 v[5];
#pragma unroll
        for (int i = 0; i < 5; ++i) v[i] = *(const u32x4*)(pr + (l16 + 16 * i) * 8);
        float sq = 0.f, skv = 0.f;
#pragma unroll
        for (int i = 0; i < 5; ++i) {
            const float s2 = bflo(v[i].x) * bflo(v[i].x) + bfhi(v[i].x) * bfhi(v[i].x) + bflo(v[i].y) * bflo(v[i].y) + bfhi(v[i].y) * bfhi(v[i].y)
                           + bflo(v[i].z) * bflo(v[i].z) + bfhi(v[i].z) * bfhi(v[i].z) + bflo(v[i].w) * bflo(v[i].w) + bfhi(v[i].w) * bfhi(v[i].w);
            if (i < 3) sq += s2; else skv += s2;
        }
#pragma unroll
        for (int o = 1; o < 16; o <<= 1) { sq += __shfl_xor(sq, o); skv += __shfl_xor(skv, o); }
        if (l16 == 0) { rsq[row] = rsqrtf(sq * (1.f / 384.f) + EPS); rskv[row] = rsqrtf(skv * (1.f / 256.f) + EPS); }
    }
}

DI int chunk_row0(int b, int pch) { return pch < 4 ? ML + b * CTXL + pch * 64 : b * SEQ + (pch - 4) * 64; }
DI void phase_scan_agg(const Params& p) {
    const bf16_t* OM = (const bf16_t*)(p.ws + O_S); const bf16_t* BB = OM + (size_t)2 * MA * 512;
    f32x4* agg = (f32x4*)(p.ws + O_AGG);
    const int tid = TIDX, lane = tid & 63, gw = (tid >> 6) * gridDim.x + BIDX, nw = gridDim.x * 8;
    for (int it = gw; it < 2 * NB * NCH; it += nw) {
        const int d = it & 1, bp = it >> 1, b = bp / NCH, pch = bp % NCH, row0 = chunk_row0(b, pch);
        const bf16_t* om = OM + ((size_t)d * MA + row0) * 512 + lane * 8; const bf16_t* bb = BB + ((size_t)d * MA + row0) * 512 + lane * 8;
        float h[8], A[8];
#pragma unroll
        for (int i = 0; i < 8; ++i) { h[i] = 0.f; A[i] = 1.f; }
#pragma unroll 8
        for (int t = 0; t < 64; ++t) {
            const int tt = d ? 63 - t : t;
            const u32x4 ov = *(const u32x4*)(om + (size_t)tt * 512), bv = *(const u32x4*)(bb + (size_t)tt * 512);
            const float a[8] = {1.f - bflo(ov.x), 1.f - bfhi(ov.x), 1.f - bflo(ov.y), 1.f - bfhi(ov.y), 1.f - bflo(ov.z), 1.f - bfhi(ov.z), 1.f - bflo(ov.w), 1.f - bfhi(ov.w)};
            const float bq[8] = {bflo(bv.x), bfhi(bv.x), bflo(bv.y), bfhi(bv.y), bflo(bv.z), bfhi(bv.z), bflo(bv.w), bfhi(bv.w)};
#pragma unroll
            for (int i = 0; i < 8; ++i) { h[i] = a[i] * h[i] + bq[i]; A[i] *= a[i]; }
        }
        f32x4* dst = agg + (((size_t)(d * NB + b) * NCH + pch) * 512 + lane * 8) / 2;
#pragma unroll
        for (int i = 0; i < 4; ++i) dst[i] = (f32x4){A[2 * i], h[2 * i], A[2 * i + 1], h[2 * i + 1]};
    }
}
DI float gelu_tanh(float x) { const float u = 0.7978845608028654f * (x + 0.044715f * x * x * x); const float e = __expf(2.f * u); const float th = 1.f - 2.f * __builtin_amdgcn_rcpf(e + 1.f); return 0.5f * x * (1.f + th); }
DI void agg_step(const f32x4* e, float (&h)[8]) {
    const f32x4 e0 = e[0], e1 = e[1], e2 = e[2], e3 = e[3];
    h[0] = e0[0] * h[0] + e0[1]; h[1] = e0[2] * h[1] + e0[3]; h[2] = e1[0] * h[2] + e1[1]; h[3] = e1[2] * h[3] + e1[3];
    h[4] = e2[0] * h[4] + e2[1]; h[5] = e2[2] * h[5] + e2[3]; h[6] = e3[0] * h[6] + e3[1]; h[7] = e3[2] * h[7] + e3[3];
}
DI void phase_scan_apply(const Params& p) {
    const bf16_t* OM = (const bf16_t*)(p.ws + O_S); const bf16_t* BB = OM + (size_t)2 * MA * 512;
    const f32x4* agg = (const f32x4*)(p.ws + O_AGG);
    bf16_t* UXY = (bf16_t*)(p.ws + O_UXY); float* HF = p.out;
    const int tid = TIDX, lane = tid & 63, gw = (tid >> 6) * gridDim.x + BIDX, nw = gridDim.x * 8;
    for (int it = gw; it < NB * NCH; it += nw) {
        const int b = it / NCH, pch = it % NCH, row0 = chunk_row0(b, pch);
        const f32x4* af = agg + (((size_t)(0 * NB + b) * NCH) * 512 + lane * 8) / 2; const f32x4* ab = agg + (((size_t)(1 * NB + b) * NCH) * 512 + lane * 8) / 2;
        float h[8];
#pragma unroll
        for (int i = 0; i < 8; ++i) h[i] = 0.f;
#pragma unroll 4
        for (int q = 0; q < pch; ++q) agg_step(af + (size_t)q * 256, h);
        { const bf16_t* om = OM + ((size_t)row0) * 512 + lane * 8; const bf16_t* bb = BB + ((size_t)row0) * 512 + lane * 8; float* hf = HF + (size_t)row0 * 512 + lane * 8;
#pragma unroll 8
          for (int t = 0; t < 64; ++t) {
              const u32x4 ov = *(const u32x4*)(om + (size_t)t * 512), bv = *(const u32x4*)(bb + (size_t)t * 512);
              h[0] = (1.f - bflo(ov.x)) * h[0] + bflo(bv.x); h[1] = (1.f - bfhi(ov.x)) * h[1] + bfhi(bv.x); h[2] = (1.f - bflo(ov.y)) * h[2] + bflo(bv.y); h[3] = (1.f - bfhi(ov.y)) * h[3] + bfhi(bv.y);
              h[4] = (1.f - bflo(ov.z)) * h[4] + bflo(bv.z); h[5] = (1.f - bfhi(ov.z)) * h[5] + bfhi(bv.z); h[6] = (1.f - bflo(ov.w)) * h[6] + bflo(bv.w); h[7] = (1.f - bfhi(ov.w)) * h[7] + bfhi(bv.w);
              *(f32x4*)(hf + (size_t)t * 512) = (f32x4){h[0], h[1], h[2], h[3]}; *(f32x4*)(hf + (size_t)t * 512 + 4) = (f32x4){h[4], h[5], h[6], h[7]};
          } }
#pragma unroll
        for (int i = 0; i < 8; ++i) h[i] = 0.f;
        if (pch >= 4) {
#pragma unroll
            for (int q = 3; q >= 0; --q) agg_step(ab + (size_t)q * 256, h);
#pragma unroll 4
            for (int q = NCH - 1; q > pch; --q) agg_step(ab + (size_t)q * 256, h);
        } else {
            for (int q = 3; q > pch; --q) agg_step(ab + (size_t)q * 256, h);
        }
        { const bf16_t* om = OM + ((size_t)MA + row0) * 512 + lane * 8; const bf16_t* bb = BB + ((size_t)MA + row0) * 512 + lane * 8; const float* hf = HF + (size_t)row0 * 512 + lane * 8;
#pragma unroll 4
          for (int t = 63; t >= 0; --t) {
              const u32x4 ov = *(const u32x4*)(om + (size_t)t * 512), bv = *(const u32x4*)(bb + (size_t)t * 512);
              const f32x4 f0 = *(const f32x4*)(hf + (size_t)t * 512), f1 = *(const f32x4*)(hf + (size_t)t * 512 + 4);
              const u32x4 uv = *(const u32x4*)(UXY + (size_t)(row0 + t) * 1024 + 512 + lane * 8);
              h[0] = (1.f - bflo(ov.x)) * h[0] + bflo(bv.x); h[1] = (1.f - bfhi(ov.x)) * h[1] + bfhi(bv.x); h[2] = (1.f - bflo(ov.y)) * h[2] + bflo(bv.y); h[3] = (1.f - bfhi(ov.y)) * h[3] + bfhi(bv.y);
              h[4] = (1.f - bflo(ov.z)) * h[4] + bflo(bv.z); h[5] = (1.f - bfhi(ov.z)) * h[5] + bfhi(bv.z); h[6] = (1.f - bflo(ov.w)) * h[6] + bflo(bv.w); h[7] = (1.f - bfhi(ov.w)) * h[7] + bfhi(bv.w);
              u32x4 o;
              o.x = pk2((f0[0] + h[0]) * gelu_tanh(bflo(uv.x)), (f0[1] + h[1]) * gelu_tanh(bfhi(uv.x))); o.y = pk2((f0[2] + h[2]) * gelu_tanh(bflo(uv.y)), (f0[3] + h[3]) * gelu_tanh(bfhi(uv.y)));
              o.z = pk2((f1[0] + h[4]) * gelu_tanh(bflo(uv.z)), (f1[1] + h[5]) * gelu_tanh(bfhi(uv.z))); o.w = pk2((f1[2] + h[6]) * gelu_tanh(bflo(uv.w)), (f1[3] + h[7]) * gelu_tanh(bfhi(uv.w)));
              *(u32x4*)(UXY + (size_t)(row0 + t) * 1024 + lane * 8) = o;
          } }
    }
}

DI void phase_qk(const Params& p, int l, unsigned char* smem) {
    const bf16_t* qraw = (const bf16_t*)p.out; const bf16_t* kn = qraw + (size_t)MA * 768;
    const bf16_t* P1 = (const bf16_t*)(p.ws + O_R1);
    bf16_t* Q = (bf16_t*)(p.ws + O_S); bf16_t* Kb = Q + (size_t)32 * TK * 96;
    const int tid = TIDX, lane = tid & 63, wave = tid >> 6, gw = BIDX * 8 + wave, nw = gridDim.x * 8, h = lane >> 3, j = lane & 7;
    unsigned char* wq = smem + wave * 4096; unsigned char* wk = wq + 1536;
    const float* qn = p.q_norm + l * 96; const float* knm = p.k_norm + l * 96;
    float gq[12], gk[12];
#pragma unroll
    for (int i = 0; i < 12; ++i) { gq[i] = qn[8 * i + j] * QSCALE; gk[i] = knm[8 * i + j]; }
    const float freq = exp2f(-(float)j * 1.6609640474436813f);
    for (int row = gw; row < MA; row += nw) {
        { const u32x4 q0 = *(const u32x4*)(qraw + (size_t)row * 768 + lane * 8);
          u32x4 q1 = {0u, 0u, 0u, 0u}, k1 = {0u, 0u, 0u, 0u};
          if (lane < 32) q1 = *(const u32x4*)(qraw + (size_t)row * 768 + 512 + lane * 8);
          const u32x4 k0 = *(const u32x4*)(kn + (size_t)row * 512 + lane * 8);
          if (lane < 4) k1 = *(const u32x4*)(P1 + (size_t)row * 768 + 640 + lane * 8);
          *(u32x4*)(wq + lane * 16) = q0; if (lane < 32) *(u32x4*)(wq + 1024 + lane * 16) = q1;
          *(u32x4*)(wk + lane * 16) = k0; if (lane < 4) *(u32x4*)(wk + 1024 + lane * 16) = k1; }
        __builtin_amdgcn_fence(__ATOMIC_RELEASE, "wavefront"); __builtin_amdgcn_wave_barrier(); __builtin_amdgcn_fence(__ATOMIC_ACQUIRE, "wavefront");
        float xq[12], xk[12];
#pragma unroll
        for (int i = 0; i < 12; ++i) xq[i] = bf2f(*(const bf16_t*)(wq + (h * 96 + 8 * i + j) * 2));
#pragma unroll
        for (int i = 0; i < 8; ++i) xk[i] = bf2f(*(const bf16_t*)(wk + (h * 64 + 8 * i + j) * 2));
#pragma unroll
        for (int i = 8; i < 12; ++i) xk[i] = bf2f(*(const bf16_t*)(wk + 1024 + (8 * (i - 8) + j) * 2));
        __builtin_amdgcn_fence(__ATOMIC_RELEASE, "wavefront"); __builtin_amdgcn_wave_barrier(); __builtin_amdgcn_fence(__ATOMIC_ACQUIRE, "wavefront");
        const bool lat = row < ML; int b, pos;
        if (lat) { b = row >> 13; pos = row & (SEQ - 1); } else { const int r = row - ML; b = r >> 8; pos = SEQ + (r & 255); }
        float c0 = 1.f, s0 = 0.f, c1 = 1.f, s1 = 0.f;
        if (lat) { float r0 = (float)(pos >> 6) * freq * 0.15915494309189535f, r1 = (float)(pos & 63) * freq * 0.15915494309189535f;
            r0 -= floorf(r0); r1 -= floorf(r1);
            c0 = __builtin_amdgcn_cosf(r0); s0 = __builtin_amdgcn_sinf(r0); c1 = __builtin_amdgcn_cosf(r1); s1 = __builtin_amdgcn_sinf(r1); }
        float sq = 0.f, sk = 0.f;
#pragma unroll
        for (int i = 0; i < 12; ++i) { sq += xq[i] * xq[i]; sk += xk[i] * xk[i]; }
        sq += __shfl_xor(sq, 1); sk += __shfl_xor(sk, 1); sq += __shfl_xor(sq, 2); sk += __shfl_xor(sk, 2); sq += __shfl_xor(sq, 4); sk += __shfl_xor(sk, 4);
        const float rq = rsqrtf(sq * (1.f / 96.f) + EPS), rk = rsqrtf(sk * (1.f / 96.f) + EPS);
#pragma unroll
        for (int i = 0; i < 12; ++i) { xq[i] *= rq * gq[i]; xk[i] *= rk * gk[i]; }
        { const float y8 = xq[8] * c0 - xq[9] * s0, y9 = xq[8] * s0 + xq[9] * c0, y10 = xq[10] * c1 - xq[11] * s1, y11 = xq[10] * s1 + xq[11] * c1;
          xq[8] = y8; xq[9] = y9; xq[10] = y10; xq[11] = y11; }
        { const float y8 = xk[8] * c0 - xk[9] * s0, y9 = xk[8] * s0 + xk[9] * c0, y10 = xk[10] * c1 - xk[11] * s1, y11 = xk[10] * s1 + xk[11] * c1;
          xk[8] = y8; xk[9] = y9; xk[10] = y10; xk[11] = y11; }
#pragma unroll
        for (int i = 0; i < 12; ++i) { *(bf16_t*)(wq + (h * 96 + 8 * i + j) * 2) = f2bf(xq[i]); *(bf16_t*)(wk + (h * 96 + 8 * i + j) * 2) = f2bf(xk[i]); }
        __builtin_amdgcn_fence(__ATOMIC_RELEASE, "wavefront"); __builtin_amdgcn_wave_barrier(); __builtin_amdgcn_fence(__ATOMIC_ACQUIRE, "wavefront");
        { const int c0i = lane, c1i = 64 + lane;
          const u32x4 oq0 = *(const u32x4*)(wq + c0i * 16), ok0 = *(const u32x4*)(wk + c0i * 16);
          const size_t d0 = ((size_t)(b * NH + c0i / 12) * TK + pos) * 96 + (c0i % 12) * 8;
          *(u32x4*)(Q + d0) = oq0; *(u32x4*)(Kb + d0) = ok0;
          if (lane < 32) { const u32x4 oq1 = *(const u32x4*)(wq + c1i * 16), ok1 = *(const u32x4*)(wk + c1i * 16);
              const size_t d1 = ((size_t)(b * NH + c1i / 12) * TK + pos) * 96 + (c1i % 12) * 8;
              *(u32x4*)(Q + d1) = oq1; *(u32x4*)(Kb + d1) = ok1; } }
        __builtin_amdgcn_fence(__ATOMIC_RELEASE, "wavefront"); __builtin_amdgcn_wave_barrier(); __builtin_amdgcn_fence(__ATOMIC_ACQUIRE, "wavefront");
    }
}

constexpr int KROW = 208, VROW = 144, KBYTES = 64 * KROW, ABUF = KBYTES + 64 * VROW;
DI void attn_item(unsigned char* lds, const bf16_t* Q, const bf16_t* Kb, const bf16_t* Vt, bf16_t* att, int bh, int qposA, int qposB, int kt0, int kt1, int outrowA, int outrowB, bool writeB) {
    const int tid = TIDX, lane = tid & 63, l31 = lane & 31, half = lane >> 5;
    bf16x8 qa[6], qb[6];
    { const bf16_t* qp = Q + ((size_t)bh * TK + qposA + l31) * 96 + 8 * half; const bf16_t* qq = Q + ((size_t)bh * TK + qposB + l31) * 96 + 8 * half;
#pragma unroll
      for (int ks = 0; ks < 6; ++ks) { qa[ks] = *(const bf16x8*)(qp + 16 * ks); qb[ks] = *(const bf16x8*)(qq + 16 * ks); } }
    f32x16 oa0, oa1, ob0, ob1;
#pragma unroll
    for (int i = 0; i < 16; ++i) { oa0[i] = 0.f; oa1[i] = 0.f; ob0[i] = 0.f; ob1[i] = 0.f; }
    float la = 0.f, lb = 0.f;
    const unsigned char* kg = (const unsigned char*)(Kb + (size_t)bh * TK * 96) + (size_t)tid * 16;
    const unsigned char* vg = (const unsigned char*)(Vt + ((size_t)bh * 64 + (tid >> 3)) * TK) + (tid & 7) * 16;
    const int kc1 = 512 + tid;
    const int koff0 = (tid / 12) * KROW + (tid % 12) * 16, koff1 = (kc1 / 12) * KROW + (kc1 % 12) * 16;
    const int voff = KBYTES + (tid >> 3) * VROW + ((tid & 7) >> 1) * 32 + (tid & 1) * 8;
    const int klo = l31 * KROW + 16 * half, vlo = KBYTES + l31 * VROW + 16 * half;
    u32x4 kr0, kr1 = {0u, 0u, 0u, 0u}, vr;
#define AT_GLOAD(kt) do { kr0 = *(const u32x4*)(kg + (size_t)(kt) * 12288); if (tid < 256) kr1 = *(const u32x4*)(kg + (size_t)(kt) * 12288 + 8192); vr = *(const u32x4*)(vg + (size_t)(kt) * 128); } while (0)
#define AT_SSTORE(stg) do { unsigned char* bp_ = lds + (stg) * ABUF; *(u32x4*)(bp_ + koff0) = kr0; if (tid < 256) *(u32x4*)(bp_ + koff1) = kr1; \
        *(u32x2*)(bp_ + voff) = (u32x2){vr.x, vr.y}; *(u32x2*)(bp_ + voff + 16) = (u32x2){vr.z, vr.w}; } while (0)
#define AT_PK(v, o) (u32x4){pk2(v[o], v[o + 1]), pk2(v[o + 2], v[o + 3]), pk2(v[o + 4], v[o + 5]), pk2(v[o + 6], v[o + 7])}
    AT_GLOAD(kt0); AT_SSTORE(0);
    __syncthreads();
    for (int kt = kt0; kt < kt1; ++kt) {
        const int cur = (kt - kt0) & 1;
        const bool more = kt + 1 < kt1;
        if (more) AT_GLOAD(kt + 1);
        const unsigned char* kl = lds + cur * ABUF + klo;
        const unsigned char* vl = lds + cur * ABUF + vlo;
        f32x16 sa0, sa1, sb0, sb1;
        const f32x16 zero16 = {0.f, 0.f, 0.f, 0.f, 0.f, 0.f, 0.f, 0.f, 0.f, 0.f, 0.f, 0.f, 0.f, 0.f, 0.f, 0.f};
#pragma unroll
        for (int ks = 0; ks < 6; ++ks) {
            const bf16x8 a0 = *(const bf16x8*)(kl + 32 * ks), a1 = *(const bf16x8*)(kl + 32 * KROW + 32 * ks);
            sa0 = __builtin_amdgcn_mfma_f32_32x32x16_bf16(a0, qa[ks], ks == 0 ? zero16 : sa0, 0, 0, 0);
            sa1 = __builtin_amdgcn_mfma_f32_32x32x16_bf16(a1, qa[ks], ks == 0 ? zero16 : sa1, 0, 0, 0);
            sb0 = __builtin_amdgcn_mfma_f32_32x32x16_bf16(a0, qb[ks], ks == 0 ? zero16 : sb0, 0, 0, 0);
            sb1 = __builtin_amdgcn_mfma_f32_32x32x16_bf16(a1, qb[ks], ks == 0 ? zero16 : sb1, 0, 0, 0);
        }
        float pa = 0.f, pb = 0.f;
#pragma unroll
        for (int i = 0; i < 16; ++i) { sa0[i] = __builtin_amdgcn_exp2f(sa0[i]); sa1[i] = __builtin_amdgcn_exp2f(sa1[i]); pa += sa0[i] + sa1[i];
                                       sb0[i] = __builtin_amdgcn_exp2f(sb0[i]); sb1[i] = __builtin_amdgcn_exp2f(sb1[i]); pb += sb0[i] + sb1[i]; }
        la += pa; lb += pb;
#pragma unroll
        for (int s = 0; s < 4; ++s) {
            const bf16x8 v0 = *(const bf16x8*)(vl + 32 * s), v1 = *(const bf16x8*)(vl + 32 * VROW + 32 * s);
            const bf16x8 fa = __builtin_bit_cast(bf16x8, s < 2 ? AT_PK(sa0, 8 * (s & 1)) : AT_PK(sa1, 8 * (s & 1)));
            const bf16x8 fb = __builtin_bit_cast(bf16x8, s < 2 ? AT_PK(sb0, 8 * (s & 1)) : AT_PK(sb1, 8 * (s & 1)));
            oa0 = __builtin_amdgcn_mfma_f32_32x32x16_bf16(v0, fa, oa0, 0, 0, 0); oa1 = __builtin_amdgcn_mfma_f32_32x32x16_bf16(v1, fa, oa1, 0, 0, 0);
            ob0 = __builtin_amdgcn_mfma_f32_32x32x16_bf16(v0, fb, ob0, 0, 0, 0); ob1 = __builtin_amdgcn_mfma_f32_32x32x16_bf16(v1, fb, ob1, 0, 0, 0);
        }
        if (more) AT_SSTORE(cur ^ 1);
        __syncthreads();
    }
#undef AT_GLOAD
#undef AT_SSTORE
#undef AT_PK
    { const float lt = la + __shfl_xor(la, 32), inv = 1.f / lt;
      bf16_t* op = att + (size_t)(outrowA + l31) * 512 + (bh & 7) * 64 + 4 * half;
#pragma unroll
      for (int g = 0; g < 4; ++g) {
          st_bf4(op + 8 * g, (f32x4){oa0[4 * g] * inv, oa0[4 * g + 1] * inv, oa0[4 * g + 2] * inv, oa0[4 * g + 3] * inv});
          st_bf4(op + 32 + 8 * g, (f32x4){oa1[4 * g] * inv, oa1[4 * g + 1] * inv, oa1[4 * g + 2] * inv, oa1[4 * g + 3] * inv}); } }
    if (writeB) { const float lt = lb + __shfl_xor(lb, 32), inv = 1.f / lt;
      bf16_t* op = att + (size_t)(outrowB + l31) * 512 + (bh & 7) * 64 + 4 * half;
#pragma unroll
      for (int g = 0; g < 4; ++g) {
          st_bf4(op + 8 * g, (f32x4){ob0[4 * g] * inv, ob0[4 * g + 1] * inv, ob0[4 * g + 2] * inv, ob0[4 * g + 3] * inv});
          st_bf4(op + 32 + 8 * g, (f32x4){ob1[4 * g] * inv, ob1[4 * g + 1] * inv, ob1[4 * g + 2] * inv, ob1[4 * g + 3] * inv}); } }
}
DI void phase_attn(const Params& p, unsigned char* lds, bool with_ctx) {
    const bf16_t* Q = (const bf16_t*)(p.ws + O_S); const bf16_t* Kb = Q + (size_t)32 * TK * 96; const bf16_t* Vt = Kb + (size_t)32 * TK * 96;
    bf16_t* att = (bf16_t*)p.out;
    const int nitems = 512 + (with_ctx ? 32 : 0);
    for (int it = BIDX; it < nitems; it += gridDim.x) {
        const int wave = TIDX >> 6;
        if (it < 512) {
            const int j = (it >> 3) & 31, bh = (it >> 8) * 16 + (it & 7) * 2 + (j >> 4), q0 = (j & 15) * 512 + wave * 64, r0 = (bh >> 3) * SEQ + q0;
            attn_item(lds, Q, Kb, Vt, att, bh, q0, q0 + 32, 0, TK / 64, r0, r0 + 32, true);
        } else {
            const int bh = it - 512, q0 = SEQ + wave * 32, r0 = ML + (bh >> 3) * CTXL + wave * 32;
            attn_item(lds, Q, Kb, Vt, att, bh, q0, q0, SEQ / 64, TK / 64, r0, r0, false);
        }
    }
}

constexpr int PH_PER_LAYER = 15, N_PHASES = 1 + DEPTH * PH_PER_LAYER;
DI int phase_case(int ph) { const int i = (ph - 1) % PH_PER_LAYER; return i < 3 ? i : (i < 13 ? i + 1 : i + 2); }
DI void run_phase(const Params& p, int ph, unsigned char* smem) {
    LAS unsigned char* lds = (LAS unsigned char*)smem;
    unsigned char* ws = p.ws;
    if (ph == 0) { phase_mod(p, (float*)smem); return; }
    const int l = (ph - 1) / PH_PER_LAYER, s = phase_case(ph);
    const bool last = (l == DEPTH - 1);
    const float* mod = (const float*)(ws + O_MOD) + (size_t)l * 5 * NMOD;
    float* X = (float*)(ws + O_X);
    bf16_t* XNY = (bf16_t*)(ws + O_XNY); bf16_t* H = (bf16_t*)(ws + O_R1); bf16_t* P1 = (bf16_t*)(ws + O_R1); bf16_t* GATE = P1 + (size_t)MA * 768;
    bf16_t* UXY = (bf16_t*)(ws + O_UXY);
    float* SS = (float*)(ws + O_SS); const float* shw = (const float*)(ws + O_SHW);
    const int Mtail = last ? ML : MA;
    switch (s) {
    case 0: phase_prep(p, l, (float*)smem); if (l == 0) phase_norm0(p); break;
    case 1: { ESwiglu E{H, SS, shw}; gemm_phase<ESwiglu, false, true>(lds, Gemm{XNY, (const bf16_t*)(ws + O_WFF1IN), MA, 2 * DFF, DM, DM, DM}, E); } break;
    case 2: { EResid<1, true> E{X, X, mod + 2 * DM, mod + 4 * DM, XNY, SS + (size_t)MA * 16}; gemm_phase<EResid<1, true>, false, true>(lds, Gemm{H, (const bf16_t*)(ws + O_WFF1OUT), MA, DM, DFF, DFF, DFF}, E); }
              { const int nthird = (MA / BM) * (DM / BM) - 2 * (int)gridDim.x, vb = (int)BIDX - nthird; if (nthird > 0 && nthird < (int)gridDim.x && vb >= 0) phase_prep_ff(p, l, 1, (float*)smem, vb, (int)gridDim.x - nthird); else if (nthird <= 0 || nthird >= (int)gridDim.x) phase_prep_ff(p, l, 1, (float*)smem, BIDX, gridDim.x); }
              break;
    case 4: { EWin E{P1, UXY, GATE, SS + (size_t)MA * 16, shw + 5 * 5632}; gemm_phase<EWin, false, true>(lds, Gemm{XNY, (const bf16_t*)(ws + O_WIN), MA, NIN, DM, DM, DM}, E); } break;
    case 5: phase_conv(p, l); break;
    case 6: { bf16_t* OM = (bf16_t*)(ws + O_S); EGate E{XNY, OM, OM + (size_t)2 * MA * 512, (const float*)(ws + O_SP), p.b_rgate + l * 1024, p.b_igate + l * 1024};
              gemm_phase<EGate, true, true>(lds, Gemm{XNY, (const bf16_t*)(ws + O_WGATE), MA, 2048, 256, 512, 256}, E); } break;
    case 7: phase_scan_agg(p); break;
    case 8: phase_scan_apply(p); break;
    case 9: { bf16_t* qraw = (bf16_t*)p.out; bf16_t* kn = qraw + (size_t)MA * 768; bf16_t* Vt = (bf16_t*)(ws + O_S) + (size_t)2 * 32 * TK * 96;
              const float* rsq = (const float*)(ws + O_RSQ); const float* rskv = (const float*)(ws + O_RSKV);
              const bf16_t* wukv = (const bf16_t*)(ws + O_WUKV);
              { EpiElem8<FRowScale> E{{qraw, 768, rsq}}; gemm_phase<EpiElem8<FRowScale>, false, true>(lds, Gemm{P1, (const bf16_t*)(ws + O_WUQ), MA, 768, 384, 768, 384}, E); }
              { EpiElem8<FRowScale> E{{kn, 512, rskv}}; gemm_phase<EpiElem8<FRowScale>, false, true>(lds, Gemm{P1 + 384, wukv, MA, 512, 256, 768, 256, 144}, E); }
              { EpiElem8<FVt> E{{Vt, rskv}}; gemm_phase<EpiElem8<FVt>, false, true>(lds, Gemm{wukv + (size_t)512 * 256, P1 + 384, 512, MA, 256, 256, 768, 152}, E); }
              } break;
    case 10: phase_qk(p, l, smem); break;
    case 11: phase_attn(p, smem, !last); break;
    case 12: { { EpiElem8<FMergeA> E{{GATE, XNY}}; gemm_phase<EpiElem8<FMergeA>, false, true>(lds, Gemm{(const bf16_t*)p.out, (const bf16_t*)(ws + O_WOA), Mtail, DM, 512, 512, 512}, E); }
               { EpiElem8<FMergeB> E{{GATE, XNY}}; gemm_phase<EpiElem8<FMergeB>, false, true>(lds, Gemm{UXY, (const bf16_t*)(ws + O_WOL), Mtail, DM, 512, 1024, 512}, E); } } break;
    case 13: { EResid<2, true> E{X, X, mod + 5 * DM, mod + 7 * DM, UXY, SS + (size_t)2 * MA * 16}; gemm_phase<EResid<2, true>, false, true>(lds, Gemm{XNY, (const bf16_t*)(ws + O_WOUT), Mtail, DM, DM, DM, DM}, E); } break;
    case 15: { ESwiglu E{H, SS + (size_t)2 * MA * 16, shw + 2 * 5 * 5632}; gemm_phase<ESwiglu, false, true>(lds, Gemm{UXY, (const bf16_t*)(ws + O_WFF2IN), Mtail, 2 * DFF, DM, DM, DM}, E); } break;
    case 16: if (last) { EResid<1, false> E{X, p.out, mod + 8 * DM, nullptr, nullptr, nullptr}; gemm_phase<EResid<1, false>, false, true>(lds, Gemm{H, (const bf16_t*)(ws + O_WFF2OUT), Mtail, DM, DFF, DFF, DFF}, E); }
             else { EResid<1, true> E{X, X, mod + 8 * DM, mod + 5 * NMOD + DM, XNY, SS}; gemm_phase<EResid<1, true>, false, true>(lds, Gemm{H, (const bf16_t*)(ws + O_WFF2OUT), Mtail, DM, DFF, DFF, DFF}, E); }
             if (!last) { const int nthird = (MA / BM) * (DM / BM) - 2 * (int)gridDim.x, vb = (int)BIDX - nthird; if (nthird > 0 && nthird < (int)gridDim.x && vb >= 0) phase_prep_ff(p, l + 1, 0, (float*)smem, vb, (int)gridDim.x - nthird); else if (nthird <= 0 || nthird >= (int)gridDim.x) phase_prep_ff(p, l + 1, 0, (float*)smem, BIDX, gridDim.x); }
             break;
    }
}

#ifndef PROBE_MASK
#define PROBE_MASK 0u
#endif
#define XB_TMO      128
#define XB_XCNT(j)  (256  + 64 * (j))
#define XB_XSUB(j)  (1280 + 64 * (j))
#define XB_XGEN(j)  (2304 + 64 * (j))
#define XB_TOP      3328
#define XB_TOPGEN   3392
#define XCD_BAR_WORDS 3456
#define XB_SPIN_CAP (1u << 18)
DI unsigned xb_ld(unsigned* p)              { return __hip_atomic_load(p, __ATOMIC_RELAXED, __HIP_MEMORY_SCOPE_AGENT); }
DI unsigned xb_add(unsigned* p, unsigned v) { return __hip_atomic_fetch_add(p, v, __ATOMIC_RELAXED, __HIP_MEMORY_SCOPE_AGENT); }
DI unsigned xb_xcc_id() { return (unsigned)__builtin_amdgcn_s_getreg((3 << 11) | 20) & 0xFu; }
#define XB_SPIN(cond, bar) do { unsigned _sp = 0; while (cond) { __builtin_amdgcn_s_sleep(1); \
    if ((++_sp & 255u) == 0u) { if (xb_ld(&(bar)[XB_TMO])) break; if (_sp > XB_SPIN_CAP) { atomicAdd(&(bar)[XB_TMO], 1u); break; } } } } while (0)
struct XcdBarrier { unsigned* bar; unsigned x; volatile LAS unsigned* st; };
DI XcdBarrier xcd_barrier_post(unsigned* bar, volatile LAS unsigned* st) {
    XcdBarrier b; b.bar = bar; b.x = xb_xcc_id(); b.st = st;
    if (threadIdx.x == 0) (void)xb_add(&bar[XB_XCNT(b.x)], 1u);
    return b;
}
DI void xcd_barrier_complete(unsigned* bar, unsigned x, unsigned& nloc, unsigned& nx) {
    const unsigned G = gridDim.x * gridDim.y * gridDim.z;
    unsigned sum, cnt, mine, sp = 0u;
    for (;;) {
        sum = 0u; cnt = 0u; mine = 0u;
#pragma unroll
        for (unsigned j = 0; j < 16; ++j) { const unsigned c = xb_ld(&bar[XB_XCNT(j)]); sum += c; cnt += (c > 0u) ? 1u : 0u; mine = (j == x) ? c : mine; }
        if (sum == G) break;
        __builtin_amdgcn_s_sleep(1);
        if ((++sp & 255u) == 0u) { if (xb_ld(&bar[XB_TMO])) break; if (sp > XB_SPIN_CAP) { atomicAdd(&bar[XB_TMO], 1u); break; } }
    }
    nloc = mine > 0u ? mine : 1u; nx = cnt > 0u ? cnt : 1u;
}
DI void xcd_barrier(const XcdBarrier& b) {
    asm volatile("s_waitcnt vmcnt(0)" ::: "memory");
    __syncthreads();
    if (threadIdx.x == 0) {
        unsigned* bar = b.bar;
        __builtin_amdgcn_s_waitcnt(0);
        unsigned nloc = b.st[0], nx = b.st[1];
        if (nloc == 0u) { xcd_barrier_complete(bar, b.x, nloc, nx); b.st[0] = nloc; b.st[1] = nx; }
        const unsigned old = xb_add(&bar[XB_XSUB(b.x)], 1u);
        const unsigned gen = old / nloc;
        if (old + 1u == (gen + 1u) * nloc) {
            __builtin_amdgcn_fence(__ATOMIC_RELEASE, "agent");
            asm volatile("s_waitcnt vmcnt(0)" ::: "memory");
            const unsigned og = xb_add(&bar[XB_TOP], 1u);
            const unsigned tg = og / nx;
            if (og + 1u == (tg + 1u) * nx) xb_add(&bar[XB_TOPGEN], 1u);
            else XB_SPIN(xb_ld(&bar[XB_TOPGEN]) == tg, bar);
            __builtin_amdgcn_fence(__ATOMIC_ACQUIRE, "agent");
            xb_add(&bar[XB_XGEN(b.x)], 1u);
            asm volatile("s_waitcnt vmcnt(0)" ::: "memory");
        } else {
            XB_SPIN(xb_ld(&bar[XB_XGEN(b.x)]) == gen, bar);
            __builtin_amdgcn_fence(__ATOMIC_ACQUIRE, "agent");
            asm volatile("s_waitcnt vmcnt(0)" ::: "memory");
        }
    }
    __syncthreads();
}
__global__ void __launch_bounds__(512) mega(Params p) {
    extern __shared__ __attribute__((aligned(16))) unsigned char smem[];
    __shared__ uint4 xb_words;
    cg::grid_group grid = cg::this_grid();
    if (threadIdx.x == 0) xb_words = make_uint4(0u, 0u, 0u, 0u);
    __syncthreads();
    const XcdBarrier xb = xcd_barrier_post((unsigned*)(p.ws + O_BAR), (volatile LAS unsigned*)&xb_words);
    unsigned long long tsel = 0;
    for (int ph = p.ph_lo; ph < p.ph_hi; ++ph) {
        const unsigned long long t0 = PROBE_MASK ? wall_clock64() : 0ull;
        run_phase(p, ph, smem);
        if (p.coop && ph + 1 < p.ph_hi) { if (ph == 0) grid.sync(); else xcd_barrier(xb); }
        if (PROBE_MASK) { const int sidx = ph == 0 ? 17 : phase_case(ph); if ((PROBE_MASK >> sidx) & 1u) tsel += wall_clock64() - t0; }
    }
    if (PROBE_MASK && blockIdx.x == 0) { const unsigned long long t0 = wall_clock64(); while (wall_clock64() - t0 < tsel) __builtin_amdgcn_s_sleep(64); }
}

extern "C" void kernel_launch(void* const* d_in, const int* in_sizes, int n_in, void* d_out, int out_size, void* d_ws, size_t ws_size, hipStream_t stream) {
    static int grid = 0;
    if (grid == 0) {
        if (n_in != 27 || ws_size < WS_END) { fprintf(stderr, "kernel_launch: need 27 inputs and %zu bytes of workspace; got %d, %zu\n", (size_t)WS_END, n_in, ws_size); grid = -1; return; }
        int dev = 0, cus = 0, per_cu = 0;
        hipGetDevice(&dev); hipDeviceGetAttribute(&cus, hipDeviceAttributeMultiprocessorCount, dev);
        if (hipFuncSetAttribute((const void*)mega, hipFuncAttributeMaxDynamicSharedMemorySize, LDS_BYTES) != hipSuccess) { fprintf(stderr, "kernel_launch: hipFuncSetAttribute failed\n"); grid = -1; return; }
        if (hipOccupancyMaxActiveBlocksPerMultiprocessor(&per_cu, (const void*)mega, 512, LDS_BYTES) != hipSuccess || per_cu < 1) { fprintf(stderr, "kernel_launch: occupancy query gave %d\n", per_cu); per_cu = 1; }
        (void)hipGetLastError();
        grid = cus;
    }
    if (grid < 0) return;
    Params p{};
    const float** pp = (const float**)&p;
    for (int i = 0; i < 27; ++i) pp[i] = (const float*)d_in[i];
    p.out = (float*)d_out; p.ws = (unsigned char*)d_ws; p.ph_lo = 0; p.ph_hi = N_PHASES; p.coop = 1; p.pad = 0;
    (void)hipMemsetAsync((unsigned char*)d_ws + O_BAR, 0, XCD_BAR_WORDS * 4, stream);
    void* args[] = {&p};
    hipError_t e = hipLaunchCooperativeKernel((const void*)mega, dim3(grid), dim3(512), args, LDS_BYTES, stream);
    if (e != hipSuccess) {
        fprintf(stderr, "cooperative launch failed: %s (grid %d); falling back to one launch per phase\n", hipGetErrorString(e), grid);
        (void)hipGetLastError();
        p.coop = 0;
        for (int ph = 0; ph < N_PHASES; ++ph) { p.ph_lo = ph; p.ph_hi = ph + 1; hipLaunchKernelGGL(mega, dim3(grid), dim3(512), LDS_BYTES, stream, p); }
    }
}
```

```cpp
#include <hip/hip_runtime.h>
#include <hip/hip_cooperative_groups.h>
#include <cstdio>
namespace cg = cooperative_groups;

#define DI __device__ __forceinline__
#define LAS __attribute__((address_space(3)))
typedef unsigned short bf16_t;
typedef short bf16x8 __attribute__((ext_vector_type(8)));
typedef float f32x2 __attribute__((ext_vector_type(2)));
typedef float f32x4 __attribute__((ext_vector_type(4)));
typedef float f32x16 __attribute__((ext_vector_type(16)));
typedef unsigned u32x2 __attribute__((ext_vector_type(2)));
typedef unsigned u32x4 __attribute__((ext_vector_type(4)));
typedef __bf16 bfv2 __attribute__((ext_vector_type(2)));

constexpr int DM = 1024, NB = 4, SEQ = 8192, CTXL = 256, DEPTH = 4;
constexpr int ML = NB * SEQ, MC = NB * CTXL, MA = ML + MC;
constexpr int DFF = 2816, NH = 8, TK = SEQ + CTXL;
constexpr int NIN = 3840;
constexpr int NMOD = 9 * DM;
constexpr float EPS = 1e-6f;
constexpr float QSCALE = 0.10206207261596577f * 1.4426950408889634f;
constexpr int NCH = 132;

constexpr size_t SZ_FFIN = (size_t)2 * DFF * DM * 2, SZ_FFOUT = (size_t)DM * DFF * 2;
constexpr size_t O_WFF1IN = 0;
constexpr size_t O_WFF1OUT = O_WFF1IN + SZ_FFIN;
constexpr size_t O_WFF2IN = O_WFF1OUT + SZ_FFOUT;
constexpr size_t O_WFF2OUT = O_WFF2IN + SZ_FFIN;
constexpr size_t O_WIN = O_WFF2OUT + SZ_FFOUT;
constexpr size_t O_WUQ = O_WIN + (size_t)NIN * DM * 2;
constexpr size_t O_WUKV = O_WUQ + (size_t)768 * 384 * 2;
constexpr size_t O_WOA = O_WUKV + (size_t)1024 * 256 * 2;
constexpr size_t O_WOL = O_WOA + (size_t)1024 * 512 * 2;
constexpr size_t O_WOUT = O_WOL + (size_t)1024 * 512 * 2;
constexpr size_t O_WGATE = O_WOUT + (size_t)1024 * 1024 * 2;
constexpr size_t O_MOD = O_WGATE + (size_t)2048 * 256 * 2;
constexpr size_t O_RSQ = O_MOD + (size_t)DEPTH * 5 * NMOD * 4;
constexpr size_t O_RSKV = O_RSQ + (size_t)MA * 4;
constexpr size_t O_AGG = O_RSKV + (size_t)MA * 4;
constexpr size_t O_SP = O_AGG + (size_t)2 * NB * NCH * 512 * 8;
constexpr size_t O_BAR = O_SP + 4096;
constexpr size_t O_SS = O_BAR + 16384;
constexpr size_t O_SHW = O_SS + (size_t)3 * MA * 16 * 4;
constexpr size_t O_X = O_SHW + (size_t)3 * 5 * 5632 * 4;
constexpr size_t O_R1 = O_X + (size_t)MA * DM * 4;
constexpr size_t O_UXY = O_R1 + (size_t)MA * DFF * 2;
constexpr size_t O_XNY = O_UXY + (size_t)MA * 1024 * 2;
constexpr size_t O_S = O_XNY + (size_t)MA * 1024 * 2;
constexpr size_t WS_END = O_S + (size_t)MA * 1024 * 4;
constexpr int LDS_BYTES = 131072;

struct Params {
    const float *x, *c, *ctx, *c_ctx, *w_ada, *b_ada, *ff1_w_in, *ff1_w_out, *ff2_w_in, *ff2_w_out, *w_in, *q_a_norm, *w_uq, *kv_a_norm, *w_ukv, *q_norm, *k_norm,
        *conv_w, *conv_b, *lru_lambda, *w_rgate, *b_rgate, *w_igate, *b_igate, *w_o_attn, *w_o_lru, *w_out;
    float* out; unsigned char* ws;
    int ph_lo, ph_hi, coop, pad;
};

DI int tidx_() { int t = threadIdx.x; asm volatile("" : "+v"(t)); return t; }
DI int bidx_() { int t = blockIdx.x; asm volatile("" : "+s"(t)); return t; }
#define TIDX tidx_()
#define BIDX bidx_()
DI unsigned pk2(float lo, float hi) { f32x2 v = {lo, hi}; bfv2 r = __builtin_convertvector(v, bfv2); return __builtin_bit_cast(unsigned, r); }
DI bf16_t f2bf(float x) { return (bf16_t)(pk2(x, 0.f) & 0xffffu); }
DI float bf2f(bf16_t v) { return __uint_as_float((unsigned)v << 16); }
DI float bflo(unsigned v) { return __uint_as_float(v << 16); }
DI float bfhi(unsigned v) { return __uint_as_float(v & 0xffff0000u); }
DI float wave_sum(float v) {
#pragma unroll
    for (int o = 1; o < 64; o <<= 1) v += __shfl_xor(v, o);
    return v;
}
DI float sigmoidf_(float x) { return __builtin_amdgcn_rcpf(1.f + __expf(-x)); }
DI int mod_row(int row) { return row < ML ? (row >> 13) : 4; }
DI float row_rstd(const float* SSP, int row) {
    const f32x4* q = (const f32x4*)(SSP + (size_t)row * 16); const f32x4 a = q[0], b = q[1], c = q[2], d = q[3];
    const float s = ((a[0] + a[1]) + (a[2] + a[3])) + ((b[0] + b[1]) + (b[2] + b[3])) + ((c[0] + c[1]) + (c[2] + c[3])) + ((d[0] + d[1]) + (d[2] + d[3]));
    return __builtin_amdgcn_rsqf(s * (1.f / DM) + EPS);
}

constexpr int BM = 256, BK = 64, HALF = 128, HTB = HALF * BK * 2, NXCD = 8, WGM = 8;
DI int lds_byte(int r, int c) { const int st = (r >> 4) * 2 + (c >> 5), rr = r & 15, cc = c & 31, ob = rr * 64 + cc * 2; return st * 1024 + (ob ^ (((ob >> 9) & 1) << 5)); }
DI void stage_rc(int b, int& R, int& C) { const int st = b / 1024, sb = b % 1024, swz = sb ^ (((sb >> 9) & 1) << 5); R = (st >> 1) * 16 + swz / 64; C = (st & 1) * 32 + (swz % 64) / 2; }
struct Unit { int pm, pn; };
struct Gemm { const bf16_t* A; const bf16_t* Bt; int M, N, K, lda, ldb; int rot = 0; };
struct StaticOrder {
    int nM, nN, nwg, G, c;
    DI void init(int M, int N, int G_, int c_) { nM = M / BM; nN = N / BM; nwg = nM * nN; G = G_; c = c_; }
    DI bool next(int i, Unit& u) const {
        const long L = (long)i * G + c; if (L >= nwg) return false;
        int wgid = (int)L; { const int q = nwg / NXCD, r = nwg % NXCD, xcd = wgid % NXCD, off = wgid / NXCD; wgid = (xcd < r ? xcd * (q + 1) : r * (q + 1) + (xcd - r) * q) + off; }
        const int nig = WGM * nN, gid = wgid / nig, fm = gid * WGM, gsz = (nM - fm) < WGM ? (nM - fm) : WGM;
        u.pm = fm + ((wgid % nig) % gsz); u.pn = (wgid % nig) / gsz; return true;
    }
};

DI int perm32(int rho) { const int n = rho >> 4, i = rho & 15; return 8 * (i >> 2) + 4 * n + (i & 3); }
template <class Epi, bool GATE_A, bool PERM = false>
DI void gemm_phase(LAS unsigned char* lds, const Gemm g, const Epi& E) {
    const int tid = TIDX, wid = __builtin_amdgcn_readfirstlane(tid >> 6), lane = tid & 63, wr = wid >> 2, wc = wid & 3, fr = lane & 15, fq = lane >> 4;
    const int K = g.K, nt = K / BK;
    StaticOrder S; S.init(g.M, g.N, gridDim.x, (BIDX - g.rot + (int)gridDim.x) % (int)gridDim.x);
    unsigned voffA[2], voffB[2];
#pragma unroll
    for (int i = 0; i < 2; ++i) { int R, C; stage_rc(tid * 16 + i * 8192, R, C); const int Rb = PERM ? ((R & ~31) + perm32(R & 31)) : R; voffA[i] = (unsigned)(R * g.lda + C) * 2u; voffB[i] = (unsigned)(Rb * g.ldb + C) * 2u; }
#pragma unroll
    for (int i = 0; i < 2; ++i) { asm volatile("" : "+v"(voffA[i])); asm volatile("" : "+v"(voffB[i])); }
    const size_t kstep = (size_t)(BK * 2);
    const size_t hstepA = (size_t)HALF * g.lda * 2, hstepB = (size_t)HALF * g.ldb * 2;
    const size_t tstepA = 2 * hstepA, tstepB = 2 * hstepB;
    const unsigned ldsw = (unsigned)wid * 1024u;
    const int aoff = lds_byte(wr * 64 + fr, fq * 8), boff = lds_byte(wc * 32 + fr, fq * 8);
#define PG8_SA(b, h) (((b) * 2 + (h)) * HTB)
#define PG8_SB(b, h) ((4 + (b) * 2 + (h)) * HTB)
#define PG8_STAGE(bufoff, gbase, voff) do { _Pragma("unroll") for (int _i = 0; _i < 2; ++_i) \
        __builtin_amdgcn_global_load_lds((const unsigned*)((const char*)(gbase) + (voff)[_i]), (LAS unsigned*)(lds + (bufoff) + ldsw + _i * 8192), 16, 0, 0); } while (0)
#define PG8_LDA(dst, b, h) do { _Pragma("unroll") for (int m = 0; m < 4; ++m) _Pragma("unroll") for (int k = 0; k < 2; ++k) dst[m][k] = *(const LAS bf16x8*)(lds + PG8_SA(b, h) + aoff + m * 2048 + k * 1024); } while (0)
#define PG8_LDB(dst, b, h) do { _Pragma("unroll") for (int n = 0; n < 2; ++n) _Pragma("unroll") for (int k = 0; k < 2; ++k) dst[n][k] = *(const LAS bf16x8*)(lds + PG8_SB(b, h) + boff + n * 2048 + k * 1024); } while (0)
#define PG8_MMA(ai, bj, At, Bt) do { __builtin_amdgcn_s_setprio(1); _Pragma("unroll") for (int m = 0; m < 4; ++m) _Pragma("unroll") for (int n = 0; n < 2; ++n) _Pragma("unroll") for (int k = 0; k < 2; ++k) \
        acc[ai][bj][m][n] = __builtin_amdgcn_mfma_f32_16x16x32_bf16(Bt[n][k], At[m][k], acc[ai][bj][m][n], 0, 0, 0); __builtin_amdgcn_s_setprio(0); } while (0)
#define PG8_WAIT_V(n) asm volatile("s_waitcnt vmcnt(" #n ")" ::: "memory")
#define PG8_WAIT_L(n) asm volatile("s_waitcnt lgkmcnt(" #n ")" ::: "memory")
#define PG8_BAR __builtin_amdgcn_s_barrier()
#define PG8_SCHED __builtin_amdgcn_sched_barrier(0)
#define PG8_ABASE(u) ((const char*)g.A + (size_t)(u).pm * tstepA + (GATE_A ? (size_t)((((u).pn & 3) >> 1) * 512) : (size_t)0))
    Unit cur, nxt; int ui = 0;
    if (!S.next(0, cur)) return;
    f32x4 acc[2][2][4][2];
#pragma unroll
    for (int a = 0; a < 2; ++a)
#pragma unroll
        for (int b = 0; b < 2; ++b)
#pragma unroll
            for (int m = 0; m < 4; ++m)
#pragma unroll
                for (int n = 0; n < 2; ++n) acc[a][b][m][n] = (f32x4){0.f, 0.f, 0.f, 0.f};
    bf16x8 At[4][2], B0[2][2], B1[2][2];
    const char* cA = PG8_ABASE(cur); const char* cB = (const char*)g.Bt + (size_t)cur.pn * tstepB;
    PG8_STAGE(PG8_SB(0, 0), cB, voffB); PG8_STAGE(PG8_SA(0, 0), cA, voffA); PG8_STAGE(PG8_SB(0, 1), cB + hstepB, voffB); PG8_STAGE(PG8_SA(0, 1), cA + hstepA, voffA);
    if (wr == 1) PG8_BAR;
    PG8_WAIT_V(4); PG8_BAR;
    PG8_STAGE(PG8_SB(1, 0), cB + kstep, voffB); PG8_STAGE(PG8_SA(1, 0), cA + kstep, voffA); PG8_STAGE(PG8_SB(1, 1), cB + hstepB + kstep, voffB);
    PG8_WAIT_V(6); PG8_BAR;
    for (;;) {
        const bool has_next = S.next(ui + 1, nxt);
        const char* nA = has_next ? PG8_ABASE(nxt) : cA; const char* nB = has_next ? (const char*)g.Bt + (size_t)nxt.pn * tstepB : cB;
#pragma nounroll
        for (int t = 0; t < nt; t += 2) {
            const bool last = (t == nt - 2);
            const char* a1 = cA + (size_t)(t + 1) * kstep;
            const char* a2 = last ? nA : cA + (size_t)(t + 2) * kstep; const char* b2 = last ? nB : cB + (size_t)(t + 2) * kstep;
            const char* a3 = a2 + kstep; const char* b3 = b2 + kstep;
            PG8_LDB(B0, 0, 0); PG8_SCHED; PG8_LDA(At, 0, 0); PG8_STAGE(PG8_SA(1, 1), a1 + hstepA, voffA);
            PG8_WAIT_L(8); PG8_BAR; PG8_WAIT_L(0); PG8_MMA(0, 0, At, B0); PG8_BAR; PG8_SCHED;
            PG8_LDB(B1, 0, 1); PG8_STAGE(PG8_SB(0, 0), b2, voffB);
            PG8_BAR; PG8_WAIT_L(0); PG8_MMA(0, 1, At, B1); PG8_BAR;
            PG8_LDA(At, 0, 1); PG8_STAGE(PG8_SA(0, 0), a2, voffA);
            PG8_BAR; PG8_WAIT_L(0); PG8_MMA(1, 0, At, B0); PG8_BAR; PG8_SCHED;
            PG8_STAGE(PG8_SB(0, 1), b2 + hstepB, voffB);
            PG8_WAIT_V(6); PG8_BAR; PG8_MMA(1, 1, At, B1); PG8_BAR;
            PG8_LDB(B0, 1, 0); PG8_SCHED; PG8_LDA(At, 1, 0); PG8_STAGE(PG8_SA(0, 1), a2 + hstepA, voffA);
            PG8_WAIT_L(8); PG8_BAR; PG8_WAIT_L(0); PG8_MMA(0, 0, At, B0); PG8_BAR; PG8_SCHED;
            PG8_LDB(B1, 1, 1); PG8_STAGE(PG8_SB(1, 0), b3, voffB);
            PG8_BAR; PG8_WAIT_L(0); PG8_MMA(0, 1, At, B1); PG8_BAR;
            PG8_LDA(At, 1, 1); PG8_STAGE(PG8_SA(1, 0), a3, voffA);
            PG8_BAR; PG8_WAIT_L(0); PG8_MMA(1, 0, At, B0); PG8_BAR; PG8_SCHED;
            PG8_STAGE(PG8_SB(1, 1), b3 + hstepB, voffB);
            PG8_WAIT_V(6); PG8_BAR; PG8_MMA(1, 1, At, B1); PG8_BAR;
        }
        E(acc, cur, wr, wc, fr, fq);
        if (!has_next) break;
#pragma unroll
        for (int a = 0; a < 2; ++a)
#pragma unroll
            for (int b = 0; b < 2; ++b)
#pragma unroll
                for (int m = 0; m < 4; ++m)
#pragma unroll
                    for (int n = 0; n < 2; ++n) acc[a][b][m][n] = (f32x4){0.f, 0.f, 0.f, 0.f};
        cur = nxt; cA = nA; cB = nB; ++ui;
    }
    PG8_WAIT_V(0);
    if (wr == 0) PG8_BAR;
    PG8_BAR;
#undef PG8_SA
#undef PG8_SB
#undef PG8_STAGE
#undef PG8_LDA
#undef PG8_LDB
#undef PG8_MMA
#undef PG8_WAIT_V
#undef PG8_WAIT_L
#undef PG8_BAR
#undef PG8_SCHED
#undef PG8_ABASE
}

template <class F> struct EpiElem {
    F f;
    DI void operator()(const f32x4 (&acc)[2][2][4][2], const Unit& u, int wr, int wc, int fr, int fq) const {
        const int row0 = u.pm * BM + wr * 64 + fr, col0 = u.pn * BM + wc * 32 + 4 * fq;
#pragma unroll
        for (int ai = 0; ai < 2; ++ai)
#pragma unroll
            for (int m = 0; m < 4; ++m)
#pragma unroll
                for (int bj = 0; bj < 2; ++bj)
#pragma unroll
                    for (int n = 0; n < 2; ++n) { f(row0 + ai * HALF + m * 16, col0 + bj * HALF + n * 16, acc[ai][bj][m][n]); }
    }
};
template <class F> struct EpiElemRow {
    F f;
    DI void operator()(const f32x4 (&acc)[2][2][4][2], const Unit& u, int wr, int wc, int fr, int fq) const {
        const int row0 = u.pm * BM + wr * 64 + fr, col0 = u.pn * BM + wc * 32 + 4 * fq;
#pragma unroll
        for (int ai = 0; ai < 2; ++ai)
#pragma unroll
            for (int m = 0; m < 4; ++m) {
                float ssq = 0.f;
#pragma unroll
                for (int bj = 0; bj < 2; ++bj)
#pragma unroll
                    for (int n = 0; n < 2; ++n) { ssq += f(row0 + ai * HALF + m * 16, col0 + bj * HALF + n * 16, acc[ai][bj][m][n]); }
                ssq += __shfl_xor(ssq, 16); ssq += __shfl_xor(ssq, 32);
                if (fq == 0) f.row(row0 + ai * HALF + m * 16, (u.pn & 3) * 4 + wc, ssq);
            }
    }
};
template <class F> struct EpiElemRS {
    F f;
    DI void operator()(const f32x4 (&acc)[2][2][4][2], const Unit& u, int wr, int wc, int fr, int fq) const {
        const int row0 = u.pm * BM + wr * 64 + fr, col0 = u.pn * BM + wc * 32 + 4 * fq;
#pragma unroll
        for (int ai = 0; ai < 2; ++ai)
#pragma unroll
            for (int m = 0; m < 4; ++m) {
                const float rs = f.rs(row0 + ai * HALF + m * 16);
#pragma unroll
                for (int bj = 0; bj < 2; ++bj)
#pragma unroll
                    for (int n = 0; n < 2; ++n) { f(row0 + ai * HALF + m * 16, col0 + bj * HALF + n * 16, acc[ai][bj][m][n], rs); }
            }
    }
};
template <class F> struct EpiPairRS {
    F f;
    DI void operator()(const f32x4 (&acc)[2][2][4][2], const Unit& u, int wr, int wc, int fr, int fq) const {
        const int row0 = u.pm * BM + wr * 64 + fr, c0 = wc * 32 + 4 * fq;
#pragma unroll
        for (int ai = 0; ai < 2; ++ai)
#pragma unroll
            for (int m = 0; m < 4; ++m) {
                const float rs = f.rs(row0 + ai * HALF + m * 16);
#pragma unroll
                for (int n = 0; n < 2; ++n) { f(row0 + ai * HALF + m * 16, u.pn, c0 + n * 16, acc[ai][0][m][n], acc[ai][1][m][n], rs); }
            }
    }
};
template <class F> struct EpiElem2 {
    F f;
    DI void operator()(const f32x4 (&acc)[2][2][4][2], const Unit& u, int wr, int wc, int fr, int fq) const {
        const int row0 = u.pm * BM + wr * 64 + fr, col0 = u.pn * BM + wc * 32 + 4 * fq;
        typename F::L cur[2][2], nxt[2][2];
#pragma unroll
        for (int bj = 0; bj < 2; ++bj)
#pragma unroll
            for (int n = 0; n < 2; ++n) cur[bj][n] = f.load(row0, col0 + bj * HALF + n * 16);
#pragma unroll
        for (int i = 0; i < 8; ++i) {
            const int row = row0 + (i >> 2) * HALF + (i & 3) * 16;
            if (i < 7) { const int rown = row0 + ((i + 1) >> 2) * HALF + ((i + 1) & 3) * 16;
#pragma unroll
                for (int bj = 0; bj < 2; ++bj)
#pragma unroll
                    for (int n = 0; n < 2; ++n) nxt[bj][n] = f.load(rown, col0 + bj * HALF + n * 16); }
#pragma unroll
            for (int bj = 0; bj < 2; ++bj)
#pragma unroll
                for (int n = 0; n < 2; ++n) f.apply(row, col0 + bj * HALF + n * 16, acc[i >> 2][bj][i & 3][n], cur[bj][n]);
#pragma unroll
            for (int bj = 0; bj < 2; ++bj)
#pragma unroll
                for (int n = 0; n < 2; ++n) cur[bj][n] = nxt[bj][n];
        }
    }
};
template <class F> struct EpiElem8 {
    F f;
    DI void operator()(const f32x4 (&acc)[2][2][4][2], const Unit& u, int wr, int wc, int fr, int fq) const {
        const int row0 = u.pm * BM + wr * 64 + fr, col0 = u.pn * BM + wc * 32 + 8 * fq;
        typename F::L cur[2], nxt[2];
#pragma unroll
        for (int bj = 0; bj < 2; ++bj) cur[bj] = f.load(row0, col0 + bj * HALF);
#pragma unroll
        for (int i = 0; i < 8; ++i) {
            const int row = row0 + (i >> 2) * HALF + (i & 3) * 16;
            if (i < 7) { const int rown = row0 + ((i + 1) >> 2) * HALF + ((i + 1) & 3) * 16;
#pragma unroll
                for (int bj = 0; bj < 2; ++bj) nxt[bj] = f.load(rown, col0 + bj * HALF); }
#pragma unroll
            for (int bj = 0; bj < 2; ++bj) f.apply(row, col0 + bj * HALF, acc[i >> 2][bj][i & 3][0], acc[i >> 2][bj][i & 3][1], cur[bj]);
#pragma unroll
            for (int bj = 0; bj < 2; ++bj) cur[bj] = nxt[bj];
        }
    }
};
template <class F> struct EpiPair {
    F f;
    DI void operator()(const f32x4 (&acc)[2][2][4][2], const Unit& u, int wr, int wc, int fr, int fq) const {
        const int row0 = u.pm * BM + wr * 64 + fr, c0 = wc * 32 + 4 * fq;
#pragma unroll
        for (int ai = 0; ai < 2; ++ai)
#pragma unroll
            for (int m = 0; m < 4; ++m)
#pragma unroll
                for (int n = 0; n < 2; ++n) { f(row0 + ai * HALF + m * 16, u.pn, c0 + n * 16, acc[ai][0][m][n], acc[ai][1][m][n]); }
    }
};
DI void st_bf4(bf16_t* p, f32x4 v) { u32x2 o; o.x = pk2(v[0], v[1]); o.y = pk2(v[2], v[3]); *(u32x2*)p = o; }
DI void st_bf8(bf16_t* p, f32x4 lo, f32x4 hi) { u32x4 o; o.x = pk2(lo[0], lo[1]); o.y = pk2(lo[2], lo[3]); o.z = pk2(hi[0], hi[1]); o.w = pk2(hi[2], hi[3]); *(u32x4*)p = o; }

struct FSwiglu { bf16_t* H; const float* SS; const float* shw;
    DI float rs(int row) const { return row_rstd(SS, row); }
    DI void operator()(int row, int pn, int c, f32x4 g, f32x4 u, float rs) const {
        const float* sw = shw + mod_row(row) * 5632 + pn * 256 + c;
        g = g * rs + *(const f32x4*)sw; u = u * rs + *(const f32x4*)(sw + 128);
        f32x4 h;
#pragma unroll
        for (int e = 0; e < 4; ++e) h[e] = g[e] * sigmoidf_(g[e]) * u[e];
        st_bf4(H + (size_t)row * DFF + pn * 128 + c, h);
    } };
struct FResid { const float* src; float* dst; const float* mod; float coef;
    DI void operator()(int row, int col, f32x4 v) const {
        const f32x4 g = *(const f32x4*)(mod + mod_row(row) * NMOD + col);
        const f32x4 x = *(const f32x4*)(src + (size_t)row * DM + col);
        *(f32x4*)(dst + (size_t)row * DM + col) = x + coef * g * v;
    } };
template <int COEF2> struct FResidN { const float* src; float* dst; const float* mod; const float* scn; bf16_t* XS; float* SS;
    DI float operator()(int row, int col, f32x4 v) const {
        const int r = mod_row(row);
        const f32x4 g = *(const f32x4*)(mod + r * NMOD + col);
        const f32x4 x = *(const f32x4*)(src + (size_t)row * DM + col);
        const f32x4 xn = x + (0.5f * COEF2) * g * v;
        *(f32x4*)(dst + (size_t)row * DM + col) = xn;
        const f32x4 sc = *(const f32x4*)(scn + r * NMOD + col);
        st_bf4(XS + (size_t)row * DM + col, xn * (1.f + sc));
        return (xn[0] * xn[0] + xn[1] * xn[1]) + (xn[2] * xn[2] + xn[3] * xn[3]);
    }
    DI void row(int row, int slot, float ssq) const { SS[(size_t)row * 16 + slot] = ssq; } };
struct FWin { bf16_t *P1, *UXY, *GATE; const float* SS; const float* shw;
    DI float rs(int row) const { return row_rstd(SS, row); }
    DI void operator()(int row, int col, f32x4 v, float rs) const {
        v = v * rs + *(const f32x4*)(shw + mod_row(row) * 5632 + col);
        bf16_t* p = col < 768 ? P1 + (size_t)row * 768 + col : (col < 1792 ? UXY + (size_t)row * 1024 + (col - 768) : GATE + (size_t)row * 2048 + (col - 1792));
        st_bf4(p, v);
    } };
struct FRowScale { bf16_t* dst; int ld; const float* rs;
    typedef float L;
    DI L load(int row, int) const { return rs[row]; }
    DI void apply(int row, int col, f32x4 v0, f32x4 v1, L sc) const { st_bf8(dst + (size_t)row * ld + col, v0 * sc, v1 * sc); } };
struct FVt { bf16_t* Vt; const float* rs;
    struct L { f32x4 a, b; };
    DI L load(int, int col) const { return L{*(const f32x4*)(rs + col), *(const f32x4*)(rs + col + 4)}; }
    DI void apply(int row, int col, f32x4 v0, f32x4 v1, L sc) const {
        int b, kpos; if (col < ML) { b = col >> 13; kpos = col & (SEQ - 1); } else { const int r = col - ML; b = r >> 8; kpos = SEQ + (r & 255); }
        st_bf8(Vt + ((size_t)(b * NH + (row >> 6)) * 64 + (row & 63)) * TK + kpos, v0 * sc.a, v1 * sc.b);
    } };
struct EGate { const bf16_t* xc; bf16_t *OM, *BB; const float *sp8, *br, *bi;
    DI void operator()(const f32x4 (&acc)[2][2][4][2], const Unit& u, int wr, int wc, int fr, int fq) const {
        const int row0 = u.pm * BM + wr * 64 + fr, d = u.pn >> 2, ch0 = (u.pn & 3) * 128 + wc * 32 + 8 * fq;
        f32x4 s4[2], br4[2], bi4[2]; u32x4 xcur, xnxt;
#pragma unroll
        for (int n = 0; n < 2; ++n) { s4[n] = *(const f32x4*)(sp8 + d * 512 + ch0 + 4 * n); br4[n] = *(const f32x4*)(br + d * 512 + ch0 + 4 * n); bi4[n] = *(const f32x4*)(bi + d * 512 + ch0 + 4 * n); }
        xcur = *(const u32x4*)(xc + (size_t)row0 * 512 + ch0);
#pragma unroll
        for (int i = 0; i < 8; ++i) {
            const int row = row0 + (i >> 2) * HALF + (i & 3) * 16;
            if (i < 7) { const int rown = row0 + ((i + 1) >> 2) * HALF + ((i + 1) & 3) * 16; xnxt = *(const u32x4*)(xc + (size_t)rown * 512 + ch0); }
            f32x4 om[2], bb[2];
#pragma unroll
            for (int n = 0; n < 2; ++n) {
                const f32x4 r4 = acc[i >> 2][0][i & 3][n], i4 = acc[i >> 2][1][i & 3][n];
                const unsigned w0 = n == 0 ? xcur.x : xcur.z, w1 = n == 0 ? xcur.y : xcur.w;
                const f32x4 xf = {bflo(w0), bfhi(w0), bflo(w1), bfhi(w1)};
#pragma unroll
                for (int e = 0; e < 4; ++e) {
                    const float r = sigmoidf_(r4[e] + br4[n][e]), ig = sigmoidf_(i4[e] + bi4[n][e]);
                    const float a = __expf(s4[n][e] * r);
                    om[n][e] = 1.f - a; bb[n][e] = __fsqrt_rn(fmaxf(1.f - a * a, 0.f)) * (ig * xf[e]);
                }
            }
            const size_t o = ((size_t)d * MA + row) * 512 + ch0;
            st_bf8(OM + o, om[0], om[1]); st_bf8(BB + o, bb[0], bb[1]);
            xcur = xnxt;
        }
    } };
DI f32x4 sig_lo(u32x4 g) { return (f32x4){sigmoidf_(bflo(g.x)), sigmoidf_(bfhi(g.x)), sigmoidf_(bflo(g.y)), sigmoidf_(bfhi(g.y))}; }
DI f32x4 sig_hi(u32x4 g) { return (f32x4){sigmoidf_(bflo(g.z)), sigmoidf_(bfhi(g.z)), sigmoidf_(bflo(g.w)), sigmoidf_(bfhi(g.w))}; }
struct FMergeA { const bf16_t* GATE; bf16_t* Y;
    typedef u32x4 L;
    DI L load(int row, int col) const { return *(const u32x4*)(GATE + (size_t)row * 2048 + col); }
    DI void apply(int row, int col, f32x4 v0, f32x4 v1, L gv) const { st_bf8(Y + (size_t)row * DM + col, sig_lo(gv) * v0, sig_hi(gv) * v1); } };
struct FMergeB { const bf16_t* GATE; bf16_t* Y;
    struct L { u32x4 g, y; };
    DI L load(int row, int col) const { return L{*(const u32x4*)(GATE + (size_t)row * 2048 + 1024 + col), *(const u32x4*)(Y + (size_t)row * DM + col)}; }
    DI void apply(int row, int col, f32x4 v0, f32x4 v1, L q) const {
        const f32x4 y0 = {bflo(q.y.x), bfhi(q.y.x), bflo(q.y.y), bfhi(q.y.y)}, y1 = {bflo(q.y.z), bfhi(q.y.z), bflo(q.y.w), bfhi(q.y.w)};
        st_bf8(Y + (size_t)row * DM + col, y0 + sig_lo(q.g) * v0, y1 + sig_hi(q.g) * v1);
    } };

struct ESwiglu { bf16_t* H; const float* SS; const float* shw;
    DI void operator()(const f32x4 (&acc)[2][2][4][2], const Unit& u, int wr, int wc, int fr, int fq) const {
        const int row0 = u.pm * BM + wr * 64 + fr, c0 = wc * 32 + 8 * fq;
        const float* sw = shw + mod_row(u.pm * BM) * 5632 + u.pn * 256 + c0;
        f32x4 sg[2], su[2]; float rs[8];
#pragma unroll
        for (int n = 0; n < 2; ++n) { sg[n] = *(const f32x4*)(sw + 4 * n); su[n] = *(const f32x4*)(sw + 128 + 4 * n); }
#pragma unroll
        for (int i = 0; i < 8; ++i) rs[i] = row_rstd(SS, row0 + (i >> 2) * HALF + (i & 3) * 16);
#pragma unroll
        for (int ai = 0; ai < 2; ++ai)
#pragma unroll
            for (int m = 0; m < 4; ++m) {
                f32x4 h[2];
#pragma unroll
                for (int n = 0; n < 2; ++n) {
                    const f32x4 g = acc[ai][0][m][n] * rs[ai * 4 + m] + sg[n], uu = acc[ai][1][m][n] * rs[ai * 4 + m] + su[n];
#pragma unroll
                    for (int e = 0; e < 4; ++e) h[n][e] = g[e] * sigmoidf_(g[e]) * uu[e];
                }
                st_bf8(H + (size_t)(row0 + ai * HALF + m * 16) * DFF + u.pn * 128 + c0, h[0], h[1]);
            }
    } };
struct EWin { bf16_t *P1, *UXY, *GATE; const float* SS; const float* shw;
    template <int LD> DI void body(const f32x4 (&acc)[2][2][4][2], bf16_t* dst, const f32x4 (&sh)[2][2], const float (&rs)[8]) const {
#pragma unroll
        for (int ai = 0; ai < 2; ++ai)
#pragma unroll
            for (int m = 0; m < 4; ++m)
#pragma unroll
                for (int bj = 0; bj < 2; ++bj)
                    st_bf8(dst + (size_t)(ai * HALF + m * 16) * LD + 128 * bj, acc[ai][bj][m][0] * rs[ai * 4 + m] + sh[bj][0], acc[ai][bj][m][1] * rs[ai * 4 + m] + sh[bj][1]);
    }
    DI void operator()(const f32x4 (&acc)[2][2][4][2], const Unit& u, int wr, int wc, int fr, int fq) const {
        const int row0 = u.pm * BM + wr * 64 + fr, c0 = wc * 32 + 8 * fq;
        const float* sw = shw + mod_row(u.pm * BM) * 5632 + u.pn * 256 + c0;
        f32x4 sh[2][2]; float rs[8];
#pragma unroll
        for (int bj = 0; bj < 2; ++bj)
#pragma unroll
            for (int n = 0; n < 2; ++n) sh[bj][n] = *(const f32x4*)(sw + 128 * bj + 4 * n);
#pragma unroll
        for (int i = 0; i < 8; ++i) { rs[i] = row_rstd(SS, row0 + (i >> 2) * HALF + (i & 3) * 16); if ((i & 1) == 1) __builtin_amdgcn_sched_barrier(0); }
        if (u.pn < 3) body<768>(acc, P1 + (size_t)row0 * 768 + u.pn * 256 + c0, sh, rs);
        else if (u.pn < 7) body<1024>(acc, UXY + (size_t)row0 * 1024 + (u.pn - 3) * 256 + c0, sh, rs);
        else body<2048>(acc, GATE + (size_t)row0 * 2048 + (u.pn - 7) * 256 + c0, sh, rs);
    } };
template <int COEF2, bool NORM> struct EResid { const float* src; float* dst; const float* mod; const float* scn; bf16_t* XS; float* SS;
    DI void operator()(const f32x4 (&acc)[2][2][4][2], const Unit& u, int wr, int wc, int fr, int fq) const {
        const int row0 = u.pm * BM + wr * 64 + fr, col0 = u.pn * BM + wc * 32 + 8 * fq, r = mod_row(u.pm * BM);
        f32x4 g[2][2], sc[2][2];
#pragma unroll
        for (int bj = 0; bj < 2; ++bj)
#pragma unroll
            for (int n = 0; n < 2; ++n) { g[bj][n] = *(const f32x4*)(mod + r * NMOD + col0 + 128 * bj + 4 * n) * (0.5f * COEF2);
                if (NORM) sc[bj][n] = *(const f32x4*)(scn + r * NMOD + col0 + 128 * bj + 4 * n) + 1.f; }
        f32x4 xc[2][2], xn_[2][2];
#pragma unroll
        for (int bj = 0; bj < 2; ++bj)
#pragma unroll
            for (int n = 0; n < 2; ++n) xc[bj][n] = *(const f32x4*)(src + (size_t)row0 * DM + col0 + 128 * bj + 4 * n);
#pragma unroll
        for (int i = 0; i < 8; ++i) {
            const int row = row0 + (i >> 2) * HALF + (i & 3) * 16;
            if (i < 7) { const int rown = row0 + ((i + 1) >> 2) * HALF + ((i + 1) & 3) * 16;
#pragma unroll
                for (int bj = 0; bj < 2; ++bj)
#pragma unroll
                    for (int n = 0; n < 2; ++n) xn_[bj][n] = *(const f32x4*)(src + (size_t)rown * DM + col0 + 128 * bj + 4 * n); }
            float ssq = 0.f;
#pragma unroll
            for (int bj = 0; bj < 2; ++bj) {
                f32x4 y[2];
#pragma unroll
                for (int n = 0; n < 2; ++n) {
                    y[n] = xc[bj][n] + g[bj][n] * acc[i >> 2][bj][i & 3][n];
                    *(f32x4*)(dst + (size_t)row * DM + col0 + 128 * bj + 4 * n) = y[n];
                    if (NORM) ssq += (y[n][0] * y[n][0] + y[n][1] * y[n][1]) + (y[n][2] * y[n][2] + y[n][3] * y[n][3]);
                }
                if (NORM) st_bf8(XS + (size_t)row * DM + col0 + 128 * bj, y[0] * sc[bj][0], y[1] * sc[bj][1]);
            }
            if (NORM) { ssq += __shfl_xor(ssq, 16); ssq += __shfl_xor(ssq, 32); if (fq == 0) SS[(size_t)row * 16 + (u.pn & 3) * 4 + wc] = ssq; }
#pragma unroll
            for (int bj = 0; bj < 2; ++bj)
#pragma unroll
                for (int n = 0; n < 2; ++n) xc[bj][n] = xn_[bj][n];
        }
    } };

DI void phase_mod(const Params& p, float* lds) {
    float* sc = lds;
    float* red = lds + 5 * DM;
    const int tid = TIDX, lane = tid & 63, wave = tid >> 6;
    for (int i = tid; i < 5 * DM; i += 512) { const float v = i < 4 * DM ? p.c[i] : p.c_ctx[i - 4 * DM]; sc[i] = v * sigmoidf_(v); }
    __syncthreads();
    float* mod = (float*)(p.ws + O_MOD);
    for (int it = BIDX; it < DEPTH * (NMOD / 64); it += gridDim.x) {
        const int l = it / (NMOD / 64), n = (it % (NMOD / 64)) * 64 + lane;
        const float* w = p.w_ada + ((size_t)l * DM + wave * 128) * NMOD + n;
        float a0 = 0.f, a1 = 0.f, a2 = 0.f, a3 = 0.f, a4 = 0.f;
#pragma unroll 8
        for (int k = 0; k < 128; ++k) { const float wv = w[(size_t)k * NMOD]; const int kk = wave * 128 + k;
            a0 += sc[kk] * wv; a1 += sc[DM + kk] * wv; a2 += sc[2 * DM + kk] * wv; a3 += sc[3 * DM + kk] * wv; a4 += sc[4 * DM + kk] * wv; }
        red[(wave * 5 + 0) * 64 + lane] = a0; red[(wave * 5 + 1) * 64 + lane] = a1; red[(wave * 5 + 2) * 64 + lane] = a2; red[(wave * 5 + 3) * 64 + lane] = a3; red[(wave * 5 + 4) * 64 + lane] = a4;
        __syncthreads();
        if (tid < 320) { const int r = tid >> 6; float s = p.b_ada[(size_t)l * NMOD + n];
#pragma unroll
            for (int w8 = 0; w8 < 8; ++w8) s += red[(w8 * 5 + r) * 64 + lane];
            mod[((size_t)l * 5 + r) * NMOD + n] = s; }
        __syncthreads();
    }
}

template <int MAP> DI int colmap(int n) {
    if (MAP == 0) return n;
    if (MAP == 1) { const int pn = n >> 8, bj = (n >> 7) & 1, c = n & 127; return bj * DFF + pn * 128 + c; }
    if (MAP == 2) return n < 672 ? n : (n < 768 ? -1 : n - 96);
    { const int m = n & 511, h = m >> 6, d = m & 63; return h * 128 + (n >> 9) * 64 + d; }
}
template <int MAP> DI void tjob(const float* src, int ld, int K, int N, bf16_t* dst, const float* kscale, float* tile, int& base, int vbid, int G) {
    const int tid = TIDX, ntn = N / 64, ntiles = ntn * (K / 64);
    int first = (vbid - base % G + G) % G;
    for (int t = first; t < ntiles; t += G) {
        const int n0 = (t % ntn) * 64, k0 = (t / ntn) * 64;
        const int c = colmap<MAP>(n0 + (tid & 63));
#pragma unroll
        for (int i = 0; i < 8; ++i) { const int kk = (tid >> 6) + 8 * i; float v = c >= 0 ? src[(size_t)(k0 + kk) * ld + c] : 0.f; if (kscale) v *= kscale[k0 + kk]; tile[kk * 65 + (tid & 63)] = v; }
        __syncthreads();
        { const int kc = tid & 7, nn = tid >> 3;
          const float* tp = tile + (kc * 8) * 65 + nn;
          u32x4 o; o.x = pk2(tp[0], tp[65]); o.y = pk2(tp[2 * 65], tp[3 * 65]); o.z = pk2(tp[4 * 65], tp[5 * 65]); o.w = pk2(tp[6 * 65], tp[7 * 65]);
          *(u32x4*)(dst + (size_t)(n0 + nn) * K + k0 + kc * 8) = o; }
        __syncthreads();
    }
    base += ntiles;
}
DI void phase_prep_ff(const Params& p, int l, int which, float* tile, int vbid, int vG) {
    unsigned char* ws = p.ws; int base = 0;
    if (which == 0) {
        tjob<1>(p.ff1_w_in + (size_t)l * DM * 2 * DFF, 2 * DFF, DM, 2 * DFF, (bf16_t*)(ws + O_WFF1IN), nullptr, tile, base, vbid, vG);
        tjob<0>(p.ff1_w_out + (size_t)l * DFF * DM, DM, DFF, DM, (bf16_t*)(ws + O_WFF1OUT), nullptr, tile, base, vbid, vG);
    } else {
        tjob<1>(p.ff2_w_in + (size_t)l * DM * 2 * DFF, 2 * DFF, DM, 2 * DFF, (bf16_t*)(ws + O_WFF2IN), nullptr, tile, base, vbid, vG);
        tjob<0>(p.ff2_w_out + (size_t)l * DFF * DM, DM, DFF, DM, (bf16_t*)(ws + O_WFF2OUT), nullptr, tile, base, vbid, vG);
    }
}
DI void phase_prep(const Params& p, int l, float* tile) {
    unsigned char* ws = p.ws; int base = 0;
    const int vbid = BIDX, vG = gridDim.x;
    const float* modl = (const float*)(ws + O_MOD) + (size_t)l * 5 * NMOD; float* shw = (float*)(ws + O_SHW);
    if (l == 0) phase_prep_ff(p, 0, 0, tile, vbid, vG);
    tjob<2>(p.w_in + (size_t)l * DM * 3744, 3744, DM, NIN, (bf16_t*)(ws + O_WIN), nullptr, tile, base, vbid, vG);
    tjob<0>(p.w_uq + (size_t)l * 384 * 768, 768, 384, 768, (bf16_t*)(ws + O_WUQ), p.q_a_norm + l * 384, tile, base, vbid, vG);
    tjob<3>(p.w_ukv + (size_t)l * 256 * 1024, 1024, 256, 1024, (bf16_t*)(ws + O_WUKV), p.kv_a_norm + l * 256, tile, base, vbid, vG);
    tjob<0>(p.w_o_attn + (size_t)l * 512 * 1024, 1024, 512, 1024, (bf16_t*)(ws + O_WOA), nullptr, tile, base, vbid, vG);
    tjob<0>(p.w_o_lru + (size_t)l * 512 * 1024, 1024, 512, 1024, (bf16_t*)(ws + O_WOL), nullptr, tile, base, vbid, vG);
    tjob<0>(p.w_out + (size_t)l * 1024 * 1024, 1024, 1024, 1024, (bf16_t*)(ws + O_WOUT), nullptr, tile, base, vbid, vG);
    { float* sh = tile; float* red = tile + 5 * DM;
      const int tid = TIDX, nn = tid & 63, ks = tid >> 6;
      for (int it = BIDX; it < 88 + 60 + 88; it += gridDim.x) {
          const int m = it < 88 ? 0 : (it < 148 ? 1 : 2), n0 = (m == 0 ? it : (m == 1 ? it - 88 : it - 148)) * 64;
          const float* W = m == 0 ? p.ff1_w_in + (size_t)l * DM * 2 * DFF : (m == 1 ? p.w_in + (size_t)l * DM * 3744 : p.ff2_w_in + (size_t)l * DM * 2 * DFF);
          const int ld = m == 1 ? 3744 : 2 * DFF, c = m == 1 ? colmap<2>(n0 + nn) : colmap<1>(n0 + nn);
          __syncthreads();
          for (int i = tid; i < 5 * DM; i += 512) sh[i] = modl[(size_t)(i >> 10) * NMOD + m * 3 * DM + (i & 1023)];
          __syncthreads();
          float a0 = 0.f, a1 = 0.f, a2 = 0.f, a3 = 0.f, a4 = 0.f;
          if (c >= 0) {
#pragma unroll 8
              for (int k = ks * 128; k < ks * 128 + 128; ++k) { const float wv = W[(size_t)k * ld + c]; a0 += sh[k] * wv; a1 += sh[DM + k] * wv; a2 += sh[2 * DM + k] * wv; a3 += sh[3 * DM + k] * wv; a4 += sh[4 * DM + k] * wv; }
          }
          red[(ks * 5 + 0) * 64 + nn] = a0; red[(ks * 5 + 1) * 64 + nn] = a1; red[(ks * 5 + 2) * 64 + nn] = a2; red[(ks * 5 + 3) * 64 + nn] = a3; red[(ks * 5 + 4) * 64 + nn] = a4;
          __syncthreads();
          if (tid < 320) { const int r = tid >> 6; float sum = 0.f;
#pragma unroll
              for (int w8 = 0; w8 < 8; ++w8) sum += red[(w8 * 5 + r) * 64 + nn];
              shw[(size_t)(m * 5 + r) * 5632 + n0 + nn] = sum; }
      }
      __syncthreads(); }
    if (BIDX == 0) { float* sp8 = (float*)(ws + O_SP);
        for (int i = TIDX; i < 1024; i += 512) { const float nl = -p.lru_lambda[l * 1024 + i]; sp8[i] = -8.f * (fmaxf(nl, 0.f) + log1pf(__expf(-fabsf(nl)))); } }
    bf16_t* wg = (bf16_t*)(ws + O_WGATE);
    for (int idx = BIDX * 512 + TIDX; idx < 2048 * 256; idx += gridDim.x * 512) {
        const int n = idx >> 8, k = idx & 255, d = n >> 10, cb = (n >> 8) & 3, gt = (n >> 7) & 1, c = n & 127, ch = cb * 128 + c, g = ch >> 6, j = ch & 63, ci = 256 * (cb >> 1) + k, gi = ci >> 6, i = ci & 63;
        float v = 0.f;
        if (gi == g) v = (gt ? p.w_igate : p.w_rgate)[((((size_t)l * 2 + d) * 8 + g) * 64 + i) * 64 + j];
        wg[idx] = f2bf(v);
    }
}

DI void phase_norm0(const Params& p) {
    const int tid = TIDX, lane = tid & 63, gw = BIDX * 8 + (tid >> 6), nw = gridDim.x * 8;
    float* X = (float*)(p.ws + O_X); bf16_t* XS = (bf16_t*)(p.ws + O_XNY); float* SS = (float*)(p.ws + O_SS);
    const float* mod = (const float*)(p.ws + O_MOD);
    for (int row = gw; row < MA; row += nw) {
        const float* src = row < ML ? p.x + (size_t)row * DM : p.ctx + (size_t)(row - ML) * DM;
        f32x4 v[4]; float s = 0.f;
#pragma unroll
        for (int j = 0; j < 4; ++j) { v[j] = *(const f32x4*)(src + 256 * j + 4 * lane); s += (v[j][0] * v[j][0] + v[j][1] * v[j][1]) + (v[j][2] * v[j][2] + v[j][3] * v[j][3]); }
        s = wave_sum(s);
        if (lane < 16) SS[(size_t)row * 16 + lane] = lane == 0 ? s : 0.f;
        const float* mr = mod + (size_t)mod_row(row) * NMOD;
#pragma unroll
        for (int j = 0; j < 4; ++j) {
            const int col = 256 * j + 4 * lane;
            *(f32x4*)(X + (size_t)row * DM + col) = v[j];
            const f32x4 sc = *(const f32x4*)(mr + DM + col);
            st_bf4(XS + (size_t)row * DM + col, v[j] * (1.f + sc));
        }
    }
}

DI void phase_conv(const Params& p, int l) {
    const bf16_t* UXY = (const bf16_t*)(p.ws + O_UXY); const bf16_t* P1 = (const bf16_t*)(p.ws + O_R1);
    bf16_t* xc = (bf16_t*)(p.ws + O_XNY);
    const float* cw = p.conv_w + (size_t)l * 4 * 512; const float* cb = p.conv_b + (size_t)l * 512;
    for (int e = BIDX * 512 + TIDX; e < MA * 64; e += gridDim.x * 512) {
        const int row = e >> 6, ch = (e & 63) * 8;
        int t, T; if (row < ML) { t = row & (SEQ - 1); T = SEQ; } else { t = (row - ML) & 255; T = CTXL; }
        u32x4 uv[4]; float ok[4];
#pragma unroll
        for (int k = 0; k < 4; ++k) { const int tt = t + k - 2; const bool in = tt >= 0 && tt < T; ok[k] = in ? 1.f : 0.f;
            uv[k] = *(const u32x4*)(UXY + (size_t)(in ? row + k - 2 : row) * 1024 + ch); }
        f32x4 y0 = *(const f32x4*)(cb + ch), y1 = *(const f32x4*)(cb + ch + 4);
#pragma unroll
        for (int k = 0; k < 4; ++k) {
            const f32x4 w0 = *(const f32x4*)(cw + k * 512 + ch) * ok[k], w1 = *(const f32x4*)(cw + k * 512 + ch + 4) * ok[k];
            const f32x4 a = {bflo(uv[k].x), bfhi(uv[k].x), bflo(uv[k].y), bfhi(uv[k].y)}, c = {bflo(uv[k].z), bfhi(uv[k].z), bflo(uv[k].w), bfhi(uv[k].w)};
            y0 += w0 * a; y1 += w1 * c;
        }
        u32x4 o; o.x = pk2(y0[0], y0[1]); o.y = pk2(y0[2], y0[3]); o.z = pk2(y1[0], y1[1]); o.w = pk2(y1[2], y1[3]);
        *(u32x4*)(xc + (size_t)row * 512 + ch) = o;
    }
    float* rsq = (float*)(p.ws + O_RSQ); float* rskv = (float*)(p.ws + O_RSKV);
    const int tid2 = TIDX, l16 = tid2 & 15, gq = BIDX * 32 + (tid2 >> 4), nq = gridDim.x * 32;
    for (int row = gq; row < MA; row += nq) {
        const bf16_t* pr = P1 + (size_t)row * 768;
        u32x4 v[5];
#pragma unroll
        for (int i = 0; i < 5; ++i) v[i] = *(const u32x4*)(pr + (l16 + 16 * i) * 8);
        float sq = 0.f, skv = 0.f;
#pragma unroll
        for (int i = 0; i < 5; ++i) {
            const float s2 = bflo(v[i].x) * bflo(v[i].x) + bfhi(v[i].x) * bfhi(v[i].x) + bflo(v[i].y) * bflo(v[i].y) + bfhi(v[i].y) * bfhi(v[i].y)
                           + bflo(v[i].z) * bflo(v[i].z) + bfhi(v[i].z) * bfhi(v[i].z) + bflo(v[i].w) * bflo(v[i].w) + bfhi(v[i].w) * bfhi(v[i].w);
            if (i < 3) sq += s2; else skv += s2;
        }
#pragma unroll
        for (int o = 1; o < 16; o <<= 1) { sq += __shfl_xor(sq, o); skv += __shfl_xor(skv, o); }
        if (l16 == 0) { rsq[row] = rsqrtf(sq * (1.f / 384.f) + EPS); rskv[row] = rsqrtf(skv * (1.f / 256.f) + EPS); }
    }
}

DI int chunk_row0(int b, int pch) { return pch < 4 ? ML + b * CTXL + pch * 64 : b * SEQ + (pch - 4) * 64; }
DI void phase_scan_agg(const Params& p) {
    const bf16_t* OM = (const bf16_t*)(p.ws + O_S); const bf16_t* BB = OM + (size_t)2 * MA * 512;
    f32x4* agg = (f32x4*)(p.ws + O_AGG);
    const int tid = TIDX, lane = tid & 63, gw = (tid >> 6) * gridDim.x + BIDX, nw = gridDim.x * 8;
    for (int it = gw; it < 2 * NB * NCH; it += nw) {
        const int d = it & 1, bp = it >> 1, b = bp / NCH, pch = bp % NCH, row0 = chunk_row0(b, pch);
        const bf16_t* om = OM + ((size_t)d * MA + row0) * 512 + lane * 8; const bf16_t* bb = BB + ((size_t)d * MA + row0) * 512 + lane * 8;
        float h[8], A[8];
#pragma unroll
        for (int i = 0; i < 8; ++i) { h[i] = 0.f; A[i] = 1.f; }
#pragma unroll 8
        for (int t = 0; t < 64; ++t) {
            const int tt = d ? 63 - t : t;
            const u32x4 ov = *(const u32x4*)(om + (size_t)tt * 512), bv = *(const u32x4*)(bb + (size_t)tt * 512);
            const float a[8] = {1.f - bflo(ov.x), 1.f - bfhi(ov.x), 1.f - bflo(ov.y), 1.f - bfhi(ov.y), 1.f - bflo(ov.z), 1.f - bfhi(ov.z), 1.f - bflo(ov.w), 1.f - bfhi(ov.w)};
            const float bq[8] = {bflo(bv.x), bfhi(bv.x), bflo(bv.y), bfhi(bv.y), bflo(bv.z), bfhi(bv.z), bflo(bv.w), bfhi(bv.w)};
#pragma unroll
            for (int i = 0; i < 8; ++i) { h[i] = a[i] * h[i] + bq[i]; A[i] *= a[i]; }
        }
        f32x4* dst = agg + (((size_t)(d * NB + b) * NCH + pch) * 512 + lane * 8) / 2;
#pragma unroll
        for (int i = 0; i < 4; ++i) dst[i] = (f32x4){A[2 * i], h[2 * i], A[2 * i + 1], h[2 * i + 1]};
    }
}
DI float gelu_tanh(float x) { const float u = 0.7978845608028654f * (x + 0.044715f * x * x * x); const float e = __expf(2.f * u); const float th = 1.f - 2.f * __builtin_amdgcn_rcpf(e + 1.f); return 0.5f * x * (1.f + th); }
DI void agg_step(const f32x4* e, float (&h)[8]) {
    const f32x4 e0 = e[0], e1 = e[1], e2 = e[2], e3 = e[3];
    h[0] = e0[0] * h[0] + e0[1]; h[1] = e0[2] * h[1] + e0[3]; h[2] = e1[0] * h[2] + e1[1]; h[3] = e1[2] * h[3] + e1[3];
    h[4] = e2[0] * h[4] + e2[1]; h[5] = e2[2] * h[5] + e2[3]; h[6] = e3[0] * h[6] + e3[1]; h[7] = e3[2] * h[7] + e3[3];
}
DI void phase_scan_apply(const Params& p) {
    const bf16_t* OM = (const bf16_t*)(p.ws + O_S); const bf16_t* BB = OM + (size_t)2 * MA * 512;
    const f32x4* agg = (const f32x4*)(p.ws + O_AGG);
    bf16_t* UXY = (bf16_t*)(p.ws + O_UXY); float* HF = p.out;
    const int tid = TIDX, lane = tid & 63, gw = (tid >> 6) * gridDim.x + BIDX, nw = gridDim.x * 8;
    for (int it = gw; it < NB * NCH; it += nw) {
        const int b = it / NCH, pch = it % NCH, row0 = chunk_row0(b, pch);
        const f32x4* af = agg + (((size_t)(0 * NB + b) * NCH) * 512 + lane * 8) / 2; const f32x4* ab = agg + (((size_t)(1 * NB + b) * NCH) * 512 + lane * 8) / 2;
        float h[8];
#pragma unroll
        for (int i = 0; i < 8; ++i) h[i] = 0.f;
#pragma unroll 4
        for (int q = 0; q < pch; ++q) agg_step(af + (size_t)q * 256, h);
        { const bf16_t* om = OM + ((size_t)row0) * 512 + lane * 8; const bf16_t* bb = BB + ((size_t)row0) * 512 + lane * 8; float* hf = HF + (size_t)row0 * 512 + lane * 8;
#pragma unroll 8
          for (int t = 0; t < 64; ++t) {
              const u32x4 ov = *(const u32x4*)(om + (size_t)t * 512), bv = *(const u32x4*)(bb + (size_t)t * 512);
              h[0] = (1.f - bflo(ov.x)) * h[0] + bflo(bv.x); h[1] = (1.f - bfhi(ov.x)) * h[1] + bfhi(bv.x); h[2] = (1.f - bflo(ov.y)) * h[2] + bflo(bv.y); h[3] = (1.f - bfhi(ov.y)) * h[3] + bfhi(bv.y);
              h[4] = (1.f - bflo(ov.z)) * h[4] + bflo(bv.z); h[5] = (1.f - bfhi(ov.z)) * h[5] + bfhi(bv.z); h[6] = (1.f - bflo(ov.w)) * h[6] + bflo(bv.w); h[7] = (1.f - bfhi(ov.w)) * h[7] + bfhi(bv.w);
              *(f32x4*)(hf + (size_t)t * 512) = (f32x4){h[0], h[1], h[2], h[3]}; *(f32x4*)(hf + (size_t)t * 512 + 4) = (f32x4){h[4], h[5], h[6], h[7]};
          } }
#pragma unroll
        for (int i = 0; i < 8; ++i) h[i] = 0.f;
        if (pch >= 4) {
#pragma unroll
            for (int q = 3; q >= 0; --q) agg_step(ab + (size_t)q * 256, h);
#pragma unroll 4
            for (int q = NCH - 1; q > pch; --q) agg_step(ab + (size_t)q * 256, h);
        } else {
            for (int q = 3; q > pch; --q) agg_step(ab + (size_t)q * 256, h);
        }
        { const bf16_t* om = OM + ((size_t)MA + row0) * 512 + lane * 8; const bf16_t* bb = BB + ((size_t)MA + row0) * 512 + lane * 8; const float* hf = HF + (size_t)row0 * 512 + lane * 8;
#pragma unroll 4
          for (int t = 63; t >= 0; --t) {
              const u32x4 ov = *(const u32x4*)(om + (size_t)t * 512), bv = *(const u32x4*)(bb + (size_t)t * 512);
              const f32x4 f0 = *(const f32x4*)(hf + (size_t)t * 512), f1 = *(const f32x4*)(hf + (size_t)t * 512 + 4);
              const u32x4 uv = *(const u32x4*)(UXY + (size_t)(row0 + t) * 1024 + 512 + lane * 8);
              h[0] = (1.f - bflo(ov.x)) * h[0] + bflo(bv.x); h[1] = (1.f - bfhi(ov.x)) * h[1] + bfhi(bv.x); h[2] = (1.f - bflo(ov.y)) * h[2] + bflo(bv.y); h[3] = (1.f - bfhi(ov.y)) * h[3] + bfhi(bv.y);
              h[4] = (1.f - bflo(ov.z)) * h[4] + bflo(bv.z); h[5] = (1.f - bfhi(ov.z)) * h[5] + bfhi(bv.z); h[6] = (1.f - bflo(ov.w)) * h[6] + bflo(bv.w); h[7] = (1.f - bfhi(ov.w)) * h[7] + bfhi(bv.w);
              u32x4 o;
              o.x = pk2((f0[0] + h[0]) * gelu_tanh(bflo(uv.x)), (f0[1] + h[1]) * gelu_tanh(bfhi(uv.x))); o.y = pk2((f0[2] + h[2]) * gelu_tanh(bflo(uv.y)), (f0[3] + h[3]) * gelu_tanh(bfhi(uv.y)));
              o.z = pk2((f1[0] + h[4]) * gelu_tanh(bflo(uv.z)), (f1[1] + h[5]) * gelu_tanh(bfhi(uv.z))); o.w = pk2((f1[2] + h[6]) * gelu_tanh(bflo(uv.w)), (f1[3] + h[7]) * gelu_tanh(bfhi(uv.w)));
              *(u32x4*)(UXY + (size_t)(row0 + t) * 1024 + lane * 8) = o;
          } }
    }
}

DI void phase_qk(const Params& p, int l, unsigned char* smem) {
    const bf16_t* qraw = (const bf16_t*)p.out; const bf16_t* kn = qraw + (size_t)MA * 768;
    const bf16_t* P1 = (const bf16_t*)(p.ws + O_R1);
    bf16_t* Q = (bf16_t*)(p.ws + O_S); bf16_t* Kb = Q + (size_t)32 * TK * 96;
    const int tid = TIDX, lane = tid & 63, wave = tid >> 6, gw = BIDX * 8 + wave, nw = gridDim.x * 8, h = lane >> 3, j = lane & 7;
    unsigned char* wq = smem + wave * 4096; unsigned char* wk = wq + 1536;
    const float* qn = p.q_norm + l * 96; const float* knm = p.k_norm + l * 96;
    float gq[12], gk[12];
#pragma unroll
    for (int i = 0; i < 12; ++i) { gq[i] = qn[8 * i + j] * QSCALE; gk[i] = knm[8 * i + j]; }
    const float freq = exp2f(-(float)j * 1.6609640474436813f);
    for (int row = gw; row < MA; row += nw) {
        { const u32x4 q0 = *(const u32x4*)(qraw + (size_t)row * 768 + lane * 8);
          u32x4 q1 = {0u, 0u, 0u, 0u}, k1 = {0u, 0u, 0u, 0u};
          if (lane < 32) q1 = *(const u32x4*)(qraw + (size_t)row * 768 + 512 + lane * 8);
          const u32x4 k0 = *(const u32x4*)(kn + (size_t)row * 512 + lane * 8);
          if (lane < 4) k1 = *(const u32x4*)(P1 + (size_t)row * 768 + 640 + lane * 8);
          *(u32x4*)(wq + lane * 16) = q0; if (lane < 32) *(u32x4*)(wq + 1024 + lane * 16) = q1;
          *(u32x4*)(wk + lane * 16) = k0; if (lane < 4) *(u32x4*)(wk + 1024 + lane * 16) = k1; }
        __builtin_amdgcn_fence(__ATOMIC_RELEASE, "wavefront"); __builtin_amdgcn_wave_barrier(); __builtin_amdgcn_fence(__ATOMIC_ACQUIRE, "wavefront");
        float xq[12], xk[12];
#pragma unroll
        for (int i = 0; i < 12; ++i) xq[i] = bf2f(*(const bf16_t*)(wq + (h * 96 + 8 * i + j) * 2));
#pragma unroll
        for (int i = 0; i < 8; ++i) xk[i] = bf2f(*(const bf16_t*)(wk + (h * 64 + 8 * i + j) * 2));
#pragma unroll
        for (int i = 8; i < 12; ++i) xk[i] = bf2f(*(const bf16_t*)(wk + 1024 + (8 * (i - 8) + j) * 2));
        __builtin_amdgcn_fence(__ATOMIC_RELEASE, "wavefront"); __builtin_amdgcn_wave_barrier(); __builtin_amdgcn_fence(__ATOMIC_ACQUIRE, "wavefront");
        const bool lat = row < ML; int b, pos;
        if (lat) { b = row >> 13; pos = row & (SEQ - 1); } else { const int r = row - ML; b = r >> 8; pos = SEQ + (r & 255); }
        float c0 = 1.f, s0 = 0.f, c1 = 1.f, s1 = 0.f;
        if (lat) { float r0 = (float)(pos >> 6) * freq * 0.15915494309189535f, r1 = (float)(pos & 63) * freq * 0.15915494309189535f;
            r0 -= floorf(r0); r1 -= floorf(r1);
            c0 = __builtin_amdgcn_cosf(r0); s0 = __builtin_amdgcn_sinf(r0); c1 = __builtin_amdgcn_cosf(r1); s1 = __builtin_amdgcn_sinf(r1); }
        float sq = 0.f, sk = 0.f;
#pragma unroll
        for (int i = 0; i < 12; ++i) { sq += xq[i] * xq[i]; sk += xk[i] * xk[i]; }
        sq += __shfl_xor(sq, 1); sk += __shfl_xor(sk, 1); sq += __shfl_xor(sq, 2); sk += __shfl_xor(sk, 2); sq += __shfl_xor(sq, 4); sk += __shfl_xor(sk, 4);
        const float rq = rsqrtf(sq * (1.f / 96.f) + EPS), rk = rsqrtf(sk * (1.f / 96.f) + EPS);
#pragma unroll
        for (int i = 0; i < 12; ++i) { xq[i] *= rq * gq[i]; xk[i] *= rk * gk[i]; }
        { const float y8 = xq[8] * c0 - xq[9] * s0, y9 = xq[8] * s0 + xq[9] * c0, y10 = xq[10] * c1 - xq[11] * s1, y11 = xq[10] * s1 + xq[11] * c1;
          xq[8] = y8; xq[9] = y9; xq[10] = y10; xq[11] = y11; }
        { const float y8 = xk[8] * c0 - xk[9] * s0, y9 = xk[8] * s0 + xk[9] * c0, y10 = xk[10] * c1 - xk[11] * s1, y11 = xk[10] * s1 + xk[11] * c1;
          xk[8] = y8; xk[9] = y9; xk[10] = y10; xk[11] = y11; }
#pragma unroll
        for (int i = 0; i < 12; ++i) { *(bf16_t*)(wq + (h * 96 + 8 * i + j) * 2) = f2bf(xq[i]); *(bf16_t*)(wk + (h * 96 + 8 * i + j) * 2) = f2bf(xk[i]); }
        __builtin_amdgcn_fence(__ATOMIC_RELEASE, "wavefront"); __builtin_amdgcn_wave_barrier(); __builtin_amdgcn_fence(__ATOMIC_ACQUIRE, "wavefront");
        { const int c0i = lane, c1i = 64 + lane;
          const u32x4 oq0 = *(const u32x4*)(wq + c0i * 16), ok0 = *(const u32x4*)(wk + c0i * 16);
          const size_t d0 = ((size_t)(b * NH + c0i / 12) * TK + pos) * 96 + (c0i % 12) * 8;
          *(u32x4*)(Q + d0) = oq0; *(u32x4*)(Kb + d0) = ok0;
          if (lane < 32) { const u32x4 oq1 = *(const u32x4*)(wq + c1i * 16), ok1 = *(const u32x4*)(wk + c1i * 16);
              const size_t d1 = ((size_t)(b * NH + c1i / 12) * TK + pos) * 96 + (c1i % 12) * 8;
              *(u32x4*)(Q + d1) = oq1; *(u32x4*)(Kb + d1) = ok1; } }
        __builtin_amdgcn_fence(__ATOMIC_RELEASE, "wavefront"); __builtin_amdgcn_wave_barrier(); __builtin_amdgcn_fence(__ATOMIC_ACQUIRE, "wavefront");
    }
}

constexpr int KROW = 208, VROW = 144, KBYTES = 64 * KROW, ABUF = KBYTES + 64 * VROW;
DI void attn_item(unsigned char* lds, const bf16_t* Q, const bf16_t* Kb, const bf16_t* Vt, bf16_t* att, int bh, int qposA, int qposB, int kt0, int kt1, int outrowA, int outrowB, bool writeB) {
    const int tid = TIDX, lane = tid & 63, l31 = lane & 31, half = lane >> 5;
    bf16x8 qa[6], qb[6];
    { const bf16_t* qp = Q + ((size_t)bh * TK + qposA + l31) * 96 + 8 * half; const bf16_t* qq = Q + ((size_t)bh * TK + qposB + l31) * 96 + 8 * half;
#pragma unroll
      for (int ks = 0; ks < 6; ++ks) { qa[ks] = *(const bf16x8*)(qp + 16 * ks); qb[ks] = *(const bf16x8*)(qq + 16 * ks); } }
    f32x16 oa0, oa1, ob0, ob1;
#pragma unroll
    for (int i = 0; i < 16; ++i) { oa0[i] = 0.f; oa1[i] = 0.f; ob0[i] = 0.f; ob1[i] = 0.f; }
    float la = 0.f, lb = 0.f;
    const unsigned char* kg = (const unsigned char*)(Kb + (size_t)bh * TK * 96) + (size_t)tid * 16;
    const unsigned char* vg = (const unsigned char*)(Vt + ((size_t)bh * 64 + (tid >> 3)) * TK) + (tid & 7) * 16;
    const int kc1 = 512 + tid;
    const int koff0 = (tid / 12) * KROW + (tid % 12) * 16, koff1 = (kc1 / 12) * KROW + (kc1 % 12) * 16;
    const int voff = KBYTES + (tid >> 3) * VROW + ((tid & 7) >> 1) * 32 + (tid & 1) * 8;
    const int klo = l31 * KROW + 16 * half, vlo = KBYTES + l31 * VROW + 16 * half;
    u32x4 kr0, kr1 = {0u, 0u, 0u, 0u}, vr;
#define AT_GLOAD(kt) do { kr0 = *(const u32x4*)(kg + (size_t)(kt) * 12288); if (tid < 256) kr1 = *(const u32x4*)(kg + (size_t)(kt) * 12288 + 8192); vr = *(const u32x4*)(vg + (size_t)(kt) * 128); } while (0)
#define AT_SSTORE(stg) do { unsigned char* bp_ = lds + (stg) * ABUF; *(u32x4*)(bp_ + koff0) = kr0; if (tid < 256) *(u32x4*)(bp_ + koff1) = kr1; \
        *(u32x2*)(bp_ + voff) = (u32x2){vr.x, vr.y}; *(u32x2*)(bp_ + voff + 16) = (u32x2){vr.z, vr.w}; } while (0)
#define AT_PK(v, o) (u32x4){pk2(v[o], v[o + 1]), pk2(v[o + 2], v[o + 3]), pk2(v[o + 4], v[o + 5]), pk2(v[o + 6], v[o + 7])}
    AT_GLOAD(kt0); AT_SSTORE(0);
    __syncthreads();
    for (int kt = kt0; kt < kt1; ++kt) {
        const int cur = (kt - kt0) & 1;
        const bool more = kt + 1 < kt1;
        if (more) AT_GLOAD(kt + 1);
        const unsigned char* kl = lds + cur * ABUF + klo;
        const unsigned char* vl = lds + cur * ABUF + vlo;
        f32x16 sa0, sa1, sb0, sb1;
        const f32x16 zero16 = {0.f, 0.f, 0.f, 0.f, 0.f, 0.f, 0.f, 0.f, 0.f, 0.f, 0.f, 0.f, 0.f, 0.f, 0.f, 0.f};
#pragma unroll
        for (int ks = 0; ks < 6; ++ks) {
            const bf16x8 a0 = *(const bf16x8*)(kl + 32 * ks), a1 = *(const bf16x8*)(kl + 32 * KROW + 32 * ks);
            sa0 = __builtin_amdgcn_mfma_f32_32x32x16_bf16(a0, qa[ks], ks == 0 ? zero16 : sa0, 0, 0, 0);
            sa1 = __builtin_amdgcn_mfma_f32_32x32x16_bf16(a1, qa[ks], ks == 0 ? zero16 : sa1, 0, 0, 0);
            sb0 = __builtin_amdgcn_mfma_f32_32x32x16_bf16(a0, qb[ks], ks == 0 ? zero16 : sb0, 0, 0, 0);
            sb1 = __builtin_amdgcn_mfma_f32_32x32x16_bf16(a1, qb[ks], ks == 0 ? zero16 : sb1, 0, 0, 0);
        }
        float pa = 0.f, pb = 0.f;
#pragma unroll
        for (int i = 0; i < 16; ++i) { sa0[i] = __builtin_amdgcn_exp2f(sa0[i]); sa1[i] = __builtin_amdgcn_exp2f(sa1[i]); pa += sa0[i] + sa1[i];
                                       sb0[i] = __builtin_amdgcn_exp2f(sb0[i]); sb1[i] = __builtin_amdgcn_exp2f(sb1[i]); pb += sb0[i] + sb1[i]; }
        la += pa; lb += pb;
#pragma unroll
        for (int s = 0; s < 4; ++s) {
            const bf16x8 v0 = *(const bf16x8*)(vl + 32 * s), v1 = *(const bf16x8*)(vl + 32 * VROW + 32 * s);
            const bf16x8 fa = __builtin_bit_cast(bf16x8, s < 2 ? AT_PK(sa0, 8 * (s & 1)) : AT_PK(sa1, 8 * (s & 1)));
            const bf16x8 fb = __builtin_bit_cast(bf16x8, s < 2 ? AT_PK(sb0, 8 * (s & 1)) : AT_PK(sb1, 8 * (s & 1)));
            oa0 = __builtin_amdgcn_mfma_f32_32x32x16_bf16(v0, fa, oa0, 0, 0, 0); oa1 = __builtin_amdgcn_mfma_f32_32x32x16_bf16(v1, fa, oa1, 0, 0, 0);
            ob0 = __builtin_amdgcn_mfma_f32_32x32x16_bf16(v0, fb, ob0, 0, 0, 0); ob1 = __builtin_amdgcn_mfma_f32_32x32x16_bf16(v1, fb, ob1, 0, 0, 0);
        }
        if (more) AT_SSTORE(cur ^ 1);
        __syncthreads();
    }
#undef AT_GLOAD
#undef AT_SSTORE
#undef AT_PK
    { const float lt = la + __shfl_xor(la, 32), inv = 1.f / lt;
      bf16_t* op = att + (size_t)(outrowA + l31) * 512 + (bh & 7) * 64 + 4 * half;
#pragma unroll
      for (int g = 0; g < 4; ++g) {
          st_bf4(op + 8 * g, (f32x4){oa0[4 * g] * inv, oa0[4 * g + 1] * inv, oa0[4 * g + 2] * inv, oa0[4 * g + 3] * inv});
          st_bf4(op + 32 + 8 * g, (f32x4){oa1[4 * g] * inv, oa1[4 * g + 1] * inv, oa1[4 * g + 2] * inv, oa1[4 * g + 3] * inv}); } }
    if (writeB) { const float lt = lb + __shfl_xor(lb, 32), inv = 1.f / lt;
      bf16_t* op = att + (size_t)(outrowB + l31) * 512 + (bh & 7) * 64 + 4 * half;
#pragma unroll
      for (int g = 0; g < 4; ++g) {
          st_bf4(op + 8 * g, (f32x4){ob0[4 * g] * inv, ob0[4 * g + 1] * inv, ob0[4 * g + 2] * inv, ob0[4 * g + 3] * inv});
          st_bf4(op + 32 + 8 * g, (f32x4){ob1[4 * g] * inv, ob1[4 * g + 1] * inv, ob1[4 * g + 2] * inv, ob1[4 * g + 3] * inv}); } }
}
DI void phase_attn(const Params& p, unsigned char* lds, bool with_ctx) {
    const bf16_t* Q = (const bf16_t*)(p.ws + O_S); const bf16_t* Kb = Q + (size_t)32 * TK * 96; const bf16_t* Vt = Kb + (size_t)32 * TK * 96;
    bf16_t* att = (bf16_t*)p.out;
    const int nitems = 512 + (with_ctx ? 32 : 0);
    for (int it = BIDX; it < nitems; it += gridDim.x) {
        const int wave = TIDX >> 6;
        if (it < 512) {
            const int j = (it >> 3) & 31, bh = (it >> 8) * 16 + (it & 7) * 2 + (j >> 4), q0 = (j & 15) * 512 + wave * 64, r0 = (bh >> 3) * SEQ + q0;
            attn_item(lds, Q, Kb, Vt, att, bh, q0, q0 + 32, 0, TK / 64, r0, r0 + 32, true);
        } else {
            const int bh = it - 512, q0 = SEQ + wave * 32, r0 = ML + (bh >> 3) * CTXL + wave * 32;
            attn_item(lds, Q, Kb, Vt, att, bh, q0, q0, SEQ / 64, TK / 64, r0, r0, false);
        }
    }
}

constexpr int PH_PER_LAYER = 15, N_PHASES = 1 + DEPTH * PH_PER_LAYER;
DI int phase_case(int ph) { const int i = (ph - 1) % PH_PER_LAYER; return i < 3 ? i : (i < 13 ? i + 1 : i + 2); }
DI void run_phase(const Params& p, int ph, unsigned char* smem) {
    LAS unsigned char* lds = (LAS unsigned char*)smem;
    unsigned char* ws = p.ws;
    if (ph == 0) { phase_mod(p, (float*)smem); return; }
    const int l = (ph - 1) / PH_PER_LAYER, s = phase_case(ph);
    const bool last = (l == DEPTH - 1);
    const float* mod = (const float*)(ws + O_MOD) + (size_t)l * 5 * NMOD;
    float* X = (float*)(ws + O_X);
    bf16_t* XNY = (bf16_t*)(ws + O_XNY); bf16_t* H = (bf16_t*)(ws + O_R1); bf16_t* P1 = (bf16_t*)(ws + O_R1); bf16_t* GATE = P1 + (size_t)MA * 768;
    bf16_t* UXY = (bf16_t*)(ws + O_UXY);
    float* SS = (float*)(ws + O_SS); const float* shw = (const float*)(ws + O_SHW);
    const int Mtail = last ? ML : MA;
    switch (s) {
    case 0: phase_prep(p, l, (float*)smem); if (l == 0) phase_norm0(p); break;
    case 1: { ESwiglu E{H, SS, shw}; gemm_phase<ESwiglu, false, true>(lds, Gemm{XNY, (const bf16_t*)(ws + O_WFF1IN), MA, 2 * DFF, DM, DM, DM}, E); } break;
    case 2: { EResid<1, true> E{X, X, mod + 2 * DM, mod + 4 * DM, XNY, SS + (size_t)MA * 16}; gemm_phase<EResid<1, true>, false, true>(lds, Gemm{H, (const bf16_t*)(ws + O_WFF1OUT), MA, DM, DFF, DFF, DFF}, E); }
              { const int nthird = (MA / BM) * (DM / BM) - 2 * (int)gridDim.x, vb = (int)BIDX - nthird; if (nthird > 0 && nthird < (int)gridDim.x && vb >= 0) phase_prep_ff(p, l, 1, (float*)smem, vb, (int)gridDim.x - nthird); else if (nthird <= 0 || nthird >= (int)gridDim.x) phase_prep_ff(p, l, 1, (float*)smem, BIDX, gridDim.x); }
              break;
    case 4: { EWin E{P1, UXY, GATE, SS + (size_t)MA * 16, shw + 5 * 5632}; gemm_phase<EWin, false, true>(lds, Gemm{XNY, (const bf16_t*)(ws + O_WIN), MA, NIN, DM, DM, DM}, E); } break;
    case 5: phase_conv(p, l); break;
    case 6: { bf16_t* OM = (bf16_t*)(ws + O_S); EGate E{XNY, OM, OM + (size_t)2 * MA * 512, (const float*)(ws + O_SP), p.b_rgate + l * 1024, p.b_igate + l * 1024};
              gemm_phase<EGate, true, true>(lds, Gemm{XNY, (const bf16_t*)(ws + O_WGATE), MA, 2048, 256, 512, 256}, E); } break;
    case 7: phase_scan_agg(p); break;
    case 8: phase_scan_apply(p); break;
    case 9: { bf16_t* qraw = (bf16_t*)p.out; bf16_t* kn = qraw + (size_t)MA * 768; bf16_t* Vt = (bf16_t*)(ws + O_S) + (size_t)2 * 32 * TK * 96;
              const float* rsq = (const float*)(ws + O_RSQ); const float* rskv = (const float*)(ws + O_RSKV);
              const bf16_t* wukv = (const bf16_t*)(ws + O_WUKV);
              { EpiElem8<FRowScale> E{{qraw, 768, rsq}}; gemm_phase<EpiElem8<FRowScale>, false, true>(lds, Gemm{P1, (const bf16_t*)(ws + O_WUQ), MA, 768, 384, 768, 384}, E); }
              { EpiElem8<FRowScale> E{{kn, 512, rskv}}; gemm_phase<EpiElem8<FRowScale>, false, true>(lds, Gemm{P1 + 384, wukv, MA, 512, 256, 768, 256, 144}, E); }
              { EpiElem8<FVt> E{{Vt, rskv}}; gemm_phase<EpiElem8<FVt>, false, true>(lds, Gemm{wukv + (size_t)512 * 256, P1 + 384, 512, MA, 256, 256, 768, 152}, E); }
              } break;
    case 10: phase_qk(p, l, smem); break;
    case 11: phase_attn(p, smem, !last); break;
    case 12: { { EpiElem8<FMergeA> E{{GATE, XNY}}; gemm_phase<EpiElem8<FMergeA>, false, true>(lds, Gemm{(const bf16_t*)p.out, (const bf16_t*)(ws + O_WOA), Mtail, DM, 512, 512, 512}, E); }
               { EpiElem8<FMergeB> E{{GATE, XNY}}; gemm_phase<EpiElem8<FMergeB>, false, true>(lds, Gemm{UXY, (const bf16_t*)(ws + O_WOL), Mtail, DM, 512, 1024, 512}, E); } } break;
    case 13: { EResid<2, true> E{X, X, mod + 5 * DM, mod + 7 * DM, UXY, SS + (size_t)2 * MA * 16}; gemm_phase<EResid<2, true>, false, true>(lds, Gemm{XNY, (const bf16_t*)(ws + O_WOUT), Mtail, DM, DM, DM, DM}, E); } break;
    case 15: { ESwiglu E{H, SS + (size_t)2 * MA * 16, shw + 2 * 5 * 5632}; gemm_phase<ESwiglu, false, true>(lds, Gemm{UXY, (const bf16_t*)(ws + O_WFF2IN), Mtail, 2 * DFF, DM, DM, DM}, E); } break;
    case 16: if (last) { EResid<1, false> E{X, p.out, mod + 8 * DM, nullptr, nullptr, nullptr}; gemm_phase<EResid<1, false>, false, true>(lds, Gemm{H, (const bf16_t*)(ws + O_WFF2OUT), Mtail, DM, DFF, DFF, DFF}, E); }
             else { EResid<1, true> E{X, X, mod + 8 * DM, mod + 5 * NMOD + DM, XNY, SS}; gemm_phase<EResid<1, true>, false, true>(lds, Gemm{H, (const bf16_t*)(ws + O_WFF2OUT), Mtail, DM, DFF, DFF, DFF}, E); }
             if (!last) { const int nthird = (MA / BM) * (DM / BM) - 2 * (int)gridDim.x, vb = (int)BIDX - nthird; if (nthird > 0 && nthird < (int)gridDim.x && vb >= 0) phase_prep_ff(p, l + 1, 0, (float*)smem, vb, (int)gridDim.x - nthird); else if (nthird <= 0 || nthird >= (int)gridDim.x) phase_prep_ff(p, l + 1, 0, (float*)smem, BIDX, gridDim.x); }
             break;
    }
}

#ifndef PROBE_MASK
#define PROBE_MASK 0u
#endif
#define XB_TMO      128
#define XB_XCNT(j)  (256  + 64 * (j))
#define XB_XSUB(j)  (1280 + 64 * (j))
#define XB_XGEN(j)  (2304 + 64 * (j))
#define XB_TOP      3328
#define XB_TOPGEN   3392
#define XCD_BAR_WORDS 3456
#define XB_SPIN_CAP (1u << 18)
DI unsigned xb_ld(unsigned* p)              { return __hip_atomic_load(p, __ATOMIC_RELAXED, __HIP_MEMORY_SCOPE_AGENT); }
DI unsigned xb_add(unsigned* p, unsigned v) { return __hip_atomic_fetch_add(p, v, __ATOMIC_RELAXED, __HIP_MEMORY_SCOPE_AGENT); }
DI unsigned xb_xcc_id() { return (unsigned)__builtin_amdgcn_s_getreg((3 << 11) | 20) & 0xFu; }
#define XB_SPIN(cond, bar) do { unsigned _sp = 0; while (cond) { __builtin_amdgcn_s_sleep(1); \
    if ((++_sp & 255u) == 0u) { if (xb_ld(&(bar)[XB_TMO])) break; if (_sp > XB_SPIN_CAP) { atomicAdd(&(bar)[XB_TMO], 1u); break; } } } } while (0)
struct XcdBarrier { unsigned* bar; unsigned x; volatile LAS unsigned* st; };
DI XcdBarrier xcd_barrier_post(unsigned* bar, volatile LAS unsigned* st) {
    XcdBarrier b; b.bar = bar; b.x = xb_xcc_id(); b.st = st;
    if (threadIdx.x == 0) (void)xb_add(&bar[XB_XCNT(b.x)], 1u);
    return b;
}
DI void xcd_barrier_complete(unsigned* bar, unsigned x, unsigned& nloc, unsigned& nx) {
    const unsigned G = gridDim.x * gridDim.y * gridDim.z;
    unsigned sum, cnt, mine, sp = 0u;
    for (;;) {
        sum = 0u; cnt = 0u; mine = 0u;
#pragma unroll
        for (unsigned j = 0; j < 16; ++j) { const unsigned c = xb_ld(&bar[XB_XCNT(j)]); sum += c; cnt += (c > 0u) ? 1u : 0u; mine = (j == x) ? c : mine; }
        if (sum == G) break;
        __builtin_amdgcn_s_sleep(1);
        if ((++sp & 255u) == 0u) { if (xb_ld(&bar[XB_TMO])) break; if (sp > XB_SPIN_CAP) { atomicAdd(&bar[XB_TMO], 1u); break; } }
    }
    nloc = mine > 0u ? mine : 1u; nx = cnt > 0u ? cnt : 1u;
}
DI void xcd_barrier(const XcdBarrier& b) {
    asm volatile("s_waitcnt vmcnt(0)" ::: "memory");
    __syncthreads();
    if (threadIdx.x == 0) {
        unsigned* bar = b.bar;
        __builtin_amdgcn_s_waitcnt(0);
        unsigned nloc = b.st[0], nx = b.st[1];
        if (nloc == 0u) { xcd_barrier_complete(bar, b.x, nloc, nx); b.st[0] = nloc; b.st[1] = nx; }
        const unsigned old = xb_add(&bar[XB_XSUB(b.x)], 1u);
        const unsigned gen = old / nloc;
        if (old + 1u == (gen + 1u) * nloc) {
            __builtin_amdgcn_fence(__ATOMIC_RELEASE, "agent");
            asm volatile("s_waitcnt vmcnt(0)" ::: "memory");
            const unsigned og = xb_add(&bar[XB_TOP], 1u);
            const unsigned tg = og / nx;
            if (og + 1u == (tg + 1u) * nx) xb_add(&bar[XB_TOPGEN], 1u);
            else XB_SPIN(xb_ld(&bar[XB_TOPGEN]) == tg, bar);
            __builtin_amdgcn_fence(__ATOMIC_ACQUIRE, "agent");
            xb_add(&bar[XB_XGEN(b.x)], 1u);
            asm volatile("s_waitcnt vmcnt(0)" ::: "memory");
        } else {
            XB_SPIN(xb_ld(&bar[XB_XGEN(b.x)]) == gen, bar);
            __builtin_amdgcn_fence(__ATOMIC_ACQUIRE, "agent");
            asm volatile("s_waitcnt vmcnt(0)" ::: "memory");
        }
    }
    __syncthreads();
}
__global__ void __launch_bounds__(512) mega(Params p) {
    extern __shared__ __attribute__((aligned(16))) unsigned char smem[];
    __shared__ uint4 xb_words;
    cg::grid_group grid = cg::this_grid();
    if (threadIdx.x == 0) xb_words = make_uint4(0u, 0u, 0u, 0u);
    __syncthreads();
    const XcdBarrier xb = xcd_barrier_post((unsigned*)(p.ws + O_BAR), (volatile LAS unsigned*)&xb_words);
    unsigned long long tsel = 0;
    for (int ph = p.ph_lo; ph < p.ph_hi; ++ph) {
        const unsigned long long t0 = PROBE_MASK ? wall_clock64() : 0ull;
        run_phase(p, ph, smem);
        if (p.coop && ph + 1 < p.ph_hi) { if (ph == 0) grid.sync(); else xcd_barrier(xb); }
        if (PROBE_MASK) { const int sidx = ph == 0 ? 17 : phase_case(ph); if ((PROBE_MASK >> sidx) & 1u) tsel += wall_clock64() - t0; }
    }
    if (PROBE_MASK && blockIdx.x == 0) { const unsigned long long t0 = wall_clock64(); while (wall_clock64() - t0 < tsel) __builtin_amdgcn_s_sleep(64); }
}

extern "C" void kernel_launch(void* const* d_in, const int* in_sizes, int n_in, void* d_out, int out_size, void* d_ws, size_t ws_size, hipStream_t stream) {
    static int grid = 0;
    if (grid == 0) {
        if (n_in != 27 || ws_size < WS_END) { fprintf(stderr, "kernel_launch: need 27 inputs and %zu bytes of workspace; got %d, %zu\n", (size_t)WS_END, n_in, ws_size); grid = -1; return; }
        int dev = 0, cus = 0, per_cu = 0;
        hipGetDevice(&dev); hipDeviceGetAttribute(&cus, hipDeviceAttributeMultiprocessorCount, dev);
        if (hipFuncSetAttribute((const void*)mega, hipFuncAttributeMaxDynamicSharedMemorySize, LDS_BYTES) != hipSuccess) { fprintf(stderr, "kernel_launch: hipFuncSetAttribute failed\n"); grid = -1; return; }
        if (hipOccupancyMaxActiveBlocksPerMultiprocessor(&per_cu, (const void*)mega, 512, LDS_BYTES) != hipSuccess || per_cu < 1) { fprintf(stderr, "kernel_launch: occupancy query gave %d\n", per_cu); per_cu = 1; }
        (void)hipGetLastError();
        grid = cus;
    }
    if (grid < 0) return;
    Params p{};
    const float** pp = (const float**)&p;
    for (int i = 0; i < 27; ++i) pp[i] = (const float*)d_in[i];
    p.out = (float*)d_out; p.ws = (unsigned char*)d_ws; p.ph_lo = 0; p.ph_hi = N_PHASES; p.coop = 1; p.pad = 0;
    (void)hipMemsetAsync((unsigned char*)d_ws + O_BAR, 0, XCD_BAR_WORDS * 4, stream);
    void* args[] = {&p};
    hipError_t e = hipLaunchCooperativeKernel((const void*)mega, dim3(grid), dim3(512), args, LDS_BYTES, stream);
    if (e != hipSuccess) {
        fprintf(stderr, "cooperative launch failed: %s (grid %d); falling back to one launch per phase\n", hipGetErrorString(e), grid);
        (void)hipGetLastError();
        p.coop = 0;
        for (int ph = 0; ph < N_PHASES; ++ph) { p.ph_lo = ph; p.ph_hi = ph + 1; hipLaunchKernelGGL(mega, dim3(grid), dim3(512), LDS_BYTES, stream, p); }
    }
}
```

```cpp
#include <hip/hip_runtime.h>
#include <hip/hip_cooperative_groups.h>
#include <cstdio>
namespace cg = cooperative_groups;

#define DI __device__ __forceinline__
#define LAS __attribute__((address_space(3)))
typedef unsigned short bf16_t;
typedef short bf16x8 __attribute__((ext_vector_type(8)));
typedef float f32x2 __attribute__((ext_vector_type(2)));
typedef float f32x4 __attribute__((ext_vector_type(4)));
typedef float f32x16 __attribute__((ext_vector_type(16)));
typedef unsigned u32x2 __attribute__((ext_vector_type(2)));
typedef unsigned u32x4 __attribute__((ext_vector_type(4)));
typedef __bf16 bfv2 __attribute__((ext_vector_type(2)));

constexpr int DM = 1024, NB = 4, SEQ = 8192, CTXL = 256, DEPTH = 4;
constexpr int ML = NB * SEQ, MC = NB * CTXL, MA = ML + MC;
constexpr int DFF = 2816, NH = 8, TK = SEQ + CTXL;
constexpr int NIN = 3840;
constexpr int NMOD = 9 * DM;
constexpr float EPS = 1e-6f;
constexpr float QSCALE = 0.10206207261596577f * 1.4426950408889634f;
constexpr int NCH = 132;

constexpr size_t SZ_FFIN = (size_t)2 * DFF * DM * 2, SZ_FFOUT = (size_t)DM * DFF * 2;
constexpr size_t O_WFF1IN = 0;
constexpr size_t O_WFF1OUT = O_WFF1IN + SZ_FFIN;
constexpr size_t O_WFF2IN = O_WFF1OUT + SZ_FFOUT;
constexpr size_t O_WFF2OUT = O_WFF2IN + SZ_FFIN;
constexpr size_t O_WIN = O_WFF2OUT + SZ_FFOUT;
constexpr size_t O_WUQ = O_WIN + (size_t)NIN * DM * 2;
constexpr size_t O_WUKV = O_WUQ + (size_t)768 * 384 * 2;
constexpr size_t O_WOA = O_WUKV + (size_t)1024 * 256 * 2;
constexpr size_t O_WOL = O_WOA + (size_t)1024 * 512 * 2;
constexpr size_t O_WOUT = O_WOL + (size_t)1024 * 512 * 2;
constexpr size_t O_WGATE = O_WOUT + (size_t)1024 * 1024 * 2;
constexpr size_t O_MOD = O_WGATE + (size_t)2048 * 256 * 2;
constexpr size_t O_RSQ = O_MOD + (size_t)DEPTH * 5 * NMOD * 4;
constexpr size_t O_RSKV = O_RSQ + (size_t)MA * 4;
constexpr size_t O_AGG = O_RSKV + (size_t)MA * 4;
constexpr size_t O_SP = O_AGG + (size_t)2 * NB * NCH * 512 * 8;
constexpr size_t O_BAR = O_SP + 4096;
constexpr size_t O_SS = O_BAR + 16384;
constexpr size_t O_SHW = O_SS + (size_t)3 * MA * 16 * 4;
constexpr size_t O_X = O_SHW + (size_t)3 * 5 * 5632 * 4;
constexpr size_t O_R1 = O_X + (size_t)MA * DM * 4;
constexpr size_t O_UXY = O_R1 + (size_t)MA * DFF * 2;
constexpr size_t O_XNY = O_UXY + (size_t)MA * 1024 * 2;
constexpr size_t O_S = O_XNY + (size_t)MA * 1024 * 2;
constexpr size_t WS_END = O_S + (size_t)MA * 1024 * 4;
constexpr int LDS_BYTES = 131072;

struct Params {
    const float *x, *c, *ctx, *c_ctx, *w_ada, *b_ada, *ff1_w_in, *ff1_w_out, *ff2_w_in, *ff2_w_out, *w_in, *q_a_norm, *w_uq, *kv_a_norm, *w_ukv, *q_norm, *k_norm,
        *conv_w, *conv_b, *lru_lambda, *w_rgate, *b_rgate, *w_igate, *b_igate, *w_o_attn, *w_o_lru, *w_out;
    float* out; unsigned char* ws;
    int ph_lo, ph_hi, coop, pad;
};

DI int tidx_() { int t = threadIdx.x; asm volatile("" : "+v"(t)); return t; }
DI int bidx_() { int t = blockIdx.x; asm volatile("" : "+s"(t)); return t; }
#define TIDX tidx_()
#define BIDX bidx_()
DI unsigned pk2(float lo, float hi) { f32x2 v = {lo, hi}; bfv2 r = __builtin_convertvector(v, bfv2); return __builtin_bit_cast(unsigned, r); }
DI bf16_t f2bf(float x) { return (bf16_t)(pk2(x, 0.f) & 0xffffu); }
DI float bf2f(bf16_t v) { return __uint_as_float((unsigned)v << 16); }
DI float bflo(unsigned v) { return __uint_as_float(v << 16); }
DI float bfhi(unsigned v) { return __uint_as_float(v & 0xffff0000u); }
DI float wave_sum(float v) {
#pragma unroll
    for (int o = 1; o < 64; o <<= 1) v += __shfl_xor(v, o);
    return v;
}
DI float sigmoidf_(float x) { return __builtin_amdgcn_rcpf(1.f + __expf(-x)); }
DI int mod_row(int row) { return row < ML ? (row >> 13) : 4; }
DI float row_rstd(const float* SSP, int row) {
    const f32x4* q = (const f32x4*)(SSP + (size_t)row * 16); const f32x4 a = q[0], b = q[1], c = q[2], d = q[3];
    const float s = ((a[0] + a[1]) + (a[2] + a[3])) + ((b[0] + b[1]) + (b[2] + b[3])) + ((c[0] + c[1]) + (c[2] + c[3])) + ((d[0] + d[1]) + (d[2] + d[3]));
    return __builtin_amdgcn_rsqf(s * (1.f / DM) + EPS);
}

constexpr int BM = 256, BK = 64, HALF = 128, HTB = HALF * BK * 2, NXCD = 8, WGM = 8;
DI int lds_byte(int r, int c) { const int st = (r >> 4) * 2 + (c >> 5), rr = r & 15, cc = c & 31, ob = rr * 64 + cc * 2; return st * 1024 + (ob ^ (((ob >> 9) & 1) << 5)); }
DI void stage_rc(int b, int& R, int& C) { const int st = b / 1024, sb = b % 1024, swz = sb ^ (((sb >> 9) & 1) << 5); R = (st >> 1) * 16 + swz / 64; C = (st & 1) * 32 + (swz % 64) / 2; }
struct Unit { int pm, pn; };
struct Gemm { const bf16_t* A; const bf16_t* Bt; int M, N, K, lda, ldb; int rot = 0; };
struct StaticOrder {
    int nM, nN, nwg, G, c;
    DI void init(int M, int N, int G_, int c_) { nM = M / BM; nN = N / BM; nwg = nM * nN; G = G_; c = c_; }
    DI bool next(int i, Unit& u) const {
        const long L = (long)i * G + c; if (L >= nwg) return false;
        int wgid = (int)L; { const int q = nwg / NXCD, r = nwg % NXCD, xcd = wgid % NXCD, off = wgid / NXCD; wgid = (xcd < r ? xcd * (q + 1) : r * (q + 1) + (xcd - r) * q) + off; }
        const int nig = WGM * nN, gid = wgid / nig, fm = gid * WGM, gsz = (nM - fm) < WGM ? (nM - fm) : WGM;
        u.pm = fm + ((wgid % nig) % gsz); u.pn = (wgid % nig) / gsz; return true;
    }
};

DI int perm32(int rho) { const int n = rho >> 4, i = rho & 15; return 8 * (i >> 2) + 4 * n + (i & 3); }
template <class Epi, bool GATE_A, bool PERM = false>
DI void gemm_phase(LAS unsigned char* lds, const Gemm g, const Epi& E) {
    const int tid = TIDX, wid = __builtin_amdgcn_readfirstlane(tid >> 6), lane = tid & 63, wr = wid >> 2, wc = wid & 3, fr = lane & 15, fq = lane >> 4;
    const int K = g.K, nt = K / BK;
    StaticOrder S; S.init(g.M, g.N, gridDim.x, (BIDX - g.rot + (int)gridDim.x) % (int)gridDim.x);
    unsigned voffA[2], voffB[2];
#pragma unroll
    for (int i = 0; i < 2; ++i) { int R, C; stage_rc(tid * 16 + i * 8192, R, C); const int Rb = PERM ? ((R & ~31) + perm32(R & 31)) : R; voffA[i] = (unsigned)(R * g.lda + C) * 2u; voffB[i] = (unsigned)(Rb * g.ldb + C) * 2u; }
#pragma unroll
    for (int i = 0; i < 2; ++i) { asm volatile("" : "+v"(voffA[i])); asm volatile("" : "+v"(voffB[i])); }
    const size_t kstep = (size_t)(BK * 2);
    const size_t hstepA = (size_t)HALF * g.lda * 2, hstepB = (size_t)HALF * g.ldb * 2;
    const size_t tstepA = 2 * hstepA, tstepB = 2 * hstepB;
    const unsigned ldsw = (unsigned)wid * 1024u;
    const int aoff = lds_byte(wr * 64 + fr, fq * 8), boff = lds_byte(wc * 32 + fr, fq * 8);
#define PG8_SA(b, h) (((b) * 2 + (h)) * HTB)
#define PG8_SB(b, h) ((4 + (b) * 2 + (h)) * HTB)
#define PG8_STAGE(bufoff, gbase, voff) do { _Pragma("unroll") for (int _i = 0; _i < 2; ++_i) \
        __builtin_amdgcn_global_load_lds((const unsigned*)((const char*)(gbase) + (voff)[_i]), (LAS unsigned*)(lds + (bufoff) + ldsw + _i * 8192), 16, 0, 0); } while (0)
#define PG8_LDA(dst, b, h) do { _Pragma("unroll") for (int m = 0; m < 4; ++m) _Pragma("unroll") for (int k = 0; k < 2; ++k) dst[m][k] = *(const LAS bf16x8*)(lds + PG8_SA(b, h) + aoff + m * 2048 + k * 1024); } while (0)
#define PG8_LDB(dst, b, h) do { _Pragma("unroll") for (int n = 0; n < 2; ++n) _Pragma("unroll") for (int k = 0; k < 2; ++k) dst[n][k] = *(const LAS bf16x8*)(lds + PG8_SB(b, h) + boff + n * 2048 + k * 1024); } while (0)
#define PG8_MMA(ai, bj, At, Bt) do { __builtin_amdgcn_s_setprio(1); _Pragma("unroll") for (int m = 0; m < 4; ++m) _Pragma("unroll") for (int n = 0; n < 2; ++n) _Pragma("unroll") for (int k = 0; k < 2; ++k) \
        acc[ai][bj][m][n] = __builtin_amdgcn_mfma_f32_16x16x32_bf16(Bt[n][k], At[m][k], acc[ai][bj][m][n], 0, 0, 0); __builtin_amdgcn_s_setprio(0); } while (0)
#define PG8_WAIT_V(n) asm volatile("s_waitcnt vmcnt(" #n ")" ::: "memory")
#define PG8_WAIT_L(n) asm volatile("s_waitcnt lgkmcnt(" #n ")" ::: "memory")
#define PG8_BAR __builtin_amdgcn_s_barrier()
#define PG8_SCHED __builtin_amdgcn_sched_barrier(0)
#define PG8_ABASE(u) ((const char*)g.A + (size_t)(u).pm * tstepA + (GATE_A ? (size_t)((((u).pn & 3) >> 1) * 512) : (size_t)0))
    Unit cur, nxt; int ui = 0;
    if (!S.next(0, cur)) return;
    f32x4 acc[2][2][4][2];
#pragma unroll
    for (int a = 0; a < 2; ++a)
#pragma unroll
        for (int b = 0; b < 2; ++b)
#pragma unroll
            for (int m = 0; m < 4; ++m)
#pragma unroll
                for (int n = 0; n < 2; ++n) acc[a][b][m][n] = (f32x4){0.f, 0.f, 0.f, 0.f};
    bf16x8 At[4][2], B0[2][2], B1[2][2];
    const char* cA = PG8_ABASE(cur); const char* cB = (const char*)g.Bt + (size_t)cur.pn * tstepB;
    PG8_STAGE(PG8_SB(0, 0), cB, voffB); PG8_STAGE(PG8_SA(0, 0), cA, voffA); PG8_STAGE(PG8_SB(0, 1), cB + hstepB, voffB); PG8_STAGE(PG8_SA(0, 1), cA + hstepA, voffA);
    if (wr == 1) PG8_BAR;
    PG8_WAIT_V(4); PG8_BAR;
    PG8_STAGE(PG8_SB(1, 0), cB + kstep, voffB); PG8_STAGE(PG8_SA(1, 0), cA + kstep, voffA); PG8_STAGE(PG8_SB(1, 1), cB + hstepB + kstep, voffB);
    PG8_WAIT_V(6); PG8_BAR;
    for (;;) {
        const bool has_next = S.next(ui + 1, nxt);
        const char* nA = has_next ? PG8_ABASE(nxt) : cA; const char* nB = has_next ? (const char*)g.Bt + (size_t)nxt.pn * tstepB : cB;
#pragma nounroll
        for (int t = 0; t < nt; t += 2) {
            const bool last = (t == nt - 2);
            const char* a1 = cA + (size_t)(t + 1) * kstep;
            const char* a2 = last ? nA : cA + (size_t)(t + 2) * kstep; const char* b2 = last ? nB : cB + (size_t)(t + 2) * kstep;
            const char* a3 = a2 + kstep; const char* b3 = b2 + kstep;
            PG8_LDB(B0, 0, 0); PG8_SCHED; PG8_LDA(At, 0, 0); PG8_STAGE(PG8_SA(1, 1), a1 + hstepA, voffA);
            PG8_WAIT_L(8); PG8_BAR; PG8_WAIT_L(0); PG8_MMA(0, 0, At, B0); PG8_BAR; PG8_SCHED;
            PG8_LDB(B1, 0, 1); PG8_STAGE(PG8_SB(0, 0), b2, voffB);
            PG8_BAR; PG8_WAIT_L(0); PG8_MMA(0, 1, At, B1); PG8_BAR;
            PG8_LDA(At, 0, 1); PG8_STAGE(PG8_SA(0, 0), a2, voffA);
            PG8_BAR; PG8_WAIT_L(0); PG8_MMA(1, 0, At, B0); PG8_BAR; PG8_SCHED;
            PG8_STAGE(PG8_SB(0, 1), b2 + hstepB, voffB);
            PG8_WAIT_V(6); PG8_BAR; PG8_MMA(1, 1, At, B1); PG8_BAR;
            PG8_LDB(B0, 1, 0); PG8_SCHED; PG8_LDA(At, 1, 0); PG8_STAGE(PG8_SA(0, 1), a2 + hstepA, voffA);
            PG8_WAIT_L(8); PG8_BAR; PG8_WAIT_L(0); PG8_MMA(0, 0, At, B0); PG8_BAR; PG8_SCHED;
            PG8_LDB(B1, 1, 1); PG8_STAGE(PG8_SB(1, 0), b3, voffB);
            PG8_BAR; PG8_WAIT_L(0); PG8_MMA(0, 1, At, B1); PG8_BAR;
            PG8_LDA(At, 1, 1); PG8_STAGE(PG8_SA(1, 0), a3, voffA);
            PG8_BAR; PG8_WAIT_L(0); PG8_MMA(1, 0, At, B0); PG8_BAR; PG8_SCHED;
            PG8_STAGE(PG8_SB(1, 1), b3 + hstepB, voffB);
            PG8_WAIT_V(6); PG8_BAR; PG8_MMA(1, 1, At, B1); PG8_BAR;
        }
        E(acc, cur, wr, wc, fr, fq);
        if (!has_next) break;
#pragma unroll
        for (int a = 0; a < 2; ++a)
#pragma unroll
            for (int b = 0; b < 2; ++b)
#pragma unroll
                for (int m = 0; m < 4; ++m)
#pragma unroll
                    for (int n = 0; n < 2; ++n) acc[a][b][m][n] = (f32x4){0.f, 0.f, 0.f, 0.f};
        cur = nxt; cA = nA; cB = nB; ++ui;
    }
    PG8_WAIT_V(0);
    if (wr == 0) PG8_BAR;
    PG8_BAR;
#undef PG8_SA
#undef PG8_SB
#undef PG8_STAGE
#undef PG8_LDA
#undef PG8_LDB
#undef PG8_MMA
#undef PG8_WAIT_V
#undef PG8_WAIT_L
#undef PG8_BAR
#undef PG8_SCHED
#undef PG8_ABASE
}

template <class F> struct EpiElem {
    F f;
    DI void operator()(const f32x4 (&acc)[2][2][4][2], const Unit& u, int wr, int wc, int fr, int fq) const {
        const int row0 = u.pm * BM + wr * 64 + fr, col0 = u.pn * BM + wc * 32 + 4 * fq;
#pragma unroll
        for (int ai = 0; ai < 2; ++ai)
#pragma unroll
            for (int m = 0; m < 4; ++m)
#pragma unroll
                for (int bj = 0; bj < 2; ++bj)
#pragma unroll
                    for (int n = 0; n < 2; ++n) { f(row0 + ai * HALF + m * 16, col0 + bj * HALF + n * 16, acc[ai][bj][m][n]); }
    }
};
template <class F> struct EpiElemRow {
    F f;
    DI void operator()(const f32x4 (&acc)[2][2][4][2], const Unit& u, int wr, int wc, int fr, int fq) const {
        const int row0 = u.pm * BM + wr * 64 + fr, col0 = u.pn * BM + wc * 32 + 4 * fq;
#pragma unroll
        for (int ai = 0; ai < 2; ++ai)
#pragma unroll
            for (int m = 0; m < 4; ++m) {
                float ssq = 0.f;
#pragma unroll
                for (int bj = 0; bj < 2; ++bj)
#pragma unroll
                    for (int n = 0; n < 2; ++n) { ssq += f(row0 + ai * HALF + m * 16, col0 + bj * HALF + n * 16, acc[ai][bj][m][n]); }
                ssq += __shfl_xor(ssq, 16); ssq += __shfl_xor(ssq, 32);
                if (fq == 0) f.row(row0 + ai * HALF + m * 16, (u.pn & 3) * 4 + wc, ssq);
            }
    }
};
template <class F> struct EpiElemRS {
    F f;
    DI void operator()(const f32x4 (&acc)[2][2][4][2], const Unit& u, int wr, int wc, int fr, int fq) const {
        const int row0 = u.pm * BM + wr * 64 + fr, col0 = u.pn * BM + wc * 32 + 4 * fq;
#pragma unroll
        for (int ai = 0; ai < 2; ++ai)
#pragma unroll
            for (int m = 0; m < 4; ++m) {
                const float rs = f.rs(row0 + ai * HALF + m * 16);
#pragma unroll
                for (int bj = 0; bj < 2; ++bj)
#pragma unroll
                    for (int n = 0; n < 2; ++n) { f(row0 + ai * HALF + m * 16, col0 + bj * HALF + n * 16, acc[ai][bj][m][n], rs); }
            }
    }
};
template <class F> struct EpiPairRS {
    F f;
    DI void operator()(const f32x4 (&acc)[2][2][4][2], const Unit& u, int wr, int wc, int fr, int fq) const {
        const int row0 = u.pm * BM + wr * 64 + fr, c0 = wc * 32 + 4 * fq;
#pragma unroll
        for (int ai = 0; ai < 2; ++ai)
#pragma unroll
            for (int m = 0; m < 4; ++m) {
                const float rs = f.rs(row0 + ai * HALF + m * 16);
#pragma unroll
                for (int n = 0; n < 2; ++n) { f(row0 + ai * HALF + m * 16, u.pn, c0 + n * 16, acc[ai][0][m][n], acc[ai][1][m][n], rs); }
            }
    }
};
template <class F> struct EpiElem2 {
    F f;
    DI void operator()(const f32x4 (&acc)[2][2][4][2], const Unit& u, int wr, int wc, int fr, int fq) const {
        const int row0 = u.pm * BM + wr * 64 + fr, col0 = u.pn * BM + wc * 32 + 4 * fq;
        typename F::L cur[2][2], nxt[2][2];
#pragma unroll
        for (int bj = 0; bj < 2; ++bj)
#pragma unroll
            for (int n = 0; n < 2; ++n) cur[bj][n] = f.load(row0, col0 + bj * HALF + n * 16);
#pragma unroll
        for (int i = 0; i < 8; ++i) {
            const int row = row0 + (i >> 2) * HALF + (i & 3) * 16;
            if (i < 7) { const int rown = row0 + ((i + 1) >> 2) * HALF + ((i + 1) & 3) * 16;
#pragma unroll
                for (int bj = 0; bj < 2; ++bj)
#pragma unroll
                    for (int n = 0; n < 2; ++n) nxt[bj][n] = f.load(rown, col0 + bj * HALF + n * 16); }
#pragma unroll
            for (int bj = 0; bj < 2; ++bj)
#pragma unroll
                for (int n = 0; n < 2; ++n) f.apply(row, col0 + bj * HALF + n * 16, acc[i >> 2][bj][i & 3][n], cur[bj][n]);
#pragma unroll
            for (int bj = 0; bj < 2; ++bj)
#pragma unroll
                for (int n = 0; n < 2; ++n) cur[bj][n] = nxt[bj][n];
        }
    }
};
template <class F> struct EpiElem8 {
    F f;
    DI void operator()(const f32x4 (&acc)[2][2][4][2], const Unit& u, int wr, int wc, int fr, int fq) const {
        const int row0 = u.pm * BM + wr * 64 + fr, col0 = u.pn * BM + wc * 32 + 8 * fq;
        typename F::L cur[2], nxt[2];
#pragma unroll
        for (int bj = 0; bj < 2; ++bj) cur[bj] = f.load(row0, col0 + bj * HALF);
#pragma unroll
        for (int i = 0; i < 8; ++i) {
            const int row = row0 + (i >> 2) * HALF + (i & 3) * 16;
            if (i < 7) { const int rown = row0 + ((i + 1) >> 2) * HALF + ((i + 1) & 3) * 16;
#pragma unroll
                for (int bj = 0; bj < 2; ++bj) nxt[bj] = f.load(rown, col0 + bj * HALF); }
#pragma unroll
            for (int bj = 0; bj < 2; ++bj) f.apply(row, col0 + bj * HALF, acc[i >> 2][bj][i & 3][0], acc[i >> 2][bj][i & 3][1], cur[bj]);
#pragma unroll
            for (int bj = 0; bj < 2; ++bj) cur[bj] = nxt[bj];
        }
    }
};
template <class F> struct EpiPair {
    F f;
    DI void operator()(const f32x4 (&acc)[2][2][4][2], const Unit& u, int wr, int wc, int fr, int fq) const {
        const int row0 = u.pm * BM + wr * 64 + fr, c0 = wc * 32 + 4 * fq;
#pragma unroll
        for (int ai = 0; ai < 2; ++ai)
#pragma unroll
            for (int m = 0; m < 4; ++m)
#pragma unroll
                for (int n = 0; n < 2; ++n) { f(row0 + ai * HALF + m * 16, u.pn, c0 + n * 16, acc[ai][0][m][n], acc[ai][1][m][n]); }
    }
};
DI void st_bf4(bf16_t* p, f32x4 v) { u32x2 o; o.x = pk2(v[0], v[1]); o.y = pk2(v[2], v[3]); *(u32x2*)p = o; }
DI void st_bf8(bf16_t* p, f32x4 lo, f32x4 hi) { u32x4 o; o.x = pk2(lo[0], lo[1]); o.y = pk2(lo[2], lo[3]); o.z = pk2(hi[0], hi[1]); o.w = pk2(hi[2], hi[3]); *(u32x4*)p = o; }

struct FSwiglu { bf16_t* H; const float* SS; const float* shw;
    DI float rs(int row) const { return row_rstd(SS, row); }
    DI void operator()(int row, int pn, int c, f32x4 g, f32x4 u, float rs) const {
        const float* sw = shw + mod_row(row) * 5632 + pn * 256 + c;
        g = g * rs + *(const f32x4*)sw; u = u * rs + *(const f32x4*)(sw + 128);
        f32x4 h;
#pragma unroll
        for (int e = 0; e < 4; ++e) h[e] = g[e] * sigmoidf_(g[e]) * u[e];
        st_bf4(H + (size_t)row * DFF + pn * 128 + c, h);
    } };
struct FResid { const float* src; float* dst; const float* mod; float coef;
    DI void operator()(int row, int col, f32x4 v) const {
        const f32x4 g = *(const f32x4*)(mod + mod_row(row) * NMOD + col);
        const f32x4 x = *(const f32x4*)(src + (size_t)row * DM + col);
        *(f32x4*)(dst + (size_t)row * DM + col) = x + coef * g * v;
    } };
template <int COEF2> struct FResidN { const float* src; float* dst; const float* mod; const float* scn; bf16_t* XS; float* SS;
    DI float operator()(int row, int col, f32x4 v) const {
        const int r = mod_row(row);
        const f32x4 g = *(const f32x4*)(mod + r * NMOD + col);
        const f32x4 x = *(const f32x4*)(src + (size_t)row * DM + col);
        const f32x4 xn = x + (0.5f * COEF2) * g * v;
        *(f32x4*)(dst + (size_t)row * DM + col) = xn;
        const f32x4 sc = *(const f32x4*)(scn + r * NMOD + col);
        st_bf4(XS + (size_t)row * DM + col, xn * (1.f + sc));
        return (xn[0] * xn[0] + xn[1] * xn[1]) + (xn[2] * xn[2] + xn[3] * xn[3]);
    }
    DI void row(int row, int slot, float ssq) const { SS[(size_t)row * 16 + slot] = ssq; } };
struct FWin { bf16_t *P1, *UXY, *GATE; const float* SS; const float* shw;
    DI float rs(int row) const { return row_rstd(SS, row); }
    DI void operator()(int row, int col, f32x4 v, float rs) const {
        v = v * rs + *(const f32x4*)(shw + mod_row(row) * 5632 + col);
        bf16_t* p = col < 768 ? P1 + (size_t)row * 768 + col : (col < 1792 ? UXY + (size_t)row * 1024 + (col - 768) : GATE + (size_t)row * 2048 + (col - 1792));
        st_bf4(p, v);
    } };
struct FRowScale { bf16_t* dst; int ld; const float* rs;
    typedef float L;
    DI L load(int row, int) const { return rs[row]; }
    DI void apply(int row, int col, f32x4 v0, f32x4 v1, L sc) const { st_bf8(dst + (size_t)row * ld + col, v0 * sc, v1 * sc); } };
struct FVt { bf16_t* Vt; const float* rs;
    struct L { f32x4 a, b; };
    DI L load(int, int col) const { return L{*(const f32x4*)(rs + col), *(const f32x4*)(rs + col + 4)}; }
    DI void apply(int row, int col, f32x4 v0, f32x4 v1, L sc) const {
        int b, kpos; if (col < ML) { b = col >> 13; kpos = col & (SEQ - 1); } else { const int r = col - ML; b = r >> 8; kpos = SEQ + (r & 255); }
        st_bf8(Vt + ((size_t)(b * NH + (row >> 6)) * 64 + (row & 63)) * TK + kpos, v0 * sc.a, v1 * sc.b);
    } };
struct EGate { const bf16_t* xc; bf16_t *OM, *BB; const float *sp8, *br, *bi;
    DI void operator()(const f32x4 (&acc)[2][2][4][2], const Unit& u, int wr, int wc, int fr, int fq) const {
        const int row0 = u.pm * BM + wr * 64 + fr, d = u.pn >> 2, ch0 = (u.pn & 3) * 128 + wc * 32 + 8 * fq;
        f32x4 s4[2], br4[2], bi4[2]; u32x4 xcur, xnxt;
#pragma unroll
        for (int n = 0; n < 2; ++n) { s4[n] = *(const f32x4*)(sp8 + d * 512 + ch0 + 4 * n); br4[n] = *(const f32x4*)(br + d * 512 + ch0 + 4 * n); bi4[n] = *(const f32x4*)(bi + d * 512 + ch0 + 4 * n); }
        xcur = *(const u32x4*)(xc + (size_t)row0 * 512 + ch0);
#pragma unroll
        for (int i = 0; i < 8; ++i) {
            const int row = row0 + (i >> 2) * HALF + (i & 3) * 16;
            if (i < 7) { const int rown = row0 + ((i + 1) >> 2) * HALF + ((i + 1) & 3) * 16; xnxt = *(const u32x4*)(xc + (size_t)rown * 512 + ch0); }
            f32x4 om[2], bb[2];
#pragma unroll
            for (int n = 0; n < 2; ++n) {
                const f32x4 r4 = acc[i >> 2][0][i & 3][n], i4 = acc[i >> 2][1][i & 3][n];
                const unsigned w0 = n == 0 ? xcur.x : xcur.z, w1 = n == 0 ? xcur.y : xcur.w;
                const f32x4 xf = {bflo(w0), bfhi(w0), bflo(w1), bfhi(w1)};
#pragma unroll
                for (int e = 0; e < 4; ++e) {
                    const float r = sigmoidf_(r4[e] + br4[n][e]), ig = sigmoidf_(i4[e] + bi4[n][e]);
                    const float a = __expf(s4[n][e] * r);
                    om[n][e] = 1.f - a; bb[n][e] = __fsqrt_rn(fmaxf(1.f - a * a, 0.f)) * (ig * xf[e]);
                }
            }
            const size_t o = ((size_t)d * MA + row) * 512 + ch0;
            st_bf8(OM + o, om[0], om[1]); st_bf8(BB + o, bb[0], bb[1]);
            xcur = xnxt;
        }
    } };
DI f32x4 sig_lo(u32x4 g) { return (f32x4){sigmoidf_(bflo(g.x)), sigmoidf_(bfhi(g.x)), sigmoidf_(bflo(g.y)), sigmoidf_(bfhi(g.y))}; }
DI f32x4 sig_hi(u32x4 g) { return (f32x4){sigmoidf_(bflo(g.z)), sigmoidf_(bfhi(g.z)), sigmoidf_(bflo(g.w)), sigmoidf_(bfhi(g.w))}; }
struct FMergeA { const bf16_t* GATE; bf16_t* Y;
    typedef u32x4 L;
    DI L load(int row, int col) const { return *(const u32x4*)(GATE + (size_t)row * 2048 + col); }
    DI void apply(int row, int col, f32x4 v0, f32x4 v1, L gv) const { st_bf8(Y + (size_t)row * DM + col, sig_lo(gv) * v0, sig_hi(gv) * v1); } };
struct FMergeB { const bf16_t* GATE; bf16_t* Y;
    struct L { u32x4 g, y; };
    DI L load(int row, int col) const { return L{*(const u32x4*)(GATE + (size_t)row * 2048 + 1024 + col), *(const u32x4*)(Y + (size_t)row * DM + col)}; }
    DI void apply(int row, int col, f32x4 v0, f32x4 v1, L q) const {
        const f32x4 y0 = {bflo(q.y.x), bfhi(q.y.x), bflo(q.y.y), bfhi(q.y.y)}, y1 = {bflo(q.y.z), bfhi(q.y.z), bflo(q.y.w), bfhi(q.y.w)};
        st_bf8(Y + (size_t)row * DM + col, y0 + sig_lo(q.g) * v0, y1 + sig_hi(q.g) * v1);
    } };

struct ESwiglu { bf16_t* H; const float* SS; const float* shw;
    DI void operator()(const f32x4 (&acc)[2][2][4][2], const Unit& u, int wr, int wc, int fr, int fq) const {
        const int row0 = u.pm * BM + wr * 64 + fr, c0 = wc * 32 + 8 * fq;
        const float* sw = shw + mod_row(u.pm * BM) * 5632 + u.pn * 256 + c0;
        f32x4 sg[2], su[2]; float rs[8];
#pragma unroll
        for (int n = 0; n < 2; ++n) { sg[n] = *(const f32x4*)(sw + 4 * n); su[n] = *(const f32x4*)(sw + 128 + 4 * n); }
#pragma unroll
        for (int i = 0; i < 8; ++i) rs[i] = row_rstd(SS, row0 + (i >> 2) * HALF + (i & 3) * 16);
#pragma unroll
        for (int ai = 0; ai < 2; ++ai)
#pragma unroll
            for (int m = 0; m < 4; ++m) {
                f32x4 h[2];
#pragma unroll
                for (int n = 0; n < 2; ++n) {
                    const f32x4 g = acc[ai][0][m][n] * rs[ai * 4 + m] + sg[n], uu = acc[ai][1][m][n] * rs[ai * 4 + m] + su[n];
#pragma unroll
                    for (int e = 0; e < 4; ++e) h[n][e] = g[e] * sigmoidf_(g[e]) * uu[e];
                }
                st_bf8(H + (size_t)(row0 + ai * HALF + m * 16) * DFF + u.pn * 128 + c0, h[0], h[1]);
            }
    } };
struct EWin { bf16_t *P1, *UXY, *GATE; const float* SS; const float* shw;
    template <int LD> DI void body(const f32x4 (&acc)[2][2][4][2], bf16_t* dst, const f32x4 (&sh)[2][2], const float (&rs)[8]) const {
#pragma unroll
        for (int ai = 0; ai < 2; ++ai)
#pragma unroll
            for (int m = 0; m < 4; ++m)
#pragma unroll
                for (int bj = 0; bj < 2; ++bj)
                    st_bf8(dst + (size_t)(ai * HALF + m * 16) * LD + 128 * bj, acc[ai][bj][m][0] * rs[ai * 4 + m] + sh[bj][0], acc[ai][bj][m][1] * rs[ai * 4 + m] + sh[bj][1]);
    }
    DI void operator()(const f32x4 (&acc)[2][2][4][2], const Unit& u, int wr, int wc, int fr, int fq) const {
        const int row0 = u.pm * BM + wr * 64 + fr, c0 = wc * 32 + 8 * fq;
        const float* sw = shw + mod_row(u.pm * BM) * 5632 + u.pn * 256 + c0;
        f32x4 sh[2][2]; float rs[8];
#pragma unroll
        for (int bj = 0; bj < 2; ++bj)
#pragma unroll
            for (int n = 0; n < 2; ++n) sh[bj][n] = *(const f32x4*)(sw + 128 * bj + 4 * n);
#pragma unroll
        for (int i = 0; i < 8; ++i) { rs[i] = row_rstd(SS, row0 + (i >> 2) * HALF + (i & 3) * 16); if ((i & 1) == 1) __builtin_amdgcn_sched_barrier(0); }
        if (u.pn < 3) body<768>(acc, P1 + (size_t)row0 * 768 + u.pn * 256 + c0, sh, rs);
        else if (u.pn < 7) body<1024>(acc, UXY + (size_t)row0 * 1024 + (u.pn - 3) * 256 + c0, sh, rs);
        else body<2048>(acc, GATE + (size_t)row0 * 2048 + (u.pn - 7) * 256 + c0, sh, rs);
    } };
template <int COEF2, bool NORM> struct EResid { const float* src; float* dst; const float* mod; const float* scn; bf16_t* XS; float* SS;
    DI void operator()(const f32x4 (&acc)[2][2][4][2], const Unit& u, int wr, int wc, int fr, int fq) const {
        const int row0 = u.pm * BM + wr * 64 + fr, col0 = u.pn * BM + wc * 32 + 8 * fq, r = mod_row(u.pm * BM);
        f32x4 g[2][2], sc[2][2];
#pragma unroll
        for (int bj = 0; bj < 2; ++bj)
#pragma unroll
            for (int n = 0; n < 2; ++n) { g[bj][n] = *(const f32x4*)(mod + r * NMOD + col0 + 128 * bj + 4 * n) * (0.5f * COEF2);
                if (NORM) sc[bj][n] = *(const f32x4*)(scn + r * NMOD + col0 + 128 * bj + 4 * n) + 1.f; }
        f32x4 xc[2][2], xn_[2][2];
#pragma unroll
        for (int bj = 0; bj < 2; ++bj)
#pragma unroll
            for (int n = 0; n < 2; ++n) xc[bj][n] = *(const f32x4*)(src + (size_t)row0 * DM + col0 + 128 * bj + 4 * n);
#pragma unroll
        for (int i = 0; i < 8; ++i) {
            const int row = row0 + (i >> 2) * HALF + (i & 3) * 16;
            if (i < 7) { const int rown = row0 + ((i + 1) >> 2) * HALF + ((i + 1) & 3) * 16;
#pragma unroll
                for (int bj = 0; bj < 2; ++bj)
#pragma unroll
                    for (int n = 0; n < 2; ++n) xn_[bj][n] = *(const f32x4*)(src + (size_t)rown * DM + col0 + 128 * bj + 4 * n); }
            float ssq = 0.f;
#pragma unroll
            for (int bj = 0; bj < 2; ++bj) {
                f32x4 y[2];
#pragma unroll
                for (int n = 0; n < 2; ++n) {
                    y[n] = xc[bj][n] + g[bj][n] * acc[i >> 2][bj][i & 3][n];
                    *(f32x4*)(dst + (size_t)row * DM + col0 + 128 * bj + 4 * n) = y[n];
                    if (NORM) ssq += (y[n][0] * y[n][0] + y[n][1] * y[n][1]) + (y[n][2] * y[n][2] + y[n][3] * y[n][3]);
                }
                if (NORM) st_bf8(XS + (size_t)row * DM + col0 + 128 * bj, y[0] * sc[bj][0], y[1] * sc[bj][1]);
            }
            if (NORM) { ssq += __shfl_xor(ssq, 16); ssq += __shfl_xor(ssq, 32); if (fq == 0) SS[(size_t)row * 16 + (u.pn & 3) * 4 + wc] = ssq; }
#pragma unroll
            for (int bj = 0; bj < 2; ++bj)
#pragma unroll
                for (int n = 0; n < 2; ++n) xc[bj][n] = xn_[bj][n];
        }
    } };

DI void phase_mod(const Params& p, float* lds) {
    float* sc = lds;
    float* red = lds + 5 * DM;
    const int tid = TIDX, lane = tid & 63, wave = tid >> 6;
    for (int i = tid; i < 5 * DM; i += 512) { const float v = i < 4 * DM ? p.c[i] : p.c_ctx[i - 4 * DM]; sc[i] = v * sigmoidf_(v); }
    __syncthreads();
    float* mod = (float*)(p.ws + O_MOD);
    for (int it = BIDX; it < DEPTH * (NMOD / 64); it += gridDim.x) {
        const int l = it / (NMOD / 64), n = (it % (NMOD / 64)) * 64 + lane;
        const float* w = p.w_ada + ((size_t)l * DM + wave * 128) * NMOD + n;
        float a0 = 0.f, a1 = 0.f, a2 = 0.f, a3 = 0.f, a4 = 0.f;
#pragma unroll 8
        for (int k = 0; k < 128; ++k) { const float wv = w[(size_t)k * NMOD]; const int kk = wave * 128 + k;
            a0 += sc[kk] * wv; a1 += sc[DM + kk] * wv; a2 += sc[2 * DM + kk] * wv; a3 += sc[3 * DM + kk] * wv; a4 += sc[4 * DM + kk] * wv; }
        red[(wave * 5 + 0) * 64 + lane] = a0; red[(wave * 5 + 1) * 64 + lane] = a1; red[(wave * 5 + 2) * 64 + lane] = a2; red[(wave * 5 + 3) * 64 + lane] = a3; red[(wave * 5 + 4) * 64 + lane] = a4;
        __syncthreads();
        if (tid < 320) { const int r = tid >> 6; float s = p.b_ada[(size_t)l * NMOD + n];
#pragma unroll
            for (int w8 = 0; w8 < 8; ++w8) s += red[(w8 * 5 + r) * 64 + lane];
            mod[((size_t)l * 5 + r) * NMOD + n] = s; }
        __syncthreads();
    }
}

template <int MAP> DI int colmap(int n) {
    if (MAP == 0) return n;
    if (MAP == 1) { const int pn = n >> 8, bj = (n >> 7) & 1, c = n & 127; return bj * DFF + pn * 128 + c; }
    if (MAP == 2) return n < 672 ? n : (n < 768 ? -1 : n - 96);
    { const int m = n & 511, h = m >> 6, d = m & 63; return h * 128 + (n >> 9) * 64 + d; }
}
template <int MAP> DI void tjob(const float* src, int ld, int K, int N, bf16_t* dst, const float* kscale, float* tile, int& base, int vbid, int G) {
    const int tid = TIDX, ntn = N / 64, ntiles = ntn * (K / 64);
    int first = (vbid - base % G + G) % G;
    for (int t = first; t < ntiles; t += G) {
        const int n0 = (t % ntn) * 64, k0 = (t / ntn) * 64;
        const int c = colmap<MAP>(n0 + (tid & 63));
#pragma unroll
        for (int i = 0; i < 8; ++i) { const int kk = (tid >> 6) + 8 * i; float v = c >= 0 ? src[(size_t)(k0 + kk) * ld + c] : 0.f; if (kscale) v *= kscale[k0 + kk]; tile[kk * 65 + (tid & 63)] = v; }
        __syncthreads();
        { const int kc = tid & 7, nn = tid >> 3;
          const float* tp = tile + (kc * 8) * 65 + nn;
          u32x4 o; o.x = pk2(tp[0], tp[65]); o.y = pk2(tp[2 * 65], tp[3 * 65]); o.z = pk2(tp[4 * 65], tp[5 * 65]); o.w = pk2(tp[6 * 65], tp[7 * 65]);
          *(u32x4*)(dst + (size_t)(n0 + nn) * K + k0 + kc * 8) = o; }
        __syncthreads();
    }
    base += ntiles;
}
DI void phase_prep_ff(const Params& p, int l, int which, float* tile, int vbid, int vG) {
    unsigned char* ws = p.ws; int base = 0;
    if (which == 0) {
        tjob<1>(p.ff1_w_in + (size_t)l * DM * 2 * DFF, 2 * DFF, DM, 2 * DFF, (bf16_t*)(ws + O_WFF1IN), nullptr, tile, base, vbid, vG);
        tjob<0>(p.ff1_w_out + (size_t)l * DFF * DM, DM, DFF, DM, (bf16_t*)(ws + O_WFF1OUT), nullptr, tile, base, vbid, vG);
    } else {
        tjob<1>(p.ff2_w_in + (size_t)l * DM * 2 * DFF, 2 * DFF, DM, 2 * DFF, (bf16_t*)(ws + O_WFF2IN), nullptr, tile, base, vbid, vG);
        tjob<0>(p.ff2_w_out + (size_t)l * DFF * DM, DM, DFF, DM, (bf16_t*)(ws + O_WFF2OUT), nullptr, tile, base, vbid, vG);
    }
}
DI void phase_prep(const Params& p, int l, float* tile) {
    unsigned char* ws = p.ws; int base = 0;
    const int vbid = BIDX, vG = gridDim.x;
    const float* modl = (const float*)(ws + O_MOD) + (size_t)l * 5 * NMOD; float* shw = (float*)(ws + O_SHW);
    if (l == 0) phase_prep_ff(p, 0, 0, tile, vbid, vG);
    tjob<2>(p.w_in + (size_t)l * DM * 3744, 3744, DM, NIN, (bf16_t*)(ws + O_WIN), nullptr, tile, base, vbid, vG);
    tjob<0>(p.w_uq + (size_t)l * 384 * 768, 768, 384, 768, (bf16_t*)(ws + O_WUQ), p.q_a_norm + l * 384, tile, base, vbid, vG);
    tjob<3>(p.w_ukv + (size_t)l * 256 * 1024, 1024, 256, 1024, (bf16_t*)(ws + O_WUKV), p.kv_a_norm + l * 256, tile, base, vbid, vG);
    tjob<0>(p.w_o_attn + (size_t)l * 512 * 1024, 1024, 512, 1024, (bf16_t*)(ws + O_WOA), nullptr, tile, base, vbid, vG);
    tjob<0>(p.w_o_lru + (size_t)l * 512 * 1024, 1024, 512, 1024, (bf16_t*)(ws + O_WOL), nullptr, tile, base, vbid, vG);
    tjob<0>(p.w_out + (size_t)l * 1024 * 1024, 1024, 1024, 1024, (bf16_t*)(ws + O_WOUT), nullptr, tile, base, vbid, vG);
    { float* sh = tile; float* red = tile + 5 * DM;
      const int tid = TIDX, nn = tid & 63, ks = tid >> 6;
      for (int it = BIDX; it < 88 + 60 + 88; it += gridDim.x) {
          const int m = it < 88 ? 0 : (it < 148 ? 1 : 2), n0 = (m == 0 ? it : (m == 1 ? it - 88 : it - 148)) * 64;
          const float* W = m == 0 ? p.ff1_w_in + (size_t)l * DM * 2 * DFF : (m == 1 ? p.w_in + (size_t)l * DM * 3744 : p.ff2_w_in + (size_t)l * DM * 2 * DFF);
          const int ld = m == 1 ? 3744 : 2 * DFF, c = m == 1 ? colmap<2>(n0 + nn) : colmap<1>(n0 + nn);
          __syncthreads();
          for (int i = tid; i < 5 * DM; i += 512) sh[i] = modl[(size_t)(i >> 10) * NMOD + m * 3 * DM + (i & 1023)];
          __syncthreads();
          float a0 = 0.f, a1 = 0.f, a2 = 0.f, a3 = 0.f, a4 = 0.f;
          if (c >= 0) {
#pragma unroll 8
              for (int k = ks * 128; k < ks * 128 + 128; ++k) { const float wv = W[(size_t)k * ld + c]; a0 += sh[k] * wv; a1 += sh[DM + k] * wv; a2 += sh[2 * DM + k] * wv; a3 += sh[3 * DM + k] * wv; a4 += sh[4 * DM + k] * wv; }
          }
          red[(ks * 5 + 0) * 64 + nn] = a0; red[(ks * 5 + 1) * 64 + nn] = a1; red[(ks * 5 + 2) * 64 + nn] = a2; red[(ks * 5 + 3) * 64 + nn] = a3; red[(ks * 5 + 4) * 64 + nn] = a4;
          __syncthreads();
          if (tid < 320) { const int r = tid >> 6; float sum = 0.f;
#pragma unroll
              for (int w8 = 0; w8 < 8; ++w8) sum += red[(w8 * 5 + r) * 64 + nn];
              shw[(size_t)(m * 5 + r) * 5632 + n0 + nn] = sum; }
      }
      __syncthreads(); }
    if (BIDX == 0) { float* sp8 = (float*)(ws + O_SP);
        for (int i = TIDX; i < 1024; i += 512) { const float nl = -p.lru_lambda[l * 1024 + i]; sp8[i] = -8.f * (fmaxf(nl, 0.f) + log1pf(__expf(-fabsf(nl)))); } }
    bf16_t* wg = (bf16_t*)(ws + O_WGATE);
    for (int idx = BIDX * 512 + TIDX; idx < 2048 * 256; idx += gridDim.x * 512) {
        const int n = idx >> 8, k = idx & 255, d = n >> 10, cb = (n >> 8) & 3, gt = (n >> 7) & 1, c = n & 127, ch = cb * 128 + c, g = ch >> 6, j = ch & 63, ci = 256 * (cb >> 1) + k, gi = ci >> 6, i = ci & 63;
        float v = 0.f;
        if (gi == g) v = (gt ? p.w_igate : p.w_rgate)[((((size_t)l * 2 + d) * 8 + g) * 64 + i) * 64 + j];
        wg[idx] = f2bf(v);
    }
}

DI void phase_norm0(const Params& p) {
    const int tid = TIDX, lane = tid & 63, gw = BIDX * 8 + (tid >> 6), nw = gridDim.x * 8;
    float* X = (float*)(p.ws + O_X); bf16_t* XS = (bf16_t*)(p.ws + O_XNY); float* SS = (float*)(p.ws + O_SS);
    const float* mod = (const float*)(p.ws + O_MOD);
    for (int row = gw; row < MA; row += nw) {
        const float* src = row < ML ? p.x + (size_t)row * DM : p.ctx + (size_t)(row - ML) * DM;
        f32x4 v[4]; float s = 0.f;
#pragma unroll
        for (int j = 0; j < 4; ++j) { v[j] = *(const f32x4*)(src + 256 * j + 4 * lane); s += (v[j][0] * v[j][0] + v[j][1] * v[j][1]) + (v[j][2] * v[j][2] + v[j][3] * v[j][3]); }
        s = wave_sum(s);
        if (lane < 16) SS[(size_t)row * 16 + lane] = lane == 0 ? s : 0.f;
        const float* mr = mod + (size_t)mod_row(row) * NMOD;
#pragma unroll
        for (int j = 0; j < 4; ++j) {
            const int col = 256 * j + 4 * lane;
            *(f32x4*)(X + (size_t)row * DM + col) = v[j];
            const f32x4 sc = *(const f32x4*)(mr + DM + col);
            st_bf4(XS + (size_t)row * DM + col, v[j] * (1.f + sc));
        }
    }
}

DI void phase_conv(const Params& p, int l) {
    const bf16_t* UXY = (const bf16_t*)(p.ws + O_UXY); const bf16_t* P1 = (const bf16_t*)(p.ws + O_R1);
    bf16_t* xc = (bf16_t*)(p.ws + O_XNY);
    const float* cw = p.conv_w + (size_t)l * 4 * 512; const float* cb = p.conv_b + (size_t)l * 512;
    for (int e = BIDX * 512 + TIDX; e < MA * 64; e += gridDim.x * 512) {
        const int row = e >> 6, ch = (e & 63) * 8;
        int t, T; if (row < ML) { t = row & (SEQ - 1); T = SEQ; } else { t = (row - ML) & 255; T = CTXL; }
        u32x4 uv[4]; float ok[4];
#pragma unroll
        for (int k = 0; k < 4; ++k) { const int tt = t + k - 2; const bool in = tt >= 0 && tt < T; ok[k] = in ? 1.f : 0.f;
            uv[k] = *(const u32x4*)(UXY + (size_t)(in ? row + k - 2 : row) * 1024 + ch); }
        f32x4 y0 = *(const f32x4*)(cb + ch), y1 = *(const f32x4*)(cb + ch + 4);
#pragma unroll
        for (int k = 0; k < 4; ++k) {
            const f32x4 w0 = *(const f32x4*)(cw + k * 512 + ch) * ok[k], w1 = *(const f32x4*)(cw + k * 512 + ch + 4) * ok[k];
            const f32x4 a = {bflo(uv[k].x), bfhi(uv[k].x), bflo(uv[k].y), bfhi(uv[k].y)}, c = {bflo(uv[k].z), bfhi(uv[k].z), bflo(uv[k].w), bfhi(uv[k].w)};
            y0 += w0 * a; y1 += w1 * c;
        }
        u32x4 o; o.x = pk2(y0[0], y0[1]); o.y = pk2(y0[2], y0[3]); o.z = pk2(y1[0], y1[1]); o.w = pk2(y1[2], y1[3]);
        *(u32x4*)(xc + (size_t)row * 512 + ch) = o;
    }
    float* rsq = (float*)(p.ws + O_RSQ); float* rskv = (float*)(p.ws + O_RSKV);
    const int tid2 = TIDX, l16 = tid2 & 15, gq = BIDX * 32 + (tid2 >> 4), nq = gridDim.x * 32;
    for (int row = gq; row < MA; row += nq) {
        const bf16_t* pr = P1 + (size_t)row * 768;
        u32x4 v[5];
#pragma unroll
        for (int i = 0; i < 5; ++i) v[i] = *(const u32x4*)(pr + (l16 + 16 * i) * 8);
        float sq = 0.f, skv = 0.f;
#pragma unroll
        for (int i = 0; i < 5; ++i) {
            const float s2 = bflo(v[i].x) * bflo(v[i].x) + bfhi(v[i].x) * bfhi(v[i].x) + bflo(v[i].y) * bflo(v[i].y) + bfhi(v[i].y) * bfhi(v[i].y)
                           + bflo(v[i].z) * bflo(v[i].z) + bfhi(v[i].z) * bfhi(v[i].z) + bflo(v[i].w) * bflo(v[i].w) + bfhi(v[i].w) * bfhi(v[i].w);
            if (i < 3) sq += s2; else skv += s2;
        }
#pragma unroll
        for (int o = 1; o < 16; o <<= 1) { sq += __shfl_xor(sq, o); skv += __shfl_xor(skv, o); }
        if (l16 == 0) { rsq[row] = rsqrtf(sq * (1.f / 384.f) + EPS); rskv[row] = rsqrtf(skv * (1.f / 256.f) + EPS); }
    }
}

DI int chunk_row0(int b, int pch) { return pch < 4 ? ML + b * CTXL + pch * 64 : b * SEQ + (pch - 4) * 64; }
DI void phase_scan_agg(const Params& p) {
    const bf16_t* OM = (const bf16_t*)(p.ws + O_S); const bf16_t* BB = OM + (size_t)2 * MA * 512;
    f32x4* agg = (f32x4*)(p.ws + O_AGG);
    const int tid = TIDX, lane = tid & 63, gw = (tid >> 6) * gridDim.x + BIDX, nw = gridDim.x * 8;
    for (int it = gw; it < 2 * NB * NCH; it += nw) {
        const int d = it & 1, bp = it >> 1, b = bp / NCH, pch = bp % NCH, row0 = chunk_row0(b, pch);
        const bf16_t* om = OM + ((size_t)d * MA + row0) * 512 + lane * 8; const bf16_t* bb = BB + ((size_t)d * MA + row0) * 512 + lane * 8;
        float h[8], A[8];
#pragma unroll
        for (int i = 0; i < 8; ++i) { h[i] = 0.f; A[i] = 1.f; }
#pragma unroll 8
        for (int t = 0; t < 64; ++t) {
            const int tt = d ? 63 - t : t;
            const u32x4 ov = *(const u32x4*)(om + (size_t)tt * 512), bv = *(const u32x4*)(bb + (size_t)tt * 512);
            const float a[8] = {1.f - bflo(ov.x), 1.f - bfhi(ov.x), 1.f - bflo(ov.y), 1.f - bfhi(ov.y), 1.f - bflo(ov.z), 1.f - bfhi(ov.z), 1.f - bflo(ov.w), 1.f - bfhi(ov.w)};
            const float bq[8] = {bflo(bv.x), bfhi(bv.x), bflo(bv.y), bfhi(bv.y), bflo(bv.z), bfhi(bv.z), bflo(bv.w), bfhi(bv.w)};
#pragma unroll
            for (int i = 0; i < 8; ++i) { h[i] = a[i] * h[i] + bq[i]; A[i] *= a[i]; }
        }
        f32x4* dst = agg + (((size_t)(d * NB + b) * NCH + pch) * 512 + lane * 8) / 2;
#pragma unroll
        for (int i = 0; i < 4; ++i) dst[i] = (f32x4){A[2 * i], h[2 * i], A[2 * i + 1], h[2 * i + 1]};
    }
}
DI float gelu_tanh(float x) { const float u = 0.7978845608028654f * (x + 0.044715f * x * x * x); const float e = __expf(2.f * u); const float th = 1.f - 2.f * __builtin_amdgcn_rcpf(e + 1.f); return 0.5f * x * (1.f + th); }
DI void agg_step(const f32x4* e, float (&h)[8]) {
    const f32x4 e0 = e[0], e1 = e[1], e2 = e[2], e3 = e[3];
    h[0] = e0[0] * h[0] + e0[1]; h[1] = e0[2] * h[1] + e0[3]; h[2] = e1[0] * h[2] + e1[1]; h[3] = e1[2] * h[3] + e1[3];
    h[4] = e2[0] * h[4] + e2[1]; h[5] = e2[2] * h[5] + e2[3]; h[6] = e3[0] * h[6] + e3[1]; h[7] = e3[2] * h[7] + e3[3];
}
DI void phase_scan_apply(const Params& p) {
    const bf16_t* OM = (const bf16_t*)(p.ws + O_S); const bf16_t* BB = OM + (size_t)2 * MA * 512;
    const f32x4* agg = (const f32x4*)(p.ws + O_AGG);
    bf16_t* UXY = (bf16_t*)(p.ws + O_UXY); float* HF = p.out;
    const int tid = TIDX, lane = tid & 63, gw = (tid >> 6) * gridDim.x + BIDX, nw = gridDim.x * 8;
    for (int it = gw; it < NB * NCH; it += nw) {
        const int b = it / NCH, pch = it % NCH, row0 = chunk_row0(b, pch);
        const f32x4* af = agg + (((size_t)(0 * NB + b) * NCH) * 512 + lane * 8) / 2; const f32x4* ab = agg + (((size_t)(1 * NB + b) * NCH) * 512 + lane * 8) / 2;
        float h[8];
#pragma unroll
        for (int i = 0; i < 8; ++i) h[i] = 0.f;
#pragma unroll 4
        for (int q = 0; q < pch; ++q) agg_step(af + (size_t)q * 256, h);
        { const bf16_t* om = OM + ((size_t)row0) * 512 + lane * 8; const bf16_t* bb = BB + ((size_t)row0) * 512 + lane * 8; float* hf = HF + (size_t)row0 * 512 + lane * 8;
#pragma unroll 8
          for (int t = 0; t < 64; ++t) {
              const u32x4 ov = *(const u32x4*)(om + (size_t)t * 512), bv = *(const u32x4*)(bb + (size_t)t * 512);
              h[0] = (1.f - bflo(ov.x)) * h[0] + bflo(bv.x); h[1] = (1.f - bfhi(ov.x)) * h[1] + bfhi(bv.x); h[2] = (1.f - bflo(ov.y)) * h[2] + bflo(bv.y); h[3] = (1.f - bfhi(ov.y)) * h[3] + bfhi(bv.y);
              h[4] = (1.f - bflo(ov.z)) * h[4] + bflo(bv.z); h[5] = (1.f - bfhi(ov.z)) * h[5] + bfhi(bv.z); h[6] = (1.f - bflo(ov.w)) * h[6] + bflo(bv.w); h[7] = (1.f - bfhi(ov.w)) * h[7] + bfhi(bv.w);
              *(f32x4*)(hf + (size_t)t * 512) = (f32x4){h[0], h[1], h[2], h[3]}; *(f32x4*)(hf + (size_t)t * 512 + 4) = (f32x4){h[4], h[5], h[6], h[7]};
          } }
#pragma unroll
        for (int i = 0; i < 8; ++i) h[i] = 0.f;
        if (pch >= 4) {
#pragma unroll
            for (int q = 3; q >= 0; --q) agg_step(ab + (size_t)q * 256, h);
#pragma unroll 4
            for (int q = NCH - 1; q > pch; --q) agg_step(ab + (size_t)q * 256, h);
        } else {
            for (int q = 3; q > pch; --q) agg_step(ab + (size_t)q * 256, h);
        }
        { const bf16_t* om = OM + ((size_t)MA + row0) * 512 + lane * 8; const bf16_t* bb = BB + ((size_t)MA + row0) * 512 + lane * 8; const float* hf = HF + (size_t)row0 * 512 + lane * 8;
#pragma unroll 4
          for (int t = 63; t >= 0; --t) {
              const u32x4 ov = *(const u32x4*)(om + (size_t)t * 512), bv = *(const u32x4*)(bb + (size_t)t * 512);
              const f32x4 f0 = *(const f32x4*)(hf + (size_t)t * 512), f1 = *(const f32x4*)(hf + (size_t)t * 512 + 4);
              const u32x4 uv = *(const u32x4*)(UXY + (size_t)(row0 + t) * 1024 + 512 + lane * 8);
              h[0] = (1.f - bflo(ov.x)) * h[0] + bflo(bv.x); h[1] = (1.f - bfhi(ov.x)) * h[1] + bfhi(bv.x); h[2] = (1.f - bflo(ov.y)) * h[2] + bflo(bv.y); h[3] = (1.f - bfhi(ov.y)) * h[3] + bfhi(bv.y);
              h[4] = (1.f - bflo(ov.z)) * h[4] + bflo(bv.z); h[5] = (1.f - bfhi(ov.z)) * h[5] + bfhi(bv.z); h[6] = (1.f - bflo(ov.w)) * h[6] + bflo(bv.w); h[7] = (1.f - bfhi(ov.w)) * h[7] + bfhi(bv.w);
              u32x4 o;
              o.x = pk2((f0[0] + h[0]) * gelu_tanh(bflo(uv.x)), (f0[1] + h[1]) * gelu_tanh(bfhi(uv.x))); o.y = pk2((f0[2] + h[2]) * gelu_tanh(bflo(uv.y)), (f0[3] + h[3]) * gelu_tanh(bfhi(uv.y)));
              o.z = pk2((f1[0] + h[4]) * gelu_tanh(bflo(uv.z)), (f1[1] + h[5]) * gelu_tanh(bfhi(uv.z))); o.w = pk2((f1[2] + h[6]) * gelu_tanh(bflo(uv.w)), (f1[3] + h[7]) * gelu_tanh(bfhi(uv.w)));
              *(u32x4*)(UXY + (size_t)(row0 + t) * 1024 + lane * 8) = o;
          } }
    }
}

DI void phase_qk(const Params& p, int l, unsigned char* smem) {
    const bf16_t* qraw = (const bf16_t*)p.out; const bf16_t* kn = qraw + (size_t)MA * 768;
    const bf16_t* P1 = (const bf16_t*)(p.ws + O_R1);
    bf16_t* Q = (bf16_t*)(p.ws + O_S); bf16_t* Kb = Q + (size_t)32 * TK * 96;
    const int tid = TIDX, lane = tid & 63, wave = tid >> 6, gw = BIDX * 8 + wave, nw = gridDim.x * 8, h = lane >> 3, j = lane & 7;
    unsigned char* wq = smem + wave * 4096; unsigned char* wk = wq + 1536;
    const float* qn = p.q_norm + l * 96; const float* knm = p.k_norm + l * 96;
    float gq[12], gk[12];
#pragma unroll
    for (int i = 0; i < 12; ++i) { gq[i] = qn[8 * i + j] * QSCALE; gk[i] = knm[8 * i + j]; }
    const float freq = exp2f(-(float)j * 1.6609640474436813f);
    for (int row = gw; row < MA; row += nw) {
        { const u32x4 q0 = *(const u32x4*)(qraw + (size_t)row * 768 + lane * 8);
          u32x4 q1 = {0u, 0u, 0u, 0u}, k1 = {0u, 0u, 0u, 0u};
          if (lane < 32) q1 = *(const u32x4*)(qraw + (size_t)row * 768 + 512 + lane * 8);
          const u32x4 k0 = *(const u32x4*)(kn + (size_t)row * 512 + lane * 8);
          if (lane < 4) k1 = *(const u32x4*)(P1 + (size_t)row * 768 + 640 + lane * 8);
          *(u32x4*)(wq + lane * 16) = q0; if (lane < 32) *(u32x4*)(wq + 1024 + lane * 16) = q1;
          *(u32x4*)(wk + lane * 16) = k0; if (lane < 4) *(u32x4*)(wk + 1024 + lane * 16) = k1; }
        __builtin_amdgcn_fence(__ATOMIC_RELEASE, "wavefront"); __builtin_amdgcn_wave_barrier(); __builtin_amdgcn_fence(__ATOMIC_ACQUIRE, "wavefront");
        float xq[12], xk[12];
#pragma unroll
        for (int i = 0; i < 12; ++i) xq[i] = bf2f(*(const bf16_t*)(wq + (h * 96 + 8 * i + j) * 2));
#pragma unroll
        for (int i = 0; i < 8; ++i) xk[i] = bf2f(*(const bf16_t*)(wk + (h * 64 + 8 * i + j) * 2));
#pragma unroll
        for (int i = 8; i < 12; ++i) xk[i] = bf2f(*(const bf16_t*)(wk + 1024 + (8 * (i - 8) + j) * 2));
        __builtin_amdgcn_fence(__ATOMIC_RELEASE, "wavefront"); __builtin_amdgcn_wave_barrier(); __builtin_amdgcn_fence(__ATOMIC_ACQUIRE, "wavefront");
        const bool lat = row < ML; int b, pos;
        if (lat) { b = row >> 13; pos = row & (SEQ - 1); } else { const int r = row - ML; b = r >> 8; pos = SEQ + (r & 255); }
        float c0 = 1.f, s0 = 0.f, c1 = 1.f, s1 = 0.f;
        if (lat) { float r0 = (float)(pos >> 6) * freq * 0.15915494309189535f, r1 = (float)(pos & 63) * freq * 0.15915494309189535f;
            r0 -= floorf(r0); r1 -= floorf(r1);
            c0 = __builtin_amdgcn_cosf(r0); s0 = __builtin_amdgcn_sinf(r0); c1 = __builtin_amdgcn_cosf(r1); s1 = __builtin_amdgcn_sinf(r1); }
        float sq = 0.f, sk = 0.f;
#pragma unroll
        for (int i = 0; i < 12; ++i) { sq += xq[i] * xq[i]; sk += xk[i] * xk[i]; }
        sq += __shfl_xor(sq, 1); sk += __shfl_xor(sk, 1); sq += __shfl_xor(sq, 2); sk += __shfl_xor(sk, 2); sq += __shfl_xor(sq, 4); sk += __shfl_xor(sk, 4);
        const float rq = rsqrtf(sq * (1.f / 96.f) + EPS), rk = rsqrtf(sk * (1.f / 96.f) + EPS);
#pragma unroll
        for (int i = 0; i < 12; ++i) { xq[i] *= rq * gq[i]; xk[i] *= rk * gk[i]; }
        { const float y8 = xq[8] * c0 - xq[9] * s0, y9 = xq[8] * s0 + xq[9] * c0, y10 = xq[10] * c1 - xq[11] * s1, y11 = xq[10] * s1 + xq[11] * c1;
          xq[8] = y8; xq[9] = y9; xq[10] = y10; xq[11] = y11; }
        { const float y8 = xk[8] * c0 - xk[9] * s0, y9 = xk[8] * s0 + xk[9] * c0, y10 = xk[10] * c1 - xk[11] * s1, y11 = xk[10] * s1 + xk[11] * c1;
          xk[8] = y8; xk[9] = y9; xk[10] = y10; xk[11] = y11; }
#pragma unroll
        for (int i = 0; i < 12; ++i) { *(bf16_t*)(wq + (h * 96 + 8 * i + j) * 2) = f2bf(xq[i]); *(bf16_t*)(wk + (h * 96 + 8 * i + j) * 2) = f2bf(xk[i]); }
        __builtin_amdgcn_fence(__ATOMIC_RELEASE, "wavefront"); __builtin_amdgcn_wave_barrier(); __builtin_amdgcn_fence(__ATOMIC_ACQUIRE, "wavefront");
        { const int c0i = lane, c1i = 64 + lane;
          const u32x4 oq0 = *(const u32x4*)(wq + c0i * 16), ok0 = *(const u32x4*)(wk + c0i * 16);
          const size_t d0 = ((size_t)(b * NH + c0i / 12) * TK + pos) * 96 + (c0i % 12) * 8;
          *(u32x4*)(Q + d0) = oq0; *(u32x4*)(Kb + d0) = ok0;
          if (lane < 32) { const u32x4 oq1 = *(const u32x4*)(wq + c1i * 16), ok1 = *(const u32x4*)(wk + c1i * 16);
              const size_t d1 = ((size_t)(b * NH + c1i / 12) * TK + pos) * 96 + (c1i % 12) * 8;
              *(u32x4*)(Q + d1) = oq1; *(u32x4*)(Kb + d1) = ok1; } }
        __builtin_amdgcn_fence(__ATOMIC_RELEASE, "wavefront"); __builtin_amdgcn_wave_barrier(); __builtin_amdgcn_fence(__ATOMIC_ACQUIRE, "wavefront");
    }
}

constexpr int KROW = 208, VROW = 144, KBYTES = 64 * KROW, ABUF = KBYTES + 64 * VROW;
DI void attn_item(unsigned char* lds, const bf16_t* Q, const bf16_t* Kb, const bf16_t* Vt, bf16_t* att, int bh, int qposA, int qposB, int kt0, int kt1, int outrowA, int outrowB, bool writeB) {
    const int tid = TIDX, lane = tid & 63, l31 = lane & 31, half = lane >> 5;
    bf16x8 qa[6], qb[6];
    { const bf16_t* qp = Q + ((size_t)bh * TK + qposA + l31) * 96 + 8 * half; const bf16_t* qq = Q + ((size_t)bh * TK + qposB + l31) * 96 + 8 * half;
#pragma unroll
      for (int ks = 0; ks < 6; ++ks) { qa[ks] = *(const bf16x8*)(qp + 16 * ks); qb[ks] = *(const bf16x8*)(qq + 16 * ks); } }
    f32x16 oa0, oa1, ob0, ob1;
#pragma unroll
    for (int i = 0; i < 16; ++i) { oa0[i] = 0.f; oa1[i] = 0.f; ob0[i] = 0.f; ob1[i] = 0.f; }
    float la = 0.f, lb = 0.f;
    const unsigned char* kg = (const unsigned char*)(Kb + (size_t)bh * TK * 96) + (size_t)tid * 16;
    const unsigned char* vg = (const unsigned char*)(Vt + ((size_t)bh * 64 + (tid >> 3)) * TK) + (tid & 7) * 16;
    const int kc1 = 512 + tid;
    const int koff0 = (tid / 12) * KROW + (tid % 12) * 16, koff1 = (kc1 / 12) * KROW + (kc1 % 12) * 16;
    const int voff = KBYTES + (tid >> 3) * VROW + ((tid & 7) >> 1) * 32 + (tid & 1) * 8;
    const int klo = l31 * KROW + 16 * half, vlo = KBYTES + l31 * VROW + 16 * half;
    u32x4 kr0, kr1 = {0u, 0u, 0u, 0u}, vr;
#define AT_GLOAD(kt) do { kr0 = *(const u32x4*)(kg + (size_t)(kt) * 12288); if (tid < 256) kr1 = *(const u32x4*)(kg + (size_t)(kt) * 12288 + 8192); vr = *(const u32x4*)(vg + (size_t)(kt) * 128); } while (0)
#define AT_SSTORE(stg) do { unsigned char* bp_ = lds + (stg) * ABUF; *(u32x4*)(bp_ + koff0) = kr0; if (tid < 256) *(u32x4*)(bp_ + koff1) = kr1; \
        *(u32x2*)(bp_ + voff) = (u32x2){vr.x, vr.y}; *(u32x2*)(bp_ + voff + 16) = (u32x2){vr.z, vr.w}; } while (0)
#define AT_PK(v, o) (u32x4){pk2(v[o], v[o + 1]), pk2(v[o + 2], v[o + 3]), pk2(v[o + 4], v[o + 5]), pk2(v[o + 6], v[o + 7])}
    AT_GLOAD(kt0); AT_SSTORE(0);
    __syncthreads();
    for (int kt = kt0; kt < kt1; ++kt) {
        const int cur = (kt - kt0) & 1;
        const bool more = kt + 1 < kt1;
        if (more) AT_GLOAD(kt + 1);
        const unsigned char* kl = lds + cur * ABUF + klo;
        const unsigned char* vl = lds + cur * ABUF + vlo;
        f32x16 sa0, sa1, sb0, sb1;
        const f32x16 zero16 = {0.f, 0.f, 0.f, 0.f, 0.f, 0.f, 0.f, 0.f, 0.f, 0.f, 0.f, 0.f, 0.f, 0.f, 0.f, 0.f};
        __builtin_amdgcn_s_setprio(1);
#pragma unroll
        for (int ks = 0; ks < 6; ++ks) {
            const bf16x8 a0 = *(const bf16x8*)(kl + 32 * ks), a1 = *(const bf16x8*)(kl + 32 * KROW + 32 * ks);
            sa0 = __builtin_amdgcn_mfma_f32_32x32x16_bf16(a0, qa[ks], ks == 0 ? zero16 : sa0, 0, 0, 0);
            sa1 = __builtin_amdgcn_mfma_f32_32x32x16_bf16(a1, qa[ks], ks == 0 ? zero16 : sa1, 0, 0, 0);
            sb0 = __builtin_amdgcn_mfma_f32_32x32x16_bf16(a0, qb[ks], ks == 0 ? zero16 : sb0, 0, 0, 0);
            sb1 = __builtin_amdgcn_mfma_f32_32x32x16_bf16(a1, qb[ks], ks == 0 ? zero16 : sb1, 0, 0, 0);
        }
        __builtin_amdgcn_s_setprio(0);
        float pa = 0.f, pb = 0.f;
#pragma unroll
        for (int i = 0; i < 16; ++i) { sa0[i] = __builtin_amdgcn_exp2f(sa0[i]); sa1[i] = __builtin_amdgcn_exp2f(sa1[i]); pa += sa0[i] + sa1[i];
                                       sb0[i] = __builtin_amdgcn_exp2f(sb0[i]); sb1[i] = __builtin_amdgcn_exp2f(sb1[i]); pb += sb0[i] + sb1[i]; }
        la += pa; lb += pb;
#pragma unroll
        for (int s = 0; s < 4; ++s) {
            const bf16x8 v0 = *(const bf16x8*)(vl + 32 * s), v1 = *(const bf16x8*)(vl + 32 * VROW + 32 * s);
            const bf16x8 fa = __builtin_bit_cast(bf16x8, s < 2 ? AT_PK(sa0, 8 * (s & 1)) : AT_PK(sa1, 8 * (s & 1)));
            const bf16x8 fb = __builtin_bit_cast(bf16x8, s < 2 ? AT_PK(sb0, 8 * (s & 1)) : AT_PK(sb1, 8 * (s & 1)));
            oa0 = __builtin_amdgcn_mfma_f32_32x32x16_bf16(v0, fa, oa0, 0, 0, 0); oa1 = __builtin_amdgcn_mfma_f32_32x32x16_bf16(v1, fa, oa1, 0, 0, 0);
            ob0 = __builtin_amdgcn_mfma_f32_32x32x16_bf16(v0, fb, ob0, 0, 0, 0); ob1 = __builtin_amdgcn_mfma_f32_32x32x16_bf16(v1, fb, ob1, 0, 0, 0);
        }
        if (more) AT_SSTORE(cur ^ 1);
        __syncthreads();
    }
#undef AT_GLOAD
#undef AT_SSTORE
#undef AT_PK
    { const float lt = la + __shfl_xor(la, 32), inv = 1.f / lt;
      bf16_t* op = att + (size_t)(outrowA + l31) * 512 + (bh & 7) * 64 + 4 * half;
#pragma unroll
      for (int g = 0; g < 4; ++g) {
          st_bf4(op + 8 * g, (f32x4){oa0[4 * g] * inv, oa0[4 * g + 1] * inv, oa0[4 * g + 2] * inv, oa0[4 * g + 3] * inv});
          st_bf4(op + 32 + 8 * g, (f32x4){oa1[4 * g] * inv, oa1[4 * g + 1] * inv, oa1[4 * g + 2] * inv, oa1[4 * g + 3] * inv}); } }
    if (writeB) { const float lt = lb + __shfl_xor(lb, 32), inv = 1.f / lt;
      bf16_t* op = att + (size_t)(outrowB + l31) * 512 + (bh & 7) * 64 + 4 * half;
#pragma unroll
      for (int g = 0; g < 4; ++g) {
          st_bf4(op + 8 * g, (f32x4){ob0[4 * g] * inv, ob0[4 * g + 1] * inv, ob0[4 * g + 2] * inv, ob0[4 * g + 3] * inv});
          st_bf4(op + 32 + 8 * g, (f32x4){ob1[4 * g] * inv, ob1[4 * g + 1] * inv, ob1[4 * g + 2] * inv, ob1[4 * g + 3] * inv}); } }
}
DI void phase_attn(const Params& p, unsigned char* lds, bool with_ctx) {
    const bf16_t* Q = (const bf16_t*)(p.ws + O_S); const bf16_t* Kb = Q + (size_t)32 * TK * 96; const bf16_t* Vt = Kb + (size_t)32 * TK * 96;
    bf16_t* att = (bf16_t*)p.out;
    const int nitems = 512 + (with_ctx ? 32 : 0);
    for (int it = BIDX; it < nitems; it += gridDim.x) {
        const int wave = TIDX >> 6;
        if (it < 512) {
            const int j = (it >> 3) & 31, bh = (it >> 8) * 16 + (it & 7) * 2 + (j >> 4), q0 = (j & 15) * 512 + wave * 64, r0 = (bh >> 3) * SEQ + q0;
            attn_item(lds, Q, Kb, Vt, att, bh, q0, q0 + 32, 0, TK / 64, r0, r0 + 32, true);
        } else {
            const int bh = it - 512, q0 = SEQ + wave * 32, r0 = ML + (bh >> 3) * CTXL + wave * 32;
            attn_item(lds, Q, Kb, Vt, att, bh, q0, q0, SEQ / 64, TK / 64, r0, r0, false);
        }
    }
}

constexpr int PH_PER_LAYER = 15, N_PHASES = 1 + DEPTH * PH_PER_LAYER;
DI int phase_case(int ph) { const int i = (ph - 1) % PH_PER_LAYER; return i < 3 ? i : (i < 13 ? i + 1 : i + 2); }
DI void run_phase(const Params& p, int ph, unsigned char* smem) {
    LAS unsigned char* lds = (LAS unsigned char*)smem;
    unsigned char* ws = p.ws;
    if (ph == 0) { phase_mod(p, (float*)smem); return; }
    const int l = (ph - 1) / PH_PER_LAYER, s = phase_case(ph);
    const bool last = (l == DEPTH - 1);
    const float* mod = (const float*)(ws + O_MOD) + (size_t)l * 5 * NMOD;
    float* X = (float*)(ws + O_X);
    bf16_t* XNY = (bf16_t*)(ws + O_XNY); bf16_t* H = (bf16_t*)(ws + O_R1); bf16_t* P1 = (bf16_t*)(ws + O_R1); bf16_t* GATE = P1 + (size_t)MA * 768;
    bf16_t* UXY = (bf16_t*)(ws + O_UXY);
    float* SS = (float*)(ws + O_SS); const float* shw = (const float*)(ws + O_SHW);
    const int Mtail = last ? ML : MA;
    switch (s) {
    case 0: phase_prep(p, l, (float*)smem); if (l == 0) phase_norm0(p); break;
    case 1: { ESwiglu E{H, SS, shw}; gemm_phase<ESwiglu, false, true>(lds, Gemm{XNY, (const bf16_t*)(ws + O_WFF1IN), MA, 2 * DFF, DM, DM, DM}, E); } break;
    case 2: { EResid<1, true> E{X, X, mod + 2 * DM, mod + 4 * DM, XNY, SS + (size_t)MA * 16}; gemm_phase<EResid<1, true>, false, true>(lds, Gemm{H, (const bf16_t*)(ws + O_WFF1OUT), MA, DM, DFF, DFF, DFF}, E); }
              { const int nthird = (MA / BM) * (DM / BM) - 2 * (int)gridDim.x, vb = (int)BIDX - nthird; if (nthird > 0 && nthird < (int)gridDim.x && vb >= 0) phase_prep_ff(p, l, 1, (float*)smem, vb, (int)gridDim.x - nthird); else if (nthird <= 0 || nthird >= (int)gridDim.x) phase_prep_ff(p, l, 1, (float*)smem, BIDX, gridDim.x); }
              break;
    case 4: { EWin E{P1, UXY, GATE, SS + (size_t)MA * 16, shw + 5 * 5632}; gemm_phase<EWin, false, true>(lds, Gemm{XNY, (const bf16_t*)(ws + O_WIN), MA, NIN, DM, DM, DM}, E); } break;
    case 5: phase_conv(p, l); break;
    case 6: { bf16_t* OM = (bf16_t*)(ws + O_S); EGate E{XNY, OM, OM + (size_t)2 * MA * 512, (const float*)(ws + O_SP), p.b_rgate + l * 1024, p.b_igate + l * 1024};
              gemm_phase<EGate, true, true>(lds, Gemm{XNY, (const bf16_t*)(ws + O_WGATE), MA, 2048, 256, 512, 256}, E); } break;
    case 7: phase_scan_agg(p); break;
    case 8: phase_scan_apply(p); break;
    case 9: { bf16_t* qraw = (bf16_t*)p.out; bf16_t* kn = qraw + (size_t)MA * 768; bf16_t* Vt = (bf16_t*)(ws + O_S) + (size_t)2 * 32 * TK * 96;
              const float* rsq = (const float*)(ws + O_RSQ); const float* rskv = (const float*)(ws + O_RSKV);
              const bf16_t* wukv = (const bf16_t*)(ws + O_WUKV);
              { EpiElem8<FRowScale> E{{qraw, 768, rsq}}; gemm_phase<EpiElem8<FRowScale>, false, true>(lds, Gemm{P1, (const bf16_t*)(ws + O_WUQ), MA, 768, 384, 768, 384}, E); }
              { EpiElem8<FRowScale> E{{kn, 512, rskv}}; gemm_phase<EpiElem8<FRowScale>, false, true>(lds, Gemm{P1 + 384, wukv, MA, 512, 256, 768, 256, 144}, E); }
              { EpiElem8<FVt> E{{Vt, rskv}}; gemm_phase<EpiElem8<FVt>, false, true>(lds, Gemm{wukv + (size_t)512 * 256, P1 + 384, 512, MA, 256, 256, 768, 152}, E); }
              } break;
    case 10: phase_qk(p, l, smem); break;
    case 11: phase_attn(p, smem, !last); break;
    case 12: { { EpiElem8<FMergeA> E{{GATE, XNY}}; gemm_phase<EpiElem8<FMergeA>, false, true>(lds, Gemm{(const bf16_t*)p.out, (const bf16_t*)(ws + O_WOA), Mtail, DM, 512, 512, 512}, E); }
               { EpiElem8<FMergeB> E{{GATE, XNY}}; gemm_phase<EpiElem8<FMergeB>, false, true>(lds, Gemm{UXY, (const bf16_t*)(ws + O_WOL), Mtail, DM, 512, 1024, 512}, E); } } break;
    case 13: { EResid<2, true> E{X, X, mod + 5 * DM, mod + 7 * DM, UXY, SS + (size_t)2 * MA * 16}; gemm_phase<EResid<2, true>, false, true>(lds, Gemm{XNY, (const bf16_t*)(ws + O_WOUT), Mtail, DM, DM, DM, DM}, E); } break;
    case 15: { ESwiglu E{H, SS + (size_t)2 * MA * 16, shw + 2 * 5 * 5632}; gemm_phase<ESwiglu, false, true>(lds, Gemm{UXY, (const bf16_t*)(ws + O_WFF2IN), Mtail, 2 * DFF, DM, DM, DM}, E); } break;
    case 16: if (last) { EResid<1, false> E{X, p.out, mod + 8 * DM, nullptr, nullptr, nullptr}; gemm_phase<EResid<1, false>, false, true>(lds, Gemm{H, (const bf16_t*)(ws + O_WFF2OUT), Mtail, DM, DFF, DFF, DFF}, E); }
             else { EResid<1, true> E{X, X, mod + 8 * DM, mod + 5 * NMOD + DM, XNY, SS}; gemm_phase<EResid<1, true>, false, true>(lds, Gemm{H, (const bf16_t*)(ws + O_WFF2OUT), Mtail, DM, DFF, DFF, DFF}, E); }
             if (!last) { const int nthird = (MA / BM) * (DM / BM) - 2 * (int)gridDim.x, vb = (int)BIDX - nthird; if (nthird > 0 && nthird < (int)gridDim.x && vb >= 0) phase_prep_ff(p, l + 1, 0, (float*)smem, vb, (int)gridDim.x - nthird); else if (nthird <= 0 || nthird >= (int)gridDim.x) phase_prep_ff(p, l + 1, 0, (float*)smem, BIDX, gridDim.x); }
             break;
    }
}

#ifndef PROBE_MASK
#define PROBE_MASK 0u
#endif
#define XB_TMO      128
#define XB_XCNT(j)  (256  + 64 * (j))
#define XB_XSUB(j)  (1280 + 64 * (j))
#define XB_XGEN(j)  (2304 + 64 * (j))
#define XB_TOP      3328
#define XB_TOPGEN   3392
#define XCD_BAR_WORDS 3456
#define XB_SPIN_CAP (1u << 18)
DI unsigned xb_ld(unsigned* p)              { return __hip_atomic_load(p, __ATOMIC_RELAXED, __HIP_MEMORY_SCOPE_AGENT); }
DI unsigned xb_add(unsigned* p, unsigned v) { return __hip_atomic_fetch_add(p, v, __ATOMIC_RELAXED, __HIP_MEMORY_SCOPE_AGENT); }
DI unsigned xb_xcc_id() { return (unsigned)__builtin_amdgcn_s_getreg((3 << 11) | 20) & 0xFu; }
#define XB_SPIN(cond, bar) do { unsigned _sp = 0; while (cond) { __builtin_amdgcn_s_sleep(1); \
    if ((++_sp & 255u) == 0u) { if (xb_ld(&(bar)[XB_TMO])) break; if (_sp > XB_SPIN_CAP) { atomicAdd(&(bar)[XB_TMO], 1u); break; } } } } while (0)
struct XcdBarrier { unsigned* bar; unsigned x; volatile LAS unsigned* st; };
DI XcdBarrier xcd_barrier_post(unsigned* bar, volatile LAS unsigned* st) {
    XcdBarrier b; b.bar = bar; b.x = xb_xcc_id(); b.st = st;
    if (threadIdx.x == 0) (void)xb_add(&bar[XB_XCNT(b.x)], 1u);
    return b;
}
DI void xcd_barrier_complete(unsigned* bar, unsigned x, unsigned& nloc, unsigned& nx) {
    const unsigned G = gridDim.x * gridDim.y * gridDim.z;
    unsigned sum, cnt, mine, sp = 0u;
    for (;;) {
        sum = 0u; cnt = 0u; mine = 0u;
#pragma unroll
        for (unsigned j = 0; j < 16; ++j) { const unsigned c = xb_ld(&bar[XB_XCNT(j)]); sum += c; cnt += (c > 0u) ? 1u : 0u; mine = (j == x) ? c : mine; }
        if (sum == G) break;
        __builtin_amdgcn_s_sleep(1);
        if ((++sp & 255u) == 0u) { if (xb_ld(&bar[XB_TMO])) break; if (sp > XB_SPIN_CAP) { atomicAdd(&bar[XB_TMO], 1u); break; } }
    }
    nloc = mine > 0u ? mine : 1u; nx = cnt > 0u ? cnt : 1u;
}
DI void xcd_barrier(const XcdBarrier& b) {
    asm volatile("s_waitcnt vmcnt(0)" ::: "memory");
    __syncthreads();
    if (threadIdx.x == 0) {
        unsigned* bar = b.bar;
        __builtin_amdgcn_s_waitcnt(0);
        unsigned nloc = b.st[0], nx = b.st[1];
        if (nloc == 0u) { xcd_barrier_complete(bar, b.x, nloc, nx); b.st[0] = nloc; b.st[1] = nx; }
        const unsigned old = xb_add(&bar[XB_XSUB(b.x)], 1u);
        const unsigned gen = old / nloc;
        if (old + 1u == (gen + 1u) * nloc) {
            __builtin_amdgcn_fence(__ATOMIC_RELEASE, "agent");
            asm volatile("s_waitcnt vmcnt(0)" ::: "memory");
            const unsigned og = xb_add(&bar[XB_TOP], 1u);
            const unsigned tg = og / nx;
            if (og + 1u == (tg + 1u) * nx) xb_add(&bar[XB_TOPGEN], 1u);
            else XB_SPIN(xb_ld(&bar[XB_TOPGEN]) == tg, bar);
            __builtin_amdgcn_fence(__ATOMIC_ACQUIRE, "agent");
            xb_add(&bar[XB_XGEN(b.x)], 1u);
            asm volatile("s_waitcnt vmcnt(0)" ::: "memory");
        } else {
            XB_SPIN(xb_ld(&bar[XB_XGEN(b.x)]) == gen, bar);
            __builtin_amdgcn_fence(__ATOMIC_ACQUIRE, "agent");
            asm volatile("s_waitcnt vmcnt(0)" ::: "memory");
        }
    }
    __syncthreads();
}
__global__ void __launch_bounds__(512) mega(Params p) {
    extern __shared__ __attribute__((aligned(16))) unsigned char smem[];
    __shared__ uint4 xb_words;
    cg::grid_group grid = cg::this_grid();
    if (threadIdx.x == 0) xb_words = make_uint4(0u, 0u, 0u, 0u);
    __syncthreads();
    const XcdBarrier xb = xcd_barrier_post((unsigned*)(p.ws + O_BAR), (volatile LAS unsigned*)&xb_words);
    unsigned long long tsel = 0;
    for (int ph = p.ph_lo; ph < p.ph_hi; ++ph) {
        const unsigned long long t0 = PROBE_MASK ? wall_clock64() : 0ull;
        run_phase(p, ph, smem);
        if (p.coop && ph + 1 < p.ph_hi) { if (ph == 0) grid.sync(); else xcd_barrier(xb); }
        if (PROBE_MASK) { const int sidx = ph == 0 ? 17 : phase_case(ph); if ((PROBE_MASK >> sidx) & 1u) tsel += wall_clock64() - t0; }
    }
    if (PROBE_MASK && blockIdx.x == 0) { const unsigned long long t0 = wall_clock64(); while (wall_clock64() - t0 < tsel) __builtin_amdgcn_s_sleep(64); }
}

extern "C" void kernel_launch(void* const* d_in, const int* in_sizes, int n_in, void* d_out, int out_size, void* d_ws, size_t ws_size, hipStream_t stream) {
    static int grid = 0;
    if (grid == 0) {
        if (n_in != 27 || ws_size < WS_END) { fprintf(stderr, "kernel_launch: need 27 inputs and %zu bytes of workspace; got %d, %zu\n", (size_t)WS_END, n_in, ws_size); grid = -1; return; }
        int dev = 0, cus = 0, per_cu = 0;
        hipGetDevice(&dev); hipDeviceGetAttribute(&cus, hipDeviceAttributeMultiprocessorCount, dev);
        if (hipFuncSetAttribute((const void*)mega, hipFuncAttributeMaxDynamicSharedMemorySize, LDS_BYTES) != hipSuccess) { fprintf(stderr, "kernel_launch: hipFuncSetAttribute failed\n"); grid = -1; return; }
        if (hipOccupancyMaxActiveBlocksPerMultiprocessor(&per_cu, (const void*)mega, 512, LDS_BYTES) != hipSuccess || per_cu < 1) { fprintf(stderr, "kernel_launch: occupancy query gave %d\n", per_cu); per_cu = 1; }
        (void)hipGetLastError();
        grid = cus;
    }
    if (grid < 0) return;
    Params p{};
    const float** pp = (const float**)&p;
    for (int i = 0; i < 27; ++i) pp[i] = (const float*)d_in[i];
    p.out = (float*)d_out; p.ws = (unsigned char*)d_ws; p.ph_lo = 0; p.ph_hi = N_PHASES; p.coop = 1; p.pad = 0;
    (void)hipMemsetAsync((unsigned char*)d_ws + O_BAR, 0, XCD_BAR_WORDS * 4, stream);
    void* args[] = {&p};
    hipError_t e = hipLaunchCooperativeKernel((const void*)mega, dim3(grid), dim3(512), args, LDS_BYTES, stream);
    if (e != hipSuccess) {
        fprintf(stderr, "cooperative launch failed: %s (grid %d); falling back to one launch per phase\n", hipGetErrorString(e), grid);
        (void)hipGetLastError();
        p.coop = 0;
        for (int ph = 0; ph < N_PHASES; ++ph) { p.ph_lo = ph; p.ph_hi = ph + 1; hipLaunchKernelGGL(mega, dim3(grid), dim3(512), LDS_BYTES, stream, p); }
    }
}
```

```cpp
#include <hip/hip_runtime.h>
#include <hip/hip_cooperative_groups.h>
#include <cstdio>
namespace cg = cooperative_groups;

#define DI __device__ __forceinline__
#define LAS __attribute__((address_space(3)))
typedef unsigned short bf16_t;
typedef short bf16x8 __attribute__((ext_vector_type(8)));
typedef float f32x2 __attribute__((ext_vector_type(2)));
typedef float f32x4 __attribute__((ext_vector_type(4)));
typedef float f32x16 __attribute__((ext_vector_type(16)));
typedef unsigned u32x2 __attribute__((ext_vector_type(2)));
typedef unsigned u32x4 __attribute__((ext_vector_type(4)));
typedef __bf16 bfv2 __attribute__((ext_vector_type(2)));

constexpr int DM = 1024, NB = 4, SEQ = 8192, CTXL = 256, DEPTH = 4;
constexpr int ML = NB * SEQ, MC = NB * CTXL, MA = ML + MC;
constexpr int DFF = 2816, NH = 8, TK = SEQ + CTXL;
constexpr int NIN = 3840;
constexpr int NMOD = 9 * DM;
constexpr float EPS = 1e-6f;
constexpr float QSCALE = 0.10206207261596577f * 1.4426950408889634f;
constexpr int NCH = 132;

constexpr size_t SZ_FFIN = (size_t)2 * DFF * DM * 2, SZ_FFOUT = (size_t)DM * DFF * 2;
constexpr size_t O_WFF1IN = 0;
constexpr size_t O_WFF1OUT = O_WFF1IN + SZ_FFIN;
constexpr size_t O_WFF2IN = O_WFF1OUT + SZ_FFOUT;
constexpr size_t O_WFF2OUT = O_WFF2IN + SZ_FFIN;
constexpr size_t O_WIN = O_WFF2OUT + SZ_FFOUT;
constexpr size_t O_WUQ = O_WIN + (size_t)NIN * DM * 2;
constexpr size_t O_WUKV = O_WUQ + (size_t)768 * 384 * 2;
constexpr size_t O_WOA = O_WUKV + (size_t)1024 * 256 * 2;
constexpr size_t O_WOL = O_WOA + (size_t)1024 * 512 * 2;
constexpr size_t O_WOUT = O_WOL + (size_t)1024 * 512 * 2;
constexpr size_t O_WGATE = O_WOUT + (size_t)1024 * 1024 * 2;
constexpr size_t O_MOD = O_WGATE + (size_t)2048 * 256 * 2;
constexpr size_t O_RSQ = O_MOD + (size_t)DEPTH * 5 * NMOD * 4;
constexpr size_t O_RSKV = O_RSQ + (size_t)MA * 4;
constexpr size_t O_AGG = O_RSKV + (size_t)MA * 4;
constexpr size_t O_SP = O_AGG + (size_t)2 * NB * NCH * 512 * 8;
constexpr size_t O_BAR = O_SP + 4096;
constexpr size_t O_SS = O_BAR + 16384;
constexpr size_t O_SHW = O_SS + (size_t)3 * MA * 16 * 4;
constexpr size_t O_X = O_SHW + (size_t)3 * 5 * 5632 * 4;
constexpr size_t O_R1 = O_X + (size_t)MA * DM * 4;
constexpr size_t O_UXY = O_R1 + (size_t)MA * DFF * 2;
constexpr size_t O_XNY = O_UXY + (size_t)MA * 1024 * 2;
constexpr size_t O_S = O_XNY + (size_t)MA * 1024 * 2;
constexpr size_t WS_END = O_S + (size_t)MA * 1024 * 4;
constexpr int LDS_BYTES = 131072;

struct Params {
    const float *x, *c, *ctx, *c_ctx, *w_ada, *b_ada, *ff1_w_in, *ff1_w_out, *ff2_w_in, *ff2_w_out, *w_in, *q_a_norm, *w_uq, *kv_a_norm, *w_ukv, *q_norm, *k_norm,
        *conv_w, *conv_b, *lru_lambda, *w_rgate, *b_rgate, *w_igate, *b_igate, *w_o_attn, *w_o_lru, *w_out;
    float* out; unsigned char* ws;
    int ph_lo, ph_hi, coop, pad;
};

DI int tidx_() { int t = threadIdx.x; asm volatile("" : "+v"(t)); return t; }
DI int bidx_() { int t = blockIdx.x; asm volatile("" : "+s"(t)); return t; }
#define TIDX tidx_()
#define BIDX bidx_()
DI unsigned pk2(float lo, float hi) { f32x2 v = {lo, hi}; bfv2 r = __builtin_convertvector(v, bfv2); return __builtin_bit_cast(unsigned, r); }
DI bf16_t f2bf(float x) { return (bf16_t)(pk2(x, 0.f) & 0xffffu); }
DI float bf2f(bf16_t v) { return __uint_as_float((unsigned)v << 16); }
DI float bflo(unsigned v) { return __uint_as_float(v << 16); }
DI float bfhi(unsigned v) { return __uint_as_float(v & 0xffff0000u); }
DI float wave_sum(float v) {
#pragma unroll
    for (int o = 1; o < 64; o <<= 1) v += __shfl_xor(v, o);
    return v;
}
DI float sigmoidf_(float x) { return __builtin_amdgcn_rcpf(1.f + __expf(-x)); }
DI int mod_row(int row) { return row < ML ? (row >> 13) : 4; }
DI float row_rstd(const float* SSP, int row) {
    const f32x4* q = (const f32x4*)(SSP + (size_t)row * 16); const f32x4 a = q[0], b = q[1], c = q[2], d = q[3];
    const float s = ((a[0] + a[1]) + (a[2] + a[3])) + ((b[0] + b[1]) + (b[2] + b[3])) + ((c[0] + c[1]) + (c[2] + c[3])) + ((d[0] + d[1]) + (d[2] + d[3]));
    return __builtin_amdgcn_rsqf(s * (1.f / DM) + EPS);
}

constexpr int BM = 256, BK = 64, HALF = 128, HTB = HALF * BK * 2, NXCD = 8, WGM = 8;
DI int lds_byte(int r, int c) { const int st = (r >> 4) * 2 + (c >> 5), rr = r & 15, cc = c & 31, ob = rr * 64 + cc * 2; return st * 1024 + (ob ^ (((ob >> 9) & 1) << 5)); }
DI void stage_rc(int b, int& R, int& C) { const int st = b / 1024, sb = b % 1024, swz = sb ^ (((sb >> 9) & 1) << 5); R = (st >> 1) * 16 + swz / 64; C = (st & 1) * 32 + (swz % 64) / 2; }
struct Unit { int pm, pn; };
struct Gemm { const bf16_t* A; const bf16_t* Bt; int M, N, K, lda, ldb; int rot = 0; };
struct StaticOrder {
    int nM, nN, nwg, G, c;
    DI void init(int M, int N, int G_, int c_) { nM = M / BM; nN = N / BM; nwg = nM * nN; G = G_; c = c_; }
    DI bool next(int i, Unit& u) const {
        const long L = (long)i * G + c; if (L >= nwg) return false;
        int wgid = (int)L; { const int q = nwg / NXCD, r = nwg % NXCD, xcd = wgid % NXCD, off = wgid / NXCD; wgid = (xcd < r ? xcd * (q + 1) : r * (q + 1) + (xcd - r) * q) + off; }
        const int nig = WGM * nN, gid = wgid / nig, fm = gid * WGM, gsz = (nM - fm) < WGM ? (nM - fm) : WGM;
        u.pm = fm + ((wgid % nig) % gsz); u.pn = (wgid % nig) / gsz; return true;
    }
};

DI int perm32(int rho) { const int n = rho >> 4, i = rho & 15; return 8 * (i >> 2) + 4 * n + (i & 3); }
template <class Epi, bool GATE_A, bool PERM = false>
DI void gemm_phase(LAS unsigned char* lds, const Gemm g, const Epi& E) {
    const int tid = TIDX, wid = __builtin_amdgcn_readfirstlane(tid >> 6), lane = tid & 63, wr = wid >> 2, wc = wid & 3, fr = lane & 15, fq = lane >> 4;
    const int K = g.K, nt = K / BK;
    StaticOrder S; S.init(g.M, g.N, gridDim.x, (BIDX - g.rot + (int)gridDim.x) % (int)gridDim.x);
    unsigned voffA[2], voffB[2];
#pragma unroll
    for (int i = 0; i < 2; ++i) { int R, C; stage_rc(tid * 16 + i * 8192, R, C); const int Rb = PERM ? ((R & ~31) + perm32(R & 31)) : R; voffA[i] = (unsigned)(R * g.lda + C) * 2u; voffB[i] = (unsigned)(Rb * g.ldb + C) * 2u; }
#pragma unroll
    for (int i = 0; i < 2; ++i) { asm volatile("" : "+v"(voffA[i])); asm volatile("" : "+v"(voffB[i])); }
    const size_t kstep = (size_t)(BK * 2);
    const size_t hstepA = (size_t)HALF * g.lda * 2, hstepB = (size_t)HALF * g.ldb * 2;
    const size_t tstepA = 2 * hstepA, tstepB = 2 * hstepB;
    const unsigned ldsw = (unsigned)wid * 1024u;
    const int aoff = lds_byte(wr * 64 + fr, fq * 8), boff = lds_byte(wc * 32 + fr, fq * 8);
#define PG8_SA(b, h) (((b) * 2 + (h)) * HTB)
#define PG8_SB(b, h) ((4 + (b) * 2 + (h)) * HTB)
#define PG8_STAGE(bufoff, gbase, voff) do { _Pragma("unroll") for (int _i = 0; _i < 2; ++_i) \
        __builtin_amdgcn_global_load_lds((const unsigned*)((const char*)(gbase) + (voff)[_i]), (LAS unsigned*)(lds + (bufoff) + ldsw + _i * 8192), 16, 0, 0); } while (0)
#define PG8_LDA(dst, b, h) do { _Pragma("unroll") for (int m = 0; m < 4; ++m) _Pragma("unroll") for (int k = 0; k < 2; ++k) dst[m][k] = *(const LAS bf16x8*)(lds + PG8_SA(b, h) + aoff + m * 2048 + k * 1024); } while (0)
#define PG8_LDB(dst, b, h) do { _Pragma("unroll") for (int n = 0; n < 2; ++n) _Pragma("unroll") for (int k = 0; k < 2; ++k) dst[n][k] = *(const LAS bf16x8*)(lds + PG8_SB(b, h) + boff + n * 2048 + k * 1024); } while (0)
#define PG8_MMA(ai, bj, At, Bt) do { __builtin_amdgcn_s_setprio(1); _Pragma("unroll") for (int m = 0; m < 4; ++m) _Pragma("unroll") for (int n = 0; n < 2; ++n) _Pragma("unroll") for (int k = 0; k < 2; ++k) \
        acc[ai][bj][m][n] = __builtin_amdgcn_mfma_f32_16x16x32_bf16(Bt[n][k], At[m][k], acc[ai][bj][m][n], 0, 0, 0); __builtin_amdgcn_s_setprio(0); } while (0)
#define PG8_WAIT_V(n) asm volatile("s_waitcnt vmcnt(" #n ")" ::: "memory")
#define PG8_WAIT_L(n) asm volatile("s_waitcnt lgkmcnt(" #n ")" ::: "memory")
#define PG8_BAR __builtin_amdgcn_s_barrier()
#define PG8_SCHED __builtin_amdgcn_sched_barrier(0)
#define PG8_ABASE(u) ((const char*)g.A + (size_t)(u).pm * tstepA + (GATE_A ? (size_t)((((u).pn & 3) >> 1) * 512) : (size_t)0))
    Unit cur, nxt; int ui = 0;
    if (!S.next(0, cur)) return;
    f32x4 acc[2][2][4][2];
#pragma unroll
    for (int a = 0; a < 2; ++a)
#pragma unroll
        for (int b = 0; b < 2; ++b)
#pragma unroll
            for (int m = 0; m < 4; ++m)
#pragma unroll
                for (int n = 0; n < 2; ++n) acc[a][b][m][n] = (f32x4){0.f, 0.f, 0.f, 0.f};
    bf16x8 At[4][2], B0[2][2], B1[2][2];
    const char* cA = PG8_ABASE(cur); const char* cB = (const char*)g.Bt + (size_t)cur.pn * tstepB;
    PG8_STAGE(PG8_SB(0, 0), cB, voffB); PG8_STAGE(PG8_SA(0, 0), cA, voffA); PG8_STAGE(PG8_SB(0, 1), cB + hstepB, voffB); PG8_STAGE(PG8_SA(0, 1), cA + hstepA, voffA);
    if (wr == 1) PG8_BAR;
    PG8_WAIT_V(4); PG8_BAR;
    PG8_STAGE(PG8_SB(1, 0), cB + kstep, voffB); PG8_STAGE(PG8_SA(1, 0), cA + kstep, voffA); PG8_STAGE(PG8_SB(1, 1), cB + hstepB + kstep, voffB);
    PG8_WAIT_V(6); PG8_BAR;
    for (;;) {
        const bool has_next = S.next(ui + 1, nxt);
        const char* nA = has_next ? PG8_ABASE(nxt) : cA; const char* nB = has_next ? (const char*)g.Bt + (size_t)nxt.pn * tstepB : cB;
#pragma nounroll
        for (int t = 0; t < nt; t += 2) {
            const bool last = (t == nt - 2);
            const char* a1 = cA + (size_t)(t + 1) * kstep;
            const char* a2 = last ? nA : cA + (size_t)(t + 2) * kstep; const char* b2 = last ? nB : cB + (size_t)(t + 2) * kstep;
            const char* a3 = a2 + kstep; const char* b3 = b2 + kstep;
            PG8_LDB(B0, 0, 0); PG8_SCHED; PG8_LDA(At, 0, 0); PG8_STAGE(PG8_SA(1, 1), a1 + hstepA, voffA);
            PG8_WAIT_L(8); PG8_BAR; PG8_WAIT_L(0); PG8_MMA(0, 0, At, B0); PG8_BAR; PG8_SCHED;
            PG8_LDB(B1, 0, 1); PG8_STAGE(PG8_SB(0, 0), b2, voffB);
            PG8_BAR; PG8_WAIT_L(0); PG8_MMA(0, 1, At, B1); PG8_BAR;
            PG8_LDA(At, 0, 1); PG8_STAGE(PG8_SA(0, 0), a2, voffA);
            PG8_BAR; PG8_WAIT_L(0); PG8_MMA(1, 0, At, B0); PG8_BAR; PG8_SCHED;
            PG8_STAGE(PG8_SB(0, 1), b2 + hstepB, voffB);
            PG8_WAIT_V(6); PG8_BAR; PG8_MMA(1, 1, At, B1); PG8_BAR;
            PG8_LDB(B0, 1, 0); PG8_SCHED; PG8_LDA(At, 1, 0); PG8_STAGE(PG8_SA(0, 1), a2 + hstepA, voffA);
            PG8_WAIT_L(8); PG8_BAR; PG8_WAIT_L(0); PG8_MMA(0, 0, At, B0); PG8_BAR; PG8_SCHED;
            PG8_LDB(B1, 1, 1); PG8_STAGE(PG8_SB(1, 0), b3, voffB);
            PG8_BAR; PG8_WAIT_L(0); PG8_MMA(0, 1, At, B1); PG8_BAR;
            PG8_LDA(At, 1, 1); PG8_STAGE(PG8_SA(1, 0), a3, voffA);
            PG8_BAR; PG8_WAIT_L(0); PG8_MMA(1, 0, At, B0); PG8_BAR; PG8_SCHED;
            PG8_STAGE(PG8_SB(1, 1), b3 + hstepB, voffB);
            PG8_WAIT_V(6); PG8_BAR; PG8_MMA(1, 1, At, B1); PG8_BAR;
        }
        E(acc, cur, wr, wc, fr, fq);
        if (!has_next) break;
#pragma unroll
        for (int a = 0; a < 2; ++a)
#pragma unroll
            for (int b = 0; b < 2; ++b)
#pragma unroll
                for (int m = 0; m < 4; ++m)
#pragma unroll
                    for (int n = 0; n < 2; ++n) acc[a][b][m][n] = (f32x4){0.f, 0.f, 0.f, 0.f};
        cur = nxt; cA = nA; cB = nB; ++ui;
    }
    PG8_WAIT_V(0);
    if (wr == 0) PG8_BAR;
    PG8_BAR;
#undef PG8_SA
#undef PG8_SB
#undef PG8_STAGE
#undef PG8_LDA
#undef PG8_LDB
#undef PG8_MMA
#undef PG8_WAIT_V
#undef PG8_WAIT_L
#undef PG8_BAR
#undef PG8_SCHED
#undef PG8_ABASE
}

template <class F> struct EpiElem {
    F f;
    DI void operator()(const f32x4 (&acc)[2][2][4][2], const Unit& u, int wr, int wc, int fr, int fq) const {
        const int row0 = u.pm * BM + wr * 64 + fr, col0 = u.pn * BM + wc * 32 + 4 * fq;
#pragma unroll
        for (int ai = 0; ai < 2; ++ai)
#pragma unroll
            for (int m = 0; m < 4; ++m)
#pragma unroll
                for (int bj = 0; bj < 2; ++bj)
#pragma unroll
                    for (int n = 0; n < 2; ++n) { f(row0 + ai * HALF + m * 16, col0 + bj * HALF + n * 16, acc[ai][bj][m][n]); }
    }
};
template <class F> struct EpiElemRow {
    F f;
    DI void operator()(const f32x4 (&acc)[2][2][4][2], const Unit& u, int wr, int wc, int fr, int fq) const {
        const int row0 = u.pm * BM + wr * 64 + fr, col0 = u.pn * BM + wc * 32 + 4 * fq;
#pragma unroll
        for (int ai = 0; ai < 2; ++ai)
#pragma unroll
            for (int m = 0; m < 4; ++m) {
                float ssq = 0.f;
#pragma unroll
                for (int bj = 0; bj < 2; ++bj)
#pragma unroll
                    for (int n = 0; n < 2; ++n) { ssq += f(row0 + ai * HALF + m * 16, col0 + bj * HALF + n * 16, acc[ai][bj][m][n]); }
                ssq += __shfl_xor(ssq, 16); ssq += __shfl_xor(ssq, 32);
                if (fq == 0) f.row(row0 + ai * HALF + m * 16, (u.pn & 3) * 4 + wc, ssq);
            }
    }
};
template <class F> struct EpiElemRS {
    F f;
    DI void operator()(const f32x4 (&acc)[2][2][4][2], const Unit& u, int wr, int wc, int fr, int fq) const {
        const int row0 = u.pm * BM + wr * 64 + fr, col0 = u.pn * BM + wc * 32 + 4 * fq;
#pragma unroll
        for (int ai = 0; ai < 2; ++ai)
#pragma unroll
            for (int m = 0; m < 4; ++m) {
                const float rs = f.rs(row0 + ai * HALF + m * 16);
#pragma unroll
                for (int bj = 0; bj < 2; ++bj)
#pragma unroll
                    for (int n = 0; n < 2; ++n) { f(row0 + ai * HALF + m * 16, col0 + bj * HALF + n * 16, acc[ai][bj][m][n], rs); }
            }
    }
};
template <class F> struct EpiPairRS {
    F f;
    DI void operator()(const f32x4 (&acc)[2][2][4][2], const Unit& u, int wr, int wc, int fr, int fq) const {
        const int row0 = u.pm * BM + wr * 64 + fr, c0 = wc * 32 + 4 * fq;
#pragma unroll
        for (int ai = 0; ai < 2; ++ai)
#pragma unroll
            for (int m = 0; m < 4; ++m) {
                const float rs = f.rs(row0 + ai * HALF + m * 16);
#pragma unroll
                for (int n = 0; n < 2; ++n) { f(row0 + ai * HALF + m * 16, u.pn, c0 + n * 16, acc[ai][0][m][n], acc[ai][1][m][n], rs); }
            }
    }
};
template <class F> struct EpiElem2 {
    F f;
    DI void operator()(const f32x4 (&acc)[2][2][4][2], const Unit& u, int wr, int wc, int fr, int fq) const {
        const int row0 = u.pm * BM + wr * 64 + fr, col0 = u.pn * BM + wc * 32 + 4 * fq;
        typename F::L cur[2][2], nxt[2][2];
#pragma unroll
        for (int bj = 0; bj < 2; ++bj)
#pragma unroll
            for (int n = 0; n < 2; ++n) cur[bj][n] = f.load(row0, col0 + bj * HALF + n * 16);
#pragma unroll
        for (int i = 0; i < 8; ++i) {
            const int row = row0 + (i >> 2) * HALF + (i & 3) * 16;
            if (i < 7) { const int rown = row0 + ((i + 1) >> 2) * HALF + ((i + 1) & 3) * 16;
#pragma unroll
                for (int bj = 0; bj < 2; ++bj)
#pragma unroll
                    for (int n = 0; n < 2; ++n) nxt[bj][n] = f.load(rown, col0 + bj * HALF + n * 16); }
#pragma unroll
            for (int bj = 0; bj < 2; ++bj)
#pragma unroll
                for (int n = 0; n < 2; ++n) f.apply(row, col0 + bj * HALF + n * 16, acc[i >> 2][bj][i & 3][n], cur[bj][n]);
#pragma unroll
            for (int bj = 0; bj < 2; ++bj)
#pragma unroll
                for (int n = 0; n < 2; ++n) cur[bj][n] = nxt[bj][n];
        }
    }
};
template <class F> struct EpiElem8 {
    F f;
    DI void operator()(const f32x4 (&acc)[2][2][4][2], const Unit& u, int wr, int wc, int fr, int fq) const {
        const int row0 = u.pm * BM + wr * 64 + fr, col0 = u.pn * BM + wc * 32 + 8 * fq;
        typename F::L cur[2], nxt[2];
#pragma unroll
        for (int bj = 0; bj < 2; ++bj) cur[bj] = f.load(row0, col0 + bj * HALF);
#pragma unroll
        for (int i = 0; i < 8; ++i) {
            const int row = row0 + (i >> 2) * HALF + (i & 3) * 16;
            if (i < 7) { const int rown = row0 + ((i + 1) >> 2) * HALF + ((i + 1) & 3) * 16;
#pragma unroll
                for (int bj = 0; bj < 2; ++bj) nxt[bj] = f.load(rown, col0 + bj * HALF); }
#pragma unroll
            for (int bj = 0; bj < 2; ++bj) f.apply(row, col0 + bj * HALF, acc[i >> 2][bj][i & 3][0], acc[i >> 2][bj][i & 3][1], cur[bj]);
#pragma unroll
            for (int bj = 0; bj < 2; ++bj) cur[bj] = nxt[bj];
        }
    }
};
template <class F> struct EpiPair {
    F f;
    DI void operator()(const f32x4 (&acc)[2][2][4][2], const Unit& u, int wr, int wc, int fr, int fq) const {
        const int row0 = u.pm * BM + wr * 64 + fr, c0 = wc * 32 + 4 * fq;
#pragma unroll
        for (int ai = 0; ai < 2; ++ai)
#pragma unroll
            for (int m = 0; m < 4; ++m)
#pragma unroll
                for (int n = 0; n < 2; ++n) { f(row0 + ai * HALF + m * 16, u.pn, c0 + n * 16, acc[ai][0][m][n], acc[ai][1][m][n]); }
    }
};
DI void st_bf4(bf16_t* p, f32x4 v) { u32x2 o; o.x = pk2(v[0], v[1]); o.y = pk2(v[2], v[3]); *(u32x2*)p = o; }
DI void st_bf8(bf16_t* p, f32x4 lo, f32x4 hi) { u32x4 o; o.x = pk2(lo[0], lo[1]); o.y = pk2(lo[2], lo[3]); o.z = pk2(hi[0], hi[1]); o.w = pk2(hi[2], hi[3]); *(u32x4*)p = o; }

struct FSwiglu { bf16_t* H; const float* SS; const float* shw;
    DI float rs(int row) const { return row_rstd(SS, row); }
    DI void operator()(int row, int pn, int c, f32x4 g, f32x4 u, float rs) const {
        const float* sw = shw + mod_row(row) * 5632 + pn * 256 + c;
        g = g * rs + *(const f32x4*)sw; u = u * rs + *(const f32x4*)(sw + 128);
        f32x4 h;
#pragma unroll
        for (int e = 0; e < 4; ++e) h[e] = g[e] * sigmoidf_(g[e]) * u[e];
        st_bf4(H + (size_t)row * DFF + pn * 128 + c, h);
    } };
struct FResid { const float* src; float* dst; const float* mod; float coef;
    DI void operator()(int row, int col, f32x4 v) const {
        const f32x4 g = *(const f32x4*)(mod + mod_row(row) * NMOD + col);
        const f32x4 x = *(const f32x4*)(src + (size_t)row * DM + col);
        *(f32x4*)(dst + (size_t)row * DM + col) = x + coef * g * v;
    } };
template <int COEF2> struct FResidN { const float* src; float* dst; const float* mod; const float* scn; bf16_t* XS; float* SS;
    DI float operator()(int row, int col, f32x4 v) const {
        const int r = mod_row(row);
        const f32x4 g = *(const f32x4*)(mod + r * NMOD + col);
        const f32x4 x = *(const f32x4*)(src + (size_t)row * DM + col);
        const f32x4 xn = x + (0.5f * COEF2) * g * v;
        *(f32x4*)(dst + (size_t)row * DM + col) = xn;
        const f32x4 sc = *(const f32x4*)(scn + r * NMOD + col);
        st_bf4(XS + (size_t)row * DM + col, xn * (1.f + sc));
        return (xn[0] * xn[0] + xn[1] * xn[1]) + (xn[2] * xn[2] + xn[3] * xn[3]);
    }
    DI void row(int row, int slot, float ssq) const { SS[(size_t)row * 16 + slot] = ssq; } };
struct FWin { bf16_t *P1, *UXY, *GATE; const float* SS; const float* shw;
    DI float rs(int row) const { return row_rstd(SS, row); }
    DI void operator()(int row, int col, f32x4 v, float rs) const {
        v = v * rs + *(const f32x4*)(shw + mod_row(row) * 5632 + col);
        bf16_t* p = col < 768 ? P1 + (size_t)row * 768 + col : (col < 1792 ? UXY + (size_t)row * 1024 + (col - 768) : GATE + (size_t)row * 2048 + (col - 1792));
        st_bf4(p, v);
    } };
struct FRowScale { bf16_t* dst; int ld; const float* rs;
    typedef float L;
    DI L load(int row, int) const { return rs[row]; }
    DI void apply(int row, int col, f32x4 v0, f32x4 v1, L sc) const { st_bf8(dst + (size_t)row * ld + col, v0 * sc, v1 * sc); } };
struct FVt { bf16_t* Vt; const float* rs;
    struct L { f32x4 a, b; };
    DI L load(int, int col) const { return L{*(const f32x4*)(rs + col), *(const f32x4*)(rs + col + 4)}; }
    DI void apply(int row, int col, f32x4 v0, f32x4 v1, L sc) const {
        int b, kpos; if (col < ML) { b = col >> 13; kpos = col & (SEQ - 1); } else { const int r = col - ML; b = r >> 8; kpos = SEQ + (r & 255); }
        st_bf8(Vt + ((size_t)(b * NH + (row >> 6)) * 64 + (row & 63)) * TK + kpos, v0 * sc.a, v1 * sc.b);
    } };
struct EGate { const bf16_t* xc; bf16_t *OM, *BB; const float *sp8, *br, *bi;
    DI void operator()(const f32x4 (&acc)[2][2][4][2], const Unit& u, int wr, int wc, int fr, int fq) const {
        const int row0 = u.pm * BM + wr * 64 + fr, d = u.pn >> 2, ch0 = (u.pn & 3) * 128 + wc * 32 + 8 * fq;
        f32x4 s4[2], br4[2], bi4[2]; u32x4 xcur, xnxt;
#pragma unroll
        for (int n = 0; n < 2; ++n) { s4[n] = *(const f32x4*)(sp8 + d * 512 + ch0 + 4 * n); br4[n] = *(const f32x4*)(br + d * 512 + ch0 + 4 * n); bi4[n] = *(const f32x4*)(bi + d * 512 + ch0 + 4 * n); }
        xcur = *(const u32x4*)(xc + (size_t)row0 * 512 + ch0);
#pragma unroll
        for (int i = 0; i < 8; ++i) {
            const int row = row0 + (i >> 2) * HALF + (i & 3) * 16;
            if (i < 7) { const int rown = row0 + ((i + 1) >> 2) * HALF + ((i + 1) & 3) * 16; xnxt = *(const u32x4*)(xc + (size_t)rown * 512 + ch0); }
            f32x4 om[2], bb[2];
#pragma unroll
            for (int n = 0; n < 2; ++n) {
                const f32x4 r4 = acc[i >> 2][0][i & 3][n], i4 = acc[i >> 2][1][i & 3][n];
                const unsigned w0 = n == 0 ? xcur.x : xcur.z, w1 = n == 0 ? xcur.y : xcur.w;
                const f32x4 xf = {bflo(w0), bfhi(w0), bflo(w1), bfhi(w1)};
#pragma unroll
                for (int e = 0; e < 4; ++e) {
                    const float r = sigmoidf_(r4[e] + br4[n][e]), ig = sigmoidf_(i4[e] + bi4[n][e]);
                    const float a = __expf(s4[n][e] * r);
                    om[n][e] = 1.f - a; bb[n][e] = __fsqrt_rn(fmaxf(1.f - a * a, 0.f)) * (ig * xf[e]);
                }
            }
            const size_t o = ((size_t)d * MA + row) * 512 + ch0;
            st_bf8(OM + o, om[0], om[1]); st_bf8(BB + o, bb[0], bb[1]);
            xcur = xnxt;
        }
    } };
DI f32x4 sig_lo(u32x4 g) { return (f32x4){sigmoidf_(bflo(g.x)), sigmoidf_(bfhi(g.x)), sigmoidf_(bflo(g.y)), sigmoidf_(bfhi(g.y))}; }
DI f32x4 sig_hi(u32x4 g) { return (f32x4){sigmoidf_(bflo(g.z)), sigmoidf_(bfhi(g.z)), sigmoidf_(bflo(g.w)), sigmoidf_(bfhi(g.w))}; }
struct FMergeA { const bf16_t* GATE; bf16_t* Y;
    typedef u32x4 L;
    DI L load(int row, int col) const { return *(const u32x4*)(GATE + (size_t)row * 2048 + col); }
    DI void apply(int row, int col, f32x4 v0, f32x4 v1, L gv) const { st_bf8(Y + (size_t)row * DM + col, sig_lo(gv) * v0, sig_hi(gv) * v1); } };
struct FMergeB { const bf16_t* GATE; bf16_t* Y;
    struct L { u32x4 g, y; };
    DI L load(int row, int col) const { return L{*(const u32x4*)(GATE + (size_t)row * 2048 + 1024 + col), *(const u32x4*)(Y + (size_t)row * DM + col)}; }
    DI void apply(int row, int col, f32x4 v0, f32x4 v1, L q) const {
        const f32x4 y0 = {bflo(q.y.x), bfhi(q.y.x), bflo(q.y.y), bfhi(q.y.y)}, y1 = {bflo(q.y.z), bfhi(q.y.z), bflo(q.y.w), bfhi(q.y.w)};
        st_bf8(Y + (size_t)row * DM + col, y0 + sig_lo(q.g) * v0, y1 + sig_hi(q.g) * v1);
    } };

struct ESwiglu { bf16_t* H; const float* SS; const float* shw;
    DI void operator()(const f32x4 (&acc)[2][2][4][2], const Unit& u, int wr, int wc, int fr, int fq) const {
        const int row0 = u.pm * BM + wr * 64 + fr, c0 = wc * 32 + 8 * fq;
        const float* sw = shw + mod_row(u.pm * BM) * 5632 + u.pn * 256 + c0;
        f32x4 sg[2], su[2]; float rs[8];
#pragma unroll
        for (int n = 0; n < 2; ++n) { sg[n] = *(const f32x4*)(sw + 4 * n); su[n] = *(const f32x4*)(sw + 128 + 4 * n); }
#pragma unroll
        for (int i = 0; i < 8; ++i) rs[i] = row_rstd(SS, row0 + (i >> 2) * HALF + (i & 3) * 16);
#pragma unroll
        for (int ai = 0; ai < 2; ++ai)
#pragma unroll
            for (int m = 0; m < 4; ++m) {
                f32x4 h[2];
#pragma unroll
                for (int n = 0; n < 2; ++n) {
                    const f32x4 g = acc[ai][0][m][n] * rs[ai * 4 + m] + sg[n], uu = acc[ai][1][m][n] * rs[ai * 4 + m] + su[n];
#pragma unroll
                    for (int e = 0; e < 4; ++e) h[n][e] = g[e] * sigmoidf_(g[e]) * uu[e];
                }
                st_bf8(H + (size_t)(row0 + ai * HALF + m * 16) * DFF + u.pn * 128 + c0, h[0], h[1]);
            }
    } };
struct EWin { bf16_t *P1, *UXY, *GATE; const float* SS; const float* shw;
    template <int LD> DI void body(const f32x4 (&acc)[2][2][4][2], bf16_t* dst, const f32x4 (&sh)[2][2], const float (&rs)[8]) const {
#pragma unroll
        for (int ai = 0; ai < 2; ++ai)
#pragma unroll
            for (int m = 0; m < 4; ++m)
#pragma unroll
                for (int bj = 0; bj < 2; ++bj)
                    st_bf8(dst + (size_t)(ai * HALF + m * 16) * LD + 128 * bj, acc[ai][bj][m][0] * rs[ai * 4 + m] + sh[bj][0], acc[ai][bj][m][1] * rs[ai * 4 + m] + sh[bj][1]);
    }
    DI void operator()(const f32x4 (&acc)[2][2][4][2], const Unit& u, int wr, int wc, int fr, int fq) const {
        const int row0 = u.pm * BM + wr * 64 + fr, c0 = wc * 32 + 8 * fq;
        const float* sw = shw + mod_row(u.pm * BM) * 5632 + u.pn * 256 + c0;
        f32x4 sh[2][2]; float rs[8];
#pragma unroll
        for (int bj = 0; bj < 2; ++bj)
#pragma unroll
            for (int n = 0; n < 2; ++n) sh[bj][n] = *(const f32x4*)(sw + 128 * bj + 4 * n);
#pragma unroll
        for (int i = 0; i < 8; ++i) { rs[i] = row_rstd(SS, row0 + (i >> 2) * HALF + (i & 3) * 16); if ((i & 1) == 1) __builtin_amdgcn_sched_barrier(0); }
        if (u.pn < 3) body<768>(acc, P1 + (size_t)row0 * 768 + u.pn * 256 + c0, sh, rs);
        else if (u.pn < 7) body<1024>(acc, UXY + (size_t)row0 * 1024 + (u.pn - 3) * 256 + c0, sh, rs);
        else body<2048>(acc, GATE + (size_t)row0 * 2048 + (u.pn - 7) * 256 + c0, sh, rs);
    } };
template <int COEF2, bool NORM> struct EResid { const float* src; float* dst; const float* mod; const float* scn; bf16_t* XS; float* SS;
    DI void operator()(const f32x4 (&acc)[2][2][4][2], const Unit& u, int wr, int wc, int fr, int fq) const {
        const int row0 = u.pm * BM + wr * 64 + fr, col0 = u.pn * BM + wc * 32 + 8 * fq, r = mod_row(u.pm * BM);
        f32x4 g[2][2], sc[2][2];
#pragma unroll
        for (int bj = 0; bj < 2; ++bj)
#pragma unroll
            for (int n = 0; n < 2; ++n) { g[bj][n] = *(const f32x4*)(mod + r * NMOD + col0 + 128 * bj + 4 * n) * (0.5f * COEF2);
                if (NORM) sc[bj][n] = *(const f32x4*)(scn + r * NMOD + col0 + 128 * bj + 4 * n) + 1.f; }
        f32x4 xc[2][2], xn_[2][2];
#pragma unroll
        for (int bj = 0; bj < 2; ++bj)
#pragma unroll
            for (int n = 0; n < 2; ++n) xc[bj][n] = *(const f32x4*)(src + (size_t)row0 * DM + col0 + 128 * bj + 4 * n);
#pragma unroll
        for (int i = 0; i < 8; ++i) {
            const int row = row0 + (i >> 2) * HALF + (i & 3) * 16;
            if (i < 7) { const int rown = row0 + ((i + 1) >> 2) * HALF + ((i + 1) & 3) * 16;
#pragma unroll
                for (int bj = 0; bj < 2; ++bj)
#pragma unroll
                    for (int n = 0; n < 2; ++n) xn_[bj][n] = *(const f32x4*)(src + (size_t)rown * DM + col0 + 128 * bj + 4 * n); }
            float ssq = 0.f;
#pragma unroll
            for (int bj = 0; bj < 2; ++bj) {
                f32x4 y[2];
#pragma unroll
                for (int n = 0; n < 2; ++n) {
                    y[n] = xc[bj][n] + g[bj][n] * acc[i >> 2][bj][i & 3][n];
                    *(f32x4*)(dst + (size_t)row * DM + col0 + 128 * bj + 4 * n) = y[n];
                    if (NORM) ssq += (y[n][0] * y[n][0] + y[n][1] * y[n][1]) + (y[n][2] * y[n][2] + y[n][3] * y[n][3]);
                }
                if (NORM) st_bf8(XS + (size_t)row * DM + col0 + 128 * bj, y[0] * sc[bj][0], y[1] * sc[bj][1]);
            }
            if (NORM) { ssq += __shfl_xor(ssq, 16); ssq += __shfl_xor(ssq, 32); if (fq == 0) SS[(size_t)row * 16 + (u.pn & 3) * 4 + wc] = ssq; }
#pragma unroll
            for (int bj = 0; bj < 2; ++bj)
#pragma unroll
                for (int n = 0; n < 2; ++n) xc[bj][n] = xn_[bj][n];
        }
    } };

DI void phase_mod(const Params& p, float* lds) {
    float* sc = lds;
    float* red = lds + 5 * DM;
    const int tid = TIDX, lane = tid & 63, wave = tid >> 6;
    for (int i = tid; i < 5 * DM; i += 512) { const float v = i < 4 * DM ? p.c[i] : p.c_ctx[i - 4 * DM]; sc[i] = v * sigmoidf_(v); }
    __syncthreads();
    float* mod = (float*)(p.ws + O_MOD);
    for (int it = BIDX; it < DEPTH * (NMOD / 64); it += gridDim.x) {
        const int l = it / (NMOD / 64), n = (it % (NMOD / 64)) * 64 + lane;
        const float* w = p.w_ada + ((size_t)l * DM + wave * 128) * NMOD + n;
        float a0 = 0.f, a1 = 0.f, a2 = 0.f, a3 = 0.f, a4 = 0.f;
#pragma unroll 8
        for (int k = 0; k < 128; ++k) { const float wv = w[(size_t)k * NMOD]; const int kk = wave * 128 + k;
            a0 += sc[kk] * wv; a1 += sc[DM + kk] * wv; a2 += sc[2 * DM + kk] * wv; a3 += sc[3 * DM + kk] * wv; a4 += sc[4 * DM + kk] * wv; }
        red[(wave * 5 + 0) * 64 + lane] = a0; red[(wave * 5 + 1) * 64 + lane] = a1; red[(wave * 5 + 2) * 64 + lane] = a2; red[(wave * 5 + 3) * 64 + lane] = a3; red[(wave * 5 + 4) * 64 + lane] = a4;
        __syncthreads();
        if (tid < 320) { const int r = tid >> 6; float s = p.b_ada[(size_t)l * NMOD + n];
#pragma unroll
            for (int w8 = 0; w8 < 8; ++w8) s += red[(w8 * 5 + r) * 64 + lane];
            mod[((size_t)l * 5 + r) * NMOD + n] = s; }
        __syncthreads();
    }
}

template <int MAP> DI int colmap(int n) {
    if (MAP == 0) return n;
    if (MAP == 1) { const int pn = n >> 8, bj = (n >> 7) & 1, c = n & 127; return bj * DFF + pn * 128 + c; }
    if (MAP == 2) return n < 672 ? n : (n < 768 ? -1 : n - 96);
    { const int m = n & 511, h = m >> 6, d = m & 63; return h * 128 + (n >> 9) * 64 + d; }
}
template <int MAP> DI void tjob(const float* src, int ld, int K, int N, bf16_t* dst, const float* kscale, float* tile, int& base, int vbid, int G) {
    const int tid = TIDX, ntn = N / 64, ntiles = ntn * (K / 64);
    int first = (vbid - base % G + G) % G;
    for (int t = first; t < ntiles; t += G) {
        const int n0 = (t % ntn) * 64, k0 = (t / ntn) * 64;
        const int c = colmap<MAP>(n0 + (tid & 63));
#pragma unroll
        for (int i = 0; i < 8; ++i) { const int kk = (tid >> 6) + 8 * i; float v = c >= 0 ? src[(size_t)(k0 + kk) * ld + c] : 0.f; if (kscale) v *= kscale[k0 + kk]; tile[kk * 65 + (tid & 63)] = v; }
        __syncthreads();
        { const int kc = tid & 7, nn = tid >> 3;
          const float* tp = tile + (kc * 8) * 65 + nn;
          u32x4 o; o.x = pk2(tp[0], tp[65]); o.y = pk2(tp[2 * 65], tp[3 * 65]); o.z = pk2(tp[4 * 65], tp[5 * 65]); o.w = pk2(tp[6 * 65], tp[7 * 65]);
          *(u32x4*)(dst + (size_t)(n0 + nn) * K + k0 + kc * 8) = o; }
        __syncthreads();
    }
    base += ntiles;
}
DI void phase_prep_ff(const Params& p, int l, int which, float* tile, int vbid, int vG) {
    unsigned char* ws = p.ws; int base = 0;
    if (which == 0) {
        tjob<1>(p.ff1_w_in + (size_t)l * DM * 2 * DFF, 2 * DFF, DM, 2 * DFF, (bf16_t*)(ws + O_WFF1IN), nullptr, tile, base, vbid, vG);
        tjob<0>(p.ff1_w_out + (size_t)l * DFF * DM, DM, DFF, DM, (bf16_t*)(ws + O_WFF1OUT), nullptr, tile, base, vbid, vG);
    } else {
        tjob<1>(p.ff2_w_in + (size_t)l * DM * 2 * DFF, 2 * DFF, DM, 2 * DFF, (bf16_t*)(ws + O_WFF2IN), nullptr, tile, base, vbid, vG);
        tjob<0>(p.ff2_w_out + (size_t)l * DFF * DM, DM, DFF, DM, (bf16_t*)(ws + O_WFF2OUT), nullptr, tile, base, vbid, vG);
    }
}
DI void phase_prep(const Params& p, int l, float* tile) {
    unsigned char* ws = p.ws; int base = 0;
    const int vbid = BIDX, vG = gridDim.x;
    const float* modl = (const float*)(ws + O_MOD) + (size_t)l * 5 * NMOD; float* shw = (float*)(ws + O_SHW);
    if (l == 0) phase_prep_ff(p, 0, 0, tile, vbid, vG);
    tjob<2>(p.w_in + (size_t)l * DM * 3744, 3744, DM, NIN, (bf16_t*)(ws + O_WIN), nullptr, tile, base, vbid, vG);
    tjob<0>(p.w_uq + (size_t)l * 384 * 768, 768, 384, 768, (bf16_t*)(ws + O_WUQ), p.q_a_norm + l * 384, tile, base, vbid, vG);
    tjob<3>(p.w_ukv + (size_t)l * 256 * 1024, 1024, 256, 1024, (bf16_t*)(ws + O_WUKV), p.kv_a_norm + l * 256, tile, base, vbid, vG);
    tjob<0>(p.w_o_attn + (size_t)l * 512 * 1024, 1024, 512, 1024, (bf16_t*)(ws + O_WOA), nullptr, tile, base, vbid, vG);
    tjob<0>(p.w_o_lru + (size_t)l * 512 * 1024, 1024, 512, 1024, (bf16_t*)(ws + O_WOL), nullptr, tile, base, vbid, vG);
    tjob<0>(p.w_out + (size_t)l * 1024 * 1024, 1024, 1024, 1024, (bf16_t*)(ws + O_WOUT), nullptr, tile, base, vbid, vG);
    { float* sh = tile; float* red = tile + 5 * DM;
      const int tid = TIDX, nn = tid & 63, ks = tid >> 6;
      for (int it = BIDX; it < 88 + 60 + 88; it += gridDim.x) {
          const int m = it < 88 ? 0 : (it < 148 ? 1 : 2), n0 = (m == 0 ? it : (m == 1 ? it - 88 : it - 148)) * 64;
          const float* W = m == 0 ? p.ff1_w_in + (size_t)l * DM * 2 * DFF : (m == 1 ? p.w_in + (size_t)l * DM * 3744 : p.ff2_w_in + (size_t)l * DM * 2 * DFF);
          const int ld = m == 1 ? 3744 : 2 * DFF, c = m == 1 ? colmap<2>(n0 + nn) : colmap<1>(n0 + nn);
          __syncthreads();
          for (int i = tid; i < 5 * DM; i += 512) sh[i] = modl[(size_t)(i >> 10) * NMOD + m * 3 * DM + (i & 1023)];
          __syncthreads();
          float a0 = 0.f, a1 = 0.f, a2 = 0.f, a3 = 0.f, a4 = 0.f;
          if (c >= 0) {
#pragma unroll 8
              for (int k = ks * 128; k < ks * 128 + 128; ++k) { const float wv = W[(size_t)k * ld + c]; a0 += sh[k] * wv; a1 += sh[DM + k] * wv; a2 += sh[2 * DM + k] * wv; a3 += sh[3 * DM + k] * wv; a4 += sh[4 * DM + k] * wv; }
          }
          red[(ks * 5 + 0) * 64 + nn] = a0; red[(ks * 5 + 1) * 64 + nn] = a1; red[(ks * 5 + 2) * 64 + nn] = a2; red[(ks * 5 + 3) * 64 + nn] = a3; red[(ks * 5 + 4) * 64 + nn] = a4;
          __syncthreads();
          if (tid < 320) { const int r = tid >> 6; float sum = 0.f;
#pragma unroll
              for (int w8 = 0; w8 < 8; ++w8) sum += red[(w8 * 5 + r) * 64 + nn];
              shw[(size_t)(m * 5 + r) * 5632 + n0 + nn] = sum; }
      }
      __syncthreads(); }
    if (BIDX == 0) { float* sp8 = (float*)(ws + O_SP);
        for (int i = TIDX; i < 1024; i += 512) { const float nl = -p.lru_lambda[l * 1024 + i]; sp8[i] = -8.f * (fmaxf(nl, 0.f) + log1pf(__expf(-fabsf(nl)))); } }
    bf16_t* wg = (bf16_t*)(ws + O_WGATE);
    for (int idx = BIDX * 512 + TIDX; idx < 2048 * 256; idx += gridDim.x * 512) {
        const int n = idx >> 8, k = idx & 255, d = n >> 10, cb = (n >> 8) & 3, gt = (n >> 7) & 1, c = n & 127, ch = cb * 128 + c, g = ch >> 6, j = ch & 63, ci = 256 * (cb >> 1) + k, gi = ci >> 6, i = ci & 63;
        float v = 0.f;
        if (gi == g) v = (gt ? p.w_igate : p.w_rgate)[((((size_t)l * 2 + d) * 8 + g) * 64 + i) * 64 + j];
        wg[idx] = f2bf(v);
    }
}

DI void phase_norm0(const Params& p) {
    const int tid = TIDX, lane = tid & 63, gw = BIDX * 8 + (tid >> 6), nw = gridDim.x * 8;
    float* X = (float*)(p.ws + O_X); bf16_t* XS = (bf16_t*)(p.ws + O_XNY); float* SS = (float*)(p.ws + O_SS);
    const float* mod = (const float*)(p.ws + O_MOD);
    for (int row = gw; row < MA; row += nw) {
        const float* src = row < ML ? p.x + (size_t)row * DM : p.ctx + (size_t)(row - ML) * DM;
        f32x4 v[4]; float s = 0.f;
#pragma unroll
        for (int j = 0; j < 4; ++j) { v[j] = *(const f32x4*)(src + 256 * j + 4 * lane); s += (v[j][0] * v[j][0] + v[j][1] * v[j][1]) + (v[j][2] * v[j][2] + v[j][3] * v[j][3]); }
        s = wave_sum(s);
        if (lane < 16) SS[(size_t)row * 16 + lane] = lane == 0 ? s : 0.f;
        const float* mr = mod + (size_t)mod_row(row) * NMOD;
#pragma unroll
        for (int j = 0; j < 4; ++j) {
            const int col = 256 * j + 4 * lane;
            *(f32x4*)(X + (size_t)row * DM + col) = v[j];
            const f32x4 sc = *(const f32x4*)(mr + DM + col);
            st_bf4(XS + (size_t)row * DM + col, v[j] * (1.f + sc));
        }
    }
}

DI void phase_conv(const Params& p, int l) {
    const bf16_t* UXY = (const bf16_t*)(p.ws + O_UXY); const bf16_t* P1 = (const bf16_t*)(p.ws + O_R1);
    bf16_t* xc = (bf16_t*)(p.ws + O_XNY);
    const float* cw = p.conv_w + (size_t)l * 4 * 512; const float* cb = p.conv_b + (size_t)l * 512;
    for (int e = BIDX * 512 + TIDX; e < MA * 64; e += gridDim.x * 512) {
        const int row = e >> 6, ch = (e & 63) * 8;
        int t, T; if (row < ML) { t = row & (SEQ - 1); T = SEQ; } else { t = (row - ML) & 255; T = CTXL; }
        u32x4 uv[4]; float ok[4];
#pragma unroll
        for (int k = 0; k < 4; ++k) { const int tt = t + k - 2; const bool in = tt >= 0 && tt < T; ok[k] = in ? 1.f : 0.f;
            uv[k] = *(const u32x4*)(UXY + (size_t)(in ? row + k - 2 : row) * 1024 + ch); }
        f32x4 y0 = *(const f32x4*)(cb + ch), y1 = *(const f32x4*)(cb + ch + 4);
#pragma unroll
        for (int k = 0; k < 4; ++k) {
            const f32x4 w0 = *(const f32x4*)(cw + k * 512 + ch) * ok[k], w1 = *(const f32x4*)(cw + k * 512 + ch + 4) * ok[k];
            const f32x4 a = {bflo(uv[k].x), bfhi(uv[k].x), bflo(uv[k].y), bfhi(uv[k].y)}, c = {bflo(uv[k].z), bfhi(uv[k].z), bflo(uv[k].w), bfhi(uv[k].w)};
            y0 += w0 * a; y1 += w1 * c;
        }
        u32x4 o; o.x = pk2(y0[0], y0[1]); o.y = pk2(y0[2], y0[3]); o.z = pk2(y1[0], y1[1]); o.w = pk2(y1[2], y1[3]);
        *(u32x4*)(xc + (size_t)row * 512 + ch) = o;
    }
    float* rsq = (float*)(p.ws + O_RSQ); float* rskv = (float*)(p.ws + O_RSKV);
    const int tid2 = TIDX, l16 = tid2 & 15, gq = BIDX * 32 + (tid2 >> 4), nq = gridDim.x * 32;
    for (int row = gq; row < MA; row += nq) {
        const bf16_t* pr = P1 + (size_t)row * 768;
        u32x4 v[5];
#pragma unroll
        for (int i = 0; i < 5; ++i) v[i] = *(const u32x4*)(pr + (l16 + 16 * i) * 8);
        float sq = 0.f, skv = 0.f;
#pragma unroll
        for (int i = 0; i < 5; ++i) {
            const float s2 = bflo(v[i].x) * bflo(v[i].x) + bfhi(v[i].x) * bfhi(v[i].x) + bflo(v[i].y) * bflo(v[i].y) + bfhi(v[i].y) * bfhi(v[i].y)
                           + bflo(v[i].z) * bflo(v[i].z) + bfhi(v[i].z) * bfhi(v[i].z) + bflo(v[i].w) * bflo(v[i].w) + bfhi(v[i].w) * bfhi(v[i].w);
            if (i < 3) sq += s2; else skv += s2;
        }
#pragma unroll
        for (int o = 1; o < 16; o <<= 1) { sq += __shfl_xor(sq, o); skv += __shfl_xor(skv, o); }
        if (l16 == 0) { rsq[row] = rsqrtf(sq * (1.f / 384.f) + EPS); rskv[row] = rsqrtf(skv * (1.f / 256.f) + EPS); }
    }
}

DI int chunk_row0(int b, int pch) { return pch < 4 ? ML + b * CTXL + pch * 64 : b * SEQ + (pch - 4) * 64; }
DI void phase_scan_agg(const Params& p) {
    const bf16_t* OM = (const bf16_t*)(p.ws + O_S); const bf16_t* BB = OM + (size_t)2 * MA * 512;
    f32x4* agg = (f32x4*)(p.ws + O_AGG);
    const int tid = TIDX, lane = tid & 63, gw = (tid >> 6) * gridDim.x + BIDX, nw = gridDim.x * 8;
    for (int it = gw; it < 2 * NB * NCH; it += nw) {
        const int d = it & 1, bp = it >> 1, b = bp / NCH, pch = bp % NCH, row0 = chunk_row0(b, pch);
        const bf16_t* om = OM + ((size_t)d * MA + row0) * 512 + lane * 8; const bf16_t* bb = BB + ((size_t)d * MA + row0) * 512 + lane * 8;
        float h[8], A[8];
#pragma unroll
        for (int i = 0; i < 8; ++i) { h[i] = 0.f; A[i] = 1.f; }
#pragma unroll 8
        for (int t = 0; t < 64; ++t) {
            const int tt = d ? 63 - t : t;
            const u32x4 ov = *(const u32x4*)(om + (size_t)tt * 512), bv = *(const u32x4*)(bb + (size_t)tt * 512);
            const float a[8] = {1.f - bflo(ov.x), 1.f - bfhi(ov.x), 1.f - bflo(ov.y), 1.f - bfhi(ov.y), 1.f - bflo(ov.z), 1.f - bfhi(ov.z), 1.f - bflo(ov.w), 1.f - bfhi(ov.w)};
            const float bq[8] = {bflo(bv.x), bfhi(bv.x), bflo(bv.y), bfhi(bv.y), bflo(bv.z), bfhi(bv.z), bflo(bv.w), bfhi(bv.w)};
#pragma unroll
            for (int i = 0; i < 8; ++i) { h[i] = a[i] * h[i] + bq[i]; A[i] *= a[i]; }
        }
        f32x4* dst = agg + (((size_t)(d * NB + b) * NCH + pch) * 512 + lane * 8) / 2;
#pragma unroll
        for (int i = 0; i < 4; ++i) dst[i] = (f32x4){A[2 * i], h[2 * i], A[2 * i + 1], h[2 * i + 1]};
    }
}
DI float gelu_tanh(float x) { const float u = 0.7978845608028654f * (x + 0.044715f * x * x * x); const float e = __expf(2.f * u); const float th = 1.f - 2.f * __builtin_amdgcn_rcpf(e + 1.f); return 0.5f * x * (1.f + th); }
DI void agg_step(const f32x4* e, float (&h)[8]) {
    const f32x4 e0 = e[0], e1 = e[1], e2 = e[2], e3 = e[3];
    h[0] = e0[0] * h[0] + e0[1]; h[1] = e0[2] * h[1] + e0[3]; h[2] = e1[0] * h[2] + e1[1]; h[3] = e1[2] * h[3] + e1[3];
    h[4] = e2[0] * h[4] + e2[1]; h[5] = e2[2] * h[5] + e2[3]; h[6] = e3[0] * h[6] + e3[1]; h[7] = e3[2] * h[7] + e3[3];
}
DI void phase_scan_apply(const Params& p) {
    const bf16_t* OM = (const bf16_t*)(p.ws + O_S); const bf16_t* BB = OM + (size_t)2 * MA * 512;
    const f32x4* agg = (const f32x4*)(p.ws + O_AGG);
    bf16_t* UXY = (bf16_t*)(p.ws + O_UXY); float* HF = p.out;
    const int tid = TIDX, lane = tid & 63, gw = (tid >> 6) * gridDim.x + BIDX, nw = gridDim.x * 8;
    for (int it = gw; it < NB * NCH; it += nw) {
        const int b = it / NCH, pch = it % NCH, row0 = chunk_row0(b, pch);
        const f32x4* af = agg + (((size_t)(0 * NB + b) * NCH) * 512 + lane * 8) / 2; const f32x4* ab = agg + (((size_t)(1 * NB + b) * NCH) * 512 + lane * 8) / 2;
        float h[8];
#pragma unroll
        for (int i = 0; i < 8; ++i) h[i] = 0.f;
#pragma unroll 4
        for (int q = 0; q < pch; ++q) agg_step(af + (size_t)q * 256, h);
        { const bf16_t* om = OM + ((size_t)row0) * 512 + lane * 8; const bf16_t* bb = BB + ((size_t)row0) * 512 + lane * 8; float* hf = HF + (size_t)row0 * 512 + lane * 8;
#pragma unroll 8
          for (int t = 0; t < 64; ++t) {
              const u32x4 ov = *(const u32x4*)(om + (size_t)t * 512), bv = *(const u32x4*)(bb + (size_t)t * 512);
              h[0] = (1.f - bflo(ov.x)) * h[0] + bflo(bv.x); h[1] = (1.f - bfhi(ov.x)) * h[1] + bfhi(bv.x); h[2] = (1.f - bflo(ov.y)) * h[2] + bflo(bv.y); h[3] = (1.f - bfhi(ov.y)) * h[3] + bfhi(bv.y);
              h[4] = (1.f - bflo(ov.z)) * h[4] + bflo(bv.z); h[5] = (1.f - bfhi(ov.z)) * h[5] + bfhi(bv.z); h[6] = (1.f - bflo(ov.w)) * h[6] + bflo(bv.w); h[7] = (1.f - bfhi(ov.w)) * h[7] + bfhi(bv.w);
              *(f32x4*)(hf + (size_t)t * 512) = (f32x4){h[0], h[1], h[2], h[3]}; *(f32x4*)(hf + (size_t)t * 512 + 4) = (f32x4){h[4], h[5], h[6], h[7]};
          } }
#pragma unroll
        for (int i = 0; i < 8; ++i) h[i] = 0.f;
        if (pch >= 4) {
#pragma unroll
            for (int q = 3; q >= 0; --q) agg_step(ab + (size_t)q * 256, h);
#pragma unroll 4
            for (int q = NCH - 1; q > pch; --q) agg_step(ab + (size_t)q * 256, h);
        } else {
            for (int q = 3; q > pch; --q) agg_step(ab + (size_t)q * 256, h);
        }
        { const bf16_t* om = OM + ((size_t)MA + row0) * 512 + lane * 8; const bf16_t* bb = BB + ((size_t)MA + row0) * 512 + lane * 8; const float* hf = HF + (size_t)row0 * 512 + lane * 8;
#pragma unroll 4
          for (int t = 63; t >= 0; --t) {
              const u32x4 ov = *(const u32x4*)(om + (size_t)t * 512), bv = *(const u32x4*)(bb + (size_t)t * 512);
              const f32x4 f0 = *(const f32x4*)(hf + (size_t)t * 512), f1 = *(const f32x4*)(hf + (size_t)t * 512 + 4);
              const u32x4 uv = *(const u32x4*)(UXY + (size_t)(row0 + t) * 1024 + 512 + lane * 8);
              h[0] = (1.f - bflo(ov.x)) * h[0] + bflo(bv.x); h[1] = (1.f - bfhi(ov.x)) * h[1] + bfhi(bv.x); h[2] = (1.f - bflo(ov.y)) * h[2] + bflo(bv.y); h[3] = (1.f - bfhi(ov.y)) * h[3] + bfhi(bv.y);
              h[4] = (1.f - bflo(ov.z)) * h[4] + bflo(bv.z); h[5] = (1.f - bfhi(ov.z)) * h[5] + bfhi(bv.z); h[6] = (1.f - bflo(ov.w)) * h[6] + bflo(bv.w); h[7] = (1.f - bfhi(ov.w)) * h[7] + bfhi(bv.w);
              u32x4 o;
              o.x = pk2((f0[0] + h[0]) * gelu_tanh(bflo(uv.x)), (f0[1] + h[1]) * gelu_tanh(bfhi(uv.x))); o.y = pk2((f0[2] + h[2]) * gelu_tanh(bflo(uv.y)), (f0[3] + h[3]) * gelu_tanh(bfhi(uv.y)));
              o.z = pk2((f1[0] + h[4]) * gelu_tanh(bflo(uv.z)), (f1[1] + h[5]) * gelu_tanh(bfhi(uv.z))); o.w = pk2((f1[2] + h[6]) * gelu_tanh(bflo(uv.w)), (f1[3] + h[7]) * gelu_tanh(bfhi(uv.w)));
              *(u32x4*)(UXY + (size_t)(row0 + t) * 1024 + lane * 8) = o;
          } }
    }
}

DI void phase_qk(const Params& p, int l, unsigned char* smem) {
    const bf16_t* qraw = (const bf16_t*)p.out; const bf16_t* kn = qraw + (size_t)MA * 768;
    const bf16_t* P1 = (const bf16_t*)(p.ws + O_R1);
    bf16_t* Q = (bf16_t*)(p.ws + O_S); bf16_t* Kb = Q + (size_t)32 * TK * 96;
    const int tid = TIDX, lane = tid & 63, wave = tid >> 6, gw = BIDX * 8 + wave, nw = gridDim.x * 8, h = lane >> 3, j = lane & 7;
    unsigned char* wq = smem + wave * 4096; unsigned char* wk = wq + 1536;
    const float* qn = p.q_norm + l * 96; const float* knm = p.k_norm + l * 96;
    float gq[12], gk[12];
#pragma unroll
    for (int i = 0; i < 12; ++i) { gq[i] = qn[8 * i + j] * QSCALE; gk[i] = knm[8 * i + j]; }
    const float freq = exp2f(-(float)j * 1.6609640474436813f);
    for (int row = gw; row < MA; row += nw) {
        { const u32x4 q0 = *(const u32x4*)(qraw + (size_t)row * 768 + lane * 8);
          u32x4 q1 = {0u, 0u, 0u, 0u}, k1 = {0u, 0u, 0u, 0u};
          if (lane < 32) q1 = *(const u32x4*)(qraw + (size_t)row * 768 + 512 + lane * 8);
          const u32x4 k0 = *(const u32x4*)(kn + (size_t)row * 512 + lane * 8);
          if (lane < 4) k1 = *(const u32x4*)(P1 + (size_t)row * 768 + 640 + lane * 8);
          *(u32x4*)(wq + lane * 16) = q0; if (lane < 32) *(u32x4*)(wq + 1024 + lane * 16) = q1;
          *(u32x4*)(wk + lane * 16) = k0; if (lane < 4) *(u32x4*)(wk + 1024 + lane * 16) = k1; }
        __builtin_amdgcn_fence(__ATOMIC_RELEASE, "wavefront"); __builtin_amdgcn_wave_barrier(); __builtin_amdgcn_fence(__ATOMIC_ACQUIRE, "wavefront");
        float xq[12], xk[12];
#pragma unroll
        for (int i = 0; i < 12; ++i) xq[i] = bf2f(*(const bf16_t*)(wq + (h * 96 + 8 * i + j) * 2));
#pragma unroll
        for (int i = 0; i < 8; ++i) xk[i] = bf2f(*(const bf16_t*)(wk + (h * 64 + 8 * i + j) * 2));
#pragma unroll
        for (int i = 8; i < 12; ++i) xk[i] = bf2f(*(const bf16_t*)(wk + 1024 + (8 * (i - 8) + j) * 2));
        __builtin_amdgcn_fence(__ATOMIC_RELEASE, "wavefront"); __builtin_amdgcn_wave_barrier(); __builtin_amdgcn_fence(__ATOMIC_ACQUIRE, "wavefront");
        const bool lat = row < ML; int b, pos;
        if (lat) { b = row >> 13; pos = row & (SEQ - 1); } else { const int r = row - ML; b = r >> 8; pos = SEQ + (r & 255); }
        float c0 = 1.f, s0 = 0.f, c1 = 1.f, s1 = 0.f;
        if (lat) { float r0 = (float)(pos >> 6) * freq * 0.15915494309189535f, r1 = (float)(pos & 63) * freq * 0.15915494309189535f;
            r0 -= floorf(r0); r1 -= floorf(r1);
            c0 = __builtin_amdgcn_cosf(r0); s0 = __builtin_amdgcn_sinf(r0); c1 = __builtin_amdgcn_cosf(r1); s1 = __builtin_amdgcn_sinf(r1); }
        float sq = 0.f, sk = 0.f;
#pragma unroll
        for (int i = 0; i < 12; ++i) { sq += xq[i] * xq[i]; sk += xk[i] * xk[i]; }
        sq += __shfl_xor(sq, 1); sk += __shfl_xor(sk, 1); sq += __shfl_xor(sq, 2); sk += __shfl_xor(sk, 2); sq += __shfl_xor(sq, 4); sk += __shfl_xor(sk, 4);
        const float rq = rsqrtf(sq * (1.f / 96.f) + EPS), rk = rsqrtf(sk * (1.f / 96.f) + EPS);
#pragma unroll
        for (int i = 0; i < 12; ++i) { xq[i] *= rq * gq[i]; xk[i] *= rk * gk[i]; }
        { const float y8 = xq[8] * c0 - xq[9] * s0, y9 = xq[8] * s0 + xq[9] * c0, y10 = xq[10] * c1 - xq[11] * s1, y11 = xq[10] * s1 + xq[11] * c1;
          xq[8] = y8; xq[9] = y9; xq[10] = y10; xq[11] = y11; }
        { const float y8 = xk[8] * c0 - xk[9] * s0, y9 = xk[8] * s0 + xk[9] * c0, y10 = xk[10] * c1 - xk[11] * s1, y11 = xk[10] * s1 + xk[11] * c1;
          xk[8] = y8; xk[9] = y9; xk[10] = y10; xk[11] = y11; }
#pragma unroll
        for (int i = 0; i < 12; ++i) { *(bf16_t*)(wq + (h * 96 + 8 * i + j) * 2) = f2bf(xq[i]); *(bf16_t*)(wk + (h * 96 + 8 * i + j) * 2) = f2bf(xk[i]); }
        __builtin_amdgcn_fence(__ATOMIC_RELEASE, "wavefront"); __builtin_amdgcn_wave_barrier(); __builtin_amdgcn_fence(__ATOMIC_ACQUIRE, "wavefront");
        { const int c0i = lane, c1i = 64 + lane;
          const u32x4 oq0 = *(const u32x4*)(wq + c0i * 16), ok0 = *(const u32x4*)(wk + c0i * 16);
          const size_t d0 = ((size_t)(b * NH + c0i / 12) * TK + pos) * 96 + (c0i % 12) * 8;
          *(u32x4*)(Q + d0) = oq0; *(u32x4*)(Kb + d0) = ok0;
          if (lane < 32) { const u32x4 oq1 = *(const u32x4*)(wq + c1i * 16), ok1 = *(const u32x4*)(wk + c1i * 16);
              const size_t d1 = ((size_t)(b * NH + c1i / 12) * TK + pos) * 96 + (c1i % 12) * 8;
              *(u32x4*)(Q + d1) = oq1; *(u32x4*)(Kb + d1) = ok1; } }
        __builtin_amdgcn_fence(__ATOMIC_RELEASE, "wavefront"); __builtin_amdgcn_wave_barrier(); __builtin_amdgcn_fence(__ATOMIC_ACQUIRE, "wavefront");
    }
}

constexpr int KROW = 208, VROW = 144, KBYTES = 64 * KROW, ABUF = KBYTES + 64 * VROW;
DI void attn_item(unsigned char* lds, const bf16_t* Q, const bf16_t* Kb, const bf16_t* Vt, bf16_t* att, int bh, int qposA, int qposB, int kt0, int kt1, int outrowA, int outrowB, bool writeB) {
    const int tid = TIDX, lane = tid & 63, l31 = lane & 31, half = lane >> 5;
    bf16x8 qa[6], qb[6];
    { const bf16_t* qp = Q + ((size_t)bh * TK + qposA + l31) * 96 + 8 * half; const bf16_t* qq = Q + ((size_t)bh * TK + qposB + l31) * 96 + 8 * half;
#pragma unroll
      for (int ks = 0; ks < 6; ++ks) { qa[ks] = *(const bf16x8*)(qp + 16 * ks); qb[ks] = *(const bf16x8*)(qq + 16 * ks); } }
    f32x16 oa0, oa1, ob0, ob1;
#pragma unroll
    for (int i = 0; i < 16; ++i) { oa0[i] = 0.f; oa1[i] = 0.f; ob0[i] = 0.f; ob1[i] = 0.f; }
    float la = 0.f, lb = 0.f;
    const unsigned char* kg = (const unsigned char*)(Kb + (size_t)bh * TK * 96) + (size_t)tid * 16;
    const unsigned char* vg = (const unsigned char*)(Vt + ((size_t)bh * 64 + (tid >> 3)) * TK) + (tid & 7) * 16;
    const int kc1 = 512 + tid;
    const int koff0 = (tid / 12) * KROW + (tid % 12) * 16, koff1 = (kc1 / 12) * KROW + (kc1 % 12) * 16;
    const int voff = KBYTES + (tid >> 3) * VROW + ((tid & 7) >> 1) * 32 + (tid & 1) * 8;
    const int klo = l31 * KROW + 16 * half, vlo = KBYTES + l31 * VROW + 16 * half;
    u32x4 kr0, kr1 = {0u, 0u, 0u, 0u}, vr;
#define AT_GLOAD(kt) do { kr0 = *(const u32x4*)(kg + (size_t)(kt) * 12288); if (tid < 256) kr1 = *(const u32x4*)(kg + (size_t)(kt) * 12288 + 8192); vr = *(const u32x4*)(vg + (size_t)(kt) * 128); } while (0)
#define AT_SSTORE(stg) do { unsigned char* bp_ = lds + (stg) * ABUF; *(u32x4*)(bp_ + koff0) = kr0; if (tid < 256) *(u32x4*)(bp_ + koff1) = kr1; \
        *(u32x2*)(bp_ + voff) = (u32x2){vr.x, vr.y}; *(u32x2*)(bp_ + voff + 16) = (u32x2){vr.z, vr.w}; } while (0)
#define AT_PK(v, o) (u32x4){pk2(v[o], v[o + 1]), pk2(v[o + 2], v[o + 3]), pk2(v[o + 4], v[o + 5]), pk2(v[o + 6], v[o + 7])}
    AT_GLOAD(kt0); AT_SSTORE(0);
    __syncthreads();
    for (int kt = kt0; kt < kt1; ++kt) {
        const int cur = (kt - kt0) & 1;
        const bool more = kt + 1 < kt1;
        if (more) AT_GLOAD(kt + 1);
        const unsigned char* kl = lds + cur * ABUF + klo;
        const unsigned char* vl = lds + cur * ABUF + vlo;
        f32x16 sa0, sa1, sb0, sb1;
        const f32x16 zero16 = {0.f, 0.f, 0.f, 0.f, 0.f, 0.f, 0.f, 0.f, 0.f, 0.f, 0.f, 0.f, 0.f, 0.f, 0.f, 0.f};
        __builtin_amdgcn_s_setprio(1);
#pragma unroll
        for (int ks = 0; ks < 6; ++ks) {
            const bf16x8 a0 = *(const bf16x8*)(kl + 32 * ks), a1 = *(const bf16x8*)(kl + 32 * KROW + 32 * ks);
            sa0 = __builtin_amdgcn_mfma_f32_32x32x16_bf16(a0, qa[ks], ks == 0 ? zero16 : sa0, 0, 0, 0);
            sa1 = __builtin_amdgcn_mfma_f32_32x32x16_bf16(a1, qa[ks], ks == 0 ? zero16 : sa1, 0, 0, 0);
            sb0 = __builtin_amdgcn_mfma_f32_32x32x16_bf16(a0, qb[ks], ks == 0 ? zero16 : sb0, 0, 0, 0);
            sb1 = __builtin_amdgcn_mfma_f32_32x32x16_bf16(a1, qb[ks], ks == 0 ? zero16 : sb1, 0, 0, 0);
        }
        __builtin_amdgcn_s_setprio(0);
        float pa = 0.f, pb = 0.f;
#pragma unroll
        for (int i = 0; i < 16; ++i) { sa0[i] = __builtin_amdgcn_exp2f(sa0[i]); sa1[i] = __builtin_amdgcn_exp2f(sa1[i]); pa += sa0[i] + sa1[i];
                                       sb0[i] = __builtin_amdgcn_exp2f(sb0[i]); sb1[i] = __builtin_amdgcn_exp2f(sb1[i]); pb += sb0[i] + sb1[i]; }
        la += pa; lb += pb;
        __builtin_amdgcn_s_setprio(1);
#pragma unroll
        for (int s = 0; s < 4; ++s) {
            const bf16x8 v0 = *(const bf16x8*)(vl + 32 * s), v1 = *(const bf16x8*)(vl + 32 * VROW + 32 * s);
            const bf16x8 fa = __builtin_bit_cast(bf16x8, s < 2 ? AT_PK(sa0, 8 * (s & 1)) : AT_PK(sa1, 8 * (s & 1)));
            const bf16x8 fb = __builtin_bit_cast(bf16x8, s < 2 ? AT_PK(sb0, 8 * (s & 1)) : AT_PK(sb1, 8 * (s & 1)));
            oa0 = __builtin_amdgcn_mfma_f32_32x32x16_bf16(v0, fa, oa0, 0, 0, 0); oa1 = __builtin_amdgcn_mfma_f32_32x32x16_bf16(v1, fa, oa1, 0, 0, 0);
            ob0 = __builtin_amdgcn_mfma_f32_32x32x16_bf16(v0, fb, ob0, 0, 0, 0); ob1 = __builtin_amdgcn_mfma_f32_32x32x16_bf16(v1, fb, ob1, 0, 0, 0);
        }
        __builtin_amdgcn_s_setprio(0);
        if (more) AT_SSTORE(cur ^ 1);
        __syncthreads();
    }
#undef AT_GLOAD
#undef AT_SSTORE
#undef AT_PK
    { const float lt = la + __shfl_xor(la, 32), inv = 1.f / lt;
      bf16_t* op = att + (size_t)(outrowA + l31) * 512 + (bh & 7) * 64 + 4 * half;
#pragma unroll
      for (int g = 0; g < 4; ++g) {
          st_bf4(op + 8 * g, (f32x4){oa0[4 * g] * inv, oa0[4 * g + 1] * inv, oa0[4 * g + 2] * inv, oa0[4 * g + 3] * inv});
          st_bf4(op + 32 + 8 * g, (f32x4){oa1[4 * g] * inv, oa1[4 * g + 1] * inv, oa1[4 * g + 2] * inv, oa1[4 * g + 3] * inv}); } }
    if (writeB) { const float lt = lb + __shfl_xor(lb, 32), inv = 1.f / lt;
      bf16_t* op = att + (size_t)(outrowB + l31) * 512 + (bh & 7) * 64 + 4 * half;
#pragma unroll
      for (int g = 0; g < 4; ++g) {
          st_bf4(op + 8 * g, (f32x4){ob0[4 * g] * inv, ob0[4 * g + 1] * inv, ob0[4 * g + 2] * inv, ob0[4 * g + 3] * inv});
          st_bf4(op + 32 + 8 * g, (f32x4){ob1[4 * g] * inv, ob1[4 * g + 1] * inv, ob1[4 * g + 2] * inv, ob1[4 * g + 3] * inv}); } }
}
DI void phase_attn(const Params& p, unsigned char* lds, bool with_ctx) {
    const bf16_t* Q = (const bf16_t*)(p.ws + O_S); const bf16_t* Kb = Q + (size_t)32 * TK * 96; const bf16_t* Vt = Kb + (size_t)32 * TK * 96;
    bf16_t* att = (bf16_t*)p.out;
    const int nitems = 512 + (with_ctx ? 32 : 0);
    for (int it = BIDX; it < nitems; it += gridDim.x) {
        const int wave = TIDX >> 6;
        if (it < 512) {
            const int j = (it >> 3) & 31, bh = (it >> 8) * 16 + (it & 7) * 2 + (j >> 4), q0 = (j & 15) * 512 + wave * 64, r0 = (bh >> 3) * SEQ + q0;
            attn_item(lds, Q, Kb, Vt, att, bh, q0, q0 + 32, 0, TK / 64, r0, r0 + 32, true);
        } else {
            const int bh = it - 512, q0 = SEQ + wave * 32, r0 = ML + (bh >> 3) * CTXL + wave * 32;
            attn_item(lds, Q, Kb, Vt, att, bh, q0, q0, SEQ / 64, TK / 64, r0, r0, false);
        }
    }
}

constexpr int PH_PER_LAYER = 15, N_PHASES = 1 + DEPTH * PH_PER_LAYER;
DI int phase_case(int ph) { const int i = (ph - 1) % PH_PER_LAYER; return i < 3 ? i : (i < 13 ? i + 1 : i + 2); }
DI void run_phase(const Params& p, int ph, unsigned char* smem) {
    LAS unsigned char* lds = (LAS unsigned char*)smem;
    unsigned char* ws = p.ws;
    if (ph == 0) { phase_mod(p, (float*)smem); return; }
    const int l = (ph - 1) / PH_PER_LAYER, s = phase_case(ph);
    const bool last = (l == DEPTH - 1);
    const float* mod = (const float*)(ws + O_MOD) + (size_t)l * 5 * NMOD;
    float* X = (float*)(ws + O_X);
    bf16_t* XNY = (bf16_t*)(ws + O_XNY); bf16_t* H = (bf16_t*)(ws + O_R1); bf16_t* P1 = (bf16_t*)(ws + O_R1); bf16_t* GATE = P1 + (size_t)MA * 768;
    bf16_t* UXY = (bf16_t*)(ws + O_UXY);
    float* SS = (float*)(ws + O_SS); const float* shw = (const float*)(ws + O_SHW);
    const int Mtail = last ? ML : MA;
    switch (s) {
    case 0: phase_prep(p, l, (float*)smem); if (l == 0) phase_norm0(p); break;
    case 1: { ESwiglu E{H, SS, shw}; gemm_phase<ESwiglu, false, true>(lds, Gemm{XNY, (const bf16_t*)(ws + O_WFF1IN), MA, 2 * DFF, DM, DM, DM}, E); } break;
    case 2: { EResid<1, true> E{X, X, mod + 2 * DM, mod + 4 * DM, XNY, SS + (size_t)MA * 16}; gemm_phase<EResid<1, true>, false, true>(lds, Gemm{H, (const bf16_t*)(ws + O_WFF1OUT), MA, DM, DFF, DFF, DFF}, E); }
              { const int nthird = (MA / BM) * (DM / BM) - 2 * (int)gridDim.x, vb = (int)BIDX - nthird; if (nthird > 0 && nthird < (int)gridDim.x && vb >= 0) phase_prep_ff(p, l, 1, (float*)smem, vb, (int)gridDim.x - nthird); else if (nthird <= 0 || nthird >= (int)gridDim.x) phase_prep_ff(p, l, 1, (float*)smem, BIDX, gridDim.x); }
              break;
    case 4: { EWin E{P1, UXY, GATE, SS + (size_t)MA * 16, shw + 5 * 5632}; gemm_phase<EWin, false, true>(lds, Gemm{XNY, (const bf16_t*)(ws + O_WIN), MA, NIN, DM, DM, DM}, E); } break;
    case 5: phase_conv(p, l); break;
    case 6: { bf16_t* OM = (bf16_t*)(ws + O_S); EGate E{XNY, OM, OM + (size_t)2 * MA * 512, (const float*)(ws + O_SP), p.b_rgate + l * 1024, p.b_igate + l * 1024};
              gemm_phase<EGate, true, true>(lds, Gemm{XNY, (const bf16_t*)(ws + O_WGATE), MA, 2048, 256, 512, 256}, E); } break;
    case 7: phase_scan_agg(p); break;
    case 8: phase_scan_apply(p); break;
    case 9: { bf16_t* qraw = (bf16_t*)p.out; bf16_t* kn = qraw + (size_t)MA * 768; bf16_t* Vt = (bf16_t*)(ws + O_S) + (size_t)2 * 32 * TK * 96;
              const float* rsq = (const float*)(ws + O_RSQ); const float* rskv = (const float*)(ws + O_RSKV);
              const bf16_t* wukv = (const bf16_t*)(ws + O_WUKV);
              { EpiElem8<FRowScale> E{{qraw, 768, rsq}}; gemm_phase<EpiElem8<FRowScale>, false, true>(lds, Gemm{P1, (const bf16_t*)(ws + O_WUQ), MA, 768, 384, 768, 384}, E); }
              { EpiElem8<FRowScale> E{{kn, 512, rskv}}; gemm_phase<EpiElem8<FRowScale>, false, true>(lds, Gemm{P1 + 384, wukv, MA, 512, 256, 768, 256, 144}, E); }
              { EpiElem8<FVt> E{{Vt, rskv}}; gemm_phase<EpiElem8<FVt>, false, true>(lds, Gemm{wukv + (size_t)512 * 256, P1 + 384, 512, MA, 256, 256, 768, 152}, E); }
              } break;
    case 10: phase_qk(p, l, smem); break;
    case 11: phase_attn(p, smem, !last); break;
    case 12: { { EpiElem8<FMergeA> E{{GATE, XNY}}; gemm_phase<EpiElem8<FMergeA>, false, true>(lds, Gemm{(const bf16_t*)p.out, (const bf16_t*)(ws + O_WOA), Mtail, DM, 512, 512, 512}, E); }
               { EpiElem8<FMergeB> E{{GATE, XNY}}; gemm_phase<EpiElem8<FMergeB>, false, true>(lds, Gemm{UXY, (const bf16_t*)(ws + O_WOL), Mtail, DM, 512, 1024, 512}, E); } } break;
    case 13: { EResid<2, true> E{X, X, mod + 5 * DM, mod + 7 * DM, UXY, SS + (size_t)2 * MA * 16}; gemm_phase<EResid<2, true>, false, true>(lds, Gemm{XNY, (const bf16_t*)(ws + O_WOUT), Mtail, DM, DM, DM, DM}, E); } break;
    case 15: { ESwiglu E{H, SS + (size_t)2 * MA * 16, shw + 2 * 5 * 5632}; gemm_phase<ESwiglu, false, true>(lds, Gemm{UXY, (const bf16_t*)(ws + O_WFF2IN), Mtail, 2 * DFF, DM, DM, DM}, E); } break;
    case 16: if (last) { EResid<1, false> E{X, p.out, mod + 8 * DM, nullptr, nullptr, nullptr}; gemm_phase<EResid<1, false>, false, true>(lds, Gemm{H, (const bf16_t*)(ws + O_WFF2OUT), Mtail, DM, DFF, DFF, DFF}, E); }
             else { EResid<1, true> E{X, X, mod + 8 * DM, mod + 5 * NMOD + DM, XNY, SS}; gemm_phase<EResid<1, true>, false, true>(lds, Gemm{H, (const bf16_t*)(ws + O_WFF2OUT), Mtail, DM, DFF, DFF, DFF}, E); }
             if (!last) { const int nthird = (MA / BM) * (DM / BM) - 2 * (int)gridDim.x, vb = (int)BIDX - nthird; if (nthird > 0 && nthird < (int)gridDim.x && vb >= 0) phase_prep_ff(p, l + 1, 0, (float*)smem, vb, (int)gridDim.x - nthird); else if (nthird <= 0 || nthird >= (int)gridDim.x) phase_prep_ff(p, l + 1, 0, (float*)smem, BIDX, gridDim.x); }
             break;
    }
}

#ifndef PROBE_MASK
#define PROBE_MASK 0u
#endif
#define XB_TMO      128
#define XB_XCNT(j)  (256  + 64 * (j))
#define XB_XSUB(j)  (1280 + 64 * (j))
#define XB_XGEN(j)  (2304 + 64 * (j))
#define XB_TOP      3328
#define XB_TOPGEN   3392
#define XCD_BAR_WORDS 3456
#define XB_SPIN_CAP (1u << 18)
DI unsigned xb_ld(unsigned* p)              { return __hip_atomic_load(p, __ATOMIC_RELAXED, __HIP_MEMORY_SCOPE_AGENT); }
DI unsigned xb_add(unsigned* p, unsigned v) { return __hip_atomic_fetch_add(p, v, __ATOMIC_RELAXED, __HIP_MEMORY_SCOPE_AGENT); }
DI unsigned xb_xcc_id() { return (unsigned)__builtin_amdgcn_s_getreg((3 << 11) | 20) & 0xFu; }
#define XB_SPIN(cond, bar) do { unsigned _sp = 0; while (cond) { __builtin_amdgcn_s_sleep(1); \
    if ((++_sp & 255u) == 0u) { if (xb_ld(&(bar)[XB_TMO])) break; if (_sp > XB_SPIN_CAP) { atomicAdd(&(bar)[XB_TMO], 1u); break; } } } } while (0)
struct XcdBarrier { unsigned* bar; unsigned x; volatile LAS unsigned* st; };
DI XcdBarrier xcd_barrier_post(unsigned* bar, volatile LAS unsigned* st) {
    XcdBarrier b; b.bar = bar; b.x = xb_xcc_id(); b.st = st;
    if (threadIdx.x == 0) (void)xb_add(&bar[XB_XCNT(b.x)], 1u);
    return b;
}
DI void xcd_barrier_complete(unsigned* bar, unsigned x, unsigned& nloc, unsigned& nx) {
    const unsigned G = gridDim.x * gridDim.y * gridDim.z;
    unsigned sum, cnt, mine, sp = 0u;
    for (;;) {
        sum = 0u; cnt = 0u; mine = 0u;
#pragma unroll
        for (unsigned j = 0; j < 16; ++j) { const unsigned c = xb_ld(&bar[XB_XCNT(j)]); sum += c; cnt += (c > 0u) ? 1u : 0u; mine = (j == x) ? c : mine; }
        if (sum == G) break;
        __builtin_amdgcn_s_sleep(1);
        if ((++sp & 255u) == 0u) { if (xb_ld(&bar[XB_TMO])) break; if (sp > XB_SPIN_CAP) { atomicAdd(&bar[XB_TMO], 1u); break; } }
    }
    nloc = mine > 0u ? mine : 1u; nx = cnt > 0u ? cnt : 1u;
}
DI void xcd_barrier(const XcdBarrier& b) {
    asm volatile("s_waitcnt vmcnt(0)" ::: "memory");
    __syncthreads();
    if (threadIdx.x == 0) {
        unsigned* bar = b.bar;
        __builtin_amdgcn_s_waitcnt(0);
        unsigned nloc = b.st[0], nx = b.st[1];
        if (nloc == 0u) { xcd_barrier_complete(bar, b.x, nloc, nx); b.st[0] = nloc; b.st[1] = nx; }
        const unsigned old = xb_add(&bar[XB_XSUB(b.x)], 1u);
        const unsigned gen = old / nloc;
        if (old + 1u == (gen + 1u) * nloc) {
            __builtin_amdgcn_fence(__ATOMIC_RELEASE, "agent");
            asm volatile("s_waitcnt vmcnt(0)" ::: "memory");
            const unsigned og = xb_add(&bar[XB_TOP], 1u);
            const unsigned tg = og / nx;
            if (og + 1u == (tg + 1u) * nx) xb_add(&bar[XB_TOPGEN], 1u);
            else XB_SPIN(xb_ld(&bar[XB_TOPGEN]) == tg, bar);
            __builtin_amdgcn_fence(__ATOMIC_ACQUIRE, "agent");
            xb_add(&bar[XB_XGEN(b.x)], 1u);
            asm volatile("s_waitcnt vmcnt(0)" ::: "memory");
        } else {
            XB_SPIN(xb_ld(&bar[XB_XGEN(b.x)]) == gen, bar);
            __builtin_amdgcn_fence(__ATOMIC_ACQUIRE, "agent");
            asm volatile("s_waitcnt vmcnt(0)" ::: "memory");
        }
    }
    __syncthreads();
}
__global__ void __launch_bounds__(512) mega(Params p) {
    extern __shared__ __attribute__((aligned(16))) unsigned char smem[];
    __shared__ uint4 xb_words;
    cg::grid_group grid = cg::this_grid();
    if (threadIdx.x == 0) xb_words = make_uint4(0u, 0u, 0u, 0u);
    __syncthreads();
    const XcdBarrier xb = xcd_barrier_post((unsigned*)(p.ws + O_BAR), (volatile LAS unsigned*)&xb_words);
    unsigned long long tsel = 0;
    for (int ph = p.ph_lo; ph < p.ph_hi; ++ph) {
        const unsigned long long t0 = PROBE_MASK ? wall_clock64() : 0ull;
        run_phase(p, ph, smem);
        if (p.coop && ph + 1 < p.ph_hi) { if (ph == 0) grid.sync(); else xcd_barrier(xb); }
        if (PROBE_MASK) { const int sidx = ph == 0 ? 17 : phase_case(ph); if ((PROBE_MASK >> sidx) & 1u) tsel += wall_clock64() - t0; }
    }
    if (PROBE_MASK && blockIdx.x == 0) { const unsigned long long t0 = wall_clock64(); while (wall_clock64() - t0 < tsel) __builtin_amdgcn_s_sleep(64); }
}

extern "C" void kernel_launch(void* const* d_in, const int* in_sizes, int n_in, void* d_out, int out_size, void* d_ws, size_t ws_size, hipStream_t stream) {
    static int grid = 0;
    if (grid == 0) {
        if (n_in != 27 || ws_size < WS_END) { fprintf(stderr, "kernel_launch: need 27 inputs and %zu bytes of workspace; got %d, %zu\n", (size_t)WS_END, n_in, ws_size); grid = -1; return; }
        int dev = 0, cus = 0, per_cu = 0;
        hipGetDevice(&dev); hipDeviceGetAttribute(&cus, hipDeviceAttributeMultiprocessorCount, dev);
        if (hipFuncSetAttribute((const void*)mega, hipFuncAttributeMaxDynamicSharedMemorySize, LDS_BYTES) != hipSuccess) { fprintf(stderr, "kernel_launch: hipFuncSetAttribute failed\n"); grid = -1; return; }
        if (hipOccupancyMaxActiveBlocksPerMultiprocessor(&per_cu, (const void*)mega, 512, LDS_BYTES) != hipSuccess || per_cu < 1) { fprintf(stderr, "kernel_launch: occupancy query gave %d\n", per_cu); per_cu = 1; }
        (void)hipGetLastError();
        grid = cus;
    }
    if (grid < 0) return;
    Params p{};
    const float** pp = (const float**)&p;
    for (int i = 0; i < 27; ++i) pp[i] = (const float*)d_in[i];
    p.out = (float*)d_out; p.ws = (unsigned char*)d_ws; p.ph_lo = 0; p.ph_hi = N_PHASES; p.coop = 1; p.pad = 0;
    (void)hipMemsetAsync((unsigned char*)d_ws + O_BAR, 0, XCD_BAR_WORDS * 4, stream);
    void* args[] = {&p};
    hipError_t e = hipLaunchCooperativeKernel((const void*)mega, dim3(grid), dim3(512), args, LDS_BYTES, stream);
    if (e != hipSuccess) {
        fprintf(stderr, "cooperative launch failed: %s (grid %d); falling back to one launch per phase\n", hipGetErrorString(e), grid);
        (void)hipGetLastError();
        p.coop = 0;
        for (int ph = 0; ph < N_PHASES; ++ph) { p.ph_lo = ph; p.ph_hi = ph + 1; hipLaunchKernelGGL(mega, dim3(grid), dim3(512), LDS_BYTES, stream, p); }
    }
}
```

```cpp
#include <hip/hip_runtime.h>
#include <hip/hip_cooperative_groups.h>
#include <cstdio>
namespace cg = cooperative_groups;

#define DI __device__ __forceinline__
#define LAS __attribute__((address_space(3)))
typedef unsigned short bf16_t;
typedef short bf16x8 __attribute__((ext_vector_type(8)));
typedef float f32x2 __attribute__((ext_vector_type(2)));
typedef float f32x4 __attribute__((ext_vector_type(4)));
typedef float f32x16 __attribute__((ext_vector_type(16)));
typedef unsigned u32x2 __attribute__((ext_vector_type(2)));
typedef unsigned u32x4 __attribute__((ext_vector_type(4)));
typedef __bf16 bfv2 __attribute__((ext_vector_type(2)));

constexpr int DM = 1024, NB = 4, SEQ = 8192, CTXL = 256, DEPTH = 4;
constexpr int ML = NB * SEQ, MC = NB * CTXL, MA = ML + MC;
constexpr int DFF = 2816, NH = 8, TK = SEQ + CTXL;
constexpr int NIN = 3840;
constexpr int NMOD = 9 * DM;
constexpr float EPS = 1e-6f;
constexpr float QSCALE = 0.10206207261596577f * 1.4426950408889634f;
constexpr int NCH = 132;

constexpr size_t SZ_FFIN = (size_t)2 * DFF * DM * 2, SZ_FFOUT = (size_t)DM * DFF * 2;
constexpr size_t O_WFF1IN = 0;
constexpr size_t O_WFF1OUT = O_WFF1IN + SZ_FFIN;
constexpr size_t O_WFF2IN = O_WFF1OUT + SZ_FFOUT;
constexpr size_t O_WFF2OUT = O_WFF2IN + SZ_FFIN;
constexpr size_t O_WIN = O_WFF2OUT + SZ_FFOUT;
constexpr size_t O_WUQ = O_WIN + (size_t)NIN * DM * 2;
constexpr size_t O_WUKV = O_WUQ + (size_t)768 * 384 * 2;
constexpr size_t O_WOA = O_WUKV + (size_t)1024 * 256 * 2;
constexpr size_t O_WOL = O_WOA + (size_t)1024 * 512 * 2;
constexpr size_t O_WOUT = O_WOL + (size_t)1024 * 512 * 2;
constexpr size_t O_WGATE = O_WOUT + (size_t)1024 * 1024 * 2;
constexpr size_t O_MOD = O_WGATE + (size_t)2048 * 256 * 2;
constexpr size_t O_RSQ = O_MOD + (size_t)DEPTH * 5 * NMOD * 4;
constexpr size_t O_RSKV = O_RSQ + (size_t)MA * 4;
constexpr size_t O_AGG = O_RSKV + (size_t)MA * 4;
constexpr size_t O_SP = O_AGG + (size_t)2 * NB * NCH * 512 * 8;
constexpr size_t O_BAR = O_SP + 4096;
constexpr size_t O_SS = O_BAR + 16384;
constexpr size_t O_SHW = O_SS + (size_t)3 * MA * 16 * 4;
constexpr size_t O_X = O_SHW + (size_t)3 * 5 * 5632 * 4;
constexpr size_t O_R1 = O_X + (size_t)MA * DM * 4;
constexpr size_t O_UXY = O_R1 + (size_t)MA * DFF * 2;
constexpr size_t O_XNY = O_UXY + (size_t)MA * 1024 * 2;
constexpr size_t O_S = O_XNY + (size_t)MA * 1024 * 2;
constexpr size_t WS_END = O_S + (size_t)MA * 1024 * 4;
constexpr int LDS_BYTES = 131072;

struct Params {
    const float *x, *c, *ctx, *c_ctx, *w_ada, *b_ada, *ff1_w_in, *ff1_w_out, *ff2_w_in, *ff2_w_out, *w_in, *q_a_norm, *w_uq, *kv_a_norm, *w_ukv, *q_norm, *k_norm,
        *conv_w, *conv_b, *lru_lambda, *w_rgate, *b_rgate, *w_igate, *b_igate, *w_o_attn, *w_o_lru, *w_out;
    float* out; unsigned char* ws;
    int ph_lo, ph_hi, coop, pad;
};

DI int tidx_() { int t = threadIdx.x; asm volatile("" : "+v"(t)); return t; }
DI int bidx_() { int t = blockIdx.x; asm volatile("" : "+s"(t)); return t; }
#define TIDX tidx_()
#define BIDX bidx_()
DI unsigned pk2(float lo, float hi) { f32x2 v = {lo, hi}; bfv2 r = __builtin_convertvector(v, bfv2); return __builtin_bit_cast(unsigned, r); }
DI bf16_t f2bf(float x) { return (bf16_t)(pk2(x, 0.f) & 0xffffu); }
DI float bf2f(bf16_t v) { return __uint_as_float((unsigned)v << 16); }
DI float bflo(unsigned v) { return __uint_as_float(v << 16); }
DI float bfhi(unsigned v) { return __uint_as_float(v & 0xffff0000u); }
DI float wave_sum(float v) {
#pragma unroll
    for (int o = 1; o < 64; o <<= 1) v += __shfl_xor(v, o);
    return v;
}
DI float sigmoidf_(float x) { return __builtin_amdgcn_rcpf(1.f + __expf(-x)); }
DI int mod_row(int row) { return row < ML ? (row >> 13) : 4; }
DI float row_rstd(const float* SSP, int row) {
    const f32x4* q = (const f32x4*)(SSP + (size_t)row * 16); const f32x4 a = q[0], b = q[1], c = q[2], d = q[3];
    const float s = ((a[0] + a[1]) + (a[2] + a[3])) + ((b[0] + b[1]) + (b[2] + b[3])) + ((c[0] + c[1]) + (c[2] + c[3])) + ((d[0] + d[1]) + (d[2] + d[3]));
    return __builtin_amdgcn_rsqf(s * (1.f / DM) + EPS);
}

constexpr int BM = 256, BK = 64, HALF = 128, HTB = HALF * BK * 2, NXCD = 8, WGM = 8;
DI int lds_byte(int r, int c) { const int st = (r >> 4) * 2 + (c >> 5), rr = r & 15, cc = c & 31, ob = rr * 64 + cc * 2; return st * 1024 + (ob ^ (((ob >> 9) & 1) << 5)); }
DI void stage_rc(int b, int& R, int& C) { const int st = b / 1024, sb = b % 1024, swz = sb ^ (((sb >> 9) & 1) << 5); R = (st >> 1) * 16 + swz / 64; C = (st & 1) * 32 + (swz % 64) / 2; }
struct Unit { int pm, pn; };
struct Gemm { const bf16_t* A; const bf16_t* Bt; int M, N, K, lda, ldb; int rot = 0; };
struct StaticOrder {
    int nM, nN, nwg, G, c;
    DI void init(int M, int N, int G_, int c_) { nM = M / BM; nN = N / BM; nwg = nM * nN; G = G_; c = c_; }
    DI bool next(int i, Unit& u) const {
        const long L = (long)i * G + c; if (L >= nwg) return false;
        int wgid = (int)L; { const int q = nwg / NXCD, r = nwg % NXCD, xcd = wgid % NXCD, off = wgid / NXCD; wgid = (xcd < r ? xcd * (q + 1) : r * (q + 1) + (xcd - r) * q) + off; }
        const int nig = WGM * nN, gid = wgid / nig, fm = gid * WGM, gsz = (nM - fm) < WGM ? (nM - fm) : WGM;
        u.pm = fm + ((wgid % nig) % gsz); u.pn = (wgid % nig) / gsz; return true;
    }
};

DI int perm32(int rho) { const int n = rho >> 4, i = rho & 15; return 8 * (i >> 2) + 4 * n + (i & 3); }
template <class Epi, bool GATE_A, bool PERM = false>
DI void gemm_phase(LAS unsigned char* lds, const Gemm g, const Epi& E) {
    const int tid = TIDX, wid = __builtin_amdgcn_readfirstlane(tid >> 6), lane = tid & 63, wr = wid >> 2, wc = wid & 3, fr = lane & 15, fq = lane >> 4;
    const int K = g.K, nt = K / BK;
    StaticOrder S; S.init(g.M, g.N, gridDim.x, (BIDX - g.rot + (int)gridDim.x) % (int)gridDim.x);
    unsigned voffA[2], voffB[2];
#pragma unroll
    for (int i = 0; i < 2; ++i) { int R, C; stage_rc(tid * 16 + i * 8192, R, C); const int Rb = PERM ? ((R & ~31) + perm32(R & 31)) : R; voffA[i] = (unsigned)(R * g.lda + C) * 2u; voffB[i] = (unsigned)(Rb * g.ldb + C) * 2u; }
#pragma unroll
    for (int i = 0; i < 2; ++i) { asm volatile("" : "+v"(voffA[i])); asm volatile("" : "+v"(voffB[i])); }
    const size_t kstep = (size_t)(BK * 2);
    const size_t hstepA = (size_t)HALF * g.lda * 2, hstepB = (size_t)HALF * g.ldb * 2;
    const size_t tstepA = 2 * hstepA, tstepB = 2 * hstepB;
    const unsigned ldsw = (unsigned)wid * 1024u;
    const int aoff = lds_byte(wr * 64 + fr, fq * 8), boff = lds_byte(wc * 32 + fr, fq * 8);
#define PG8_SA(b, h) (((b) * 2 + (h)) * HTB)
#define PG8_SB(b, h) ((4 + (b) * 2 + (h)) * HTB)
#define PG8_STAGE(bufoff, gbase, voff) do { _Pragma("unroll") for (int _i = 0; _i < 2; ++_i) \
        __builtin_amdgcn_global_load_lds((const unsigned*)((const char*)(gbase) + (voff)[_i]), (LAS unsigned*)(lds + (bufoff) + ldsw + _i * 8192), 16, 0, 0); } while (0)
#define PG8_LDA(dst, b, h) do { _Pragma("unroll") for (int m = 0; m < 4; ++m) _Pragma("unroll") for (int k = 0; k < 2; ++k) dst[m][k] = *(const LAS bf16x8*)(lds + PG8_SA(b, h) + aoff + m * 2048 + k * 1024); } while (0)
#define PG8_LDB(dst, b, h) do { _Pragma("unroll") for (int n = 0; n < 2; ++n) _Pragma("unroll") for (int k = 0; k < 2; ++k) dst[n][k] = *(const LAS bf16x8*)(lds + PG8_SB(b, h) + boff + n * 2048 + k * 1024); } while (0)
#define PG8_MMA(ai, bj, At, Bt) do { __builtin_amdgcn_s_setprio(1); _Pragma("unroll") for (int m = 0; m < 4; ++m) _Pragma("unroll") for (int n = 0; n < 2; ++n) _Pragma("unroll") for (int k = 0; k < 2; ++k) \
        acc[ai][bj][m][n] = __builtin_amdgcn_mfma_f32_16x16x32_bf16(Bt[n][k], At[m][k], acc[ai][bj][m][n], 0, 0, 0); __builtin_amdgcn_s_setprio(0); } while (0)
#define PG8_WAIT_V(n) asm volatile("s_waitcnt vmcnt(" #n ")" ::: "memory")
#define PG8_WAIT_L(n) asm volatile("s_waitcnt lgkmcnt(" #n ")" ::: "memory")
#define PG8_BAR __builtin_amdgcn_s_barrier()
#define PG8_SCHED __builtin_amdgcn_sched_barrier(0)
#define PG8_ABASE(u) ((const char*)g.A + (size_t)(u).pm * tstepA + (GATE_A ? (size_t)((((u).pn & 3) >> 1) * 512) : (size_t)0))
    Unit cur, nxt; int ui = 0;
    if (!S.next(0, cur)) return;
    f32x4 acc[2][2][4][2];
#pragma unroll
    for (int a = 0; a < 2; ++a)
#pragma unroll
        for (int b = 0; b < 2; ++b)
#pragma unroll
            for (int m = 0; m < 4; ++m)
#pragma unroll
                for (int n = 0; n < 2; ++n) acc[a][b][m][n] = (f32x4){0.f, 0.f, 0.f, 0.f};
    bf16x8 At[4][2], B0[2][2], B1[2][2];
    const char* cA = PG8_ABASE(cur); const char* cB = (const char*)g.Bt + (size_t)cur.pn * tstepB;
    PG8_STAGE(PG8_SB(0, 0), cB, voffB); PG8_STAGE(PG8_SA(0, 0), cA, voffA); PG8_STAGE(PG8_SB(0, 1), cB + hstepB, voffB); PG8_STAGE(PG8_SA(0, 1), cA + hstepA, voffA);
    if (wr == 1) PG8_BAR;
    PG8_WAIT_V(4); PG8_BAR;
    PG8_STAGE(PG8_SB(1, 0), cB + kstep, voffB); PG8_STAGE(PG8_SA(1, 0), cA + kstep, voffA); PG8_STAGE(PG8_SB(1, 1), cB + hstepB + kstep, voffB);
    PG8_WAIT_V(6); PG8_BAR;
    for (;;) {
        const bool has_next = S.next(ui + 1, nxt);
        const char* nA = has_next ? PG8_ABASE(nxt) : cA; const char* nB = has_next ? (const char*)g.Bt + (size_t)nxt.pn * tstepB : cB;
#pragma nounroll
        for (int t = 0; t < nt; t += 2) {
            const bool last = (t == nt - 2);
            const char* a1 = cA + (size_t)(t + 1) * kstep;
            const char* a2 = last ? nA : cA + (size_t)(t + 2) * kstep; const char* b2 = last ? nB : cB + (size_t)(t + 2) * kstep;
            const char* a3 = a2 + kstep; const char* b3 = b2 + kstep;
            PG8_LDB(B0, 0, 0); PG8_SCHED; PG8_LDA(At, 0, 0); PG8_STAGE(PG8_SA(1, 1), a1 + hstepA, voffA);
            PG8_WAIT_L(8); PG8_BAR; PG8_WAIT_L(0); PG8_MMA(0, 0, At, B0); PG8_BAR; PG8_SCHED;
            PG8_LDB(B1, 0, 1); PG8_STAGE(PG8_SB(0, 0), b2, voffB);
            PG8_BAR; PG8_WAIT_L(0); PG8_MMA(0, 1, At, B1); PG8_BAR;
            PG8_LDA(At, 0, 1); PG8_STAGE(PG8_SA(0, 0), a2, voffA);
            PG8_BAR; PG8_WAIT_L(0); PG8_MMA(1, 0, At, B0); PG8_BAR; PG8_SCHED;
            PG8_STAGE(PG8_SB(0, 1), b2 + hstepB, voffB);
            PG8_WAIT_V(6); PG8_BAR; PG8_MMA(1, 1, At, B1); PG8_BAR;
            PG8_LDB(B0, 1, 0); PG8_SCHED; PG8_LDA(At, 1, 0); PG8_STAGE(PG8_SA(0, 1), a2 + hstepA, voffA);
            PG8_WAIT_L(8); PG8_BAR; PG8_WAIT_L(0); PG8_MMA(0, 0, At, B0); PG8_BAR; PG8_SCHED;
            PG8_LDB(B1, 1, 1); PG8_STAGE(PG8_SB(1, 0), b3, voffB);
            PG8_BAR; PG8_WAIT_L(0); PG8_MMA(0, 1, At, B1); PG8_BAR;
            PG8_LDA(At, 1, 1); PG8_STAGE(PG8_SA(1, 0), a3, voffA);
            PG8_BAR; PG8_WAIT_L(0); PG8_MMA(1, 0, At, B0); PG8_BAR; PG8_SCHED;
            PG8_STAGE(PG8_SB(1, 1), b3 + hstepB, voffB);
            PG8_WAIT_V(6); PG8_BAR; PG8_MMA(1, 1, At, B1); PG8_BAR;
        }
        E(acc, cur, wr, wc, fr, fq);
        if (!has_next) break;
#pragma unroll
        for (int a = 0; a < 2; ++a)
#pragma unroll
            for (int b = 0; b < 2; ++b)
#pragma unroll
                for (int m = 0; m < 4; ++m)
#pragma unroll
                    for (int n = 0; n < 2; ++n) acc[a][b][m][n] = (f32x4){0.f, 0.f, 0.f, 0.f};
        cur = nxt; cA = nA; cB = nB; ++ui;
    }
    PG8_WAIT_V(0);
    if (wr == 0) PG8_BAR;
    PG8_BAR;
#undef PG8_SA
#undef PG8_SB
#undef PG8_STAGE
#undef PG8_LDA
#undef PG8_LDB
#undef PG8_MMA
#undef PG8_WAIT_V
#undef PG8_WAIT_L
#undef PG8_BAR
#undef PG8_SCHED
#undef PG8_ABASE
}

DI float row_rstd4(const float* SSP, int row, int fq) {
    const f32x4 a = *(const f32x4*)(SSP + (size_t)row * 16 + 4 * fq);
    float s = (a[0] + a[1]) + (a[2] + a[3]); s += __shfl_xor(s, 16); s += __shfl_xor(s, 32);
    return __builtin_amdgcn_rsqf(s * (1.f / DM) + EPS);
}
template <class F> struct EpiElem {
    F f;
    DI void operator()(const f32x4 (&acc)[2][2][4][2], const Unit& u, int wr, int wc, int fr, int fq) const {
        const int row0 = u.pm * BM + wr * 64 + fr, col0 = u.pn * BM + wc * 32 + 4 * fq;
#pragma unroll
        for (int ai = 0; ai < 2; ++ai)
#pragma unroll
            for (int m = 0; m < 4; ++m)
#pragma unroll
                for (int bj = 0; bj < 2; ++bj)
#pragma unroll
                    for (int n = 0; n < 2; ++n) { f(row0 + ai * HALF + m * 16, col0 + bj * HALF + n * 16, acc[ai][bj][m][n]); }
    }
};
template <class F> struct EpiElemRow {
    F f;
    DI void operator()(const f32x4 (&acc)[2][2][4][2], const Unit& u, int wr, int wc, int fr, int fq) const {
        const int row0 = u.pm * BM + wr * 64 + fr, col0 = u.pn * BM + wc * 32 + 4 * fq;
#pragma unroll
        for (int ai = 0; ai < 2; ++ai)
#pragma unroll
            for (int m = 0; m < 4; ++m) {
                float ssq = 0.f;
#pragma unroll
                for (int bj = 0; bj < 2; ++bj)
#pragma unroll
                    for (int n = 0; n < 2; ++n) { ssq += f(row0 + ai * HALF + m * 16, col0 + bj * HALF + n * 16, acc[ai][bj][m][n]); }
                ssq += __shfl_xor(ssq, 16); ssq += __shfl_xor(ssq, 32);
                if (fq == 0) f.row(row0 + ai * HALF + m * 16, (u.pn & 3) * 4 + wc, ssq);
            }
    }
};
template <class F> struct EpiElemRS {
    F f;
    DI void operator()(const f32x4 (&acc)[2][2][4][2], const Unit& u, int wr, int wc, int fr, int fq) const {
        const int row0 = u.pm * BM + wr * 64 + fr, col0 = u.pn * BM + wc * 32 + 4 * fq;
#pragma unroll
        for (int ai = 0; ai < 2; ++ai)
#pragma unroll
            for (int m = 0; m < 4; ++m) {
                const float rs = f.rs(row0 + ai * HALF + m * 16);
#pragma unroll
                for (int bj = 0; bj < 2; ++bj)
#pragma unroll
                    for (int n = 0; n < 2; ++n) { f(row0 + ai * HALF + m * 16, col0 + bj * HALF + n * 16, acc[ai][bj][m][n], rs); }
            }
    }
};
template <class F> struct EpiPairRS {
    F f;
    DI void operator()(const f32x4 (&acc)[2][2][4][2], const Unit& u, int wr, int wc, int fr, int fq) const {
        const int row0 = u.pm * BM + wr * 64 + fr, c0 = wc * 32 + 4 * fq;
#pragma unroll
        for (int ai = 0; ai < 2; ++ai)
#pragma unroll
            for (int m = 0; m < 4; ++m) {
                const float rs = f.rs(row0 + ai * HALF + m * 16);
#pragma unroll
                for (int n = 0; n < 2; ++n) { f(row0 + ai * HALF + m * 16, u.pn, c0 + n * 16, acc[ai][0][m][n], acc[ai][1][m][n], rs); }
            }
    }
};
template <class F> struct EpiElem2 {
    F f;
    DI void operator()(const f32x4 (&acc)[2][2][4][2], const Unit& u, int wr, int wc, int fr, int fq) const {
        const int row0 = u.pm * BM + wr * 64 + fr, col0 = u.pn * BM + wc * 32 + 4 * fq;
        typename F::L cur[2][2], nxt[2][2];
#pragma unroll
        for (int bj = 0; bj < 2; ++bj)
#pragma unroll
            for (int n = 0; n < 2; ++n) cur[bj][n] = f.load(row0, col0 + bj * HALF + n * 16);
#pragma unroll
        for (int i = 0; i < 8; ++i) {
            const int row = row0 + (i >> 2) * HALF + (i & 3) * 16;
            if (i < 7) { const int rown = row0 + ((i + 1) >> 2) * HALF + ((i + 1) & 3) * 16;
#pragma unroll
                for (int bj = 0; bj < 2; ++bj)
#pragma unroll
                    for (int n = 0; n < 2; ++n) nxt[bj][n] = f.load(rown, col0 + bj * HALF + n * 16); }
#pragma unroll
            for (int bj = 0; bj < 2; ++bj)
#pragma unroll
                for (int n = 0; n < 2; ++n) f.apply(row, col0 + bj * HALF + n * 16, acc[i >> 2][bj][i & 3][n], cur[bj][n]);
#pragma unroll
            for (int bj = 0; bj < 2; ++bj)
#pragma unroll
                for (int n = 0; n < 2; ++n) cur[bj][n] = nxt[bj][n];
        }
    }
};
template <class F> struct EpiElem8 {
    F f;
    DI void operator()(const f32x4 (&acc)[2][2][4][2], const Unit& u, int wr, int wc, int fr, int fq) const {
        const int row0 = u.pm * BM + wr * 64 + fr, col0 = u.pn * BM + wc * 32 + 8 * fq;
        typename F::L cur[2], nxt[2];
#pragma unroll
        for (int bj = 0; bj < 2; ++bj) cur[bj] = f.load(row0, col0 + bj * HALF);
#pragma unroll
        for (int i = 0; i < 8; ++i) {
            const int row = row0 + (i >> 2) * HALF + (i & 3) * 16;
            if (i < 7) { const int rown = row0 + ((i + 1) >> 2) * HALF + ((i + 1) & 3) * 16;
#pragma unroll
                for (int bj = 0; bj < 2; ++bj) nxt[bj] = f.load(rown, col0 + bj * HALF); }
#pragma unroll
            for (int bj = 0; bj < 2; ++bj) f.apply(row, col0 + bj * HALF, acc[i >> 2][bj][i & 3][0], acc[i >> 2][bj][i & 3][1], cur[bj]);
#pragma unroll
            for (int bj = 0; bj < 2; ++bj) cur[bj] = nxt[bj];
        }
    }
};
template <class F> struct EpiPair {
    F f;
    DI void operator()(const f32x4 (&acc)[2][2][4][2], const Unit& u, int wr, int wc, int fr, int fq) const {
        const int row0 = u.pm * BM + wr * 64 + fr, c0 = wc * 32 + 4 * fq;
#pragma unroll
        for (int ai = 0; ai < 2; ++ai)
#pragma unroll
            for (int m = 0; m < 4; ++m)
#pragma unroll
                for (int n = 0; n < 2; ++n) { f(row0 + ai * HALF + m * 16, u.pn, c0 + n * 16, acc[ai][0][m][n], acc[ai][1][m][n]); }
    }
};
DI void st_bf4(bf16_t* p, f32x4 v) { u32x2 o; o.x = pk2(v[0], v[1]); o.y = pk2(v[2], v[3]); *(u32x2*)p = o; }
DI void st_bf8(bf16_t* p, f32x4 lo, f32x4 hi) { u32x4 o; o.x = pk2(lo[0], lo[1]); o.y = pk2(lo[2], lo[3]); o.z = pk2(hi[0], hi[1]); o.w = pk2(hi[2], hi[3]); *(u32x4*)p = o; }

struct FSwiglu { bf16_t* H; const float* SS; const float* shw;
    DI float rs(int row) const { return row_rstd(SS, row); }
    DI void operator()(int row, int pn, int c, f32x4 g, f32x4 u, float rs) const {
        const float* sw = shw + mod_row(row) * 5632 + pn * 256 + c;
        g = g * rs + *(const f32x4*)sw; u = u * rs + *(const f32x4*)(sw + 128);
        f32x4 h;
#pragma unroll
        for (int e = 0; e < 4; ++e) h[e] = g[e] * sigmoidf_(g[e]) * u[e];
        st_bf4(H + (size_t)row * DFF + pn * 128 + c, h);
    } };
struct FResid { const float* src; float* dst; const float* mod; float coef;
    DI void operator()(int row, int col, f32x4 v) const {
        const f32x4 g = *(const f32x4*)(mod + mod_row(row) * NMOD + col);
        const f32x4 x = *(const f32x4*)(src + (size_t)row * DM + col);
        *(f32x4*)(dst + (size_t)row * DM + col) = x + coef * g * v;
    } };
template <int COEF2> struct FResidN { const float* src; float* dst; const float* mod; const float* scn; bf16_t* XS; float* SS;
    DI float operator()(int row, int col, f32x4 v) const {
        const int r = mod_row(row);
        const f32x4 g = *(const f32x4*)(mod + r * NMOD + col);
        const f32x4 x = *(const f32x4*)(src + (size_t)row * DM + col);
        const f32x4 xn = x + (0.5f * COEF2) * g * v;
        *(f32x4*)(dst + (size_t)row * DM + col) = xn;
        const f32x4 sc = *(const f32x4*)(scn + r * NMOD + col);
        st_bf4(XS + (size_t)row * DM + col, xn * (1.f + sc));
        return (xn[0] * xn[0] + xn[1] * xn[1]) + (xn[2] * xn[2] + xn[3] * xn[3]);
    }
    DI void row(int row, int slot, float ssq) const { SS[(size_t)row * 16 + slot] = ssq; } };
struct FWin { bf16_t *P1, *UXY, *GATE; const float* SS; const float* shw;
    DI float rs(int row) const { return row_rstd(SS, row); }
    DI void operator()(int row, int col, f32x4 v, float rs) const {
        v = v * rs + *(const f32x4*)(shw + mod_row(row) * 5632 + col);
        bf16_t* p = col < 768 ? P1 + (size_t)row * 768 + col : (col < 1792 ? UXY + (size_t)row * 1024 + (col - 768) : GATE + (size_t)row * 2048 + (col - 1792));
        st_bf4(p, v);
    } };
struct FRowScale { bf16_t* dst; int ld; const float* rs;
    typedef float L;
    DI L load(int row, int) const { return rs[row]; }
    DI void apply(int row, int col, f32x4 v0, f32x4 v1, L sc) const { st_bf8(dst + (size_t)row * ld + col, v0 * sc, v1 * sc); } };
struct FVt { bf16_t* Vt; const float* rs;
    struct L { f32x4 a, b; };
    DI L load(int, int col) const { return L{*(const f32x4*)(rs + col), *(const f32x4*)(rs + col + 4)}; }
    DI void apply(int row, int col, f32x4 v0, f32x4 v1, L sc) const {
        int b, kpos; if (col < ML) { b = col >> 13; kpos = col & (SEQ - 1); } else { const int r = col - ML; b = r >> 8; kpos = SEQ + (r & 255); }
        st_bf8(Vt + ((size_t)(b * NH + (row >> 6)) * 64 + (row & 63)) * TK + kpos, v0 * sc.a, v1 * sc.b);
    } };
struct EGate { const bf16_t* xc; bf16_t *OM, *BB; const float *sp8, *br, *bi;
    DI void operator()(const f32x4 (&acc)[2][2][4][2], const Unit& u, int wr, int wc, int fr, int fq) const {
        const int row0 = u.pm * BM + wr * 64 + fr, d = u.pn >> 2, ch0 = (u.pn & 3) * 128 + wc * 32 + 8 * fq;
        f32x4 s4[2], br4[2], bi4[2]; u32x4 xcur, xnxt;
#pragma unroll
        for (int n = 0; n < 2; ++n) { s4[n] = *(const f32x4*)(sp8 + d * 512 + ch0 + 4 * n); br4[n] = *(const f32x4*)(br + d * 512 + ch0 + 4 * n); bi4[n] = *(const f32x4*)(bi + d * 512 + ch0 + 4 * n); }
        xcur = *(const u32x4*)(xc + (size_t)row0 * 512 + ch0);
#pragma unroll
        for (int i = 0; i < 8; ++i) {
            const int row = row0 + (i >> 2) * HALF + (i & 3) * 16;
            if (i < 7) { const int rown = row0 + ((i + 1) >> 2) * HALF + ((i + 1) & 3) * 16; xnxt = *(const u32x4*)(xc + (size_t)rown * 512 + ch0); }
            f32x4 om[2], bb[2];
#pragma unroll
            for (int n = 0; n < 2; ++n) {
                const f32x4 r4 = acc[i >> 2][0][i & 3][n], i4 = acc[i >> 2][1][i & 3][n];
                const unsigned w0 = n == 0 ? xcur.x : xcur.z, w1 = n == 0 ? xcur.y : xcur.w;
                const f32x4 xf = {bflo(w0), bfhi(w0), bflo(w1), bfhi(w1)};
#pragma unroll
                for (int e = 0; e < 4; ++e) {
                    const float r = sigmoidf_(r4[e] + br4[n][e]), ig = sigmoidf_(i4[e] + bi4[n][e]);
                    const float a = __expf(s4[n][e] * r);
                    om[n][e] = 1.f - a; bb[n][e] = __fsqrt_rn(fmaxf(1.f - a * a, 0.f)) * (ig * xf[e]);
                }
            }
            const size_t o = ((size_t)d * MA + row) * 512 + ch0;
            st_bf8(OM + o, om[0], om[1]); st_bf8(BB + o, bb[0], bb[1]);
            xcur = xnxt;
        }
    } };
DI f32x4 sig_lo(u32x4 g) { return (f32x4){sigmoidf_(bflo(g.x)), sigmoidf_(bfhi(g.x)), sigmoidf_(bflo(g.y)), sigmoidf_(bfhi(g.y))}; }
DI f32x4 sig_hi(u32x4 g) { return (f32x4){sigmoidf_(bflo(g.z)), sigmoidf_(bfhi(g.z)), sigmoidf_(bflo(g.w)), sigmoidf_(bfhi(g.w))}; }
struct FMergeA { const bf16_t* GATE; bf16_t* Y;
    typedef u32x4 L;
    DI L load(int row, int col) const { return *(const u32x4*)(GATE + (size_t)row * 2048 + col); }
    DI void apply(int row, int col, f32x4 v0, f32x4 v1, L gv) const { st_bf8(Y + (size_t)row * DM + col, sig_lo(gv) * v0, sig_hi(gv) * v1); } };
struct FMergeB { const bf16_t* GATE; bf16_t* Y;
    struct L { u32x4 g, y; };
    DI L load(int row, int col) const { return L{*(const u32x4*)(GATE + (size_t)row * 2048 + 1024 + col), *(const u32x4*)(Y + (size_t)row * DM + col)}; }
    DI void apply(int row, int col, f32x4 v0, f32x4 v1, L q) const {
        const f32x4 y0 = {bflo(q.y.x), bfhi(q.y.x), bflo(q.y.y), bfhi(q.y.y)}, y1 = {bflo(q.y.z), bfhi(q.y.z), bflo(q.y.w), bfhi(q.y.w)};
        st_bf8(Y + (size_t)row * DM + col, y0 + sig_lo(q.g) * v0, y1 + sig_hi(q.g) * v1);
    } };

struct ESwiglu { bf16_t* H; const float* SS; const float* shw;
    DI void operator()(const f32x4 (&acc)[2][2][4][2], const Unit& u, int wr, int wc, int fr, int fq) const {
        const int row0 = u.pm * BM + wr * 64 + fr, c0 = wc * 32 + 8 * fq;
        const float* sw = shw + mod_row(u.pm * BM) * 5632 + u.pn * 256 + c0;
        f32x4 sg[2], su[2]; float rs[8];
#pragma unroll
        for (int n = 0; n < 2; ++n) { sg[n] = *(const f32x4*)(sw + 4 * n); su[n] = *(const f32x4*)(sw + 128 + 4 * n); }
#pragma unroll
        for (int i = 0; i < 8; ++i) rs[i] = row_rstd4(SS, row0 + (i >> 2) * HALF + (i & 3) * 16, fq);
#pragma unroll
        for (int ai = 0; ai < 2; ++ai)
#pragma unroll
            for (int m = 0; m < 4; ++m) {
                f32x4 h[2];
#pragma unroll
                for (int n = 0; n < 2; ++n) {
                    const f32x4 g = acc[ai][0][m][n] * rs[ai * 4 + m] + sg[n], uu = acc[ai][1][m][n] * rs[ai * 4 + m] + su[n];
#pragma unroll
                    for (int e = 0; e < 4; ++e) h[n][e] = g[e] * sigmoidf_(g[e]) * uu[e];
                }
                st_bf8(H + (size_t)(row0 + ai * HALF + m * 16) * DFF + u.pn * 128 + c0, h[0], h[1]);
            }
    } };
struct EWin { bf16_t *P1, *UXY, *GATE; const float* SS; const float* shw;
    template <int LD> DI void body(const f32x4 (&acc)[2][2][4][2], bf16_t* dst, const f32x4 (&sh)[2][2], const float (&rs)[8]) const {
#pragma unroll
        for (int ai = 0; ai < 2; ++ai)
#pragma unroll
            for (int m = 0; m < 4; ++m)
#pragma unroll
                for (int bj = 0; bj < 2; ++bj)
                    st_bf8(dst + (size_t)(ai * HALF + m * 16) * LD + 128 * bj, acc[ai][bj][m][0] * rs[ai * 4 + m] + sh[bj][0], acc[ai][bj][m][1] * rs[ai * 4 + m] + sh[bj][1]);
    }
    DI void operator()(const f32x4 (&acc)[2][2][4][2], const Unit& u, int wr, int wc, int fr, int fq) const {
        const int row0 = u.pm * BM + wr * 64 + fr, c0 = wc * 32 + 8 * fq;
        const float* sw = shw + mod_row(u.pm * BM) * 5632 + u.pn * 256 + c0;
        f32x4 sh[2][2]; float rs[8];
#pragma unroll
        for (int bj = 0; bj < 2; ++bj)
#pragma unroll
            for (int n = 0; n < 2; ++n) sh[bj][n] = *(const f32x4*)(sw + 128 * bj + 4 * n);
#pragma unroll
        for (int i = 0; i < 8; ++i) rs[i] = row_rstd4(SS, row0 + (i >> 2) * HALF + (i & 3) * 16, fq);
        if (u.pn < 3) body<768>(acc, P1 + (size_t)row0 * 768 + u.pn * 256 + c0, sh, rs);
        else if (u.pn < 7) body<1024>(acc, UXY + (size_t)row0 * 1024 + (u.pn - 3) * 256 + c0, sh, rs);
        else body<2048>(acc, GATE + (size_t)row0 * 2048 + (u.pn - 7) * 256 + c0, sh, rs);
    } };
template <int COEF2, bool NORM> struct EResid { const float* src; float* dst; const float* mod; const float* scn; bf16_t* XS; float* SS;
    DI void operator()(const f32x4 (&acc)[2][2][4][2], const Unit& u, int wr, int wc, int fr, int fq) const {
        const int row0 = u.pm * BM + wr * 64 + fr, col0 = u.pn * BM + wc * 32 + 8 * fq, r = mod_row(u.pm * BM);
        f32x4 g[2][2], sc[2][2];
#pragma unroll
        for (int bj = 0; bj < 2; ++bj)
#pragma unroll
            for (int n = 0; n < 2; ++n) { g[bj][n] = *(const f32x4*)(mod + r * NMOD + col0 + 128 * bj + 4 * n) * (0.5f * COEF2);
                if (NORM) sc[bj][n] = *(const f32x4*)(scn + r * NMOD + col0 + 128 * bj + 4 * n) + 1.f; }
        f32x4 xc[2][2], xn_[2][2];
#pragma unroll
        for (int bj = 0; bj < 2; ++bj)
#pragma unroll
            for (int n = 0; n < 2; ++n) xc[bj][n] = *(const f32x4*)(src + (size_t)row0 * DM + col0 + 128 * bj + 4 * n);
#pragma unroll
        for (int i = 0; i < 8; ++i) {
            const int row = row0 + (i >> 2) * HALF + (i & 3) * 16;
            if (i < 7) { const int rown = row0 + ((i + 1) >> 2) * HALF + ((i + 1) & 3) * 16;
#pragma unroll
                for (int bj = 0; bj < 2; ++bj)
#pragma unroll
                    for (int n = 0; n < 2; ++n) xn_[bj][n] = *(const f32x4*)(src + (size_t)rown * DM + col0 + 128 * bj + 4 * n); }
            float ssq = 0.f;
#pragma unroll
            for (int bj = 0; bj < 2; ++bj) {
                f32x4 y[2];
#pragma unroll
                for (int n = 0; n < 2; ++n) {
                    y[n] = xc[bj][n] + g[bj][n] * acc[i >> 2][bj][i & 3][n];
                    *(f32x4*)(dst + (size_t)row * DM + col0 + 128 * bj + 4 * n) = y[n];
                    if (NORM) ssq += (y[n][0] * y[n][0] + y[n][1] * y[n][1]) + (y[n][2] * y[n][2] + y[n][3] * y[n][3]);
                }
                if (NORM) st_bf8(XS + (size_t)row * DM + col0 + 128 * bj, y[0] * sc[bj][0], y[1] * sc[bj][1]);
            }
            if (NORM) { ssq += __shfl_xor(ssq, 16); ssq += __shfl_xor(ssq, 32); if (fq == 0) SS[(size_t)row * 16 + (u.pn & 3) * 4 + wc] = ssq; }
#pragma unroll
            for (int bj = 0; bj < 2; ++bj)
#pragma unroll
                for (int n = 0; n < 2; ++n) xc[bj][n] = xn_[bj][n];
        }
    } };

DI void phase_mod(const Params& p, float* lds) {
    float* sc = lds;
    float* red = lds + 5 * DM;
    const int tid = TIDX, lane = tid & 63, wave = tid >> 6;
    for (int i = tid; i < 5 * DM; i += 512) { const float v = i < 4 * DM ? p.c[i] : p.c_ctx[i - 4 * DM]; sc[i] = v * sigmoidf_(v); }
    __syncthreads();
    float* mod = (float*)(p.ws + O_MOD);
    for (int it = BIDX; it < DEPTH * (NMOD / 64); it += gridDim.x) {
        const int l = it / (NMOD / 64), n = (it % (NMOD / 64)) * 64 + lane;
        const float* w = p.w_ada + ((size_t)l * DM + wave * 128) * NMOD + n;
        float a0 = 0.f, a1 = 0.f, a2 = 0.f, a3 = 0.f, a4 = 0.f;
#pragma unroll 8
        for (int k = 0; k < 128; ++k) { const float wv = w[(size_t)k * NMOD]; const int kk = wave * 128 + k;
            a0 += sc[kk] * wv; a1 += sc[DM + kk] * wv; a2 += sc[2 * DM + kk] * wv; a3 += sc[3 * DM + kk] * wv; a4 += sc[4 * DM + kk] * wv; }
        red[(wave * 5 + 0) * 64 + lane] = a0; red[(wave * 5 + 1) * 64 + lane] = a1; red[(wave * 5 + 2) * 64 + lane] = a2; red[(wave * 5 + 3) * 64 + lane] = a3; red[(wave * 5 + 4) * 64 + lane] = a4;
        __syncthreads();
        if (tid < 320) { const int r = tid >> 6; float s = p.b_ada[(size_t)l * NMOD + n];
#pragma unroll
            for (int w8 = 0; w8 < 8; ++w8) s += red[(w8 * 5 + r) * 64 + lane];
            mod[((size_t)l * 5 + r) * NMOD + n] = s; }
        __syncthreads();
    }
}

template <int MAP> DI int colmap(int n) {
    if (MAP == 0) return n;
    if (MAP == 1) { const int pn = n >> 8, bj = (n >> 7) & 1, c = n & 127; return bj * DFF + pn * 128 + c; }
    if (MAP == 2) return n < 672 ? n : (n < 768 ? -1 : n - 96);
    { const int m = n & 511, h = m >> 6, d = m & 63; return h * 128 + (n >> 9) * 64 + d; }
}
template <int MAP> DI void tjob(const float* src, int ld, int K, int N, bf16_t* dst, const float* kscale, float* tile, int& base, int vbid, int G) {
    const int tid = TIDX, ntn = N / 64, ntiles = ntn * (K / 64);
    int first = (vbid - base % G + G) % G;
    for (int t = first; t < ntiles; t += G) {
        const int n0 = (t % ntn) * 64, k0 = (t / ntn) * 64;
        const int c = colmap<MAP>(n0 + (tid & 63));
#pragma unroll
        for (int i = 0; i < 8; ++i) { const int kk = (tid >> 6) + 8 * i; float v = c >= 0 ? src[(size_t)(k0 + kk) * ld + c] : 0.f; if (kscale) v *= kscale[k0 + kk]; tile[kk * 65 + (tid & 63)] = v; }
        __syncthreads();
        { const int kc = tid & 7, nn = tid >> 3;
          const float* tp = tile + (kc * 8) * 65 + nn;
          u32x4 o; o.x = pk2(tp[0], tp[65]); o.y = pk2(tp[2 * 65], tp[3 * 65]); o.z = pk2(tp[4 * 65], tp[5 * 65]); o.w = pk2(tp[6 * 65], tp[7 * 65]);
          *(u32x4*)(dst + (size_t)(n0 + nn) * K + k0 + kc * 8) = o; }
        __syncthreads();
    }
    base += ntiles;
}
DI void phase_prep_ff(const Params& p, int l, int which, float* tile, int vbid, int vG) {
    unsigned char* ws = p.ws; int base = 0;
    if (which == 0) {
        tjob<1>(p.ff1_w_in + (size_t)l * DM * 2 * DFF, 2 * DFF, DM, 2 * DFF, (bf16_t*)(ws + O_WFF1IN), nullptr, tile, base, vbid, vG);
        tjob<0>(p.ff1_w_out + (size_t)l * DFF * DM, DM, DFF, DM, (bf16_t*)(ws + O_WFF1OUT), nullptr, tile, base, vbid, vG);
    } else {
        tjob<1>(p.ff2_w_in + (size_t)l * DM * 2 * DFF, 2 * DFF, DM, 2 * DFF, (bf16_t*)(ws + O_WFF2IN), nullptr, tile, base, vbid, vG);
        tjob<0>(p.ff2_w_out + (size_t)l * DFF * DM, DM, DFF, DM, (bf16_t*)(ws + O_WFF2OUT), nullptr, tile, base, vbid, vG);
    }
}
DI void phase_prep(const Params& p, int l, float* tile) {
    unsigned char* ws = p.ws; int base = 0;
    const int vbid = BIDX, vG = gridDim.x;
    const float* modl = (const float*)(ws + O_MOD) + (size_t)l * 5 * NMOD; float* shw = (float*)(ws + O_SHW);
    if (l == 0) phase_prep_ff(p, 0, 0, tile, vbid, vG);
    tjob<2>(p.w_in + (size_t)l * DM * 3744, 3744, DM, NIN, (bf16_t*)(ws + O_WIN), nullptr, tile, base, vbid, vG);
    tjob<0>(p.w_uq + (size_t)l * 384 * 768, 768, 384, 768, (bf16_t*)(ws + O_WUQ), p.q_a_norm + l * 384, tile, base, vbid, vG);
    tjob<3>(p.w_ukv + (size_t)l * 256 * 1024, 1024, 256, 1024, (bf16_t*)(ws + O_WUKV), p.kv_a_norm + l * 256, tile, base, vbid, vG);
    tjob<0>(p.w_o_attn + (size_t)l * 512 * 1024, 1024, 512, 1024, (bf16_t*)(ws + O_WOA), nullptr, tile, base, vbid, vG);
    tjob<0>(p.w_o_lru + (size_t)l * 512 * 1024, 1024, 512, 1024, (bf16_t*)(ws + O_WOL), nullptr, tile, base, vbid, vG);
    tjob<0>(p.w_out + (size_t)l * 1024 * 1024, 1024, 1024, 1024, (bf16_t*)(ws + O_WOUT), nullptr, tile, base, vbid, vG);
    { float* sh = tile; float* red = tile + 5 * DM;
      const int tid = TIDX, nn = tid & 63, ks = tid >> 6;
      for (int it = BIDX; it < 88 + 60 + 88; it += gridDim.x) {
          const int m = it < 88 ? 0 : (it < 148 ? 1 : 2), n0 = (m == 0 ? it : (m == 1 ? it - 88 : it - 148)) * 64;
          const float* W = m == 0 ? p.ff1_w_in + (size_t)l * DM * 2 * DFF : (m == 1 ? p.w_in + (size_t)l * DM * 3744 : p.ff2_w_in + (size_t)l * DM * 2 * DFF);
          const int ld = m == 1 ? 3744 : 2 * DFF, c = m == 1 ? colmap<2>(n0 + nn) : colmap<1>(n0 + nn);
          __syncthreads();
          for (int i = tid; i < 5 * DM; i += 512) sh[i] = modl[(size_t)(i >> 10) * NMOD + m * 3 * DM + (i & 1023)];
          __syncthreads();
          float a0 = 0.f, a1 = 0.f, a2 = 0.f, a3 = 0.f, a4 = 0.f;
          if (c >= 0) {
#pragma unroll 8
              for (int k = ks * 128; k < ks * 128 + 128; ++k) { const float wv = W[(size_t)k * ld + c]; a0 += sh[k] * wv; a1 += sh[DM + k] * wv; a2 += sh[2 * DM + k] * wv; a3 += sh[3 * DM + k] * wv; a4 += sh[4 * DM + k] * wv; }
          }
          red[(ks * 5 + 0) * 64 + nn] = a0; red[(ks * 5 + 1) * 64 + nn] = a1; red[(ks * 5 + 2) * 64 + nn] = a2; red[(ks * 5 + 3) * 64 + nn] = a3; red[(ks * 5 + 4) * 64 + nn] = a4;
          __syncthreads();
          if (tid < 320) { const int r = tid >> 6; float sum = 0.f;
#pragma unroll
              for (int w8 = 0; w8 < 8; ++w8) sum += red[(w8 * 5 + r) * 64 + nn];
              shw[(size_t)(m * 5 + r) * 5632 + n0 + nn] = sum; }
      }
      __syncthreads(); }
    if (BIDX == 0) { float* sp8 = (float*)(ws + O_SP);
        for (int i = TIDX; i < 1024; i += 512) { const float nl = -p.lru_lambda[l * 1024 + i]; sp8[i] = -8.f * (fmaxf(nl, 0.f) + log1pf(__expf(-fabsf(nl)))); } }
    bf16_t* wg = (bf16_t*)(ws + O_WGATE);
    for (int idx = BIDX * 512 + TIDX; idx < 2048 * 256; idx += gridDim.x * 512) {
        const int n = idx >> 8, k = idx & 255, d = n >> 10, cb = (n >> 8) & 3, gt = (n >> 7) & 1, c = n & 127, ch = cb * 128 + c, g = ch >> 6, j = ch & 63, ci = 256 * (cb >> 1) + k, gi = ci >> 6, i = ci & 63;
        float v = 0.f;
        if (gi == g) v = (gt ? p.w_igate : p.w_rgate)[((((size_t)l * 2 + d) * 8 + g) * 64 + i) * 64 + j];
        wg[idx] = f2bf(v);
    }
}

DI void phase_norm0(const Params& p) {
    const int tid = TIDX, lane = tid & 63, gw = BIDX * 8 + (tid >> 6), nw = gridDim.x * 8;
    float* X = (float*)(p.ws + O_X); bf16_t* XS = (bf16_t*)(p.ws + O_XNY); float* SS = (float*)(p.ws + O_SS);
    const float* mod = (const float*)(p.ws + O_MOD);
    for (int row = gw; row < MA; row += nw) {
        const float* src = row < ML ? p.x + (size_t)row * DM : p.ctx + (size_t)(row - ML) * DM;
        f32x4 v[4]; float s = 0.f;
#pragma unroll
        for (int j = 0; j < 4; ++j) { v[j] = *(const f32x4*)(src + 256 * j + 4 * lane); s += (v[j][0] * v[j][0] + v[j][1] * v[j][1]) + (v[j][2] * v[j][2] + v[j][3] * v[j][3]); }
        s = wave_sum(s);
        if (lane < 16) SS[(size_t)row * 16 + lane] = lane == 0 ? s : 0.f;
        const float* mr = mod + (size_t)mod_row(row) * NMOD;
#pragma unroll
        for (int j = 0; j < 4; ++j) {
            const int col = 256 * j + 4 * lane;
            *(f32x4*)(X + (size_t)row * DM + col) = v[j];
            const f32x4 sc = *(const f32x4*)(mr + DM + col);
            st_bf4(XS + (size_t)row * DM + col, v[j] * (1.f + sc));
        }
    }
}

DI void phase_conv(const Params& p, int l) {
    const bf16_t* UXY = (const bf16_t*)(p.ws + O_UXY); const bf16_t* P1 = (const bf16_t*)(p.ws + O_R1);
    bf16_t* xc = (bf16_t*)(p.ws + O_XNY);
    const float* cw = p.conv_w + (size_t)l * 4 * 512; const float* cb = p.conv_b + (size_t)l * 512;
    for (int e = BIDX * 512 + TIDX; e < MA * 64; e += gridDim.x * 512) {
        const int row = e >> 6, ch = (e & 63) * 8;
        int t, T; if (row < ML) { t = row & (SEQ - 1); T = SEQ; } else { t = (row - ML) & 255; T = CTXL; }
        u32x4 uv[4]; float ok[4];
#pragma unroll
        for (int k = 0; k < 4; ++k) { const int tt = t + k - 2; const bool in = tt >= 0 && tt < T; ok[k] = in ? 1.f : 0.f;
            uv[k] = *(const u32x4*)(UXY + (size_t)(in ? row + k - 2 : row) * 1024 + ch); }
        f32x4 y0 = *(const f32x4*)(cb + ch), y1 = *(const f32x4*)(cb + ch + 4);
#pragma unroll
        for (int k = 0; k < 4; ++k) {
            const f32x4 w0 = *(const f32x4*)(cw + k * 512 + ch) * ok[k], w1 = *(const f32x4*)(cw + k * 512 + ch + 4) * ok[k];
            const f32x4 a = {bflo(uv[k].x), bfhi(uv[k].x), bflo(uv[k].y), bfhi(uv[k].y)}, c = {bflo(uv[k].z), bfhi(uv[k].z), bflo(uv[k].w), bfhi(uv[k].w)};
            y0 += w0 * a; y1 += w1 * c;
        }
        u32x4 o; o.x = pk2(y0[0], y0[1]); o.y = pk2(y0[2], y0[3]); o.z = pk2(y1[0], y1[1]); o.w = pk2(y1[2], y1[3]);
        *(u32x4*)(xc + (size_t)row * 512 + ch) = o;
    }
    float* rsq = (float*)(p.ws + O_RSQ); float* rskv = (float*)(p.ws + O_RSKV);
    const int tid2 = TIDX, l16 = tid2 & 15, gq = BIDX * 32 + (tid2 >> 4), nq = gridDim.x * 32;
    for (int row = gq; row < MA; row += nq) {
        const bf16_t* pr = P1 + (size_t)row * 768;
        u32x4 v[5];
#pragma unroll
        for (int i = 0; i < 5; ++i) v[i] = *(const u32x4*)(pr + (l16 + 16 * i) * 8);
        float sq = 0.f, skv = 0.f;
#pragma unroll
        for (int i = 0; i < 5; ++i) {
            const float s2 = bflo(v[i].x) * bflo(v[i].x) + bfhi(v[i].x) * bfhi(v[i].x) + bflo(v[i].y) * bflo(v[i].y) + bfhi(v[i].y) * bfhi(v[i].y)
                           + bflo(v[i].z) * bflo(v[i].z) + bfhi(v[i].z) * bfhi(v[i].z) + bflo(v[i].w) * bflo(v[i].w) + bfhi(v[i].w) * bfhi(v[i].w);
            if (i < 3) sq += s2; else skv += s2;
        }
#pragma unroll
        for (int o = 1; o < 16; o <<= 1) { sq += __shfl_xor(sq, o); skv += __shfl_xor(skv, o); }
        if (l16 == 0) { rsq[row] = rsqrtf(sq * (1.f / 384.f) + EPS); rskv[row] = rsqrtf(skv * (1.f / 256.f) + EPS); }
    }
}

DI int chunk_row0(int b, int pch) { return pch < 4 ? ML + b * CTXL + pch * 64 : b * SEQ + (pch - 4) * 64; }
DI void phase_scan_agg(const Params& p) {
    const bf16_t* OM = (const bf16_t*)(p.ws + O_S); const bf16_t* BB = OM + (size_t)2 * MA * 512;
    f32x4* agg = (f32x4*)(p.ws + O_AGG);
    const int tid = TIDX, lane = tid & 63, gw = (tid >> 6) * gridDim.x + BIDX, nw = gridDim.x * 8;
    for (int it = gw; it < 2 * NB * NCH; it += nw) {
        const int d = it & 1, bp = it >> 1, b = bp / NCH, pch = bp % NCH, row0 = chunk_row0(b, pch);
        const bf16_t* om = OM + ((size_t)d * MA + row0) * 512 + lane * 8; const bf16_t* bb = BB + ((size_t)d * MA + row0) * 512 + lane * 8;
        float h[8], A[8];
#pragma unroll
        for (int i = 0; i < 8; ++i) { h[i] = 0.f; A[i] = 1.f; }
#pragma unroll 8
        for (int t = 0; t < 64; ++t) {
            const int tt = d ? 63 - t : t;
            const u32x4 ov = *(const u32x4*)(om + (size_t)tt * 512), bv = *(const u32x4*)(bb + (size_t)tt * 512);
            const float a[8] = {1.f - bflo(ov.x), 1.f - bfhi(ov.x), 1.f - bflo(ov.y), 1.f - bfhi(ov.y), 1.f - bflo(ov.z), 1.f - bfhi(ov.z), 1.f - bflo(ov.w), 1.f - bfhi(ov.w)};
            const float bq[8] = {bflo(bv.x), bfhi(bv.x), bflo(bv.y), bfhi(bv.y), bflo(bv.z), bfhi(bv.z), bflo(bv.w), bfhi(bv.w)};
#pragma unroll
            for (int i = 0; i < 8; ++i) { h[i] = a[i] * h[i] + bq[i]; A[i] *= a[i]; }
        }
        f32x4* dst = agg + (((size_t)(d * NB + b) * NCH + pch) * 512 + lane * 8) / 2;
#pragma unroll
        for (int i = 0; i < 4; ++i) dst[i] = (f32x4){A[2 * i], h[2 * i], A[2 * i + 1], h[2 * i + 1]};
    }
}
DI float gelu_tanh(float x) { const float u = 0.7978845608028654f * (x + 0.044715f * x * x * x); const float e = __expf(2.f * u); const float th = 1.f - 2.f * __builtin_amdgcn_rcpf(e + 1.f); return 0.5f * x * (1.f + th); }
DI void agg_step(const f32x4* e, float (&h)[8]) {
    const f32x4 e0 = e[0], e1 = e[1], e2 = e[2], e3 = e[3];
    h[0] = e0[0] * h[0] + e0[1]; h[1] = e0[2] * h[1] + e0[3]; h[2] = e1[0] * h[2] + e1[1]; h[3] = e1[2] * h[3] + e1[3];
    h[4] = e2[0] * h[4] + e2[1]; h[5] = e2[2] * h[5] + e2[3]; h[6] = e3[0] * h[6] + e3[1]; h[7] = e3[2] * h[7] + e3[3];
}
DI void phase_scan_apply(const Params& p) {
    const bf16_t* OM = (const bf16_t*)(p.ws + O_S); const bf16_t* BB = OM + (size_t)2 * MA * 512;
    const f32x4* agg = (const f32x4*)(p.ws + O_AGG);
    bf16_t* UXY = (bf16_t*)(p.ws + O_UXY); float* HF = p.out;
    const int tid = TIDX, lane = tid & 63, gw = (tid >> 6) * gridDim.x + BIDX, nw = gridDim.x * 8;
    for (int it = gw; it < NB * NCH; it += nw) {
        const int b = it / NCH, pch = it % NCH, row0 = chunk_row0(b, pch);
        const f32x4* af = agg + (((size_t)(0 * NB + b) * NCH) * 512 + lane * 8) / 2; const f32x4* ab = agg + (((size_t)(1 * NB + b) * NCH) * 512 + lane * 8) / 2;
        float h[8];
#pragma unroll
        for (int i = 0; i < 8; ++i) h[i] = 0.f;
#pragma unroll 4
        for (int q = 0; q < pch; ++q) agg_step(af + (size_t)q * 256, h);
        { const bf16_t* om = OM + ((size_t)row0) * 512 + lane * 8; const bf16_t* bb = BB + ((size_t)row0) * 512 + lane * 8; float* hf = HF + (size_t)row0 * 512 + lane * 8;
#pragma unroll 8
          for (int t = 0; t < 64; ++t) {
              const u32x4 ov = *(const u32x4*)(om + (size_t)t * 512), bv = *(const u32x4*)(bb + (size_t)t * 512);
              h[0] = (1.f - bflo(ov.x)) * h[0] + bflo(bv.x); h[1] = (1.f - bfhi(ov.x)) * h[1] + bfhi(bv.x); h[2] = (1.f - bflo(ov.y)) * h[2] + bflo(bv.y); h[3] = (1.f - bfhi(ov.y)) * h[3] + bfhi(bv.y);
              h[4] = (1.f - bflo(ov.z)) * h[4] + bflo(bv.z); h[5] = (1.f - bfhi(ov.z)) * h[5] + bfhi(bv.z); h[6] = (1.f - bflo(ov.w)) * h[6] + bflo(bv.w); h[7] = (1.f - bfhi(ov.w)) * h[7] + bfhi(bv.w);
              *(f32x4*)(hf + (size_t)t * 512) = (f32x4){h[0], h[1], h[2], h[3]}; *(f32x4*)(hf + (size_t)t * 512 + 4) = (f32x4){h[4], h[5], h[6], h[7]};
          } }
#pragma unroll
        for (int i = 0; i < 8; ++i) h[i] = 0.f;
        if (pch >= 4) {
#pragma unroll
            for (int q = 3; q >= 0; --q) agg_step(ab + (size_t)q * 256, h);
#pragma unroll 4
            for (int q = NCH - 1; q > pch; --q) agg_step(ab + (size_t)q * 256, h);
        } else {
            for (int q = 3; q > pch; --q) agg_step(ab + (size_t)q * 256, h);
        }
        { const bf16_t* om = OM + ((size_t)MA + row0) * 512 + lane * 8; const bf16_t* bb = BB + ((size_t)MA + row0) * 512 + lane * 8; const float* hf = HF + (size_t)row0 * 512 + lane * 8;
#pragma unroll 4
          for (int t = 63; t >= 0; --t) {
              const u32x4 ov = *(const u32x4*)(om + (size_t)t * 512), bv = *(const u32x4*)(bb + (size_t)t * 512);
              const f32x4 f0 = *(const f32x4*)(hf + (size_t)t * 512), f1 = *(const f32x4*)(hf + (size_t)t * 512 + 4);
              const u32x4 uv = *(const u32x4*)(UXY + (size_t)(row0 + t) * 1024 + 512 + lane * 8);
              h[0] = (1.f - bflo(ov.x)) * h[0] + bflo(bv.x); h[1] = (1.f - bfhi(ov.x)) * h[1] + bfhi(bv.x); h[2] = (1.f - bflo(ov.y)) * h[2] + bflo(bv.y); h[3] = (1.f - bfhi(ov.y)) * h[3] + bfhi(bv.y);
              h[4] = (1.f - bflo(ov.z)) * h[4] + bflo(bv.z); h[5] = (1.f - bfhi(ov.z)) * h[5] + bfhi(bv.z); h[6] = (1.f - bflo(ov.w)) * h[6] + bflo(bv.w); h[7] = (1.f - bfhi(ov.w)) * h[7] + bfhi(bv.w);
              u32x4 o;
              o.x = pk2((f0[0] + h[0]) * gelu_tanh(bflo(uv.x)), (f0[1] + h[1]) * gelu_tanh(bfhi(uv.x))); o.y = pk2((f0[2] + h[2]) * gelu_tanh(bflo(uv.y)), (f0[3] + h[3]) * gelu_tanh(bfhi(uv.y)));
              o.z = pk2((f1[0] + h[4]) * gelu_tanh(bflo(uv.z)), (f1[1] + h[5]) * gelu_tanh(bfhi(uv.z))); o.w = pk2((f1[2] + h[6]) * gelu_tanh(bflo(uv.w)), (f1[3] + h[7]) * gelu_tanh(bfhi(uv.w)));
              *(u32x4*)(UXY + (size_t)(row0 + t) * 1024 + lane * 8) = o;
          } }
    }
}

DI void phase_qk(const Params& p, int l, unsigned char* smem) {
    const bf16_t* qraw = (const bf16_t*)p.out; const bf16_t* kn = qraw + (size_t)MA * 768;
    const bf16_t* P1 = (const bf16_t*)(p.ws + O_R1);
    bf16_t* Q = (bf16_t*)(p.ws + O_S); bf16_t* Kb = Q + (size_t)32 * TK * 96;
    const int tid = TIDX, lane = tid & 63, wave = tid >> 6, gw = BIDX * 8 + wave, nw = gridDim.x * 8, h = lane >> 3, j = lane & 7;
    unsigned char* wq = smem + wave * 4096; unsigned char* wk = wq + 1536;
    const float* qn = p.q_norm + l * 96; const float* knm = p.k_norm + l * 96;
    float gq[12], gk[12];
#pragma unroll
    for (int i = 0; i < 12; ++i) { gq[i] = qn[8 * i + j] * QSCALE; gk[i] = knm[8 * i + j]; }
    const float freq = exp2f(-(float)j * 1.6609640474436813f);
    for (int row = gw; row < MA; row += nw) {
        { const u32x4 q0 = *(const u32x4*)(qraw + (size_t)row * 768 + lane * 8);
          u32x4 q1 = {0u, 0u, 0u, 0u}, k1 = {0u, 0u, 0u, 0u};
          if (lane < 32) q1 = *(const u32x4*)(qraw + (size_t)row * 768 + 512 + lane * 8);
          const u32x4 k0 = *(const u32x4*)(kn + (size_t)row * 512 + lane * 8);
          if (lane < 4) k1 = *(const u32x4*)(P1 + (size_t)row * 768 + 640 + lane * 8);
          *(u32x4*)(wq + lane * 16) = q0; if (lane < 32) *(u32x4*)(wq + 1024 + lane * 16) = q1;
          *(u32x4*)(wk + lane * 16) = k0; if (lane < 4) *(u32x4*)(wk + 1024 + lane * 16) = k1; }
        __builtin_amdgcn_fence(__ATOMIC_RELEASE, "wavefront"); __builtin_amdgcn_wave_barrier(); __builtin_amdgcn_fence(__ATOMIC_ACQUIRE, "wavefront");
        float xq[12], xk[12];
#pragma unroll
        for (int i = 0; i < 12; ++i) xq[i] = bf2f(*(const bf16_t*)(wq + (h * 96 + 8 * i + j) * 2));
#pragma unroll
        for (int i = 0; i < 8; ++i) xk[i] = bf2f(*(const bf16_t*)(wk + (h * 64 + 8 * i + j) * 2));
#pragma unroll
        for (int i = 8; i < 12; ++i) xk[i] = bf2f(*(const bf16_t*)(wk + 1024 + (8 * (i - 8) + j) * 2));
        __builtin_amdgcn_fence(__ATOMIC_RELEASE, "wavefront"); __builtin_amdgcn_wave_barrier(); __builtin_amdgcn_fence(__ATOMIC_ACQUIRE, "wavefront");
        const bool lat = row < ML; int b, pos;
        if (lat) { b = row >> 13; pos = row & (SEQ - 1); } else { const int r = row - ML; b = r >> 8; pos = SEQ + (r & 255); }
        float c0 = 1.f, s0 = 0.f, c1 = 1.f, s1 = 0.f;
        if (lat) { float r0 = (float)(pos >> 6) * freq * 0.15915494309189535f, r1 = (float)(pos & 63) * freq * 0.15915494309189535f;
            r0 -= floorf(r0); r1 -= floorf(r1);
            c0 = __builtin_amdgcn_cosf(r0); s0 = __builtin_amdgcn_sinf(r0); c1 = __builtin_amdgcn_cosf(r1); s1 = __builtin_amdgcn_sinf(r1); }
        float sq = 0.f, sk = 0.f;
#pragma unroll
        for (int i = 0; i < 12; ++i) { sq += xq[i] * xq[i]; sk += xk[i] * xk[i]; }
        sq += __shfl_xor(sq, 1); sk += __shfl_xor(sk, 1); sq += __shfl_xor(sq, 2); sk += __shfl_xor(sk, 2); sq += __shfl_xor(sq, 4); sk += __shfl_xor(sk, 4);
        const float rq = rsqrtf(sq * (1.f / 96.f) + EPS), rk = rsqrtf(sk * (1.f / 96.f) + EPS);
#pragma unroll
        for (int i = 0; i < 12; ++i) { xq[i] *= rq * gq[i]; xk[i] *= rk * gk[i]; }
        { const float y8 = xq[8] * c0 - xq[9] * s0, y9 = xq[8] * s0 + xq[9] * c0, y10 = xq[10] * c1 - xq[11] * s1, y11 = xq[10] * s1 + xq[11] * c1;
          xq[8] = y8; xq[9] = y9; xq[10] = y10; xq[11] = y11; }
        { const float y8 = xk[8] * c0 - xk[9] * s0, y9 = xk[8] * s0 + xk[9] * c0, y10 = xk[10] * c1 - xk[11] * s1, y11 = xk[10] * s1 + xk[11] * c1;
          xk[8] = y8; xk[9] = y9; xk[10] = y10; xk[11] = y11; }
#pragma unroll
        for (int i = 0; i < 12; ++i) { *(bf16_t*)(wq + (h * 96 + 8 * i + j) * 2) = f2bf(xq[i]); *(bf16_t*)(wk + (h * 96 + 8 * i + j) * 2) = f2bf(xk[i]); }
        __builtin_amdgcn_fence(__ATOMIC_RELEASE, "wavefront"); __builtin_amdgcn_wave_barrier(); __builtin_amdgcn_fence(__ATOMIC_ACQUIRE, "wavefront");
        { const int c0i = lane, c1i = 64 + lane;
          const u32x4 oq0 = *(const u32x4*)(wq + c0i * 16), ok0 = *(const u32x4*)(wk + c0i * 16);
          const size_t d0 = ((size_t)(b * NH + c0i / 12) * TK + pos) * 96 + (c0i % 12) * 8;
          *(u32x4*)(Q + d0) = oq0; *(u32x4*)(Kb + d0) = ok0;
          if (lane < 32) { const u32x4 oq1 = *(const u32x4*)(wq + c1i * 16), ok1 = *(const u32x4*)(wk + c1i * 16);
              const size_t d1 = ((size_t)(b * NH + c1i / 12) * TK + pos) * 96 + (c1i % 12) * 8;
              *(u32x4*)(Q + d1) = oq1; *(u32x4*)(Kb + d1) = ok1; } }
        __builtin_amdgcn_fence(__ATOMIC_RELEASE, "wavefront"); __builtin_amdgcn_wave_barrier(); __builtin_amdgcn_fence(__ATOMIC_ACQUIRE, "wavefront");
    }
}

constexpr int KROW = 208, VROW = 144, KBYTES = 64 * KROW, ABUF = KBYTES + 64 * VROW;
DI void attn_item(unsigned char* lds, const bf16_t* Q, const bf16_t* Kb, const bf16_t* Vt, bf16_t* att, int bh, int qposA, int qposB, int kt0, int kt1, int outrowA, int outrowB, bool writeB) {
    const int tid = TIDX, lane = tid & 63, l31 = lane & 31, half = lane >> 5;
    bf16x8 qa[6], qb[6];
    { const bf16_t* qp = Q + ((size_t)bh * TK + qposA + l31) * 96 + 8 * half; const bf16_t* qq = Q + ((size_t)bh * TK + qposB + l31) * 96 + 8 * half;
#pragma unroll
      for (int ks = 0; ks < 6; ++ks) { qa[ks] = *(const bf16x8*)(qp + 16 * ks); qb[ks] = *(const bf16x8*)(qq + 16 * ks); } }
    f32x16 oa0, oa1, ob0, ob1;
#pragma unroll
    for (int i = 0; i < 16; ++i) { oa0[i] = 0.f; oa1[i] = 0.f; ob0[i] = 0.f; ob1[i] = 0.f; }
    float la = 0.f, lb = 0.f;
    const unsigned char* kg = (const unsigned char*)(Kb + (size_t)bh * TK * 96) + (size_t)tid * 16;
    const unsigned char* vg = (const unsigned char*)(Vt + ((size_t)bh * 64 + (tid >> 3)) * TK) + (tid & 7) * 16;
    const int kc1 = 512 + tid;
    const int koff0 = (tid / 12) * KROW + (tid % 12) * 16, koff1 = (kc1 / 12) * KROW + (kc1 % 12) * 16;
    const int voff = KBYTES + (tid >> 3) * VROW + ((tid & 7) >> 1) * 32 + (tid & 1) * 8;
    const int klo = l31 * KROW + 16 * half, vlo = KBYTES + l31 * VROW + 16 * half;
    u32x4 kr0, kr1 = {0u, 0u, 0u, 0u}, vr;
#define AT_GLOAD(kt) do { kr0 = *(const u32x4*)(kg + (size_t)(kt) * 12288); if (tid < 256) kr1 = *(const u32x4*)(kg + (size_t)(kt) * 12288 + 8192); vr = *(const u32x4*)(vg + (size_t)(kt) * 128); } while (0)
#define AT_SSTORE(stg) do { unsigned char* bp_ = lds + (stg) * ABUF; *(u32x4*)(bp_ + koff0) = kr0; if (tid < 256) *(u32x4*)(bp_ + koff1) = kr1; \
        *(u32x2*)(bp_ + voff) = (u32x2){vr.x, vr.y}; *(u32x2*)(bp_ + voff + 16) = (u32x2){vr.z, vr.w}; } while (0)
#define AT_PK(v, o) (u32x4){pk2(v[o], v[o + 1]), pk2(v[o + 2], v[o + 3]), pk2(v[o + 4], v[o + 5]), pk2(v[o + 6], v[o + 7])}
    AT_GLOAD(kt0); AT_SSTORE(0);
    __syncthreads();
    for (int kt = kt0; kt < kt1; ++kt) {
        const int cur = (kt - kt0) & 1;
        const bool more = kt + 1 < kt1;
        if (more) AT_GLOAD(kt + 1);
        const unsigned char* kl = lds + cur * ABUF + klo;
        const unsigned char* vl = lds + cur * ABUF + vlo;
        f32x16 sa0, sa1, sb0, sb1;
        const f32x16 zero16 = {0.f, 0.f, 0.f, 0.f, 0.f, 0.f, 0.f, 0.f, 0.f, 0.f, 0.f, 0.f, 0.f, 0.f, 0.f, 0.f};
        __builtin_amdgcn_s_setprio(1);
#pragma unroll
        for (int ks = 0; ks < 6; ++ks) {
            const bf16x8 a0 = *(const bf16x8*)(kl + 32 * ks), a1 = *(const bf16x8*)(kl + 32 * KROW + 32 * ks);
            sa0 = __builtin_amdgcn_mfma_f32_32x32x16_bf16(a0, qa[ks], ks == 0 ? zero16 : sa0, 0, 0, 0);
            sa1 = __builtin_amdgcn_mfma_f32_32x32x16_bf16(a1, qa[ks], ks == 0 ? zero16 : sa1, 0, 0, 0);
            sb0 = __builtin_amdgcn_mfma_f32_32x32x16_bf16(a0, qb[ks], ks == 0 ? zero16 : sb0, 0, 0, 0);
            sb1 = __builtin_amdgcn_mfma_f32_32x32x16_bf16(a1, qb[ks], ks == 0 ? zero16 : sb1, 0, 0, 0);
        }
        __builtin_amdgcn_s_setprio(0);
        float pa = 0.f, pb = 0.f;
#pragma unroll
        for (int i = 0; i < 16; ++i) { sa0[i] = __builtin_amdgcn_exp2f(sa0[i]); sa1[i] = __builtin_amdgcn_exp2f(sa1[i]); pa += sa0[i] + sa1[i];
                                       sb0[i] = __builtin_amdgcn_exp2f(sb0[i]); sb1[i] = __builtin_amdgcn_exp2f(sb1[i]); pb += sb0[i] + sb1[i]; }
        la += pa; lb += pb;
        __builtin_amdgcn_s_setprio(1);
#pragma unroll
        for (int s = 0; s < 4; ++s) {
            const bf16x8 v0 = *(const bf16x8*)(vl + 32 * s), v1 = *(const bf16x8*)(vl + 32 * VROW + 32 * s);
            const bf16x8 fa = __builtin_bit_cast(bf16x8, s < 2 ? AT_PK(sa0, 8 * (s & 1)) : AT_PK(sa1, 8 * (s & 1)));
            const bf16x8 fb = __builtin_bit_cast(bf16x8, s < 2 ? AT_PK(sb0, 8 * (s & 1)) : AT_PK(sb1, 8 * (s & 1)));
            oa0 = __builtin_amdgcn_mfma_f32_32x32x16_bf16(v0, fa, oa0, 0, 0, 0); oa1 = __builtin_amdgcn_mfma_f32_32x32x16_bf16(v1, fa, oa1, 0, 0, 0);
            ob0 = __builtin_amdgcn_mfma_f32_32x32x16_bf16(v0, fb, ob0, 0, 0, 0); ob1 = __builtin_amdgcn_mfma_f32_32x32x16_bf16(v1, fb, ob1, 0, 0, 0);
        }
        __builtin_amdgcn_s_setprio(0);
        if (more) AT_SSTORE(cur ^ 1);
        __syncthreads();
    }
#undef AT_GLOAD
#undef AT_SSTORE
#undef AT_PK
    { const float lt = la + __shfl_xor(la, 32), inv = 1.f / lt;
      bf16_t* op = att + (size_t)(outrowA + l31) * 512 + (bh & 7) * 64 + 4 * half;
#pragma unroll
      for (int g = 0; g < 4; ++g) {
          st_bf4(op + 8 * g, (f32x4){oa0[4 * g] * inv, oa0[4 * g + 1] * inv, oa0[4 * g + 2] * inv, oa0[4 * g + 3] * inv});
          st_bf4(op + 32 + 8 * g, (f32x4){oa1[4 * g] * inv, oa1[4 * g + 1] * inv, oa1[4 * g + 2] * inv, oa1[4 * g + 3] * inv}); } }
    if (writeB) { const float lt = lb + __shfl_xor(lb, 32), inv = 1.f / lt;
      bf16_t* op = att + (size_t)(outrowB + l31) * 512 + (bh & 7) * 64 + 4 * half;
#pragma unroll
      for (int g = 0; g < 4; ++g) {
          st_bf4(op + 8 * g, (f32x4){ob0[4 * g] * inv, ob0[4 * g + 1] * inv, ob0[4 * g + 2] * inv, ob0[4 * g + 3] * inv});
          st_bf4(op + 32 + 8 * g, (f32x4){ob1[4 * g] * inv, ob1[4 * g + 1] * inv, ob1[4 * g + 2] * inv, ob1[4 * g + 3] * inv}); } }
}
DI void phase_attn(const Params& p, unsigned char* lds, bool with_ctx) {
    const bf16_t* Q = (const bf16_t*)(p.ws + O_S); const bf16_t* Kb = Q + (size_t)32 * TK * 96; const bf16_t* Vt = Kb + (size_t)32 * TK * 96;
    bf16_t* att = (bf16_t*)p.out;
    const int nitems = 512 + (with_ctx ? 32 : 0);
    for (int it = BIDX; it < nitems; it += gridDim.x) {
        const int wave = TIDX >> 6;
        if (it < 512) {
            const int j = (it >> 3) & 31, bh = (it >> 8) * 16 + (it & 7) * 2 + (j >> 4), q0 = (j & 15) * 512 + wave * 64, r0 = (bh >> 3) * SEQ + q0;
            attn_item(lds, Q, Kb, Vt, att, bh, q0, q0 + 32, 0, TK / 64, r0, r0 + 32, true);
        } else {
            const int bh = it - 512, q0 = SEQ + wave * 32, r0 = ML + (bh >> 3) * CTXL + wave * 32;
            attn_item(lds, Q, Kb, Vt, att, bh, q0, q0, SEQ / 64, TK / 64, r0, r0, false);
        }
    }
}

constexpr int PH_PER_LAYER = 15, N_PHASES = 1 + DEPTH * PH_PER_LAYER;
DI int phase_case(int ph) { const int i = (ph - 1) % PH_PER_LAYER; return i < 3 ? i : (i < 13 ? i + 1 : i + 2); }
DI void run_phase(const Params& p, int ph, unsigned char* smem) {
    LAS unsigned char* lds = (LAS unsigned char*)smem;
    unsigned char* ws = p.ws;
    if (ph == 0) { phase_mod(p, (float*)smem); return; }
    const int l = (ph - 1) / PH_PER_LAYER, s = phase_case(ph);
    const bool last = (l == DEPTH - 1);
    const float* mod = (const float*)(ws + O_MOD) + (size_t)l * 5 * NMOD;
    float* X = (float*)(ws + O_X);
    bf16_t* XNY = (bf16_t*)(ws + O_XNY); bf16_t* H = (bf16_t*)(ws + O_R1); bf16_t* P1 = (bf16_t*)(ws + O_R1); bf16_t* GATE = P1 + (size_t)MA * 768;
    bf16_t* UXY = (bf16_t*)(ws + O_UXY);
    float* SS = (float*)(ws + O_SS); const float* shw = (const float*)(ws + O_SHW);
    const int Mtail = last ? ML : MA;
    switch (s) {
    case 0: phase_prep(p, l, (float*)smem); if (l == 0) phase_norm0(p); break;
    case 1: { ESwiglu E{H, SS, shw}; gemm_phase<ESwiglu, false, true>(lds, Gemm{XNY, (const bf16_t*)(ws + O_WFF1IN), MA, 2 * DFF, DM, DM, DM}, E); } break;
    case 2: { EResid<1, true> E{X, X, mod + 2 * DM, mod + 4 * DM, XNY, SS + (size_t)MA * 16}; gemm_phase<EResid<1, true>, false, true>(lds, Gemm{H, (const bf16_t*)(ws + O_WFF1OUT), MA, DM, DFF, DFF, DFF}, E); }
              { const int nthird = (MA / BM) * (DM / BM) - 2 * (int)gridDim.x, vb = (int)BIDX - nthird; if (nthird > 0 && nthird < (int)gridDim.x && vb >= 0) phase_prep_ff(p, l, 1, (float*)smem, vb, (int)gridDim.x - nthird); else if (nthird <= 0 || nthird >= (int)gridDim.x) phase_prep_ff(p, l, 1, (float*)smem, BIDX, gridDim.x); }
              break;
    case 4: { EWin E{P1, UXY, GATE, SS + (size_t)MA * 16, shw + 5 * 5632}; gemm_phase<EWin, false, true>(lds, Gemm{XNY, (const bf16_t*)(ws + O_WIN), MA, NIN, DM, DM, DM}, E); } break;
    case 5: phase_conv(p, l); break;
    case 6: { bf16_t* OM = (bf16_t*)(ws + O_S); EGate E{XNY, OM, OM + (size_t)2 * MA * 512, (const float*)(ws + O_SP), p.b_rgate + l * 1024, p.b_igate + l * 1024};
              gemm_phase<EGate, true, true>(lds, Gemm{XNY, (const bf16_t*)(ws + O_WGATE), MA, 2048, 256, 512, 256}, E); } break;
    case 7: phase_scan_agg(p); break;
    case 8: phase_scan_apply(p); break;
    case 9: { bf16_t* qraw = (bf16_t*)p.out; bf16_t* kn = qraw + (size_t)MA * 768; bf16_t* Vt = (bf16_t*)(ws + O_S) + (size_t)2 * 32 * TK * 96;
              const float* rsq = (const float*)(ws + O_RSQ); const float* rskv = (const float*)(ws + O_RSKV);
              const bf16_t* wukv = (const bf16_t*)(ws + O_WUKV);
              { EpiElem8<FRowScale> E{{qraw, 768, rsq}}; gemm_phase<EpiElem8<FRowScale>, false, true>(lds, Gemm{P1, (const bf16_t*)(ws + O_WUQ), MA, 768, 384, 768, 384}, E); }
              { EpiElem8<FRowScale> E{{kn, 512, rskv}}; gemm_phase<EpiElem8<FRowScale>, false, true>(lds, Gemm{P1 + 384, wukv, MA, 512, 256, 768, 256, 144}, E); }
              { EpiElem8<FVt> E{{Vt, rskv}}; gemm_phase<EpiElem8<FVt>, false, true>(lds, Gemm{wukv + (size_t)512 * 256, P1 + 384, 512, MA, 256, 256, 768, 152}, E); }
              } break;
    case 10: phase_qk(p, l, smem); break;
    case 11: phase_attn(p, smem, !last); break;
    case 12: { { EpiElem8<FMergeA> E{{GATE, XNY}}; gemm_phase<EpiElem8<FMergeA>, false, true>(lds, Gemm{(const bf16_t*)p.out, (const bf16_t*)(ws + O_WOA), Mtail, DM, 512, 512, 512}, E); }
               { EpiElem8<FMergeB> E{{GATE, XNY}}; gemm_phase<EpiElem8<FMergeB>, false, true>(lds, Gemm{UXY, (const bf16_t*)(ws + O_WOL), Mtail, DM, 512, 1024, 512}, E); } } break;
    case 13: { EResid<2, true> E{X, X, mod + 5 * DM, mod + 7 * DM, UXY, SS + (size_t)2 * MA * 16}; gemm_phase<EResid<2, true>, false, true>(lds, Gemm{XNY, (const bf16_t*)(ws + O_WOUT), Mtail, DM, DM, DM, DM}, E); } break;
    case 15: { ESwiglu E{H, SS + (size_t)2 * MA * 16, shw + 2 * 5 * 5632}; gemm_phase<ESwiglu, false, true>(lds, Gemm{UXY, (const bf16_t*)(ws + O_WFF2IN), Mtail, 2 * DFF, DM, DM, DM}, E); } break;
    case 16: if (last) { EResid<1, false> E{X, p.out, mod + 8 * DM, nullptr, nullptr, nullptr}; gemm_phase<EResid<1, false>, false, true>(lds, Gemm{H, (const bf16_t*)(ws + O_WFF2OUT), Mtail, DM, DFF, DFF, DFF}, E); }
             else { EResid<1, true> E{X, X, mod + 8 * DM, mod + 5 * NMOD + DM, XNY, SS}; gemm_phase<EResid<1, true>, false, true>(lds, Gemm{H, (const bf16_t*)(ws + O_WFF2OUT), Mtail, DM, DFF, DFF, DFF}, E); }
             if (!last) { const int nthird = (MA / BM) * (DM / BM) - 2 * (int)gridDim.x, vb = (int)BIDX - nthird; if (nthird > 0 && nthird < (int)gridDim.x && vb >= 0) phase_prep_ff(p, l + 1, 0, (float*)smem, vb, (int)gridDim.x - nthird); else if (nthird <= 0 || nthird >= (int)gridDim.x) phase_prep_ff(p, l + 1, 0, (float*)smem, BIDX, gridDim.x); }
             break;
    }
}

#ifndef PROBE_MASK
#define PROBE_MASK 0u
#endif
#define XB_TMO      128
#define XB_XCNT(j)  (256  + 64 * (j))
#define XB_XSUB(j)  (1280 + 64 * (j))
#define XB_XGEN(j)  (2304 + 64 * (j))
#define XB_TOP      3328
#define XB_TOPGEN   3392
#define XCD_BAR_WORDS 3456
#define XB_SPIN_CAP (1u << 18)
DI unsigned xb_ld(unsigned* p)              { return __hip_atomic_load(p, __ATOMIC_RELAXED, __HIP_MEMORY_SCOPE_AGENT); }
DI unsigned xb_add(unsigned* p, unsigned v) { return __hip_atomic_fetch_add(p, v, __ATOMIC_RELAXED, __HIP_MEMORY_SCOPE_AGENT); }
DI unsigned xb_xcc_id() { return (unsigned)__builtin_amdgcn_s_getreg((3 << 11) | 20) & 0xFu; }
#define XB_SPIN(cond, bar) do { unsigned _sp = 0; while (cond) { __builtin_amdgcn_s_sleep(1); \
    if ((++_sp & 255u) == 0u) { if (xb_ld(&(bar)[XB_TMO])) break; if (_sp > XB_SPIN_CAP) { atomicAdd(&(bar)[XB_TMO], 1u); break; } } } } while (0)
struct XcdBarrier { unsigned* bar; unsigned x; volatile LAS unsigned* st; };
DI XcdBarrier xcd_barrier_post(unsigned* bar, volatile LAS unsigned* st) {
    XcdBarrier b; b.bar = bar; b.x = xb_xcc_id(); b.st = st;
    if (threadIdx.x == 0) (void)xb_add(&bar[XB_XCNT(b.x)], 1u);
    return b;
}
DI void xcd_barrier_complete(unsigned* bar, unsigned x, unsigned& nloc, unsigned& nx) {
    const unsigned G = gridDim.x * gridDim.y * gridDim.z;
    unsigned sum, cnt, mine, sp = 0u;
    for (;;) {
        sum = 0u; cnt = 0u; mine = 0u;
#pragma unroll
        for (unsigned j = 0; j < 16; ++j) { const unsigned c = xb_ld(&bar[XB_XCNT(j)]); sum += c; cnt += (c > 0u) ? 1u : 0u; mine = (j == x) ? c : mine; }
        if (sum == G) break;
        __builtin_amdgcn_s_sleep(1);
        if ((++sp & 255u) == 0u) { if (xb_ld(&bar[XB_TMO])) break; if (sp > XB_SPIN_CAP) { atomicAdd(&bar[XB_TMO], 1u); break; } }
    }
    nloc = mine > 0u ? mine : 1u; nx = cnt > 0u ? cnt : 1u;
}
DI void xcd_barrier(const XcdBarrier& b) {
    asm volatile("s_waitcnt vmcnt(0)" ::: "memory");
    __syncthreads();
    if (threadIdx.x == 0) {
        unsigned* bar = b.bar;
        __builtin_amdgcn_s_waitcnt(0);
        unsigned nloc = b.st[0], nx = b.st[1];
        if (nloc == 0u) { xcd_barrier_complete(bar, b.x, nloc, nx); b.st[0] = nloc; b.st[1] = nx; }
        const unsigned old = xb_add(&bar[XB_XSUB(b.x)], 1u);
        const unsigned gen = old / nloc;
        if (old + 1u == (gen + 1u) * nloc) {
            __builtin_amdgcn_fence(__ATOMIC_RELEASE, "agent");
            asm volatile("s_waitcnt vmcnt(0)" ::: "memory");
            const unsigned og = xb_add(&bar[XB_TOP], 1u);
            const unsigned tg = og / nx;
            if (og + 1u == (tg + 1u) * nx) xb_add(&bar[XB_TOPGEN], 1u);
            else XB_SPIN(xb_ld(&bar[XB_TOPGEN]) == tg, bar);
            __builtin_amdgcn_fence(__ATOMIC_ACQUIRE, "agent");
            xb_add(&bar[XB_XGEN(b.x)], 1u);
            asm volatile("s_waitcnt vmcnt(0)" ::: "memory");
        } else {
            XB_SPIN(xb_ld(&bar[XB_XGEN(b.x)]) == gen, bar);
            __builtin_amdgcn_fence(__ATOMIC_ACQUIRE, "agent");
            asm volatile("s_waitcnt vmcnt(0)" ::: "memory");
        }
    }
    __syncthreads();
}
__global__ void __launch_bounds__(512) mega(Params p) {
    extern __shared__ __attribute__((aligned(16))) unsigned char smem[];
    __shared__ uint4 xb_words;
    cg::grid_group grid = cg::this_grid();
    if (threadIdx.x == 0) xb_words = make_uint4(0u, 0u, 0u, 0u);
    __syncthreads();
    const XcdBarrier xb = xcd_barrier_post((unsigned*)(p.ws + O_BAR), (volatile LAS unsigned*)&xb_words);
    unsigned long long tsel = 0;
    for (int ph = p.ph_lo; ph < p.ph_hi; ++ph) {
        const unsigned long long t0 = PROBE_MASK ? wall_clock64() : 0ull;
        run_phase(p, ph, smem);
        if (p.coop && ph + 1 < p.ph_hi) { if (ph == 0) grid.sync(); else xcd_barrier(xb); }
        if (PROBE_MASK) { const int sidx = ph == 0 ? 17 : phase_case(ph); if ((PROBE_MASK >> sidx) & 1u) tsel += wall_clock64() - t0; }
    }
    if (PROBE_MASK && blockIdx.x == 0) { const unsigned long long t0 = wall_clock64(); while (wall_clock64() - t0 < tsel) __builtin_amdgcn_s_sleep(64); }
}

extern "C" void kernel_launch(void* const* d_in, const int* in_sizes, int n_in, void* d_out, int out_size, void* d_ws, size_t ws_size, hipStream_t stream) {
    static int grid = 0;
    if (grid == 0) {
        if (n_in != 27 || ws_size < WS_END) { fprintf(stderr, "kernel_launch: need 27 inputs and %zu bytes of workspace; got %d, %zu\n", (size_t)WS_END, n_in, ws_size); grid = -1; return; }
        int dev = 0, cus = 0, per_cu = 0;
        hipGetDevice(&dev); hipDeviceGetAttribute(&cus, hipDeviceAttributeMultiprocessorCount, dev);
        if (hipFuncSetAttribute((const void*)mega, hipFuncAttributeMaxDynamicSharedMemorySize, LDS_BYTES) != hipSuccess) { fprintf(stderr, "kernel_launch: hipFuncSetAttribute failed\n"); grid = -1; return; }
        if (hipOccupancyMaxActiveBlocksPerMultiprocessor(&per_cu, (const void*)mega, 512, LDS_BYTES) != hipSuccess || per_cu < 1) { fprintf(stderr, "kernel_launch: occupancy query gave %d\n", per_cu); per_cu = 1; }
        (void)hipGetLastError();
        grid = cus;
    }
    if (grid < 0) return;
    Params p{};
    const float** pp = (const float**)&p;
    for (int i = 0; i < 27; ++i) pp[i] = (const float*)d_in[i];
    p.out = (float*)d_out; p.ws = (unsigned char*)d_ws; p.ph_lo = 0; p.ph_hi = N_PHASES; p.coop = 1; p.pad = 0;
    (void)hipMemsetAsync((unsigned char*)d_ws + O_BAR, 0, XCD_BAR_WORDS * 4, stream);
    void* args[] = {&p};
    hipError_t e = hipLaunchCooperativeKernel((const void*)mega, dim3(grid), dim3(512), args, LDS_BYTES, stream);
    if (e != hipSuccess) {
        fprintf(stderr, "cooperative launch failed: %s (grid %d); falling back to one launch per phase\n", hipGetErrorString(e), grid);
        (void)hipGetLastError();
        p.coop = 0;
        for (int ph = 0; ph < N_PHASES; ++ph) { p.ph_lo = ph; p.ph_hi = ph + 1; hipLaunchKernelGGL(mega, dim3(grid), dim3(512), LDS_BYTES, stream, p); }
    }
}
```

```cpp
#include <hip/hip_runtime.h>
#include <hip/hip_cooperative_groups.h>
#include <cstdio>
namespace cg = cooperative_groups;

#define DI __device__ __forceinline__
#define LAS __attribute__((address_space(3)))
typedef unsigned short bf16_t;
typedef short bf16x8 __attribute__((ext_vector_type(8)));
typedef float f32x2 __attribute__((ext_vector_type(2)));
typedef float f32x4 __attribute__((ext_vector_type(4)));
typedef float f32x16 __attribute__((ext_vector_type(16)));
typedef unsigned u32x2 __attribute__((ext_vector_type(2)));
typedef unsigned u32x4 __attribute__((ext_vector_type(4)));
typedef __bf16 bfv2 __attribute__((ext_vector_type(2)));

constexpr int DM = 1024, NB = 4, SEQ = 8192, CTXL = 256, DEPTH = 4;
constexpr int ML = NB * SEQ, MC = NB * CTXL, MA = ML + MC;
constexpr int DFF = 2816, NH = 8, TK = SEQ + CTXL;
constexpr int NIN = 3840;
constexpr int NMOD = 9 * DM;
constexpr float EPS = 1e-6f;
constexpr float QSCALE = 0.10206207261596577f * 1.4426950408889634f;
constexpr int NCH = 132;

constexpr size_t SZ_FFIN = (size_t)2 * DFF * DM * 2, SZ_FFOUT = (size_t)DM * DFF * 2;
constexpr size_t O_WFF1IN = 0;
constexpr size_t O_WFF1OUT = O_WFF1IN + SZ_FFIN;
constexpr size_t O_WFF2IN = O_WFF1OUT + SZ_FFOUT;
constexpr size_t O_WFF2OUT = O_WFF2IN + SZ_FFIN;
constexpr size_t O_WIN = O_WFF2OUT + SZ_FFOUT;
constexpr size_t O_WUQ = O_WIN + (size_t)NIN * DM * 2;
constexpr size_t O_WUKV = O_WUQ + (size_t)768 * 384 * 2;
constexpr size_t O_WOA = O_WUKV + (size_t)1024 * 256 * 2;
constexpr size_t O_WOL = O_WOA + (size_t)1024 * 512 * 2;
constexpr size_t O_WOUT = O_WOL + (size_t)1024 * 512 * 2;
constexpr size_t O_WGATE = O_WOUT + (size_t)1024 * 1024 * 2;
constexpr size_t O_MOD = O_WGATE + (size_t)2048 * 256 * 2;
constexpr size_t O_RSQ = O_MOD + (size_t)DEPTH * 5 * NMOD * 4;
constexpr size_t O_RSKV = O_RSQ + (size_t)MA * 4;
constexpr size_t O_AGG = O_RSKV + (size_t)MA * 4;
constexpr size_t O_SP = O_AGG + (size_t)2 * NB * NCH * 512 * 8;
constexpr size_t O_BAR = O_SP + 4096;
constexpr size_t O_SS = O_BAR + 16384;
constexpr size_t O_SHW = O_SS + (size_t)3 * MA * 16 * 4;
constexpr size_t O_X = O_SHW + (size_t)3 * 5 * 5632 * 4;
constexpr size_t O_R1 = O_X + (size_t)MA * DM * 4;
constexpr size_t O_UXY = O_R1 + (size_t)MA * DFF * 2;
constexpr size_t O_XNY = O_UXY + (size_t)MA * 1024 * 2;
constexpr size_t O_S = O_XNY + (size_t)MA * 1024 * 2;
constexpr size_t WS_END = O_S + (size_t)MA * 1024 * 4;
constexpr int LDS_BYTES = 131072;

struct Params {
    const float *x, *c, *ctx, *c_ctx, *w_ada, *b_ada, *ff1_w_in, *ff1_w_out, *ff2_w_in, *ff2_w_out, *w_in, *q_a_norm, *w_uq, *kv_a_norm, *w_ukv, *q_norm, *k_norm,
        *conv_w, *conv_b, *lru_lambda, *w_rgate, *b_rgate, *w_igate, *b_igate, *w_o_attn, *w_o_lru, *w_out;
    float* out; unsigned char* ws;
    int ph_lo, ph_hi, coop, pad;
};

DI int tidx_() { int t = threadIdx.x; asm volatile("" : "+v"(t)); return t; }
DI int bidx_() { int t = blockIdx.x; asm volatile("" : "+s"(t)); return t; }
#define TIDX tidx_()
#define BIDX bidx_()
DI unsigned pk2(float lo, float hi) { f32x2 v = {lo, hi}; bfv2 r = __builtin_convertvector(v, bfv2); return __builtin_bit_cast(unsigned, r); }
DI bf16_t f2bf(float x) { return (bf16_t)(pk2(x, 0.f) & 0xffffu); }
DI float bf2f(bf16_t v) { return __uint_as_float((unsigned)v << 16); }
DI float bflo(unsigned v) { return __uint_as_float(v << 16); }
DI float bfhi(unsigned v) { return __uint_as_float(v & 0xffff0000u); }
DI float wave_sum(float v) {
#pragma unroll
    for (int o = 1; o < 64; o <<= 1) v += __shfl_xor(v, o);
    return v;
}
DI float sigmoidf_(float x) { return __builtin_amdgcn_rcpf(1.f + __expf(-x)); }
DI int mod_row(int row) { return row < ML ? (row >> 13) : 4; }
DI float row_rstd(const float* SSP, int row) {
    const f32x4* q = (const f32x4*)(SSP + (size_t)row * 16); const f32x4 a = q[0], b = q[1], c = q[2], d = q[3];
    const float s = ((a[0] + a[1]) + (a[2] + a[3])) + ((b[0] + b[1]) + (b[2] + b[3])) + ((c[0] + c[1]) + (c[2] + c[3])) + ((d[0] + d[1]) + (d[2] + d[3]));
    return __builtin_amdgcn_rsqf(s * (1.f / DM) + EPS);
}

constexpr int BM = 256, BK = 64, HALF = 128, HTB = HALF * BK * 2, NXCD = 8, WGM = 8;
DI int lds_byte(int r, int c) { const int st = (r >> 4) * 2 + (c >> 5), rr = r & 15, cc = c & 31, ob = rr * 64 + cc * 2; return st * 1024 + (ob ^ (((ob >> 9) & 1) << 5)); }
DI void stage_rc(int b, int& R, int& C) { const int st = b / 1024, sb = b % 1024, swz = sb ^ (((sb >> 9) & 1) << 5); R = (st >> 1) * 16 + swz / 64; C = (st & 1) * 32 + (swz % 64) / 2; }
struct Unit { int pm, pn; };
struct Gemm { const bf16_t* A; const bf16_t* Bt; int M, N, K, lda, ldb; int rot = 0; };
struct StaticOrder {
    int nM, nN, nwg, G, c;
    DI void init(int M, int N, int G_, int c_) { nM = M / BM; nN = N / BM; nwg = nM * nN; G = G_; c = c_; }
    DI bool next(int i, Unit& u) const {
        const long L = (long)i * G + c; if (L >= nwg) return false;
        int wgid = (int)L; { const int q = nwg / NXCD, r = nwg % NXCD, xcd = wgid % NXCD, off = wgid / NXCD; wgid = (xcd < r ? xcd * (q + 1) : r * (q + 1) + (xcd - r) * q) + off; }
        const int nig = WGM * nN, gid = wgid / nig, fm = gid * WGM, gsz = (nM - fm) < WGM ? (nM - fm) : WGM;
        u.pm = fm + ((wgid % nig) % gsz); u.pn = (wgid % nig) / gsz; return true;
    }
};

DI int perm32(int rho) { const int n = rho >> 4, i = rho & 15; return 8 * (i >> 2) + 4 * n + (i & 3); }
template <class Epi, bool GATE_A, bool PERM = false>
DI void gemm_phase(LAS unsigned char* lds, const Gemm g, const Epi& E) {
    const int tid = TIDX, wid = __builtin_amdgcn_readfirstlane(tid >> 6), lane = tid & 63, wr = wid >> 2, wc = wid & 3, fr = lane & 15, fq = lane >> 4;
    const int K = g.K, nt = K / BK;
    StaticOrder S; S.init(g.M, g.N, gridDim.x, (BIDX - g.rot + (int)gridDim.x) % (int)gridDim.x);
    unsigned voffA[2], voffB[2];
#pragma unroll
    for (int i = 0; i < 2; ++i) { int R, C; stage_rc(tid * 16 + i * 8192, R, C); const int Rb = PERM ? ((R & ~31) + perm32(R & 31)) : R; voffA[i] = (unsigned)(R * g.lda + C) * 2u; voffB[i] = (unsigned)(Rb * g.ldb + C) * 2u; }
#pragma unroll
    for (int i = 0; i < 2; ++i) { asm volatile("" : "+v"(voffA[i])); asm volatile("" : "+v"(voffB[i])); }
    const size_t kstep = (size_t)(BK * 2);
    const size_t hstepA = (size_t)HALF * g.lda * 2, hstepB = (size_t)HALF * g.ldb * 2;
    const size_t tstepA = 2 * hstepA, tstepB = 2 * hstepB;
    const unsigned ldsw = (unsigned)wid * 1024u;
    const int aoff = lds_byte(wr * 64 + fr, fq * 8), boff = lds_byte(wc * 32 + fr, fq * 8);
#define PG8_SA(b, h) (((b) * 2 + (h)) * HTB)
#define PG8_SB(b, h) ((4 + (b) * 2 + (h)) * HTB)
#define PG8_STAGE(bufoff, gbase, voff) do { _Pragma("unroll") for (int _i = 0; _i < 2; ++_i) \
        __builtin_amdgcn_global_load_lds((const unsigned*)((const char*)(gbase) + (voff)[_i]), (LAS unsigned*)(lds + (bufoff) + ldsw + _i * 8192), 16, 0, 0); } while (0)
#define PG8_LDA(dst, b, h) do { _Pragma("unroll") for (int m = 0; m < 4; ++m) _Pragma("unroll") for (int k = 0; k < 2; ++k) dst[m][k] = *(const LAS bf16x8*)(lds + PG8_SA(b, h) + aoff + m * 2048 + k * 1024); } while (0)
#define PG8_LDB(dst, b, h) do { _Pragma("unroll") for (int n = 0; n < 2; ++n) _Pragma("unroll") for (int k = 0; k < 2; ++k) dst[n][k] = *(const LAS bf16x8*)(lds + PG8_SB(b, h) + boff + n * 2048 + k * 1024); } while (0)
#define PG8_MMA(ai, bj, At, Bt) do { __builtin_amdgcn_s_setprio(1); _Pragma("unroll") for (int m = 0; m < 4; ++m) _Pragma("unroll") for (int n = 0; n < 2; ++n) _Pragma("unroll") for (int k = 0; k < 2; ++k) \
        acc[ai][bj][m][n] = __builtin_amdgcn_mfma_f32_16x16x32_bf16(Bt[n][k], At[m][k], acc[ai][bj][m][n], 0, 0, 0); __builtin_amdgcn_s_setprio(0); } while (0)
#define PG8_WAIT_V(n) asm volatile("s_waitcnt vmcnt(" #n ")" ::: "memory")
#define PG8_WAIT_L(n) asm volatile("s_waitcnt lgkmcnt(" #n ")" ::: "memory")
#define PG8_BAR __builtin_amdgcn_s_barrier()
#define PG8_SCHED __builtin_amdgcn_sched_barrier(0)
#define PG8_ABASE(u) ((const char*)g.A + (size_t)(u).pm * tstepA + (GATE_A ? (size_t)((((u).pn & 3) >> 1) * 512) : (size_t)0))
    Unit cur, nxt; int ui = 0;
    if (!S.next(0, cur)) return;
    f32x4 acc[2][2][4][2];
#pragma unroll
    for (int a = 0; a < 2; ++a)
#pragma unroll
        for (int b = 0; b < 2; ++b)
#pragma unroll
            for (int m = 0; m < 4; ++m)
#pragma unroll
                for (int n = 0; n < 2; ++n) acc[a][b][m][n] = (f32x4){0.f, 0.f, 0.f, 0.f};
    bf16x8 At[4][2], B0[2][2], B1[2][2];
    const char* cA = PG8_ABASE(cur); const char* cB = (const char*)g.Bt + (size_t)cur.pn * tstepB;
    PG8_STAGE(PG8_SB(0, 0), cB, voffB); PG8_STAGE(PG8_SA(0, 0), cA, voffA); PG8_STAGE(PG8_SB(0, 1), cB + hstepB, voffB); PG8_STAGE(PG8_SA(0, 1), cA + hstepA, voffA);
    if (wr == 1) PG8_BAR;
    PG8_WAIT_V(4); PG8_BAR;
    PG8_STAGE(PG8_SB(1, 0), cB + kstep, voffB); PG8_STAGE(PG8_SA(1, 0), cA + kstep, voffA); PG8_STAGE(PG8_SB(1, 1), cB + hstepB + kstep, voffB);
    PG8_WAIT_V(6); PG8_BAR;
    for (;;) {
        const bool has_next = S.next(ui + 1, nxt);
        const char* nA = has_next ? PG8_ABASE(nxt) : cA; const char* nB = has_next ? (const char*)g.Bt + (size_t)nxt.pn * tstepB : cB;
#pragma nounroll
        for (int t = 0; t < nt; t += 2) {
            const bool last = (t == nt - 2);
            const char* a1 = cA + (size_t)(t + 1) * kstep;
            const char* a2 = last ? nA : cA + (size_t)(t + 2) * kstep; const char* b2 = last ? nB : cB + (size_t)(t + 2) * kstep;
            const char* a3 = a2 + kstep; const char* b3 = b2 + kstep;
            PG8_LDB(B0, 0, 0); PG8_SCHED; PG8_LDA(At, 0, 0); PG8_STAGE(PG8_SA(1, 1), a1 + hstepA, voffA);
            PG8_WAIT_L(8); PG8_BAR; PG8_WAIT_L(0); PG8_MMA(0, 0, At, B0); PG8_BAR; PG8_SCHED;
            PG8_LDB(B1, 0, 1); PG8_STAGE(PG8_SB(0, 0), b2, voffB);
            PG8_BAR; PG8_WAIT_L(0); PG8_MMA(0, 1, At, B1); PG8_BAR;
            PG8_LDA(At, 0, 1); PG8_STAGE(PG8_SA(0, 0), a2, voffA);
            PG8_BAR; PG8_WAIT_L(0); PG8_MMA(1, 0, At, B0); PG8_BAR; PG8_SCHED;
            PG8_STAGE(PG8_SB(0, 1), b2 + hstepB, voffB);
            PG8_WAIT_V(6); PG8_BAR; PG8_MMA(1, 1, At, B1); PG8_BAR;
            PG8_LDB(B0, 1, 0); PG8_SCHED; PG8_LDA(At, 1, 0); PG8_STAGE(PG8_SA(0, 1), a2 + hstepA, voffA);
            PG8_WAIT_L(8); PG8_BAR; PG8_WAIT_L(0); PG8_MMA(0, 0, At, B0); PG8_BAR; PG8_SCHED;
            PG8_LDB(B1, 1, 1); PG8_STAGE(PG8_SB(1, 0), b3, voffB);
            PG8_BAR; PG8_WAIT_L(0); PG8_MMA(0, 1, At, B1); PG8_BAR;
            PG8_LDA(At, 1, 1); PG8_STAGE(PG8_SA(1, 0), a3, voffA);
            PG8_BAR; PG8_WAIT_L(0); PG8_MMA(1, 0, At, B0); PG8_BAR; PG8_SCHED;
            PG8_STAGE(PG8_SB(1, 1), b3 + hstepB, voffB);
            PG8_WAIT_V(6); PG8_BAR; PG8_MMA(1, 1, At, B1); PG8_BAR;
        }
        E(acc, cur, wr, wc, fr, fq);
        if (!has_next) break;
#pragma unroll
        for (int a = 0; a < 2; ++a)
#pragma unroll
            for (int b = 0; b < 2; ++b)
#pragma unroll
                for (int m = 0; m < 4; ++m)
#pragma unroll
                    for (int n = 0; n < 2; ++n) acc[a][b][m][n] = (f32x4){0.f, 0.f, 0.f, 0.f};
        cur = nxt; cA = nA; cB = nB; ++ui;
    }
    PG8_WAIT_V(0);
    if (wr == 0) PG8_BAR;
    PG8_BAR;
#undef PG8_SA
#undef PG8_SB
#undef PG8_STAGE
#undef PG8_LDA
#undef PG8_LDB
#undef PG8_MMA
#undef PG8_WAIT_V
#undef PG8_WAIT_L
#undef PG8_BAR
#undef PG8_SCHED
#undef PG8_ABASE
}

DI float row_rstd4(const float* SSP, int row, int fq) {
    const f32x4 a = *(const f32x4*)(SSP + (size_t)row * 16 + 4 * fq);
    float s = (a[0] + a[1]) + (a[2] + a[3]); s += __shfl_xor(s, 16); s += __shfl_xor(s, 32);
    return __builtin_amdgcn_rsqf(s * (1.f / DM) + EPS);
}
template <class F> struct EpiElem {
    F f;
    DI void operator()(const f32x4 (&acc)[2][2][4][2], const Unit& u, int wr, int wc, int fr, int fq) const {
        const int row0 = u.pm * BM + wr * 64 + fr, col0 = u.pn * BM + wc * 32 + 4 * fq;
#pragma unroll
        for (int ai = 0; ai < 2; ++ai)
#pragma unroll
            for (int m = 0; m < 4; ++m)
#pragma unroll
                for (int bj = 0; bj < 2; ++bj)
#pragma unroll
                    for (int n = 0; n < 2; ++n) { f(row0 + ai * HALF + m * 16, col0 + bj * HALF + n * 16, acc[ai][bj][m][n]); }
    }
};
template <class F> struct EpiElemRow {
    F f;
    DI void operator()(const f32x4 (&acc)[2][2][4][2], const Unit& u, int wr, int wc, int fr, int fq) const {
        const int row0 = u.pm * BM + wr * 64 + fr, col0 = u.pn * BM + wc * 32 + 4 * fq;
#pragma unroll
        for (int ai = 0; ai < 2; ++ai)
#pragma unroll
            for (int m = 0; m < 4; ++m) {
                float ssq = 0.f;
#pragma unroll
                for (int bj = 0; bj < 2; ++bj)
#pragma unroll
                    for (int n = 0; n < 2; ++n) { ssq += f(row0 + ai * HALF + m * 16, col0 + bj * HALF + n * 16, acc[ai][bj][m][n]); }
                ssq += __shfl_xor(ssq, 16); ssq += __shfl_xor(ssq, 32);
                if (fq == 0) f.row(row0 + ai * HALF + m * 16, (u.pn & 3) * 4 + wc, ssq);
            }
    }
};
template <class F> struct EpiElemRS {
    F f;
    DI void operator()(const f32x4 (&acc)[2][2][4][2], const Unit& u, int wr, int wc, int fr, int fq) const {
        const int row0 = u.pm * BM + wr * 64 + fr, col0 = u.pn * BM + wc * 32 + 4 * fq;
#pragma unroll
        for (int ai = 0; ai < 2; ++ai)
#pragma unroll
            for (int m = 0; m < 4; ++m) {
                const float rs = f.rs(row0 + ai * HALF + m * 16);
#pragma unroll
                for (int bj = 0; bj < 2; ++bj)
#pragma unroll
                    for (int n = 0; n < 2; ++n) { f(row0 + ai * HALF + m * 16, col0 + bj * HALF + n * 16, acc[ai][bj][m][n], rs); }
            }
    }
};
template <class F> struct EpiPairRS {
    F f;
    DI void operator()(const f32x4 (&acc)[2][2][4][2], const Unit& u, int wr, int wc, int fr, int fq) const {
        const int row0 = u.pm * BM + wr * 64 + fr, c0 = wc * 32 + 4 * fq;
#pragma unroll
        for (int ai = 0; ai < 2; ++ai)
#pragma unroll
            for (int m = 0; m < 4; ++m) {
                const float rs = f.rs(row0 + ai * HALF + m * 16);
#pragma unroll
                for (int n = 0; n < 2; ++n) { f(row0 + ai * HALF + m * 16, u.pn, c0 + n * 16, acc[ai][0][m][n], acc[ai][1][m][n], rs); }
            }
    }
};
template <class F> struct EpiElem2 {
    F f;
    DI void operator()(const f32x4 (&acc)[2][2][4][2], const Unit& u, int wr, int wc, int fr, int fq) const {
        const int row0 = u.pm * BM + wr * 64 + fr, col0 = u.pn * BM + wc * 32 + 4 * fq;
        typename F::L cur[2][2], nxt[2][2];
#pragma unroll
        for (int bj = 0; bj < 2; ++bj)
#pragma unroll
            for (int n = 0; n < 2; ++n) cur[bj][n] = f.load(row0, col0 + bj * HALF + n * 16);
#pragma unroll
        for (int i = 0; i < 8; ++i) {
            const int row = row0 + (i >> 2) * HALF + (i & 3) * 16;
            if (i < 7) { const int rown = row0 + ((i + 1) >> 2) * HALF + ((i + 1) & 3) * 16;
#pragma unroll
                for (int bj = 0; bj < 2; ++bj)
#pragma unroll
                    for (int n = 0; n < 2; ++n) nxt[bj][n] = f.load(rown, col0 + bj * HALF + n * 16); }
#pragma unroll
            for (int bj = 0; bj < 2; ++bj)
#pragma unroll
                for (int n = 0; n < 2; ++n) f.apply(row, col0 + bj * HALF + n * 16, acc[i >> 2][bj][i & 3][n], cur[bj][n]);
#pragma unroll
            for (int bj = 0; bj < 2; ++bj)
#pragma unroll
                for (int n = 0; n < 2; ++n) cur[bj][n] = nxt[bj][n];
        }
    }
};
template <class F> struct EpiElem8 {
    F f;
    DI void operator()(const f32x4 (&acc)[2][2][4][2], const Unit& u, int wr, int wc, int fr, int fq) const {
        const int row0 = u.pm * BM + wr * 64 + fr, col0 = u.pn * BM + wc * 32 + 8 * fq;
        typename F::L cur[2], nxt[2];
#pragma unroll
        for (int bj = 0; bj < 2; ++bj) cur[bj] = f.load(row0, col0 + bj * HALF);
#pragma unroll
        for (int i = 0; i < 8; ++i) {
            const int row = row0 + (i >> 2) * HALF + (i & 3) * 16;
            if (i < 7) { const int rown = row0 + ((i + 1) >> 2) * HALF + ((i + 1) & 3) * 16;
#pragma unroll
                for (int bj = 0; bj < 2; ++bj) nxt[bj] = f.load(rown, col0 + bj * HALF); }
#pragma unroll
            for (int bj = 0; bj < 2; ++bj) f.apply(row, col0 + bj * HALF, acc[i >> 2][bj][i & 3][0], acc[i >> 2][bj][i & 3][1], cur[bj]);
#pragma unroll
            for (int bj = 0; bj < 2; ++bj) cur[bj] = nxt[bj];
        }
    }
};
template <class F> struct EpiPair {
    F f;
    DI void operator()(const f32x4 (&acc)[2][2][4][2], const Unit& u, int wr, int wc, int fr, int fq) const {
        const int row0 = u.pm * BM + wr * 64 + fr, c0 = wc * 32 + 4 * fq;
#pragma unroll
        for (int ai = 0; ai < 2; ++ai)
#pragma unroll
            for (int m = 0; m < 4; ++m)
#pragma unroll
                for (int n = 0; n < 2; ++n) { f(row0 + ai * HALF + m * 16, u.pn, c0 + n * 16, acc[ai][0][m][n], acc[ai][1][m][n]); }
    }
};
DI void st_bf4(bf16_t* p, f32x4 v) { u32x2 o; o.x = pk2(v[0], v[1]); o.y = pk2(v[2], v[3]); *(u32x2*)p = o; }
DI void st_bf8(bf16_t* p, f32x4 lo, f32x4 hi) { u32x4 o; o.x = pk2(lo[0], lo[1]); o.y = pk2(lo[2], lo[3]); o.z = pk2(hi[0], hi[1]); o.w = pk2(hi[2], hi[3]); *(u32x4*)p = o; }

struct FSwiglu { bf16_t* H; const float* SS; const float* shw;
    DI float rs(int row) const { return row_rstd(SS, row); }
    DI void operator()(int row, int pn, int c, f32x4 g, f32x4 u, float rs) const {
        const float* sw = shw + mod_row(row) * 5632 + pn * 256 + c;
        g = g * rs + *(const f32x4*)sw; u = u * rs + *(const f32x4*)(sw + 128);
        f32x4 h;
#pragma unroll
        for (int e = 0; e < 4; ++e) h[e] = g[e] * sigmoidf_(g[e]) * u[e];
        st_bf4(H + (size_t)row * DFF + pn * 128 + c, h);
    } };
struct FResid { const float* src; float* dst; const float* mod; float coef;
    DI void operator()(int row, int col, f32x4 v) const {
        const f32x4 g = *(const f32x4*)(mod + mod_row(row) * NMOD + col);
        const f32x4 x = *(const f32x4*)(src + (size_t)row * DM + col);
        *(f32x4*)(dst + (size_t)row * DM + col) = x + coef * g * v;
    } };
template <int COEF2> struct FResidN { const float* src; float* dst; const float* mod; const float* scn; bf16_t* XS; float* SS;
    DI float operator()(int row, int col, f32x4 v) const {
        const int r = mod_row(row);
        const f32x4 g = *(const f32x4*)(mod + r * NMOD + col);
        const f32x4 x = *(const f32x4*)(src + (size_t)row * DM + col);
        const f32x4 xn = x + (0.5f * COEF2) * g * v;
        *(f32x4*)(dst + (size_t)row * DM + col) = xn;
        const f32x4 sc = *(const f32x4*)(scn + r * NMOD + col);
        st_bf4(XS + (size_t)row * DM + col, xn * (1.f + sc));
        return (xn[0] * xn[0] + xn[1] * xn[1]) + (xn[2] * xn[2] + xn[3] * xn[3]);
    }
    DI void row(int row, int slot, float ssq) const { SS[(size_t)row * 16 + slot] = ssq; } };
struct FWin { bf16_t *P1, *UXY, *GATE; const float* SS; const float* shw;
    DI float rs(int row) const { return row_rstd(SS, row); }
    DI void operator()(int row, int col, f32x4 v, float rs) const {
        v = v * rs + *(const f32x4*)(shw + mod_row(row) * 5632 + col);
        bf16_t* p = col < 768 ? P1 + (size_t)row * 768 + col : (col < 1792 ? UXY + (size_t)row * 1024 + (col - 768) : GATE + (size_t)row * 2048 + (col - 1792));
        st_bf4(p, v);
    } };
struct FRowScale { bf16_t* dst; int ld; const float* rs;
    typedef float L;
    DI L load(int row, int) const { return rs[row]; }
    DI void apply(int row, int col, f32x4 v0, f32x4 v1, L sc) const { st_bf8(dst + (size_t)row * ld + col, v0 * sc, v1 * sc); } };
struct FVt { bf16_t* Vt; const float* rs;
    struct L { f32x4 a, b; };
    DI L load(int, int col) const { return L{*(const f32x4*)(rs + col), *(const f32x4*)(rs + col + 4)}; }
    DI void apply(int row, int col, f32x4 v0, f32x4 v1, L sc) const {
        int b, kpos; if (col < ML) { b = col >> 13; kpos = col & (SEQ - 1); } else { const int r = col - ML; b = r >> 8; kpos = SEQ + (r & 255); }
        st_bf8(Vt + ((size_t)(b * NH + (row >> 6)) * 64 + (row & 63)) * TK + kpos, v0 * sc.a, v1 * sc.b);
    } };
struct EGate { const bf16_t* xc; bf16_t *OM, *BB; const float *sp8, *br, *bi;
    DI void operator()(const f32x4 (&acc)[2][2][4][2], const Unit& u, int wr, int wc, int fr, int fq) const {
        const int row0 = u.pm * BM + wr * 64 + fr, d = u.pn >> 2, ch0 = (u.pn & 3) * 128 + wc * 32 + 8 * fq;
        f32x4 s4[2], br4[2], bi4[2]; u32x4 xcur, xnxt;
#pragma unroll
        for (int n = 0; n < 2; ++n) { s4[n] = *(const f32x4*)(sp8 + d * 512 + ch0 + 4 * n); br4[n] = *(const f32x4*)(br + d * 512 + ch0 + 4 * n); bi4[n] = *(const f32x4*)(bi + d * 512 + ch0 + 4 * n); }
        xcur = *(const u32x4*)(xc + (size_t)row0 * 512 + ch0);
#pragma unroll
        for (int i = 0; i < 8; ++i) {
            const int row = row0 + (i >> 2) * HALF + (i & 3) * 16;
            if (i < 7) { const int rown = row0 + ((i + 1) >> 2) * HALF + ((i + 1) & 3) * 16; xnxt = *(const u32x4*)(xc + (size_t)rown * 512 + ch0); }
            f32x4 om[2], bb[2];
#pragma unroll
            for (int n = 0; n < 2; ++n) {
                const f32x4 r4 = acc[i >> 2][0][i & 3][n], i4 = acc[i >> 2][1][i & 3][n];
                const unsigned w0 = n == 0 ? xcur.x : xcur.z, w1 = n == 0 ? xcur.y : xcur.w;
                const f32x4 xf = {bflo(w0), bfhi(w0), bflo(w1), bfhi(w1)};
#pragma unroll
                for (int e = 0; e < 4; ++e) {
                    const float r = sigmoidf_(r4[e] + br4[n][e]), ig = sigmoidf_(i4[e] + bi4[n][e]);
                    const float a = __expf(s4[n][e] * r);
                    om[n][e] = 1.f - a; bb[n][e] = __builtin_amdgcn_sqrtf(fmaxf(1.f - a * a, 0.f)) * (ig * xf[e]);
                }
            }
            const size_t o = ((size_t)d * MA + row) * 512 + ch0;
            st_bf8(OM + o, om[0], om[1]); st_bf8(BB + o, bb[0], bb[1]);
            xcur = xnxt;
        }
    } };
DI f32x4 sig_lo(u32x4 g) { return (f32x4){sigmoidf_(bflo(g.x)), sigmoidf_(bfhi(g.x)), sigmoidf_(bflo(g.y)), sigmoidf_(bfhi(g.y))}; }
DI f32x4 sig_hi(u32x4 g) { return (f32x4){sigmoidf_(bflo(g.z)), sigmoidf_(bfhi(g.z)), sigmoidf_(bflo(g.w)), sigmoidf_(bfhi(g.w))}; }
struct FMergeA { const bf16_t* GATE; bf16_t* Y;
    typedef u32x4 L;
    DI L load(int row, int col) const { return *(const u32x4*)(GATE + (size_t)row * 2048 + col); }
    DI void apply(int row, int col, f32x4 v0, f32x4 v1, L gv) const { st_bf8(Y + (size_t)row * DM + col, sig_lo(gv) * v0, sig_hi(gv) * v1); } };
struct FMergeB { const bf16_t* GATE; bf16_t* Y;
    struct L { u32x4 g, y; };
    DI L load(int row, int col) const { return L{*(const u32x4*)(GATE + (size_t)row * 2048 + 1024 + col), *(const u32x4*)(Y + (size_t)row * DM + col)}; }
    DI void apply(int row, int col, f32x4 v0, f32x4 v1, L q) const {
        const f32x4 y0 = {bflo(q.y.x), bfhi(q.y.x), bflo(q.y.y), bfhi(q.y.y)}, y1 = {bflo(q.y.z), bfhi(q.y.z), bflo(q.y.w), bfhi(q.y.w)};
        st_bf8(Y + (size_t)row * DM + col, y0 + sig_lo(q.g) * v0, y1 + sig_hi(q.g) * v1);
    } };

struct ESwiglu { bf16_t* H; const float* SS; const float* shw;
    DI void operator()(const f32x4 (&acc)[2][2][4][2], const Unit& u, int wr, int wc, int fr, int fq) const {
        const int row0 = u.pm * BM + wr * 64 + fr, c0 = wc * 32 + 8 * fq;
        const float* sw = shw + mod_row(u.pm * BM) * 5632 + u.pn * 256 + c0;
        f32x4 sg[2], su[2]; float rs[8];
#pragma unroll
        for (int n = 0; n < 2; ++n) { sg[n] = *(const f32x4*)(sw + 4 * n); su[n] = *(const f32x4*)(sw + 128 + 4 * n); }
#pragma unroll
        for (int i = 0; i < 8; ++i) rs[i] = row_rstd4(SS, row0 + (i >> 2) * HALF + (i & 3) * 16, fq);
#pragma unroll
        for (int ai = 0; ai < 2; ++ai)
#pragma unroll
            for (int m = 0; m < 4; ++m) {
                f32x4 h[2];
#pragma unroll
                for (int n = 0; n < 2; ++n) {
                    const f32x4 g = acc[ai][0][m][n] * rs[ai * 4 + m] + sg[n], uu = acc[ai][1][m][n] * rs[ai * 4 + m] + su[n];
#pragma unroll
                    for (int e = 0; e < 4; ++e) h[n][e] = g[e] * sigmoidf_(g[e]) * uu[e];
                }
                st_bf8(H + (size_t)(row0 + ai * HALF + m * 16) * DFF + u.pn * 128 + c0, h[0], h[1]);
            }
    } };
struct EWin { bf16_t *P1, *UXY, *GATE; const float* SS; const float* shw;
    template <int LD> DI void body(const f32x4 (&acc)[2][2][4][2], bf16_t* dst, const f32x4 (&sh)[2][2], const float (&rs)[8]) const {
#pragma unroll
        for (int ai = 0; ai < 2; ++ai)
#pragma unroll
            for (int m = 0; m < 4; ++m)
#pragma unroll
                for (int bj = 0; bj < 2; ++bj)
                    st_bf8(dst + (size_t)(ai * HALF + m * 16) * LD + 128 * bj, acc[ai][bj][m][0] * rs[ai * 4 + m] + sh[bj][0], acc[ai][bj][m][1] * rs[ai * 4 + m] + sh[bj][1]);
    }
    DI void operator()(const f32x4 (&acc)[2][2][4][2], const Unit& u, int wr, int wc, int fr, int fq) const {
        const int row0 = u.pm * BM + wr * 64 + fr, c0 = wc * 32 + 8 * fq;
        const float* sw = shw + mod_row(u.pm * BM) * 5632 + u.pn * 256 + c0;
        f32x4 sh[2][2]; float rs[8];
#pragma unroll
        for (int bj = 0; bj < 2; ++bj)
#pragma unroll
            for (int n = 0; n < 2; ++n) sh[bj][n] = *(const f32x4*)(sw + 128 * bj + 4 * n);
#pragma unroll
        for (int i = 0; i < 8; ++i) rs[i] = row_rstd4(SS, row0 + (i >> 2) * HALF + (i & 3) * 16, fq);
        if (u.pn < 3) body<768>(acc, P1 + (size_t)row0 * 768 + u.pn * 256 + c0, sh, rs);
        else if (u.pn < 7) body<1024>(acc, UXY + (size_t)row0 * 1024 + (u.pn - 3) * 256 + c0, sh, rs);
        else body<2048>(acc, GATE + (size_t)row0 * 2048 + (u.pn - 7) * 256 + c0, sh, rs);
    } };
template <int COEF2, bool NORM> struct EResid { const float* src; float* dst; const float* mod; const float* scn; bf16_t* XS; float* SS;
    DI void operator()(const f32x4 (&acc)[2][2][4][2], const Unit& u, int wr, int wc, int fr, int fq) const {
        const int row0 = u.pm * BM + wr * 64 + fr, col0 = u.pn * BM + wc * 32 + 8 * fq, r = mod_row(u.pm * BM);
        f32x4 g[2][2], sc[2][2];
#pragma unroll
        for (int bj = 0; bj < 2; ++bj)
#pragma unroll
            for (int n = 0; n < 2; ++n) { g[bj][n] = *(const f32x4*)(mod + r * NMOD + col0 + 128 * bj + 4 * n) * (0.5f * COEF2);
                if (NORM) sc[bj][n] = *(const f32x4*)(scn + r * NMOD + col0 + 128 * bj + 4 * n) + 1.f; }
        f32x4 xc[2][2], xn_[2][2];
#pragma unroll
        for (int bj = 0; bj < 2; ++bj)
#pragma unroll
            for (int n = 0; n < 2; ++n) xc[bj][n] = *(const f32x4*)(src + (size_t)row0 * DM + col0 + 128 * bj + 4 * n);
#pragma unroll
        for (int i = 0; i < 8; ++i) {
            const int row = row0 + (i >> 2) * HALF + (i & 3) * 16;
            if (i < 7) { const int rown = row0 + ((i + 1) >> 2) * HALF + ((i + 1) & 3) * 16;
#pragma unroll
                for (int bj = 0; bj < 2; ++bj)
#pragma unroll
                    for (int n = 0; n < 2; ++n) xn_[bj][n] = *(const f32x4*)(src + (size_t)rown * DM + col0 + 128 * bj + 4 * n); }
            float ssq = 0.f;
#pragma unroll
            for (int bj = 0; bj < 2; ++bj) {
                f32x4 y[2];
#pragma unroll
                for (int n = 0; n < 2; ++n) {
                    y[n] = xc[bj][n] + g[bj][n] * acc[i >> 2][bj][i & 3][n];
                    *(f32x4*)(dst + (size_t)row * DM + col0 + 128 * bj + 4 * n) = y[n];
                    if (NORM) ssq += (y[n][0] * y[n][0] + y[n][1] * y[n][1]) + (y[n][2] * y[n][2] + y[n][3] * y[n][3]);
                }
                if (NORM) st_bf8(XS + (size_t)row * DM + col0 + 128 * bj, y[0] * sc[bj][0], y[1] * sc[bj][1]);
            }
            if (NORM) { ssq += __shfl_xor(ssq, 16); ssq += __shfl_xor(ssq, 32); if (fq == 0) SS[(size_t)row * 16 + (u.pn & 3) * 4 + wc] = ssq; }
#pragma unroll
            for (int bj = 0; bj < 2; ++bj)
#pragma unroll
                for (int n = 0; n < 2; ++n) xc[bj][n] = xn_[bj][n];
        }
    } };

DI void phase_mod(const Params& p, float* lds) {
    float* sc = lds;
    float* red = lds + 5 * DM;
    const int tid = TIDX, lane = tid & 63, wave = tid >> 6;
    for (int i = tid; i < 5 * DM; i += 512) { const float v = i < 4 * DM ? p.c[i] : p.c_ctx[i - 4 * DM]; sc[i] = v * sigmoidf_(v); }
    __syncthreads();
    float* mod = (float*)(p.ws + O_MOD);
    for (int it = BIDX; it < DEPTH * (NMOD / 64); it += gridDim.x) {
        const int l = it / (NMOD / 64), n = (it % (NMOD / 64)) * 64 + lane;
        const float* w = p.w_ada + ((size_t)l * DM + wave * 128) * NMOD + n;
        float a0 = 0.f, a1 = 0.f, a2 = 0.f, a3 = 0.f, a4 = 0.f;
#pragma unroll 8
        for (int k = 0; k < 128; ++k) { const float wv = w[(size_t)k * NMOD]; const int kk = wave * 128 + k;
            a0 += sc[kk] * wv; a1 += sc[DM + kk] * wv; a2 += sc[2 * DM + kk] * wv; a3 += sc[3 * DM + kk] * wv; a4 += sc[4 * DM + kk] * wv; }
        red[(wave * 5 + 0) * 64 + lane] = a0; red[(wave * 5 + 1) * 64 + lane] = a1; red[(wave * 5 + 2) * 64 + lane] = a2; red[(wave * 5 + 3) * 64 + lane] = a3; red[(wave * 5 + 4) * 64 + lane] = a4;
        __syncthreads();
        if (tid < 320) { const int r = tid >> 6; float s = p.b_ada[(size_t)l * NMOD + n];
#pragma unroll
            for (int w8 = 0; w8 < 8; ++w8) s += red[(w8 * 5 + r) * 64 + lane];
            mod[((size_t)l * 5 + r) * NMOD + n] = s; }
        __syncthreads();
    }
}

template <int MAP> DI int colmap(int n) {
    if (MAP == 0) return n;
    if (MAP == 1) { const int pn = n >> 8, bj = (n >> 7) & 1, c = n & 127; return bj * DFF + pn * 128 + c; }
    if (MAP == 2) return n < 672 ? n : (n < 768 ? -1 : n - 96);
    { const int m = n & 511, h = m >> 6, d = m & 63; return h * 128 + (n >> 9) * 64 + d; }
}
template <int MAP> DI void tjob(const float* src, int ld, int K, int N, bf16_t* dst, const float* kscale, float* tile, int& base, int vbid, int G) {
    const int tid = TIDX, ntn = N / 64, ntiles = ntn * (K / 64);
    int first = (vbid - base % G + G) % G;
    for (int t = first; t < ntiles; t += G) {
        const int n0 = (t % ntn) * 64, k0 = (t / ntn) * 64;
        const int c = colmap<MAP>(n0 + (tid & 63));
#pragma unroll
        for (int i = 0; i < 8; ++i) { const int kk = (tid >> 6) + 8 * i; float v = c >= 0 ? src[(size_t)(k0 + kk) * ld + c] : 0.f; if (kscale) v *= kscale[k0 + kk]; tile[kk * 65 + (tid & 63)] = v; }
        __syncthreads();
        { const int kc = tid & 7, nn = tid >> 3;
          const float* tp = tile + (kc * 8) * 65 + nn;
          u32x4 o; o.x = pk2(tp[0], tp[65]); o.y = pk2(tp[2 * 65], tp[3 * 65]); o.z = pk2(tp[4 * 65], tp[5 * 65]); o.w = pk2(tp[6 * 65], tp[7 * 65]);
          *(u32x4*)(dst + (size_t)(n0 + nn) * K + k0 + kc * 8) = o; }
        __syncthreads();
    }
    base += ntiles;
}
DI void phase_prep_ff(const Params& p, int l, int which, float* tile, int vbid, int vG) {
    unsigned char* ws = p.ws; int base = 0;
    if (which == 0) {
        tjob<1>(p.ff1_w_in + (size_t)l * DM * 2 * DFF, 2 * DFF, DM, 2 * DFF, (bf16_t*)(ws + O_WFF1IN), nullptr, tile, base, vbid, vG);
        tjob<0>(p.ff1_w_out + (size_t)l * DFF * DM, DM, DFF, DM, (bf16_t*)(ws + O_WFF1OUT), nullptr, tile, base, vbid, vG);
    } else {
        tjob<1>(p.ff2_w_in + (size_t)l * DM * 2 * DFF, 2 * DFF, DM, 2 * DFF, (bf16_t*)(ws + O_WFF2IN), nullptr, tile, base, vbid, vG);
        tjob<0>(p.ff2_w_out + (size_t)l * DFF * DM, DM, DFF, DM, (bf16_t*)(ws + O_WFF2OUT), nullptr, tile, base, vbid, vG);
    }
}
DI void phase_prep(const Params& p, int l, float* tile) {
    unsigned char* ws = p.ws; int base = 0;
    const int vbid = BIDX, vG = gridDim.x;
    const float* modl = (const float*)(ws + O_MOD) + (size_t)l * 5 * NMOD; float* shw = (float*)(ws + O_SHW);
    if (l == 0) phase_prep_ff(p, 0, 0, tile, vbid, vG);
    tjob<2>(p.w_in + (size_t)l * DM * 3744, 3744, DM, NIN, (bf16_t*)(ws + O_WIN), nullptr, tile, base, vbid, vG);
    tjob<0>(p.w_uq + (size_t)l * 384 * 768, 768, 384, 768, (bf16_t*)(ws + O_WUQ), p.q_a_norm + l * 384, tile, base, vbid, vG);
    tjob<3>(p.w_ukv + (size_t)l * 256 * 1024, 1024, 256, 1024, (bf16_t*)(ws + O_WUKV), p.kv_a_norm + l * 256, tile, base, vbid, vG);
    tjob<0>(p.w_o_attn + (size_t)l * 512 * 1024, 1024, 512, 1024, (bf16_t*)(ws + O_WOA), nullptr, tile, base, vbid, vG);
    tjob<0>(p.w_o_lru + (size_t)l * 512 * 1024, 1024, 512, 1024, (bf16_t*)(ws + O_WOL), nullptr, tile, base, vbid, vG);
    tjob<0>(p.w_out + (size_t)l * 1024 * 1024, 1024, 1024, 1024, (bf16_t*)(ws + O_WOUT), nullptr, tile, base, vbid, vG);
    { float* sh = tile; float* red = tile + 5 * DM;
      const int tid = TIDX, nn = tid & 63, ks = tid >> 6;
      for (int it = BIDX; it < 88 + 60 + 88; it += gridDim.x) {
          const int m = it < 88 ? 0 : (it < 148 ? 1 : 2), n0 = (m == 0 ? it : (m == 1 ? it - 88 : it - 148)) * 64;
          const float* W = m == 0 ? p.ff1_w_in + (size_t)l * DM * 2 * DFF : (m == 1 ? p.w_in + (size_t)l * DM * 3744 : p.ff2_w_in + (size_t)l * DM * 2 * DFF);
          const int ld = m == 1 ? 3744 : 2 * DFF, c = m == 1 ? colmap<2>(n0 + nn) : colmap<1>(n0 + nn);
          __syncthreads();
          for (int i = tid; i < 5 * DM; i += 512) sh[i] = modl[(size_t)(i >> 10) * NMOD + m * 3 * DM + (i & 1023)];
          __syncthreads();
          float a0 = 0.f, a1 = 0.f, a2 = 0.f, a3 = 0.f, a4 = 0.f;
          if (c >= 0) {
#pragma unroll 8
              for (int k = ks * 128; k < ks * 128 + 128; ++k) { const float wv = W[(size_t)k * ld + c]; a0 += sh[k] * wv; a1 += sh[DM + k] * wv; a2 += sh[2 * DM + k] * wv; a3 += sh[3 * DM + k] * wv; a4 += sh[4 * DM + k] * wv; }
          }
          red[(ks * 5 + 0) * 64 + nn] = a0; red[(ks * 5 + 1) * 64 + nn] = a1; red[(ks * 5 + 2) * 64 + nn] = a2; red[(ks * 5 + 3) * 64 + nn] = a3; red[(ks * 5 + 4) * 64 + nn] = a4;
          __syncthreads();
          if (tid < 320) { const int r = tid >> 6; float sum = 0.f;
#pragma unroll
              for (int w8 = 0; w8 < 8; ++w8) sum += red[(w8 * 5 + r) * 64 + nn];
              shw[(size_t)(m * 5 + r) * 5632 + n0 + nn] = sum; }
      }
      __syncthreads(); }
    if (BIDX == 0) { float* sp8 = (float*)(ws + O_SP);
        for (int i = TIDX; i < 1024; i += 512) { const float nl = -p.lru_lambda[l * 1024 + i]; sp8[i] = -8.f * (fmaxf(nl, 0.f) + log1pf(__expf(-fabsf(nl)))); } }
    bf16_t* wg = (bf16_t*)(ws + O_WGATE);
    for (int idx = BIDX * 512 + TIDX; idx < 2048 * 256; idx += gridDim.x * 512) {
        const int n = idx >> 8, k = idx & 255, d = n >> 10, cb = (n >> 8) & 3, gt = (n >> 7) & 1, c = n & 127, ch = cb * 128 + c, g = ch >> 6, j = ch & 63, ci = 256 * (cb >> 1) + k, gi = ci >> 6, i = ci & 63;
        float v = 0.f;
        if (gi == g) v = (gt ? p.w_igate : p.w_rgate)[((((size_t)l * 2 + d) * 8 + g) * 64 + i) * 64 + j];
        wg[idx] = f2bf(v);
    }
}

DI void phase_norm0(const Params& p) {
    const int tid = TIDX, lane = tid & 63, gw = BIDX * 8 + (tid >> 6), nw = gridDim.x * 8;
    float* X = (float*)(p.ws + O_X); bf16_t* XS = (bf16_t*)(p.ws + O_XNY); float* SS = (float*)(p.ws + O_SS);
    const float* mod = (const float*)(p.ws + O_MOD);
    for (int row = gw; row < MA; row += nw) {
        const float* src = row < ML ? p.x + (size_t)row * DM : p.ctx + (size_t)(row - ML) * DM;
        f32x4 v[4]; float s = 0.f;
#pragma unroll
        for (int j = 0; j < 4; ++j) { v[j] = *(const f32x4*)(src + 256 * j + 4 * lane); s += (v[j][0] * v[j][0] + v[j][1] * v[j][1]) + (v[j][2] * v[j][2] + v[j][3] * v[j][3]); }
        s = wave_sum(s);
        if (lane < 16) SS[(size_t)row * 16 + lane] = lane == 0 ? s : 0.f;
        const float* mr = mod + (size_t)mod_row(row) * NMOD;
#pragma unroll
        for (int j = 0; j < 4; ++j) {
            const int col = 256 * j + 4 * lane;
            *(f32x4*)(X + (size_t)row * DM + col) = v[j];
            const f32x4 sc = *(const f32x4*)(mr + DM + col);
            st_bf4(XS + (size_t)row * DM + col, v[j] * (1.f + sc));
        }
    }
}

DI void phase_conv(const Params& p, int l) {
    const bf16_t* UXY = (const bf16_t*)(p.ws + O_UXY); const bf16_t* P1 = (const bf16_t*)(p.ws + O_R1);
    bf16_t* xc = (bf16_t*)(p.ws + O_XNY);
    const float* cw = p.conv_w + (size_t)l * 4 * 512; const float* cb = p.conv_b + (size_t)l * 512;
    for (int e = BIDX * 512 + TIDX; e < MA * 64; e += gridDim.x * 512) {
        const int row = e >> 6, ch = (e & 63) * 8;
        int t, T; if (row < ML) { t = row & (SEQ - 1); T = SEQ; } else { t = (row - ML) & 255; T = CTXL; }
        u32x4 uv[4]; float ok[4];
#pragma unroll
        for (int k = 0; k < 4; ++k) { const int tt = t + k - 2; const bool in = tt >= 0 && tt < T; ok[k] = in ? 1.f : 0.f;
            uv[k] = *(const u32x4*)(UXY + (size_t)(in ? row + k - 2 : row) * 1024 + ch); }
        f32x4 y0 = *(const f32x4*)(cb + ch), y1 = *(const f32x4*)(cb + ch + 4);
#pragma unroll
        for (int k = 0; k < 4; ++k) {
            const f32x4 w0 = *(const f32x4*)(cw + k * 512 + ch) * ok[k], w1 = *(const f32x4*)(cw + k * 512 + ch + 4) * ok[k];
            const f32x4 a = {bflo(uv[k].x), bfhi(uv[k].x), bflo(uv[k].y), bfhi(uv[k].y)}, c = {bflo(uv[k].z), bfhi(uv[k].z), bflo(uv[k].w), bfhi(uv[k].w)};
            y0 += w0 * a; y1 += w1 * c;
        }
        u32x4 o; o.x = pk2(y0[0], y0[1]); o.y = pk2(y0[2], y0[3]); o.z = pk2(y1[0], y1[1]); o.w = pk2(y1[2], y1[3]);
        *(u32x4*)(xc + (size_t)row * 512 + ch) = o;
    }
    float* rsq = (float*)(p.ws + O_RSQ); float* rskv = (float*)(p.ws + O_RSKV);
    const int tid2 = TIDX, l16 = tid2 & 15, gq = BIDX * 32 + (tid2 >> 4), nq = gridDim.x * 32;
    for (int row = gq; row < MA; row += nq) {
        const bf16_t* pr = P1 + (size_t)row * 768;
        u32x4 v[5];
#pragma unroll
        for (int i = 0; i < 5; ++i) v[i] = *(const u32x4*)(pr + (l16 + 16 * i) * 8);
        float sq = 0.f, skv = 0.f;
#pragma unroll
        for (int i = 0; i < 5; ++i) {
            const float s2 = bflo(v[i].x) * bflo(v[i].x) + bfhi(v[i].x) * bfhi(v[i].x) + bflo(v[i].y) * bflo(v[i].y) + bfhi(v[i].y) * bfhi(v[i].y)
                           + bflo(v[i].z) * bflo(v[i].z) + bfhi(v[i].z) * bfhi(v[i].z) + bflo(v[i].w) * bflo(v[i].w) + bfhi(v[i].w) * bfhi(v[i].w);
            if (i < 3) sq += s2; else skv += s2;
        }
#pragma unroll
        for (int o = 1; o < 16; o <<= 1) { sq += __shfl_xor(sq, o); skv += __shfl_xor(skv, o); }
        if (l16 == 0) { rsq[row] = rsqrtf(sq * (1.f / 384.f) + EPS); rskv[row] = rsqrtf(skv * (1.f / 256.f) + EPS); }
    }
}

DI int chunk_row0(int b, int pch) { return pch < 4 ? ML + b * CTXL + pch * 64 : b * SEQ + (pch - 4) * 64; }
DI void phase_scan_agg(const Params& p) {
    const bf16_t* OM = (const bf16_t*)(p.ws + O_S); const bf16_t* BB = OM + (size_t)2 * MA * 512;
    f32x4* agg = (f32x4*)(p.ws + O_AGG);
    const int tid = TIDX, lane = tid & 63, gw = (tid >> 6) * gridDim.x + BIDX, nw = gridDim.x * 8;
    for (int it = gw; it < 2 * NB * NCH; it += nw) {
        const int d = it & 1, bp = it >> 1, b = bp / NCH, pch = bp % NCH, row0 = chunk_row0(b, pch);
        const bf16_t* om = OM + ((size_t)d * MA + row0) * 512 + lane * 8; const bf16_t* bb = BB + ((size_t)d * MA + row0) * 512 + lane * 8;
        float h[8], A[8];
#pragma unroll
        for (int i = 0; i < 8; ++i) { h[i] = 0.f; A[i] = 1.f; }
#pragma unroll 8
        for (int t = 0; t < 64; ++t) {
            const int tt = d ? 63 - t : t;
            const u32x4 ov = *(const u32x4*)(om + (size_t)tt * 512), bv = *(const u32x4*)(bb + (size_t)tt * 512);
            const float a[8] = {1.f - bflo(ov.x), 1.f - bfhi(ov.x), 1.f - bflo(ov.y), 1.f - bfhi(ov.y), 1.f - bflo(ov.z), 1.f - bfhi(ov.z), 1.f - bflo(ov.w), 1.f - bfhi(ov.w)};
            const float bq[8] = {bflo(bv.x), bfhi(bv.x), bflo(bv.y), bfhi(bv.y), bflo(bv.z), bfhi(bv.z), bflo(bv.w), bfhi(bv.w)};
#pragma unroll
            for (int i = 0; i < 8; ++i) { h[i] = a[i] * h[i] + bq[i]; A[i] *= a[i]; }
        }
        f32x4* dst = agg + (((size_t)(d * NB + b) * NCH + pch) * 512 + lane * 8) / 2;
#pragma unroll
        for (int i = 0; i < 4; ++i) dst[i] = (f32x4){A[2 * i], h[2 * i], A[2 * i + 1], h[2 * i + 1]};
    }
}
DI float gelu_tanh(float x) { const float u = 0.7978845608028654f * (x + 0.044715f * x * x * x); const float e = __expf(2.f * u); const float th = 1.f - 2.f * __builtin_amdgcn_rcpf(e + 1.f); return 0.5f * x * (1.f + th); }
DI void agg_step(const f32x4* e, float (&h)[8]) {
    const f32x4 e0 = e[0], e1 = e[1], e2 = e[2], e3 = e[3];
    h[0] = e0[0] * h[0] + e0[1]; h[1] = e0[2] * h[1] + e0[3]; h[2] = e1[0] * h[2] + e1[1]; h[3] = e1[2] * h[3] + e1[3];
    h[4] = e2[0] * h[4] + e2[1]; h[5] = e2[2] * h[5] + e2[3]; h[6] = e3[0] * h[6] + e3[1]; h[7] = e3[2] * h[7] + e3[3];
}
DI void phase_scan_apply(const Params& p) {
    const bf16_t* OM = (const bf16_t*)(p.ws + O_S); const bf16_t* BB = OM + (size_t)2 * MA * 512;
    const f32x4* agg = (const f32x4*)(p.ws + O_AGG);
    bf16_t* UXY = (bf16_t*)(p.ws + O_UXY); float* HF = p.out;
    const int tid = TIDX, lane = tid & 63, gw = (tid >> 6) * gridDim.x + BIDX, nw = gridDim.x * 8;
    for (int it = gw; it < NB * NCH; it += nw) {
        const int b = it / NCH, pch = it % NCH, row0 = chunk_row0(b, pch);
        const f32x4* af = agg + (((size_t)(0 * NB + b) * NCH) * 512 + lane * 8) / 2; const f32x4* ab = agg + (((size_t)(1 * NB + b) * NCH) * 512 + lane * 8) / 2;
        float h[8];
#pragma unroll
        for (int i = 0; i < 8; ++i) h[i] = 0.f;
#pragma unroll 4
        for (int q = 0; q < pch; ++q) agg_step(af + (size_t)q * 256, h);
        { const bf16_t* om = OM + ((size_t)row0) * 512 + lane * 8; const bf16_t* bb = BB + ((size_t)row0) * 512 + lane * 8; float* hf = HF + (size_t)row0 * 512 + lane * 8;
#pragma unroll 8
          for (int t = 0; t < 64; ++t) {
              const u32x4 ov = *(const u32x4*)(om + (size_t)t * 512), bv = *(const u32x4*)(bb + (size_t)t * 512);
              h[0] = (1.f - bflo(ov.x)) * h[0] + bflo(bv.x); h[1] = (1.f - bfhi(ov.x)) * h[1] + bfhi(bv.x); h[2] = (1.f - bflo(ov.y)) * h[2] + bflo(bv.y); h[3] = (1.f - bfhi(ov.y)) * h[3] + bfhi(bv.y);
              h[4] = (1.f - bflo(ov.z)) * h[4] + bflo(bv.z); h[5] = (1.f - bfhi(ov.z)) * h[5] + bfhi(bv.z); h[6] = (1.f - bflo(ov.w)) * h[6] + bflo(bv.w); h[7] = (1.f - bfhi(ov.w)) * h[7] + bfhi(bv.w);
              *(f32x4*)(hf + (size_t)t * 512) = (f32x4){h[0], h[1], h[2], h[3]}; *(f32x4*)(hf + (size_t)t * 512 + 4) = (f32x4){h[4], h[5], h[6], h[7]};
          } }
#pragma unroll
        for (int i = 0; i < 8; ++i) h[i] = 0.f;
        if (pch >= 4) {
#pragma unroll
            for (int q = 3; q >= 0; --q) agg_step(ab + (size_t)q * 256, h);
#pragma unroll 4
            for (int q = NCH - 1; q > pch; --q) agg_step(ab + (size_t)q * 256, h);
        } else {
            for (int q = 3; q > pch; --q) agg_step(ab + (size_t)q * 256, h);
        }
        { const bf16_t* om = OM + ((size_t)MA + row0) * 512 + lane * 8; const bf16_t* bb = BB + ((size_t)MA + row0) * 512 + lane * 8; const float* hf = HF + (size_t)row0 * 512 + lane * 8;
#pragma unroll 4
          for (int t = 63; t >= 0; --t) {
              const u32x4 ov = *(const u32x4*)(om + (size_t)t * 512), bv = *(const u32x4*)(bb + (size_t)t * 512);
              const f32x4 f0 = *(const f32x4*)(hf + (size_t)t * 512), f1 = *(const f32x4*)(hf + (size_t)t * 512 + 4);
              const u32x4 uv = *(const u32x4*)(UXY + (size_t)(row0 + t) * 1024 + 512 + lane * 8);
              h[0] = (1.f - bflo(ov.x)) * h[0] + bflo(bv.x); h[1] = (1.f - bfhi(ov.x)) * h[1] + bfhi(bv.x); h[2] = (1.f - bflo(ov.y)) * h[2] + bflo(bv.y); h[3] = (1.f - bfhi(ov.y)) * h[3] + bfhi(bv.y);
              h[4] = (1.f - bflo(ov.z)) * h[4] + bflo(bv.z); h[5] = (1.f - bfhi(ov.z)) * h[5] + bfhi(bv.z); h[6] = (1.f - bflo(ov.w)) * h[6] + bflo(bv.w); h[7] = (1.f - bfhi(ov.w)) * h[7] + bfhi(bv.w);
              u32x4 o;
              o.x = pk2((f0[0] + h[0]) * gelu_tanh(bflo(uv.x)), (f0[1] + h[1]) * gelu_tanh(bfhi(uv.x))); o.y = pk2((f0[2] + h[2]) * gelu_tanh(bflo(uv.y)), (f0[3] + h[3]) * gelu_tanh(bfhi(uv.y)));
              o.z = pk2((f1[0] + h[4]) * gelu_tanh(bflo(uv.z)), (f1[1] + h[5]) * gelu_tanh(bfhi(uv.z))); o.w = pk2((f1[2] + h[6]) * gelu_tanh(bflo(uv.w)), (f1[3] + h[7]) * gelu_tanh(bfhi(uv.w)));
              *(u32x4*)(UXY + (size_t)(row0 + t) * 1024 + lane * 8) = o;
          } }
    }
}

DI void phase_qk(const Params& p, int l, unsigned char* smem) {
    const bf16_t* qraw = (const bf16_t*)p.out; const bf16_t* kn = qraw + (size_t)MA * 768;
    const bf16_t* P1 = (const bf16_t*)(p.ws + O_R1);
    bf16_t* Q = (bf16_t*)(p.ws + O_S); bf16_t* Kb = Q + (size_t)32 * TK * 96;
    const int tid = TIDX, lane = tid & 63, wave = tid >> 6, gw = BIDX * 8 + wave, nw = gridDim.x * 8, h = lane >> 3, j = lane & 7;
    unsigned char* wq = smem + wave * 4096; unsigned char* wk = wq + 1536;
    const float* qn = p.q_norm + l * 96; const float* knm = p.k_norm + l * 96;
    float gq[12], gk[12];
#pragma unroll
    for (int i = 0; i < 12; ++i) { gq[i] = qn[8 * i + j] * QSCALE; gk[i] = knm[8 * i + j]; }
    const float freq = exp2f(-(float)j * 1.6609640474436813f);
    for (int row = gw; row < MA; row += nw) {
        { const u32x4 q0 = *(const u32x4*)(qraw + (size_t)row * 768 + lane * 8);
          u32x4 q1 = {0u, 0u, 0u, 0u}, k1 = {0u, 0u, 0u, 0u};
          if (lane < 32) q1 = *(const u32x4*)(qraw + (size_t)row * 768 + 512 + lane * 8);
          const u32x4 k0 = *(const u32x4*)(kn + (size_t)row * 512 + lane * 8);
          if (lane < 4) k1 = *(const u32x4*)(P1 + (size_t)row * 768 + 640 + lane * 8);
          *(u32x4*)(wq + lane * 16) = q0; if (lane < 32) *(u32x4*)(wq + 1024 + lane * 16) = q1;
          *(u32x4*)(wk + lane * 16) = k0; if (lane < 4) *(u32x4*)(wk + 1024 + lane * 16) = k1; }
        __builtin_amdgcn_fence(__ATOMIC_RELEASE, "wavefront"); __builtin_amdgcn_wave_barrier(); __builtin_amdgcn_fence(__ATOMIC_ACQUIRE, "wavefront");
        float xq[12], xk[12];
#pragma unroll
        for (int i = 0; i < 12; ++i) xq[i] = bf2f(*(const bf16_t*)(wq + (h * 96 + 8 * i + j) * 2));
#pragma unroll
        for (int i = 0; i < 8; ++i) xk[i] = bf2f(*(const bf16_t*)(wk + (h * 64 + 8 * i + j) * 2));
#pragma unroll
        for (int i = 8; i < 12; ++i) xk[i] = bf2f(*(const bf16_t*)(wk + 1024 + (8 * (i - 8) + j) * 2));
        __builtin_amdgcn_fence(__ATOMIC_RELEASE, "wavefront"); __builtin_amdgcn_wave_barrier(); __builtin_amdgcn_fence(__ATOMIC_ACQUIRE, "wavefront");
        const bool lat = row < ML; int b, pos;
        if (lat) { b = row >> 13; pos = row & (SEQ - 1); } else { const int r = row - ML; b = r >> 8; pos = SEQ + (r & 255); }
        float c0 = 1.f, s0 = 0.f, c1 = 1.f, s1 = 0.f;
        if (lat) { float r0 = (float)(pos >> 6) * freq * 0.15915494309189535f, r1 = (float)(pos & 63) * freq * 0.15915494309189535f;
            r0 -= floorf(r0); r1 -= floorf(r1);
            c0 = __builtin_amdgcn_cosf(r0); s0 = __builtin_amdgcn_sinf(r0); c1 = __builtin_amdgcn_cosf(r1); s1 = __builtin_amdgcn_sinf(r1); }
        float sq = 0.f, sk = 0.f;
#pragma unroll
        for (int i = 0; i < 12; ++i) { sq += xq[i] * xq[i]; sk += xk[i] * xk[i]; }
        sq += __shfl_xor(sq, 1); sk += __shfl_xor(sk, 1); sq += __shfl_xor(sq, 2); sk += __shfl_xor(sk, 2); sq += __shfl_xor(sq, 4); sk += __shfl_xor(sk, 4);
        const float rq = rsqrtf(sq * (1.f / 96.f) + EPS), rk = rsqrtf(sk * (1.f / 96.f) + EPS);
#pragma unroll
        for (int i = 0; i < 12; ++i) { xq[i] *= rq * gq[i]; xk[i] *= rk * gk[i]; }
        { const float y8 = xq[8] * c0 - xq[9] * s0, y9 = xq[8] * s0 + xq[9] * c0, y10 = xq[10] * c1 - xq[11] * s1, y11 = xq[10] * s1 + xq[11] * c1;
          xq[8] = y8; xq[9] = y9; xq[10] = y10; xq[11] = y11; }
        { const float y8 = xk[8] * c0 - xk[9] * s0, y9 = xk[8] * s0 + xk[9] * c0, y10 = xk[10] * c1 - xk[11] * s1, y11 = xk[10] * s1 + xk[11] * c1;
          xk[8] = y8; xk[9] = y9; xk[10] = y10; xk[11] = y11; }
#pragma unroll
        for (int i = 0; i < 12; ++i) { *(bf16_t*)(wq + (h * 96 + 8 * i + j) * 2) = f2bf(xq[i]); *(bf16_t*)(wk + (h * 96 + 8 * i + j) * 2) = f2bf(xk[i]); }
        __builtin_amdgcn_fence(__ATOMIC_RELEASE, "wavefront"); __builtin_amdgcn_wave_barrier(); __builtin_amdgcn_fence(__ATOMIC_ACQUIRE, "wavefront");
        { const int c0i = lane, c1i = 64 + lane;
          const u32x4 oq0 = *(const u32x4*)(wq + c0i * 16), ok0 = *(const u32x4*)(wk + c0i * 16);
          const size_t d0 = ((size_t)(b * NH + c0i / 12) * TK + pos) * 96 + (c0i % 12) * 8;
          *(u32x4*)(Q + d0) = oq0; *(u32x4*)(Kb + d0) = ok0;
          if (lane < 32) { const u32x4 oq1 = *(const u32x4*)(wq + c1i * 16), ok1 = *(const u32x4*)(wk + c1i * 16);
              const size_t d1 = ((size_t)(b * NH + c1i / 12) * TK + pos) * 96 + (c1i % 12) * 8;
              *(u32x4*)(Q + d1) = oq1; *(u32x4*)(Kb + d1) = ok1; } }
        __builtin_amdgcn_fence(__ATOMIC_RELEASE, "wavefront"); __builtin_amdgcn_wave_barrier(); __builtin_amdgcn_fence(__ATOMIC_ACQUIRE, "wavefront");
    }
}

constexpr int KROW = 208, VROW = 144, KBYTES = 64 * KROW, ABUF = KBYTES + 64 * VROW;
DI void attn_item(unsigned char* lds, const bf16_t* Q, const bf16_t* Kb, const bf16_t* Vt, bf16_t* att, int bh, int qposA, int qposB, int kt0, int kt1, int outrowA, int outrowB, bool writeB) {
    const int tid = TIDX, lane = tid & 63, l31 = lane & 31, half = lane >> 5;
    bf16x8 qa[6], qb[6];
    { const bf16_t* qp = Q + ((size_t)bh * TK + qposA + l31) * 96 + 8 * half; const bf16_t* qq = Q + ((size_t)bh * TK + qposB + l31) * 96 + 8 * half;
#pragma unroll
      for (int ks = 0; ks < 6; ++ks) { qa[ks] = *(const bf16x8*)(qp + 16 * ks); qb[ks] = *(const bf16x8*)(qq + 16 * ks); } }
    f32x16 oa0, oa1, ob0, ob1;
#pragma unroll
    for (int i = 0; i < 16; ++i) { oa0[i] = 0.f; oa1[i] = 0.f; ob0[i] = 0.f; ob1[i] = 0.f; }
    float la = 0.f, lb = 0.f;
    const unsigned char* kg = (const unsigned char*)(Kb + (size_t)bh * TK * 96) + (size_t)tid * 16;
    const unsigned char* vg = (const unsigned char*)(Vt + ((size_t)bh * 64 + (tid >> 3)) * TK) + (tid & 7) * 16;
    const int kc1 = 512 + tid;
    const int koff0 = (tid / 12) * KROW + (tid % 12) * 16, koff1 = (kc1 / 12) * KROW + (kc1 % 12) * 16;
    const int voff = KBYTES + (tid >> 3) * VROW + ((tid & 7) >> 1) * 32 + (tid & 1) * 8;
    const int klo = l31 * KROW + 16 * half, vlo = KBYTES + l31 * VROW + 16 * half;
    u32x4 kr0, kr1 = {0u, 0u, 0u, 0u}, vr;
#define AT_GLOAD(kt) do { kr0 = *(const u32x4*)(kg + (size_t)(kt) * 12288); if (tid < 256) kr1 = *(const u32x4*)(kg + (size_t)(kt) * 12288 + 8192); vr = *(const u32x4*)(vg + (size_t)(kt) * 128); } while (0)
#define AT_SSTORE(stg) do { unsigned char* bp_ = lds + (stg) * ABUF; *(u32x4*)(bp_ + koff0) = kr0; if (tid < 256) *(u32x4*)(bp_ + koff1) = kr1; \
        *(u32x2*)(bp_ + voff) = (u32x2){vr.x, vr.y}; *(u32x2*)(bp_ + voff + 16) = (u32x2){vr.z, vr.w}; } while (0)
#define AT_PK(v, o) (u32x4){pk2(v[o], v[o + 1]), pk2(v[o + 2], v[o + 3]), pk2(v[o + 4], v[o + 5]), pk2(v[o + 6], v[o + 7])}
    AT_GLOAD(kt0); AT_SSTORE(0);
    __syncthreads();
    for (int kt = kt0; kt < kt1; ++kt) {
        const int cur = (kt - kt0) & 1;
        const bool more = kt + 1 < kt1;
        if (more) AT_GLOAD(kt + 1);
        const unsigned char* kl = lds + cur * ABUF + klo;
        const unsigned char* vl = lds + cur * ABUF + vlo;
        f32x16 sa0, sa1, sb0, sb1;
        const f32x16 zero16 = {0.f, 0.f, 0.f, 0.f, 0.f, 0.f, 0.f, 0.f, 0.f, 0.f, 0.f, 0.f, 0.f, 0.f, 0.f, 0.f};
        __builtin_amdgcn_s_setprio(1);
#pragma unroll
        for (int ks = 0; ks < 6; ++ks) {
            const bf16x8 a0 = *(const bf16x8*)(kl + 32 * ks), a1 = *(const bf16x8*)(kl + 32 * KROW + 32 * ks);
            sa0 = __builtin_amdgcn_mfma_f32_32x32x16_bf16(a0, qa[ks], ks == 0 ? zero16 : sa0, 0, 0, 0);
            sa1 = __builtin_amdgcn_mfma_f32_32x32x16_bf16(a1, qa[ks], ks == 0 ? zero16 : sa1, 0, 0, 0);
            sb0 = __builtin_amdgcn_mfma_f32_32x32x16_bf16(a0, qb[ks], ks == 0 ? zero16 : sb0, 0, 0, 0);
            sb1 = __builtin_amdgcn_mfma_f32_32x32x16_bf16(a1, qb[ks], ks == 0 ? zero16 : sb1, 0, 0, 0);
        }
        __builtin_amdgcn_s_setprio(0);
        float pa = 0.f, pb = 0.f;
#pragma unroll
        for (int i = 0; i < 16; ++i) { sa0[i] = __builtin_amdgcn_exp2f(sa0[i]); sa1[i] = __builtin_amdgcn_exp2f(sa1[i]); pa += sa0[i] + sa1[i];
                                       sb0[i] = __builtin_amdgcn_exp2f(sb0[i]); sb1[i] = __builtin_amdgcn_exp2f(sb1[i]); pb += sb0[i] + sb1[i]; }
        la += pa; lb += pb;
        __builtin_amdgcn_s_setprio(1);
#pragma unroll
        for (int s = 0; s < 4; ++s) {
            const bf16x8 v0 = *(const bf16x8*)(vl + 32 * s), v1 = *(const bf16x8*)(vl + 32 * VROW + 32 * s);
            const bf16x8 fa = __builtin_bit_cast(bf16x8, s < 2 ? AT_PK(sa0, 8 * (s & 1)) : AT_PK(sa1, 8 * (s & 1)));
            const bf16x8 fb = __builtin_bit_cast(bf16x8, s < 2 ? AT_PK(sb0, 8 * (s & 1)) : AT_PK(sb1, 8 * (s & 1)));
            oa0 = __builtin_amdgcn_mfma_f32_32x32x16_bf16(v0, fa, oa0, 0, 0, 0); oa1 = __builtin_amdgcn_mfma_f32_32x32x16_bf16(v1, fa, oa1, 0, 0, 0);
            ob0 = __builtin_amdgcn_mfma_f32_32x32x16_bf16(v0, fb, ob0, 0, 0, 0); ob1 = __builtin_amdgcn_mfma_f32_32x32x16_bf16(v1, fb, ob1, 0, 0, 0);
        }
        __builtin_amdgcn_s_setprio(0);
        if (more) AT_SSTORE(cur ^ 1);
        __syncthreads();
    }
#undef AT_GLOAD
#undef AT_SSTORE
#undef AT_PK
    { const float lt = la + __shfl_xor(la, 32), inv = 1.f / lt;
      bf16_t* op = att + (size_t)(outrowA + l31) * 512 + (bh & 7) * 64 + 4 * half;
#pragma unroll
      for (int g = 0; g < 4; ++g) {
          st_bf4(op + 8 * g, (f32x4){oa0[4 * g] * inv, oa0[4 * g + 1] * inv, oa0[4 * g + 2] * inv, oa0[4 * g + 3] * inv});
          st_bf4(op + 32 + 8 * g, (f32x4){oa1[4 * g] * inv, oa1[4 * g + 1] * inv, oa1[4 * g + 2] * inv, oa1[4 * g + 3] * inv}); } }
    if (writeB) { const float lt = lb + __shfl_xor(lb, 32), inv = 1.f / lt;
      bf16_t* op = att + (size_t)(outrowB + l31) * 512 + (bh & 7) * 64 + 4 * half;
#pragma unroll
      for (int g = 0; g < 4; ++g) {
          st_bf4(op + 8 * g, (f32x4){ob0[4 * g] * inv, ob0[4 * g + 1] * inv, ob0[4 * g + 2] * inv, ob0[4 * g + 3] * inv});
          st_bf4(op + 32 + 8 * g, (f32x4){ob1[4 * g] * inv, ob1[4 * g + 1] * inv, ob1[4 * g + 2] * inv, ob1[4 * g + 3] * inv}); } }
}
DI void phase_attn(const Params& p, unsigned char* lds, bool with_ctx) {
    const bf16_t* Q = (const bf16_t*)(p.ws + O_S); const bf16_t* Kb = Q + (size_t)32 * TK * 96; const bf16_t* Vt = Kb + (size_t)32 * TK * 96;
    bf16_t* att = (bf16_t*)p.out;
    const int nitems = 512 + (with_ctx ? 32 : 0);
    for (int it = BIDX; it < nitems; it += gridDim.x) {
        const int wave = TIDX >> 6;
        if (it < 512) {
            const int j = (it >> 3) & 31, bh = (it >> 8) * 16 + (it & 7) * 2 + (j >> 4), q0 = (j & 15) * 512 + wave * 64, r0 = (bh >> 3) * SEQ + q0;
            attn_item(lds, Q, Kb, Vt, att, bh, q0, q0 + 32, 0, TK / 64, r0, r0 + 32, true);
        } else {
            const int bh = it - 512, q0 = SEQ + wave * 32, r0 = ML + (bh >> 3) * CTXL + wave * 32;
            attn_item(lds, Q, Kb, Vt, att, bh, q0, q0, SEQ / 64, TK / 64, r0, r0, false);
        }
    }
}

constexpr int PH_PER_LAYER = 15, N_PHASES = 1 + DEPTH * PH_PER_LAYER;
DI int phase_case(int ph) { const int i = (ph - 1) % PH_PER_LAYER; return i < 3 ? i : (i < 13 ? i + 1 : i + 2); }
DI void run_phase(const Params& p, int ph, unsigned char* smem) {
    LAS unsigned char* lds = (LAS unsigned char*)smem;
    unsigned char* ws = p.ws;
    if (ph == 0) { phase_mod(p, (float*)smem); return; }
    const int l = (ph - 1) / PH_PER_LAYER, s = phase_case(ph);
    const bool last = (l == DEPTH - 1);
    const float* mod = (const float*)(ws + O_MOD) + (size_t)l * 5 * NMOD;
    float* X = (float*)(ws + O_X);
    bf16_t* XNY = (bf16_t*)(ws + O_XNY); bf16_t* H = (bf16_t*)(ws + O_R1); bf16_t* P1 = (bf16_t*)(ws + O_R1); bf16_t* GATE = P1 + (size_t)MA * 768;
    bf16_t* UXY = (bf16_t*)(ws + O_UXY);
    float* SS = (float*)(ws + O_SS); const float* shw = (const float*)(ws + O_SHW);
    const int Mtail = last ? ML : MA;
    switch (s) {
    case 0: phase_prep(p, l, (float*)smem); if (l == 0) phase_norm0(p); break;
    case 1: { ESwiglu E{H, SS, shw}; gemm_phase<ESwiglu, false, true>(lds, Gemm{XNY, (const bf16_t*)(ws + O_WFF1IN), MA, 2 * DFF, DM, DM, DM}, E); } break;
    case 2: { EResid<1, true> E{X, X, mod + 2 * DM, mod + 4 * DM, XNY, SS + (size_t)MA * 16}; gemm_phase<EResid<1, true>, false, true>(lds, Gemm{H, (const bf16_t*)(ws + O_WFF1OUT), MA, DM, DFF, DFF, DFF}, E); }
              { const int nthird = (MA / BM) * (DM / BM) - 2 * (int)gridDim.x, vb = (int)BIDX - nthird; if (nthird > 0 && nthird < (int)gridDim.x && vb >= 0) phase_prep_ff(p, l, 1, (float*)smem, vb, (int)gridDim.x - nthird); else if (nthird <= 0 || nthird >= (int)gridDim.x) phase_prep_ff(p, l, 1, (float*)smem, BIDX, gridDim.x); }
              break;
    case 4: { EWin E{P1, UXY, GATE, SS + (size_t)MA * 16, shw + 5 * 5632}; gemm_phase<EWin, false, true>(lds, Gemm{XNY, (const bf16_t*)(ws + O_WIN), MA, NIN, DM, DM, DM}, E); } break;
    case 5: phase_conv(p, l); break;
    case 6: { bf16_t* OM = (bf16_t*)(ws + O_S); EGate E{XNY, OM, OM + (size_t)2 * MA * 512, (const float*)(ws + O_SP), p.b_rgate + l * 1024, p.b_igate + l * 1024};
              gemm_phase<EGate, true, true>(lds, Gemm{XNY, (const bf16_t*)(ws + O_WGATE), MA, 2048, 256, 512, 256}, E); } break;
    case 7: phase_scan_agg(p); break;
    case 8: phase_scan_apply(p); break;
    case 9: { bf16_t* qraw = (bf16_t*)p.out; bf16_t* kn = qraw + (size_t)MA * 768; bf16_t* Vt = (bf16_t*)(ws + O_S) + (size_t)2 * 32 * TK * 96;
              const float* rsq = (const float*)(ws + O_RSQ); const float* rskv = (const float*)(ws + O_RSKV);
              const bf16_t* wukv = (const bf16_t*)(ws + O_WUKV);
              { EpiElem8<FRowScale> E{{qraw, 768, rsq}}; gemm_phase<EpiElem8<FRowScale>, false, true>(lds, Gemm{P1, (const bf16_t*)(ws + O_WUQ), MA, 768, 384, 768, 384}, E); }
              { EpiElem8<FRowScale> E{{kn, 512, rskv}}; gemm_phase<EpiElem8<FRowScale>, false, true>(lds, Gemm{P1 + 384, wukv, MA, 512, 256, 768, 256, 144}, E); }
              { EpiElem8<FVt> E{{Vt, rskv}}; gemm_phase<EpiElem8<FVt>, false, true>(lds, Gemm{wukv + (size_t)512 * 256, P1 + 384, 512, MA, 256, 256, 768, 152}, E); }
              } break;
    case 10: phase_qk(p, l, smem); break;
    case 11: phase_attn(p, smem, !last); break;
    case 12: { { EpiElem8<FMergeA> E{{GATE, XNY}}; gemm_phase<EpiElem8<FMergeA>, false, true>(lds, Gemm{(const bf16_t*)p.out, (const bf16_t*)(ws + O_WOA), Mtail, DM, 512, 512, 512}, E); }
               { EpiElem8<FMergeB> E{{GATE, XNY}}; gemm_phase<EpiElem8<FMergeB>, false, true>(lds, Gemm{UXY, (const bf16_t*)(ws + O_WOL), Mtail, DM, 512, 1024, 512}, E); } } break;
    case 13: { EResid<2, true> E{X, X, mod + 5 * DM, mod + 7 * DM, UXY, SS + (size_t)2 * MA * 16}; gemm_phase<EResid<2, true>, false, true>(lds, Gemm{XNY, (const bf16_t*)(ws + O_WOUT), Mtail, DM, DM, DM, DM}, E); } break;
    case 15: { ESwiglu E{H, SS + (size_t)2 * MA * 16, shw + 2 * 5 * 5632}; gemm_phase<ESwiglu, false, true>(lds, Gemm{UXY, (const bf16_t*)(ws + O_WFF2IN), Mtail, 2 * DFF, DM, DM, DM}, E); } break;
    case 16: if (last) { EResid<1, false> E{X, p.out, mod + 8 * DM, nullptr, nullptr, nullptr}; gemm_phase<EResid<1, false>, false, true>(lds, Gemm{H, (const bf16_t*)(ws + O_WFF2OUT), Mtail, DM, DFF, DFF, DFF}, E); }
             else { EResid<1, true> E{X, X, mod + 8 * DM, mod + 5 * NMOD + DM, XNY, SS}; gemm_phase<EResid<1, true>, false, true>(lds, Gemm{H, (const bf16_t*)(ws + O_WFF2OUT), Mtail, DM, DFF, DFF, DFF}, E); }
             if (!last) { const int nthird = (MA / BM) * (DM / BM) - 2 * (int)gridDim.x, vb = (int)BIDX - nthird; if (nthird > 0 && nthird < (int)gridDim.x && vb >= 0) phase_prep_ff(p, l + 1, 0, (float*)smem, vb, (int)gridDim.x - nthird); else if (nthird <= 0 || nthird >= (int)gridDim.x) phase_prep_ff(p, l + 1, 0, (float*)smem, BIDX, gridDim.x); }
             break;
    }
}

#ifndef PROBE_MASK
#define PROBE_MASK 0u
#endif
#define XB_TMO      128
#define XB_XCNT(j)  (256  + 64 * (j))
#define XB_XSUB(j)  (1280 + 64 * (j))
#define XB_XGEN(j)  (2304 + 64 * (j))
#define XB_TOP      3328
#define XB_TOPGEN   3392
#define XCD_BAR_WORDS 3456
#define XB_SPIN_CAP (1u << 18)
DI unsigned xb_ld(unsigned* p)              { return __hip_atomic_load(p, __ATOMIC_RELAXED, __HIP_MEMORY_SCOPE_AGENT); }
DI unsigned xb_add(unsigned* p, unsigned v) { return __hip_atomic_fetch_add(p, v, __ATOMIC_RELAXED, __HIP_MEMORY_SCOPE_AGENT); }
DI unsigned xb_xcc_id() { return (unsigned)__builtin_amdgcn_s_getreg((3 << 11) | 20) & 0xFu; }
#define XB_SPIN(cond, bar) do { unsigned _sp = 0; while (cond) { __builtin_amdgcn_s_sleep(1); \
    if ((++_sp & 255u) == 0u) { if (xb_ld(&(bar)[XB_TMO])) break; if (_sp > XB_SPIN_CAP) { atomicAdd(&(bar)[XB_TMO], 1u); break; } } } } while (0)
struct XcdBarrier { unsigned* bar; unsigned x; volatile LAS unsigned* st; };
DI XcdBarrier xcd_barrier_post(unsigned* bar, volatile LAS unsigned* st) {
    XcdBarrier b; b.bar = bar; b.x = xb_xcc_id(); b.st = st;
    if (threadIdx.x == 0) (void)xb_add(&bar[XB_XCNT(b.x)], 1u);
    return b;
}
DI void xcd_barrier_complete(unsigned* bar, unsigned x, unsigned& nloc, unsigned& nx) {
    const unsigned G = gridDim.x * gridDim.y * gridDim.z;
    unsigned sum, cnt, mine, sp = 0u;
    for (;;) {
        sum = 0u; cnt = 0u; mine = 0u;
#pragma unroll
        for (unsigned j = 0; j < 16; ++j) { const unsigned c = xb_ld(&bar[XB_XCNT(j)]); sum += c; cnt += (c > 0u) ? 1u : 0u; mine = (j == x) ? c : mine; }
        if (sum == G) break;
        __builtin_amdgcn_s_sleep(1);
        if ((++sp & 255u) == 0u) { if (xb_ld(&bar[XB_TMO])) break; if (sp > XB_SPIN_CAP) { atomicAdd(&bar[XB_TMO], 1u); break; } }
    }
    nloc = mine > 0u ? mine : 1u; nx = cnt > 0u ? cnt : 1u;
}
DI void xcd_barrier(const XcdBarrier& b) {
    asm volatile("s_waitcnt vmcnt(0)" ::: "memory");
    __syncthreads();
    if (threadIdx.x == 0) {
        unsigned* bar = b.bar;
        __builtin_amdgcn_s_waitcnt(0);
        unsigned nloc = b.st[0], nx = b.st[1];
        if (nloc == 0u) { xcd_barrier_complete(bar, b.x, nloc, nx); b.st[0] = nloc; b.st[1] = nx; }
        const unsigned old = xb_add(&bar[XB_XSUB(b.x)], 1u);
        const unsigned gen = old / nloc;
        if (old + 1u == (gen + 1u) * nloc) {
            __builtin_amdgcn_fence(__ATOMIC_RELEASE, "agent");
            asm volatile("s_waitcnt vmcnt(0)" ::: "memory");
            const unsigned og = xb_add(&bar[XB_TOP], 1u);
            const unsigned tg = og / nx;
            if (og + 1u == (tg + 1u) * nx) xb_add(&bar[XB_TOPGEN], 1u);
            else XB_SPIN(xb_ld(&bar[XB_TOPGEN]) == tg, bar);
            __builtin_amdgcn_fence(__ATOMIC_ACQUIRE, "agent");
            xb_add(&bar[XB_XGEN(b.x)], 1u);
            asm volatile("s_waitcnt vmcnt(0)" ::: "memory");
        } else {
            XB_SPIN(xb_ld(&bar[XB_XGEN(b.x)]) == gen, bar);
            __builtin_amdgcn_fence(__ATOMIC_ACQUIRE, "agent");
            asm volatile("s_waitcnt vmcnt(0)" ::: "memory");
        }
    }
    __syncthreads();
}
__global__ void __launch_bounds__(512) mega(Params p) {
    extern __shared__ __attribute__((aligned(16))) unsigned char smem[];
    __shared__ uint4 xb_words;
    cg::grid_group grid = cg::this_grid();
    if (threadIdx.x == 0) xb_words = make_uint4(0u, 0u, 0u, 0u);
    __syncthreads();
    const XcdBarrier xb = xcd_barrier_post((unsigned*)(p.ws + O_BAR), (volatile LAS unsigned*)&xb_words);
    unsigned long long tsel = 0;
    for (int ph = p.ph_lo; ph < p.ph_hi; ++ph) {
        const unsigned long long t0 = PROBE_MASK ? wall_clock64() : 0ull;
        run_phase(p, ph, smem);
        if (p.coop && ph + 1 < p.ph_hi) { if (ph == 0) grid.sync(); else xcd_barrier(xb); }
        if (PROBE_MASK) { const int sidx = ph == 0 ? 17 : phase_case(ph); if ((PROBE_MASK >> sidx) & 1u) tsel += wall_clock64() - t0; }
    }
    if (PROBE_MASK && blockIdx.x == 0) { const unsigned long long t0 = wall_clock64(); while (wall_clock64() - t0 < tsel) __builtin_amdgcn_s_sleep(64); }
}

extern "C" void kernel_launch(void* const* d_in, const int* in_sizes, int n_in, void* d_out, int out_size, void* d_ws, size_t ws_size, hipStream_t stream) {
    static int grid = 0;
    if (grid == 0) {
        if (n_in != 27 || ws_size < WS_END) { fprintf(stderr, "kernel_launch: need 27 inputs and %zu bytes of workspace; got %d, %zu\n", (size_t)WS_END, n_in, ws_size); grid = -1; return; }
        int dev = 0, cus = 0, per_cu = 0;
        hipGetDevice(&dev); hipDeviceGetAttribute(&cus, hipDeviceAttributeMultiprocessorCount, dev);
        if (hipFuncSetAttribute((const void*)mega, hipFuncAttributeMaxDynamicSharedMemorySize, LDS_BYTES) != hipSuccess) { fprintf(stderr, "kernel_launch: hipFuncSetAttribute failed\n"); grid = -1; return; }
        if (hipOccupancyMaxActiveBlocksPerMultiprocessor(&per_cu, (const void*)mega, 512, LDS_BYTES) != hipSuccess || per_cu < 1) { fprintf(stderr, "kernel_launch: occupancy query gave %d\n", per_cu); per_cu = 1; }
        (void)hipGetLastError();
        grid = cus;
    }
    if (grid < 0) return;
    Params p{};
    const float** pp = (const float**)&p;
    for (int i = 0; i < 27; ++i) pp[i] = (const float*)d_in[i];
    p.out = (float*)d_out; p.ws = (unsigned char*)d_ws; p.ph_lo = 0; p.ph_hi = N_PHASES; p.coop = 1; p.pad = 0;
    (void)hipMemsetAsync((unsigned char*)d_ws + O_BAR, 0, XCD_BAR_WORDS * 4, stream);
    void* args[] = {&p};
    hipError_t e = hipLaunchCooperativeKernel((const void*)mega, dim3(grid), dim3(512), args, LDS_BYTES, stream);
    if (e != hipSuccess) {
        fprintf(stderr, "cooperative launch failed: %s (grid %d); falling back to one launch per phase\n", hipGetErrorString(e), grid);
        (void)hipGetLastError();
        p.coop = 0;
        for (int ph = 0; ph < N_PHASES; ++ph) { p.ph_lo = ph; p.ph_hi = ph + 1; hipLaunchKernelGGL(mega, dim3(grid), dim3(512), LDS_BYTES, stream, p); }
    }
}
```

```cpp
#include <hip/hip_runtime.h>
#include <hip/hip_cooperative_groups.h>
#include <cstdio>
namespace cg = cooperative_groups;

#define DI __device__ __forceinline__
#define LAS __attribute__((address_space(3)))
typedef unsigned short bf16_t;
typedef short bf16x8 __attribute__((ext_vector_type(8)));
typedef float f32x2 __attribute__((ext_vector_type(2)));
typedef float f32x4 __attribute__((ext_vector_type(4)));
typedef float f32x16 __attribute__((ext_vector_type(16)));
typedef unsigned u32x2 __attribute__((ext_vector_type(2)));
typedef unsigned u32x4 __attribute__((ext_vector_type(4)));
typedef __bf16 bfv2 __attribute__((ext_vector_type(2)));

constexpr int DM = 1024, NB = 4, SEQ = 8192, CTXL = 256, DEPTH = 4;
constexpr int ML = NB * SEQ, MC = NB * CTXL, MA = ML + MC;
constexpr int DFF = 2816, NH = 8, TK = SEQ + CTXL;
constexpr int NIN = 3840;
constexpr int NMOD = 9 * DM;
constexpr float EPS = 1e-6f;
constexpr float QSCALE = 0.10206207261596577f * 1.4426950408889634f;
constexpr int NCH = 132;

constexpr size_t SZ_FFIN = (size_t)2 * DFF * DM * 2, SZ_FFOUT = (size_t)DM * DFF * 2;
constexpr size_t O_WFF1IN = 0;
constexpr size_t O_WFF1OUT = O_WFF1IN + SZ_FFIN;
constexpr size_t O_WFF2IN = O_WFF1OUT + SZ_FFOUT;
constexpr size_t O_WFF2OUT = O_WFF2IN + SZ_FFIN;
constexpr size_t O_WIN = O_WFF2OUT + SZ_FFOUT;
constexpr size_t O_WUQ = O_WIN + (size_t)NIN * DM * 2;
constexpr size_t O_WUKV = O_WUQ + (size_t)768 * 384 * 2;
constexpr size_t O_WOA = O_WUKV + (size_t)1024 * 256 * 2;
constexpr size_t O_WOL = O_WOA + (size_t)1024 * 512 * 2;
constexpr size_t O_WOUT = O_WOL + (size_t)1024 * 512 * 2;
constexpr size_t O_WGATE = O_WOUT + (size_t)1024 * 1024 * 2;
constexpr size_t O_MOD = O_WGATE + (size_t)2048 * 256 * 2;
constexpr size_t O_RSQ = O_MOD + (size_t)DEPTH * 5 * NMOD * 4;
constexpr size_t O_RSKV = O_RSQ + (size_t)MA * 4;
constexpr size_t O_AGG = O_RSKV + (size_t)MA * 4;
constexpr size_t O_SP = O_AGG + (size_t)2 * NB * NCH * 512 * 8;
constexpr size_t O_BAR = O_SP + 4096;
constexpr size_t O_SS = O_BAR + 16384;
constexpr size_t O_SHW = O_SS + (size_t)3 * MA * 16 * 4;
constexpr size_t O_X = O_SHW + (size_t)3 * 5 * 5632 * 4;
constexpr size_t O_R1 = O_X + (size_t)MA * DM * 4;
constexpr size_t O_UXY = O_R1 + (size_t)MA * DFF * 2;
constexpr size_t O_XNY = O_UXY + (size_t)MA * 1024 * 2;
constexpr size_t O_S = O_XNY + (size_t)MA * 1024 * 2;
constexpr size_t WS_END = O_S + (size_t)MA * 1024 * 4;
constexpr int LDS_BYTES = 131072;

struct Params {
    const float *x, *c, *ctx, *c_ctx, *w_ada, *b_ada, *ff1_w_in, *ff1_w_out, *ff2_w_in, *ff2_w_out, *w_in, *q_a_norm, *w_uq, *kv_a_norm, *w_ukv, *q_norm, *k_norm,
        *conv_w, *conv_b, *lru_lambda, *w_rgate, *b_rgate, *w_igate, *b_igate, *w_o_attn, *w_o_lru, *w_out;
    float* out; unsigned char* ws;
    int ph_lo, ph_hi, coop, pad;
};

DI int tidx_() { int t = threadIdx.x; asm volatile("" : "+v"(t)); return t; }
DI int bidx_() { int t = blockIdx.x; asm volatile("" : "+s"(t)); return t; }
#define TIDX tidx_()
#define BIDX bidx_()
DI unsigned pk2(float lo, float hi) { f32x2 v = {lo, hi}; bfv2 r = __builtin_convertvector(v, bfv2); return __builtin_bit_cast(unsigned, r); }
DI bf16_t f2bf(float x) { return (bf16_t)(pk2(x, 0.f) & 0xffffu); }
DI float bf2f(bf16_t v) { return __uint_as_float((unsigned)v << 16); }
DI float bflo(unsigned v) { return __uint_as_float(v << 16); }
DI float bfhi(unsigned v) { return __uint_as_float(v & 0xffff0000u); }
DI float wave_sum(float v) {
#pragma unroll
    for (int o = 1; o < 64; o <<= 1) v += __shfl_xor(v, o);
    return v;
}
DI float sigmoidf_(float x) { return __builtin_amdgcn_rcpf(1.f + __expf(-x)); }
DI int mod_row(int row) { return row < ML ? (row >> 13) : 4; }
DI float row_rstd(const float* SSP, int row) {
    const f32x4* q = (const f32x4*)(SSP + (size_t)row * 16); const f32x4 a = q[0], b = q[1], c = q[2], d = q[3];
    const float s = ((a[0] + a[1]) + (a[2] + a[3])) + ((b[0] + b[1]) + (b[2] + b[3])) + ((c[0] + c[1]) + (c[2] + c[3])) + ((d[0] + d[1]) + (d[2] + d[3]));
    return __builtin_amdgcn_rsqf(s * (1.f / DM) + EPS);
}

constexpr int BM = 256, BK = 64, HALF = 128, HTB = HALF * BK * 2, NXCD = 8, WGM = 8;
DI int lds_byte(int r, int c) { const int st = (r >> 4) * 2 + (c >> 5), rr = r & 15, cc = c & 31, ob = rr * 64 + cc * 2; return st * 1024 + (ob ^ (((ob >> 9) & 1) << 5)); }
DI void stage_rc(int b, int& R, int& C) { const int st = b / 1024, sb = b % 1024, swz = sb ^ (((sb >> 9) & 1) << 5); R = (st >> 1) * 16 + swz / 64; C = (st & 1) * 32 + (swz % 64) / 2; }
struct Unit { int pm, pn; };
struct Gemm { const bf16_t* A; const bf16_t* Bt; int M, N, K, lda, ldb; int rot = 0; };
struct StaticOrder {
    int nM, nN, nwg, G, c;
    DI void init(int M, int N, int G_, int c_) { nM = M / BM; nN = N / BM; nwg = nM * nN; G = G_; c = c_; }
    DI bool next(int i, Unit& u) const {
        const long L = (long)i * G + c; if (L >= nwg) return false;
        int wgid = (int)L; { const int q = nwg / NXCD, r = nwg % NXCD, xcd = wgid % NXCD, off = wgid / NXCD; wgid = (xcd < r ? xcd * (q + 1) : r * (q + 1) + (xcd - r) * q) + off; }
        const int nig = WGM * nN, gid = wgid / nig, fm = gid * WGM, gsz = (nM - fm) < WGM ? (nM - fm) : WGM;
        u.pm = fm + ((wgid % nig) % gsz); u.pn = (wgid % nig) / gsz; return true;
    }
};

DI int perm32(int rho) { const int n = rho >> 4, i = rho & 15; return 8 * (i >> 2) + 4 * n + (i & 3); }
template <class Epi, bool GATE_A, bool PERM = false>
DI void gemm_phase(LAS unsigned char* lds, const Gemm g, const Epi& E) {
    const int tid = TIDX, wid = __builtin_amdgcn_readfirstlane(tid >> 6), lane = tid & 63, wr = wid >> 2, wc = wid & 3, fr = lane & 15, fq = lane >> 4;
    const int K = g.K, nt = K / BK;
    StaticOrder S; S.init(g.M, g.N, gridDim.x, (BIDX - g.rot + (int)gridDim.x) % (int)gridDim.x);
    unsigned voffA[2], voffB[2];
#pragma unroll
    for (int i = 0; i < 2; ++i) { int R, C; stage_rc(tid * 16 + i * 8192, R, C); const int Rb = PERM ? ((R & ~31) + perm32(R & 31)) : R; voffA[i] = (unsigned)(R * g.lda + C) * 2u; voffB[i] = (unsigned)(Rb * g.ldb + C) * 2u; }
#pragma unroll
    for (int i = 0; i < 2; ++i) { asm volatile("" : "+v"(voffA[i])); asm volatile("" : "+v"(voffB[i])); }
    const size_t kstep = (size_t)(BK * 2);
    const size_t hstepA = (size_t)HALF * g.lda * 2, hstepB = (size_t)HALF * g.ldb * 2;
    const size_t tstepA = 2 * hstepA, tstepB = 2 * hstepB;
    const unsigned ldsw = (unsigned)wid * 1024u;
    const int aoff = lds_byte(wr * 64 + fr, fq * 8), boff = lds_byte(wc * 32 + fr, fq * 8);
#define PG8_SA(b, h) (((b) * 2 + (h)) * HTB)
#define PG8_SB(b, h) ((4 + (b) * 2 + (h)) * HTB)
#define PG8_STAGE(bufoff, gbase, voff) do { _Pragma("unroll") for (int _i = 0; _i < 2; ++_i) \
        __builtin_amdgcn_global_load_lds((const unsigned*)((const char*)(gbase) + (voff)[_i]), (LAS unsigned*)(lds + (bufoff) + ldsw + _i * 8192), 16, 0, 0); } while (0)
#define PG8_LDA(dst, b, h) do { _Pragma("unroll") for (int m = 0; m < 4; ++m) _Pragma("unroll") for (int k = 0; k < 2; ++k) dst[m][k] = *(const LAS bf16x8*)(lds + PG8_SA(b, h) + aoff + m * 2048 + k * 1024); } while (0)
#define PG8_LDB(dst, b, h) do { _Pragma("unroll") for (int n = 0; n < 2; ++n) _Pragma("unroll") for (int k = 0; k < 2; ++k) dst[n][k] = *(const LAS bf16x8*)(lds + PG8_SB(b, h) + boff + n * 2048 + k * 1024); } while (0)
#define PG8_MMA(ai, bj, At, Bt) do { __builtin_amdgcn_s_setprio(1); _Pragma("unroll") for (int m = 0; m < 4; ++m) _Pragma("unroll") for (int n = 0; n < 2; ++n) _Pragma("unroll") for (int k = 0; k < 2; ++k) \
        acc[ai][bj][m][n] = __builtin_amdgcn_mfma_f32_16x16x32_bf16(Bt[n][k], At[m][k], acc[ai][bj][m][n], 0, 0, 0); __builtin_amdgcn_s_setprio(0); } while (0)
#define PG8_WAIT_V(n) asm volatile("s_waitcnt vmcnt(" #n ")" ::: "memory")
#define PG8_WAIT_L(n) asm volatile("s_waitcnt lgkmcnt(" #n ")" ::: "memory")
#define PG8_BAR __builtin_amdgcn_s_barrier()
#define PG8_SCHED __builtin_amdgcn_sched_barrier(0)
#define PG8_ABASE(u) ((const char*)g.A + (size_t)(u).pm * tstepA + (GATE_A ? (size_t)((((u).pn & 3) >> 1) * 512) : (size_t)0))
    Unit cur, nxt; int ui = 0;
    if (!S.next(0, cur)) return;
    f32x4 acc[2][2][4][2];
#pragma unroll
    for (int a = 0; a < 2; ++a)
#pragma unroll
        for (int b = 0; b < 2; ++b)
#pragma unroll
            for (int m = 0; m < 4; ++m)
#pragma unroll
                for (int n = 0; n < 2; ++n) acc[a][b][m][n] = (f32x4){0.f, 0.f, 0.f, 0.f};
    bf16x8 At[4][2], B0[2][2], B1[2][2];
    const char* cA = PG8_ABASE(cur); const char* cB = (const char*)g.Bt + (size_t)cur.pn * tstepB;
    PG8_STAGE(PG8_SB(0, 0), cB, voffB); PG8_STAGE(PG8_SA(0, 0), cA, voffA); PG8_STAGE(PG8_SB(0, 1), cB + hstepB, voffB); PG8_STAGE(PG8_SA(0, 1), cA + hstepA, voffA);
    if (wr == 1) PG8_BAR;
    PG8_WAIT_V(4); PG8_BAR;
    PG8_STAGE(PG8_SB(1, 0), cB + kstep, voffB); PG8_STAGE(PG8_SA(1, 0), cA + kstep, voffA); PG8_STAGE(PG8_SB(1, 1), cB + hstepB + kstep, voffB);
    PG8_WAIT_V(6); PG8_BAR;
    for (;;) {
        const bool has_next = S.next(ui + 1, nxt);
        const char* nA = has_next ? PG8_ABASE(nxt) : cA; const char* nB = has_next ? (const char*)g.Bt + (size_t)nxt.pn * tstepB : cB;
#pragma nounroll
        for (int t = 0; t < nt; t += 2) {
            const bool last = (t == nt - 2);
            const char* a1 = cA + (size_t)(t + 1) * kstep;
            const char* a2 = last ? nA : cA + (size_t)(t + 2) * kstep; const char* b2 = last ? nB : cB + (size_t)(t + 2) * kstep;
            const char* a3 = a2 + kstep; const char* b3 = b2 + kstep;
            PG8_LDB(B0, 0, 0); PG8_SCHED; PG8_LDA(At, 0, 0); PG8_STAGE(PG8_SA(1, 1), a1 + hstepA, voffA);
            PG8_WAIT_L(8); PG8_BAR; PG8_WAIT_L(0); PG8_MMA(0, 0, At, B0); PG8_BAR; PG8_SCHED;
            PG8_LDB(B1, 0, 1); PG8_STAGE(PG8_SB(0, 0), b2, voffB);
            PG8_BAR; PG8_WAIT_L(0); PG8_MMA(0, 1, At, B1); PG8_BAR;
            PG8_LDA(At, 0, 1); PG8_STAGE(PG8_SA(0, 0), a2, voffA);
            PG8_BAR; PG8_WAIT_L(0); PG8_MMA(1, 0, At, B0); PG8_BAR; PG8_SCHED;
            PG8_STAGE(PG8_SB(0, 1), b2 + hstepB, voffB);
            PG8_WAIT_V(6); PG8_BAR; PG8_MMA(1, 1, At, B1); PG8_BAR;
            PG8_LDB(B0, 1, 0); PG8_SCHED; PG8_LDA(At, 1, 0); PG8_STAGE(PG8_SA(0, 1), a2 + hstepA, voffA);
            PG8_WAIT_L(8); PG8_BAR; PG8_WAIT_L(0); PG8_MMA(0, 0, At, B0); PG8_BAR; PG8_SCHED;
            PG8_LDB(B1, 1, 1); PG8_STAGE(PG8_SB(1, 0), b3, voffB);
            PG8_BAR; PG8_WAIT_L(0); PG8_MMA(0, 1, At, B1); PG8_BAR;
            PG8_LDA(At, 1, 1); PG8_STAGE(PG8_SA(1, 0), a3, voffA);
            PG8_BAR; PG8_WAIT_L(0); PG8_MMA(1, 0, At, B0); PG8_BAR; PG8_SCHED;
            PG8_STAGE(PG8_SB(1, 1), b3 + hstepB, voffB);
            PG8_WAIT_V(6); PG8_BAR; PG8_MMA(1, 1, At, B1); PG8_BAR;
        }
        E(acc, cur, wr, wc, fr, fq);
        if (!has_next) break;
#pragma unroll
        for (int a = 0; a < 2; ++a)
#pragma unroll
            for (int b = 0; b < 2; ++b)
#pragma unroll
                for (int m = 0; m < 4; ++m)
#pragma unroll
                    for (int n = 0; n < 2; ++n) acc[a][b][m][n] = (f32x4){0.f, 0.f, 0.f, 0.f};
        cur = nxt; cA = nA; cB = nB; ++ui;
    }
    PG8_WAIT_V(0);
    if (wr == 0) PG8_BAR;
    PG8_BAR;
#undef PG8_SA
#undef PG8_SB
#undef PG8_STAGE
#undef PG8_LDA
#undef PG8_LDB
#undef PG8_MMA
#undef PG8_WAIT_V
#undef PG8_WAIT_L
#undef PG8_BAR
#undef PG8_SCHED
#undef PG8_ABASE
}

DI float row_rstd4(const float* SSP, int row, int fq) {
    const f32x4 a = *(const f32x4*)(SSP + (size_t)row * 16 + 4 * fq);
    float s = (a[0] + a[1]) + (a[2] + a[3]); s += __shfl_xor(s, 16); s += __shfl_xor(s, 32);
    return __builtin_amdgcn_rsqf(s * (1.f / DM) + EPS);
}
template <class F> struct EpiElem {
    F f;
    DI void operator()(const f32x4 (&acc)[2][2][4][2], const Unit& u, int wr, int wc, int fr, int fq) const {
        const int row0 = u.pm * BM + wr * 64 + fr, col0 = u.pn * BM + wc * 32 + 4 * fq;
#pragma unroll
        for (int ai = 0; ai < 2; ++ai)
#pragma unroll
            for (int m = 0; m < 4; ++m)
#pragma unroll
                for (int bj = 0; bj < 2; ++bj)
#pragma unroll
                    for (int n = 0; n < 2; ++n) { f(row0 + ai * HALF + m * 16, col0 + bj * HALF + n * 16, acc[ai][bj][m][n]); }
    }
};
template <class F> struct EpiElemRow {
    F f;
    DI void operator()(const f32x4 (&acc)[2][2][4][2], const Unit& u, int wr, int wc, int fr, int fq) const {
        const int row0 = u.pm * BM + wr * 64 + fr, col0 = u.pn * BM + wc * 32 + 4 * fq;
#pragma unroll
        for (int ai = 0; ai < 2; ++ai)
#pragma unroll
            for (int m = 0; m < 4; ++m) {
                float ssq = 0.f;
#pragma unroll
                for (int bj = 0; bj < 2; ++bj)
#pragma unroll
                    for (int n = 0; n < 2; ++n) { ssq += f(row0 + ai * HALF + m * 16, col0 + bj * HALF + n * 16, acc[ai][bj][m][n]); }
                ssq += __shfl_xor(ssq, 16); ssq += __shfl_xor(ssq, 32);
                if (fq == 0) f.row(row0 + ai * HALF + m * 16, (u.pn & 3) * 4 + wc, ssq);
            }
    }
};
template <class F> struct EpiElemRS {
    F f;
    DI void operator()(const f32x4 (&acc)[2][2][4][2], const Unit& u, int wr, int wc, int fr, int fq) const {
        const int row0 = u.pm * BM + wr * 64 + fr, col0 = u.pn * BM + wc * 32 + 4 * fq;
#pragma unroll
        for (int ai = 0; ai < 2; ++ai)
#pragma unroll
            for (int m = 0; m < 4; ++m) {
                const float rs = f.rs(row0 + ai * HALF + m * 16);
#pragma unroll
                for (int bj = 0; bj < 2; ++bj)
#pragma unroll
                    for (int n = 0; n < 2; ++n) { f(row0 + ai * HALF + m * 16, col0 + bj * HALF + n * 16, acc[ai][bj][m][n], rs); }
            }
    }
};
template <class F> struct EpiPairRS {
    F f;
    DI void operator()(const f32x4 (&acc)[2][2][4][2], const Unit& u, int wr, int wc, int fr, int fq) const {
        const int row0 = u.pm * BM + wr * 64 + fr, c0 = wc * 32 + 4 * fq;
#pragma unroll
        for (int ai = 0; ai < 2; ++ai)
#pragma unroll
            for (int m = 0; m < 4; ++m) {
                const float rs = f.rs(row0 + ai * HALF + m * 16);
#pragma unroll
                for (int n = 0; n < 2; ++n) { f(row0 + ai * HALF + m * 16, u.pn, c0 + n * 16, acc[ai][0][m][n], acc[ai][1][m][n], rs); }
            }
    }
};
template <class F> struct EpiElem2 {
    F f;
    DI void operator()(const f32x4 (&acc)[2][2][4][2], const Unit& u, int wr, int wc, int fr, int fq) const {
        const int row0 = u.pm * BM + wr * 64 + fr, col0 = u.pn * BM + wc * 32 + 4 * fq;
        typename F::L cur[2][2], nxt[2][2];
#pragma unroll
        for (int bj = 0; bj < 2; ++bj)
#pragma unroll
            for (int n = 0; n < 2; ++n) cur[bj][n] = f.load(row0, col0 + bj * HALF + n * 16);
#pragma unroll
        for (int i = 0; i < 8; ++i) {
            const int row = row0 + (i >> 2) * HALF + (i & 3) * 16;
            if (i < 7) { const int rown = row0 + ((i + 1) >> 2) * HALF + ((i + 1) & 3) * 16;
#pragma unroll
                for (int bj = 0; bj < 2; ++bj)
#pragma unroll
                    for (int n = 0; n < 2; ++n) nxt[bj][n] = f.load(rown, col0 + bj * HALF + n * 16); }
#pragma unroll
            for (int bj = 0; bj < 2; ++bj)
#pragma unroll
                for (int n = 0; n < 2; ++n) f.apply(row, col0 + bj * HALF + n * 16, acc[i >> 2][bj][i & 3][n], cur[bj][n]);
#pragma unroll
            for (int bj = 0; bj < 2; ++bj)
#pragma unroll
                for (int n = 0; n < 2; ++n) cur[bj][n] = nxt[bj][n];
        }
    }
};
template <class F> struct EpiElem8 {
    F f;
    DI void operator()(const f32x4 (&acc)[2][2][4][2], const Unit& u, int wr, int wc, int fr, int fq) const {
        const int row0 = u.pm * BM + wr * 64 + fr, col0 = u.pn * BM + wc * 32 + 8 * fq;
        typename F::L cur[2], nxt[2];
#pragma unroll
        for (int bj = 0; bj < 2; ++bj) cur[bj] = f.load(row0, col0 + bj * HALF);
#pragma unroll
        for (int i = 0; i < 8; ++i) {
            const int row = row0 + (i >> 2) * HALF + (i & 3) * 16;
            if (i < 7) { const int rown = row0 + ((i + 1) >> 2) * HALF + ((i + 1) & 3) * 16;
#pragma unroll
                for (int bj = 0; bj < 2; ++bj) nxt[bj] = f.load(rown, col0 + bj * HALF); }
#pragma unroll
            for (int bj = 0; bj < 2; ++bj) f.apply(row, col0 + bj * HALF, acc[i >> 2][bj][i & 3][0], acc[i >> 2][bj][i & 3][1], cur[bj]);
#pragma unroll
            for (int bj = 0; bj < 2; ++bj) cur[bj] = nxt[bj];
        }
    }
};
template <class F> struct EpiPair {
    F f;
    DI void operator()(const f32x4 (&acc)[2][2][4][2], const Unit& u, int wr, int wc, int fr, int fq) const {
        const int row0 = u.pm * BM + wr * 64 + fr, c0 = wc * 32 + 4 * fq;
#pragma unroll
        for (int ai = 0; ai < 2; ++ai)
#pragma unroll
            for (int m = 0; m < 4; ++m)
#pragma unroll
                for (int n = 0; n < 2; ++n) { f(row0 + ai * HALF + m * 16, u.pn, c0 + n * 16, acc[ai][0][m][n], acc[ai][1][m][n]); }
    }
};
DI void st_bf4(bf16_t* p, f32x4 v) { u32x2 o; o.x = pk2(v[0], v[1]); o.y = pk2(v[2], v[3]); *(u32x2*)p = o; }
DI void st_bf8(bf16_t* p, f32x4 lo, f32x4 hi) { u32x4 o; o.x = pk2(lo[0], lo[1]); o.y = pk2(lo[2], lo[3]); o.z = pk2(hi[0], hi[1]); o.w = pk2(hi[2], hi[3]); *(u32x4*)p = o; }

struct FSwiglu { bf16_t* H; const float* SS; const float* shw;
    DI float rs(int row) const { return row_rstd(SS, row); }
    DI void operator()(int row, int pn, int c, f32x4 g, f32x4 u, float rs) const {
        const float* sw = shw + mod_row(row) * 5632 + pn * 256 + c;
        g = g * rs + *(const f32x4*)sw; u = u * rs + *(const f32x4*)(sw + 128);
        f32x4 h;
#pragma unroll
        for (int e = 0; e < 4; ++e) h[e] = g[e] * sigmoidf_(g[e]) * u[e];
        st_bf4(H + (size_t)row * DFF + pn * 128 + c, h);
    } };
struct FResid { const float* src; float* dst; const float* mod; float coef;
    DI void operator()(int row, int col, f32x4 v) const {
        const f32x4 g = *(const f32x4*)(mod + mod_row(row) * NMOD + col);
        const f32x4 x = *(const f32x4*)(src + (size_t)row * DM + col);
        *(f32x4*)(dst + (size_t)row * DM + col) = x + coef * g * v;
    } };
template <int COEF2> struct FResidN { const float* src; float* dst; const float* mod; const float* scn; bf16_t* XS; float* SS;
    DI float operator()(int row, int col, f32x4 v) const {
        const int r = mod_row(row);
        const f32x4 g = *(const f32x4*)(mod + r * NMOD + col);
        const f32x4 x = *(const f32x4*)(src + (size_t)row * DM + col);
        const f32x4 xn = x + (0.5f * COEF2) * g * v;
        *(f32x4*)(dst + (size_t)row * DM + col) = xn;
        const f32x4 sc = *(const f32x4*)(scn + r * NMOD + col);
        st_bf4(XS + (size_t)row * DM + col, xn * (1.f + sc));
        return (xn[0] * xn[0] + xn[1] * xn[1]) + (xn[2] * xn[2] + xn[3] * xn[3]);
    }
    DI void row(int row, int slot, float ssq) const { SS[(size_t)row * 16 + slot] = ssq; } };
struct FWin { bf16_t *P1, *UXY, *GATE; const float* SS; const float* shw;
    DI float rs(int row) const { return row_rstd(SS, row); }
    DI void operator()(int row, int col, f32x4 v, float rs) const {
        v = v * rs + *(const f32x4*)(shw + mod_row(row) * 5632 + col);
        bf16_t* p = col < 768 ? P1 + (size_t)row * 768 + col : (col < 1792 ? UXY + (size_t)row * 1024 + (col - 768) : GATE + (size_t)row * 2048 + (col - 1792));
        st_bf4(p, v);
    } };
struct FRowScale { bf16_t* dst; int ld; const float* rs;
    typedef float L;
    DI L load(int row, int) const { return rs[row]; }
    DI void apply(int row, int col, f32x4 v0, f32x4 v1, L sc) const { st_bf8(dst + (size_t)row * ld + col, v0 * sc, v1 * sc); } };
struct FVt { bf16_t* Vt; const float* rs;
    struct L { f32x4 a, b; };
    DI L load(int, int col) const { return L{*(const f32x4*)(rs + col), *(const f32x4*)(rs + col + 4)}; }
    DI void apply(int row, int col, f32x4 v0, f32x4 v1, L sc) const {
        int b, kpos; if (col < ML) { b = col >> 13; kpos = col & (SEQ - 1); } else { const int r = col - ML; b = r >> 8; kpos = SEQ + (r & 255); }
        st_bf8(Vt + ((size_t)(b * NH + (row >> 6)) * 64 + (row & 63)) * TK + kpos, v0 * sc.a, v1 * sc.b);
    } };
struct EGate { const bf16_t* xc; bf16_t *OM, *BB; const float *sp8, *br, *bi;
    DI void operator()(const f32x4 (&acc)[2][2][4][2], const Unit& u, int wr, int wc, int fr, int fq) const {
        const int row0 = u.pm * BM + wr * 64 + fr, d = u.pn >> 2, ch0 = (u.pn & 3) * 128 + wc * 32 + 8 * fq;
        f32x4 s4[2], br4[2], bi4[2]; u32x4 xcur, xnxt;
#pragma unroll
        for (int n = 0; n < 2; ++n) { s4[n] = *(const f32x4*)(sp8 + d * 512 + ch0 + 4 * n); br4[n] = *(const f32x4*)(br + d * 512 + ch0 + 4 * n); bi4[n] = *(const f32x4*)(bi + d * 512 + ch0 + 4 * n); }
        xcur = *(const u32x4*)(xc + (size_t)row0 * 512 + ch0);
#pragma unroll
        for (int i = 0; i < 8; ++i) {
            const int row = row0 + (i >> 2) * HALF + (i & 3) * 16;
            if (i < 7) { const int rown = row0 + ((i + 1) >> 2) * HALF + ((i + 1) & 3) * 16; xnxt = *(const u32x4*)(xc + (size_t)rown * 512 + ch0); }
            f32x4 om[2], bb[2];
#pragma unroll
            for (int n = 0; n < 2; ++n) {
                const f32x4 r4 = acc[i >> 2][0][i & 3][n], i4 = acc[i >> 2][1][i & 3][n];
                const unsigned w0 = n == 0 ? xcur.x : xcur.z, w1 = n == 0 ? xcur.y : xcur.w;
                const f32x4 xf = {bflo(w0), bfhi(w0), bflo(w1), bfhi(w1)};
#pragma unroll
                for (int e = 0; e < 4; ++e) {
                    const float r = sigmoidf_(r4[e] + br4[n][e]), ig = sigmoidf_(i4[e] + bi4[n][e]);
                    const float a = __expf(s4[n][e] * r);
                    om[n][e] = 1.f - a; bb[n][e] = __builtin_amdgcn_sqrtf(fmaxf(1.f - a * a, 0.f)) * (ig * xf[e]);
                }
            }
            const size_t o = ((size_t)d * MA + row) * 512 + ch0;
            st_bf8(OM + o, om[0], om[1]); st_bf8(BB + o, bb[0], bb[1]);
            xcur = xnxt;
        }
    } };
DI f32x4 sig_lo(u32x4 g) { return (f32x4){sigmoidf_(bflo(g.x)), sigmoidf_(bfhi(g.x)), sigmoidf_(bflo(g.y)), sigmoidf_(bfhi(g.y))}; }
DI f32x4 sig_hi(u32x4 g) { return (f32x4){sigmoidf_(bflo(g.z)), sigmoidf_(bfhi(g.z)), sigmoidf_(bflo(g.w)), sigmoidf_(bfhi(g.w))}; }
struct FMergeA { const bf16_t* GATE; bf16_t* Y;
    typedef u32x4 L;
    DI L load(int row, int col) const { return *(const u32x4*)(GATE + (size_t)row * 2048 + col); }
    DI void apply(int row, int col, f32x4 v0, f32x4 v1, L gv) const { st_bf8(Y + (size_t)row * DM + col, sig_lo(gv) * v0, sig_hi(gv) * v1); } };
struct FMergeB { const bf16_t* GATE; bf16_t* Y;
    struct L { u32x4 g, y; };
    DI L load(int row, int col) const { return L{*(const u32x4*)(GATE + (size_t)row * 2048 + 1024 + col), *(const u32x4*)(Y + (size_t)row * DM + col)}; }
    DI void apply(int row, int col, f32x4 v0, f32x4 v1, L q) const {
        const f32x4 y0 = {bflo(q.y.x), bfhi(q.y.x), bflo(q.y.y), bfhi(q.y.y)}, y1 = {bflo(q.y.z), bfhi(q.y.z), bflo(q.y.w), bfhi(q.y.w)};
        st_bf8(Y + (size_t)row * DM + col, y0 + sig_lo(q.g) * v0, y1 + sig_hi(q.g) * v1);
    } };

struct ESwiglu { bf16_t* H; const float* SS; const float* shw;
    DI void operator()(const f32x4 (&acc)[2][2][4][2], const Unit& u, int wr, int wc, int fr, int fq) const {
        const int row0 = u.pm * BM + wr * 64 + fr, c0 = wc * 32 + 8 * fq;
        const float* sw = shw + mod_row(u.pm * BM) * 5632 + u.pn * 256 + c0;
        f32x4 sg[2], su[2]; float rs[8];
#pragma unroll
        for (int n = 0; n < 2; ++n) { sg[n] = *(const f32x4*)(sw + 4 * n); su[n] = *(const f32x4*)(sw + 128 + 4 * n); }
#pragma unroll
        for (int i = 0; i < 8; ++i) rs[i] = row_rstd4(SS, row0 + (i >> 2) * HALF + (i & 3) * 16, fq);
#pragma unroll
        for (int ai = 0; ai < 2; ++ai)
#pragma unroll
            for (int m = 0; m < 4; ++m) {
                f32x4 h[2];
#pragma unroll
                for (int n = 0; n < 2; ++n) {
                    const f32x4 g = acc[ai][0][m][n] * rs[ai * 4 + m] + sg[n], uu = acc[ai][1][m][n] * rs[ai * 4 + m] + su[n];
#pragma unroll
                    for (int e = 0; e < 4; ++e) h[n][e] = g[e] * sigmoidf_(g[e]) * uu[e];
                }
                st_bf8(H + (size_t)(row0 + ai * HALF + m * 16) * DFF + u.pn * 128 + c0, h[0], h[1]);
            }
    } };
struct EWin { bf16_t *P1, *UXY, *GATE; const float* SS; const float* shw;
    template <int LD> DI void body(const f32x4 (&acc)[2][2][4][2], bf16_t* dst, const f32x4 (&sh)[2][2], const float (&rs)[8]) const {
#pragma unroll
        for (int ai = 0; ai < 2; ++ai)
#pragma unroll
            for (int m = 0; m < 4; ++m)
#pragma unroll
                for (int bj = 0; bj < 2; ++bj)
                    st_bf8(dst + (size_t)(ai * HALF + m * 16) * LD + 128 * bj, acc[ai][bj][m][0] * rs[ai * 4 + m] + sh[bj][0], acc[ai][bj][m][1] * rs[ai * 4 + m] + sh[bj][1]);
    }
    DI void operator()(const f32x4 (&acc)[2][2][4][2], const Unit& u, int wr, int wc, int fr, int fq) const {
        const int row0 = u.pm * BM + wr * 64 + fr, c0 = wc * 32 + 8 * fq;
        const float* sw = shw + mod_row(u.pm * BM) * 5632 + u.pn * 256 + c0;
        f32x4 sh[2][2]; float rs[8];
#pragma unroll
        for (int bj = 0; bj < 2; ++bj)
#pragma unroll
            for (int n = 0; n < 2; ++n) sh[bj][n] = *(const f32x4*)(sw + 128 * bj + 4 * n);
#pragma unroll
        for (int i = 0; i < 8; ++i) rs[i] = row_rstd4(SS, row0 + (i >> 2) * HALF + (i & 3) * 16, fq);
        if (u.pn < 3) body<768>(acc, P1 + (size_t)row0 * 768 + u.pn * 256 + c0, sh, rs);
        else if (u.pn < 7) body<1024>(acc, UXY + (size_t)row0 * 1024 + (u.pn - 3) * 256 + c0, sh, rs);
        else body<2048>(acc, GATE + (size_t)row0 * 2048 + (u.pn - 7) * 256 + c0, sh, rs);
    } };
template <int COEF2, bool NORM> struct EResid { const float* src; float* dst; const float* mod; const float* scn; bf16_t* XS; float* SS;
    DI void operator()(const f32x4 (&acc)[2][2][4][2], const Unit& u, int wr, int wc, int fr, int fq) const {
        const int row0 = u.pm * BM + wr * 64 + fr, col0 = u.pn * BM + wc * 32 + 8 * fq, r = mod_row(u.pm * BM);
        f32x4 g[2][2], sc[2][2];
#pragma unroll
        for (int bj = 0; bj < 2; ++bj)
#pragma unroll
            for (int n = 0; n < 2; ++n) { g[bj][n] = *(const f32x4*)(mod + r * NMOD + col0 + 128 * bj + 4 * n) * (0.5f * COEF2);
                if (NORM) sc[bj][n] = *(const f32x4*)(scn + r * NMOD + col0 + 128 * bj + 4 * n) + 1.f; }
        f32x4 xc[2][2], xn_[2][2];
#pragma unroll
        for (int bj = 0; bj < 2; ++bj)
#pragma unroll
            for (int n = 0; n < 2; ++n) xc[bj][n] = *(const f32x4*)(src + (size_t)row0 * DM + col0 + 128 * bj + 4 * n);
#pragma unroll
        for (int i = 0; i < 8; ++i) {
            const int row = row0 + (i >> 2) * HALF + (i & 3) * 16;
            if (i < 7) { const int rown = row0 + ((i + 1) >> 2) * HALF + ((i + 1) & 3) * 16;
#pragma unroll
                for (int bj = 0; bj < 2; ++bj)
#pragma unroll
                    for (int n = 0; n < 2; ++n) xn_[bj][n] = *(const f32x4*)(src + (size_t)rown * DM + col0 + 128 * bj + 4 * n); }
            float ssq = 0.f;
#pragma unroll
            for (int bj = 0; bj < 2; ++bj) {
                f32x4 y[2];
#pragma unroll
                for (int n = 0; n < 2; ++n) {
                    y[n] = xc[bj][n] + g[bj][n] * acc[i >> 2][bj][i & 3][n];
                    *(f32x4*)(dst + (size_t)row * DM + col0 + 128 * bj + 4 * n) = y[n];
                    if (NORM) ssq += (y[n][0] * y[n][0] + y[n][1] * y[n][1]) + (y[n][2] * y[n][2] + y[n][3] * y[n][3]);
                }
                if (NORM) st_bf8(XS + (size_t)row * DM + col0 + 128 * bj, y[0] * sc[bj][0], y[1] * sc[bj][1]);
            }
            if (NORM) { ssq += __shfl_xor(ssq, 16); ssq += __shfl_xor(ssq, 32); if (fq == 0) SS[(size_t)row * 16 + (u.pn & 3) * 4 + wc] = ssq; }
#pragma unroll
            for (int bj = 0; bj < 2; ++bj)
#pragma unroll
                for (int n = 0; n < 2; ++n) xc[bj][n] = xn_[bj][n];
        }
    } };

DI void phase_mod(const Params& p, float* lds) {
    float* sc = lds;
    float* red = lds + 5 * DM;
    const int tid = TIDX, lane = tid & 63, wave = tid >> 6;
    for (int i = tid; i < 5 * DM; i += 512) { const float v = i < 4 * DM ? p.c[i] : p.c_ctx[i - 4 * DM]; sc[i] = v * sigmoidf_(v); }
    __syncthreads();
    float* mod = (float*)(p.ws + O_MOD);
    for (int it = BIDX; it < DEPTH * (NMOD / 64); it += gridDim.x) {
        const int l = it / (NMOD / 64), n = (it % (NMOD / 64)) * 64 + lane;
        const float* w = p.w_ada + ((size_t)l * DM + wave * 128) * NMOD + n;
        float a0 = 0.f, a1 = 0.f, a2 = 0.f, a3 = 0.f, a4 = 0.f;
#pragma unroll 8
        for (int k = 0; k < 128; ++k) { const float wv = w[(size_t)k * NMOD]; const int kk = wave * 128 + k;
            a0 += sc[kk] * wv; a1 += sc[DM + kk] * wv; a2 += sc[2 * DM + kk] * wv; a3 += sc[3 * DM + kk] * wv; a4 += sc[4 * DM + kk] * wv; }
        red[(wave * 5 + 0) * 64 + lane] = a0; red[(wave * 5 + 1) * 64 + lane] = a1; red[(wave * 5 + 2) * 64 + lane] = a2; red[(wave * 5 + 3) * 64 + lane] = a3; red[(wave * 5 + 4) * 64 + lane] = a4;
        __syncthreads();
        if (tid < 320) { const int r = tid >> 6; float s = p.b_ada[(size_t)l * NMOD + n];
#pragma unroll
            for (int w8 = 0; w8 < 8; ++w8) s += red[(w8 * 5 + r) * 64 + lane];
            mod[((size_t)l * 5 + r) * NMOD + n] = s; }
        __syncthreads();
    }
}

template <int MAP> DI int colmap(int n) {
    if (MAP == 0) return n;
    if (MAP == 1) { const int pn = n >> 8, bj = (n >> 7) & 1, c = n & 127; return bj * DFF + pn * 128 + c; }
    if (MAP == 2) return n < 672 ? n : (n < 768 ? -1 : n - 96);
    { const int m = n & 511, h = m >> 6, d = m & 63; return h * 128 + (n >> 9) * 64 + d; }
}
template <int MAP> DI void tjob(const float* src, int ld, int K, int N, bf16_t* dst, const float* kscale, float* tile, int& base, int vbid, int G) {
    const int tid = TIDX, ntn = N / 64, ntiles = ntn * (K / 64);
    int first = (vbid - base % G + G) % G;
    for (int t = first; t < ntiles; t += G) {
        const int n0 = (t % ntn) * 64, k0 = (t / ntn) * 64;
        const int c = colmap<MAP>(n0 + (tid & 63));
#pragma unroll
        for (int i = 0; i < 8; ++i) { const int kk = (tid >> 6) + 8 * i; float v = c >= 0 ? src[(size_t)(k0 + kk) * ld + c] : 0.f; if (kscale) v *= kscale[k0 + kk]; tile[kk * 65 + (tid & 63)] = v; }
        __syncthreads();
        { const int kc = tid & 7, nn = tid >> 3;
          const float* tp = tile + (kc * 8) * 65 + nn;
          u32x4 o; o.x = pk2(tp[0], tp[65]); o.y = pk2(tp[2 * 65], tp[3 * 65]); o.z = pk2(tp[4 * 65], tp[5 * 65]); o.w = pk2(tp[6 * 65], tp[7 * 65]);
          *(u32x4*)(dst + (size_t)(n0 + nn) * K + k0 + kc * 8) = o; }
        __syncthreads();
    }
    base += ntiles;
}
DI void phase_prep_ff(const Params& p, int l, int which, float* tile, int vbid, int vG) {
    unsigned char* ws = p.ws; int base = 0;
    if (which == 0) {
        tjob<1>(p.ff1_w_in + (size_t)l * DM * 2 * DFF, 2 * DFF, DM, 2 * DFF, (bf16_t*)(ws + O_WFF1IN), nullptr, tile, base, vbid, vG);
        tjob<0>(p.ff1_w_out + (size_t)l * DFF * DM, DM, DFF, DM, (bf16_t*)(ws + O_WFF1OUT), nullptr, tile, base, vbid, vG);
    } else {
        tjob<1>(p.ff2_w_in + (size_t)l * DM * 2 * DFF, 2 * DFF, DM, 2 * DFF, (bf16_t*)(ws + O_WFF2IN), nullptr, tile, base, vbid, vG);
        tjob<0>(p.ff2_w_out + (size_t)l * DFF * DM, DM, DFF, DM, (bf16_t*)(ws + O_WFF2OUT), nullptr, tile, base, vbid, vG);
    }
}
DI void phase_prep(const Params& p, int l, float* tile) {
    unsigned char* ws = p.ws; int base = 0;
    const int vbid = BIDX, vG = gridDim.x;
    const float* modl = (const float*)(ws + O_MOD) + (size_t)l * 5 * NMOD; float* shw = (float*)(ws + O_SHW);
    if (l == 0) phase_prep_ff(p, 0, 0, tile, vbid, vG);
    tjob<2>(p.w_in + (size_t)l * DM * 3744, 3744, DM, NIN, (bf16_t*)(ws + O_WIN), nullptr, tile, base, vbid, vG);
    tjob<0>(p.w_uq + (size_t)l * 384 * 768, 768, 384, 768, (bf16_t*)(ws + O_WUQ), p.q_a_norm + l * 384, tile, base, vbid, vG);
    tjob<3>(p.w_ukv + (size_t)l * 256 * 1024, 1024, 256, 1024, (bf16_t*)(ws + O_WUKV), p.kv_a_norm + l * 256, tile, base, vbid, vG);
    tjob<0>(p.w_o_attn + (size_t)l * 512 * 1024, 1024, 512, 1024, (bf16_t*)(ws + O_WOA), nullptr, tile, base, vbid, vG);
    tjob<0>(p.w_o_lru + (size_t)l * 512 * 1024, 1024, 512, 1024, (bf16_t*)(ws + O_WOL), nullptr, tile, base, vbid, vG);
    tjob<0>(p.w_out + (size_t)l * 1024 * 1024, 1024, 1024, 1024, (bf16_t*)(ws + O_WOUT), nullptr, tile, base, vbid, vG);
    { float* sh = tile; float* red = tile + 5 * DM;
      const int tid = TIDX, nn = tid & 63, ks = tid >> 6;
      for (int it = BIDX; it < 88 + 60 + 88; it += gridDim.x) {
          const int m = it < 88 ? 0 : (it < 148 ? 1 : 2), n0 = (m == 0 ? it : (m == 1 ? it - 88 : it - 148)) * 64;
          const float* W = m == 0 ? p.ff1_w_in + (size_t)l * DM * 2 * DFF : (m == 1 ? p.w_in + (size_t)l * DM * 3744 : p.ff2_w_in + (size_t)l * DM * 2 * DFF);
          const int ld = m == 1 ? 3744 : 2 * DFF, c = m == 1 ? colmap<2>(n0 + nn) : colmap<1>(n0 + nn);
          __syncthreads();
          for (int i = tid; i < 5 * DM; i += 512) sh[i] = modl[(size_t)(i >> 10) * NMOD + m * 3 * DM + (i & 1023)];
          __syncthreads();
          float a0 = 0.f, a1 = 0.f, a2 = 0.f, a3 = 0.f, a4 = 0.f;
          if (c >= 0) {
#pragma unroll 8
              for (int k = ks * 128; k < ks * 128 + 128; ++k) { const float wv = W[(size_t)k * ld + c]; a0 += sh[k] * wv; a1 += sh[DM + k] * wv; a2 += sh[2 * DM + k] * wv; a3 += sh[3 * DM + k] * wv; a4 += sh[4 * DM + k] * wv; }
          }
          red[(ks * 5 + 0) * 64 + nn] = a0; red[(ks * 5 + 1) * 64 + nn] = a1; red[(ks * 5 + 2) * 64 + nn] = a2; red[(ks * 5 + 3) * 64 + nn] = a3; red[(ks * 5 + 4) * 64 + nn] = a4;
          __syncthreads();
          if (tid < 320) { const int r = tid >> 6; float sum = 0.f;
#pragma unroll
              for (int w8 = 0; w8 < 8; ++w8) sum += red[(w8 * 5 + r) * 64 + nn];
              shw[(size_t)(m * 5 + r) * 5632 + n0 + nn] = sum; }
      }
      __syncthreads(); }
    if (BIDX == 0) { float* sp8 = (float*)(ws + O_SP);
        for (int i = TIDX; i < 1024; i += 512) { const float nl = -p.lru_lambda[l * 1024 + i]; sp8[i] = -8.f * (fmaxf(nl, 0.f) + log1pf(__expf(-fabsf(nl)))); } }
    bf16_t* wg = (bf16_t*)(ws + O_WGATE);
    for (int idx = BIDX * 512 + TIDX; idx < 2048 * 256; idx += gridDim.x * 512) {
        const int n = idx >> 8, k = idx & 255, d = n >> 10, cb = (n >> 8) & 3, gt = (n >> 7) & 1, c = n & 127, ch = cb * 128 + c, g = ch >> 6, j = ch & 63, ci = 256 * (cb >> 1) + k, gi = ci >> 6, i = ci & 63;
        float v = 0.f;
        if (gi == g) v = (gt ? p.w_igate : p.w_rgate)[((((size_t)l * 2 + d) * 8 + g) * 64 + i) * 64 + j];
        wg[idx] = f2bf(v);
    }
}

DI void phase_norm0(const Params& p) {
    const int tid = TIDX, lane = tid & 63, gw = BIDX * 8 + (tid >> 6), nw = gridDim.x * 8;
    float* X = (float*)(p.ws + O_X); bf16_t* XS = (bf16_t*)(p.ws + O_XNY); float* SS = (float*)(p.ws + O_SS);
    const float* mod = (const float*)(p.ws + O_MOD);
    for (int row = gw; row < MA; row += nw) {
        const float* src = row < ML ? p.x + (size_t)row * DM : p.ctx + (size_t)(row - ML) * DM;
        f32x4 v[4]; float s = 0.f;
#pragma unroll
        for (int j = 0; j < 4; ++j) { v[j] = *(const f32x4*)(src + 256 * j + 4 * lane); s += (v[j][0] * v[j][0] + v[j][1] * v[j][1]) + (v[j][2] * v[j][2] + v[j][3] * v[j][3]); }
        s = wave_sum(s);
        if (lane < 16) SS[(size_t)row * 16 + lane] = lane == 0 ? s : 0.f;
        const float* mr = mod + (size_t)mod_row(row) * NMOD;
#pragma unroll
        for (int j = 0; j < 4; ++j) {
            const int col = 256 * j + 4 * lane;
            *(f32x4*)(X + (size_t)row * DM + col) = v[j];
            const f32x4 sc = *(const f32x4*)(mr + DM + col);
            st_bf4(XS + (size_t)row * DM + col, v[j] * (1.f + sc));
        }
    }
}

DI void phase_conv(const Params& p, int l) {
    const bf16_t* UXY = (const bf16_t*)(p.ws + O_UXY); const bf16_t* P1 = (const bf16_t*)(p.ws + O_R1);
    bf16_t* xc = (bf16_t*)(p.ws + O_XNY);
    const float* cw = p.conv_w + (size_t)l * 4 * 512; const float* cb = p.conv_b + (size_t)l * 512;
    { const int e0 = BIDX * 512 + TIDX, ch = (e0 & 63) * 8;
      f32x4 w[4][2], bias[2];
#pragma unroll
      for (int k = 0; k < 4; ++k) { w[k][0] = *(const f32x4*)(cw + k * 512 + ch); w[k][1] = *(const f32x4*)(cw + k * 512 + ch + 4); }
      bias[0] = *(const f32x4*)(cb + ch); bias[1] = *(const f32x4*)(cb + ch + 4);
      for (int e = e0; e < MA * 64; e += gridDim.x * 512) {
        const int row = e >> 6;
        int t, T; if (row < ML) { t = row & (SEQ - 1); T = SEQ; } else { t = (row - ML) & 255; T = CTXL; }
        u32x4 uv[4]; float ok[4];
#pragma unroll
        for (int k = 0; k < 4; ++k) { const int tt = t + k - 2; const bool in = tt >= 0 && tt < T; ok[k] = in ? 1.f : 0.f;
            uv[k] = *(const u32x4*)(UXY + (size_t)(in ? row + k - 2 : row) * 1024 + ch); }
        f32x4 y0 = bias[0], y1 = bias[1];
#pragma unroll
        for (int k = 0; k < 4; ++k) {
            const f32x4 a = {bflo(uv[k].x), bfhi(uv[k].x), bflo(uv[k].y), bfhi(uv[k].y)}, c = {bflo(uv[k].z), bfhi(uv[k].z), bflo(uv[k].w), bfhi(uv[k].w)};
            y0 += (w[k][0] * ok[k]) * a; y1 += (w[k][1] * ok[k]) * c;
        }
        u32x4 o; o.x = pk2(y0[0], y0[1]); o.y = pk2(y0[2], y0[3]); o.z = pk2(y1[0], y1[1]); o.w = pk2(y1[2], y1[3]);
        *(u32x4*)(xc + (size_t)row * 512 + ch) = o;
      } }
    float* rsq = (float*)(p.ws + O_RSQ); float* rskv = (float*)(p.ws + O_RSKV);
    const int tid2 = TIDX, l16 = tid2 & 15, gq = BIDX * 32 + (tid2 >> 4), nq = gridDim.x * 32;
    for (int row = gq; row < MA; row += nq) {
        const bf16_t* pr = P1 + (size_t)row * 768;
        u32x4 v[5];
#pragma unroll
        for (int i = 0; i < 5; ++i) v[i] = *(const u32x4*)(pr + (l16 + 16 * i) * 8);
        float sq = 0.f, skv = 0.f;
#pragma unroll
        for (int i = 0; i < 5; ++i) {
            const float s2 = bflo(v[i].x) * bflo(v[i].x) + bfhi(v[i].x) * bfhi(v[i].x) + bflo(v[i].y) * bflo(v[i].y) + bfhi(v[i].y) * bfhi(v[i].y)
                           + bflo(v[i].z) * bflo(v[i].z) + bfhi(v[i].z) * bfhi(v[i].z) + bflo(v[i].w) * bflo(v[i].w) + bfhi(v[i].w) * bfhi(v[i].w);
            if (i < 3) sq += s2; else skv += s2;
        }
#pragma unroll
        for (int o = 1; o < 16; o <<= 1) { sq += __shfl_xor(sq, o); skv += __shfl_xor(skv, o); }
        if (l16 == 0) { rsq[row] = rsqrtf(sq * (1.f / 384.f) + EPS); rskv[row] = rsqrtf(skv * (1.f / 256.f) + EPS); }
    }
}

DI int chunk_row0(int b, int pch) { return pch < 4 ? ML + b * CTXL + pch * 64 : b * SEQ + (pch - 4) * 64; }
DI void phase_scan_agg(const Params& p) {
    const bf16_t* OM = (const bf16_t*)(p.ws + O_S); const bf16_t* BB = OM + (size_t)2 * MA * 512;
    f32x4* agg = (f32x4*)(p.ws + O_AGG);
    const int tid = TIDX, lane = tid & 63, gw = (tid >> 6) * gridDim.x + BIDX, nw = gridDim.x * 8;
    for (int it = gw; it < 2 * NB * NCH; it += nw) {
        const int d = it & 1, bp = it >> 1, b = bp / NCH, pch = bp % NCH, row0 = chunk_row0(b, pch);
        const bf16_t* om = OM + ((size_t)d * MA + row0) * 512 + lane * 8; const bf16_t* bb = BB + ((size_t)d * MA + row0) * 512 + lane * 8;
        float h[8], A[8];
#pragma unroll
        for (int i = 0; i < 8; ++i) { h[i] = 0.f; A[i] = 1.f; }
#pragma unroll 8
        for (int t = 0; t < 64; ++t) {
            const int tt = d ? 63 - t : t;
            const u32x4 ov = *(const u32x4*)(om + (size_t)tt * 512), bv = *(const u32x4*)(bb + (size_t)tt * 512);
            const float a[8] = {1.f - bflo(ov.x), 1.f - bfhi(ov.x), 1.f - bflo(ov.y), 1.f - bfhi(ov.y), 1.f - bflo(ov.z), 1.f - bfhi(ov.z), 1.f - bflo(ov.w), 1.f - bfhi(ov.w)};
            const float bq[8] = {bflo(bv.x), bfhi(bv.x), bflo(bv.y), bfhi(bv.y), bflo(bv.z), bfhi(bv.z), bflo(bv.w), bfhi(bv.w)};
#pragma unroll
            for (int i = 0; i < 8; ++i) { h[i] = a[i] * h[i] + bq[i]; A[i] *= a[i]; }
        }
        f32x4* dst = agg + (((size_t)(d * NB + b) * NCH + pch) * 512 + lane * 8) / 2;
#pragma unroll
        for (int i = 0; i < 4; ++i) dst[i] = (f32x4){A[2 * i], h[2 * i], A[2 * i + 1], h[2 * i + 1]};
    }
}
DI float gelu_tanh(float x) { const float u = 0.7978845608028654f * (x + 0.044715f * x * x * x); const float e = __expf(2.f * u); const float th = 1.f - 2.f * __builtin_amdgcn_rcpf(e + 1.f); return 0.5f * x * (1.f + th); }
DI void agg_step(const f32x4* e, float (&h)[8]) {
    const f32x4 e0 = e[0], e1 = e[1], e2 = e[2], e3 = e[3];
    h[0] = e0[0] * h[0] + e0[1]; h[1] = e0[2] * h[1] + e0[3]; h[2] = e1[0] * h[2] + e1[1]; h[3] = e1[2] * h[3] + e1[3];
    h[4] = e2[0] * h[4] + e2[1]; h[5] = e2[2] * h[5] + e2[3]; h[6] = e3[0] * h[6] + e3[1]; h[7] = e3[2] * h[7] + e3[3];
}
DI void phase_scan_apply(const Params& p) {
    const bf16_t* OM = (const bf16_t*)(p.ws + O_S); const bf16_t* BB = OM + (size_t)2 * MA * 512;
    const f32x4* agg = (const f32x4*)(p.ws + O_AGG);
    bf16_t* UXY = (bf16_t*)(p.ws + O_UXY); float* HF = p.out;
    const int tid = TIDX, lane = tid & 63, gw = (tid >> 6) * gridDim.x + BIDX, nw = gridDim.x * 8;
    for (int it = gw; it < NB * NCH; it += nw) {
        const int b = it / NCH, pch = it % NCH, row0 = chunk_row0(b, pch);
        const f32x4* af = agg + (((size_t)(0 * NB + b) * NCH) * 512 + lane * 8) / 2; const f32x4* ab = agg + (((size_t)(1 * NB + b) * NCH) * 512 + lane * 8) / 2;
        float h[8];
#pragma unroll
        for (int i = 0; i < 8; ++i) h[i] = 0.f;
#pragma unroll 4
        for (int q = 0; q < pch; ++q) agg_step(af + (size_t)q * 256, h);
        { const bf16_t* om = OM + ((size_t)row0) * 512 + lane * 8; const bf16_t* bb = BB + ((size_t)row0) * 512 + lane * 8; float* hf = HF + (size_t)row0 * 512 + lane * 8;
#pragma unroll 8
          for (int t = 0; t < 64; ++t) {
              const u32x4 ov = *(const u32x4*)(om + (size_t)t * 512), bv = *(const u32x4*)(bb + (size_t)t * 512);
              h[0] = (1.f - bflo(ov.x)) * h[0] + bflo(bv.x); h[1] = (1.f - bfhi(ov.x)) * h[1] + bfhi(bv.x); h[2] = (1.f - bflo(ov.y)) * h[2] + bflo(bv.y); h[3] = (1.f - bfhi(ov.y)) * h[3] + bfhi(bv.y);
              h[4] = (1.f - bflo(ov.z)) * h[4] + bflo(bv.z); h[5] = (1.f - bfhi(ov.z)) * h[5] + bfhi(bv.z); h[6] = (1.f - bflo(ov.w)) * h[6] + bflo(bv.w); h[7] = (1.f - bfhi(ov.w)) * h[7] + bfhi(bv.w);
              *(f32x4*)(hf + (size_t)t * 512) = (f32x4){h[0], h[1], h[2], h[3]}; *(f32x4*)(hf + (size_t)t * 512 + 4) = (f32x4){h[4], h[5], h[6], h[7]};
          } }
#pragma unroll
        for (int i = 0; i < 8; ++i) h[i] = 0.f;
        if (pch >= 4) {
#pragma unroll
            for (int q = 3; q >= 0; --q) agg_step(ab + (size_t)q * 256, h);
#pragma unroll 4
            for (int q = NCH - 1; q > pch; --q) agg_step(ab + (size_t)q * 256, h);
        } else {
            for (int q = 3; q > pch; --q) agg_step(ab + (size_t)q * 256, h);
        }
        { const bf16_t* om = OM + ((size_t)MA + row0) * 512 + lane * 8; const bf16_t* bb = BB + ((size_t)MA + row0) * 512 + lane * 8; const float* hf = HF + (size_t)row0 * 512 + lane * 8;
#pragma unroll 4
          for (int t = 63; t >= 0; --t) {
              const u32x4 ov = *(const u32x4*)(om + (size_t)t * 512), bv = *(const u32x4*)(bb + (size_t)t * 512);
              const f32x4 f0 = *(const f32x4*)(hf + (size_t)t * 512), f1 = *(const f32x4*)(hf + (size_t)t * 512 + 4);
              const u32x4 uv = *(const u32x4*)(UXY + (size_t)(row0 + t) * 1024 + 512 + lane * 8);
              h[0] = (1.f - bflo(ov.x)) * h[0] + bflo(bv.x); h[1] = (1.f - bfhi(ov.x)) * h[1] + bfhi(bv.x); h[2] = (1.f - bflo(ov.y)) * h[2] + bflo(bv.y); h[3] = (1.f - bfhi(ov.y)) * h[3] + bfhi(bv.y);
              h[4] = (1.f - bflo(ov.z)) * h[4] + bflo(bv.z); h[5] = (1.f - bfhi(ov.z)) * h[5] + bfhi(bv.z); h[6] = (1.f - bflo(ov.w)) * h[6] + bflo(bv.w); h[7] = (1.f - bfhi(ov.w)) * h[7] + bfhi(bv.w);
              u32x4 o;
              o.x = pk2((f0[0] + h[0]) * gelu_tanh(bflo(uv.x)), (f0[1] + h[1]) * gelu_tanh(bfhi(uv.x))); o.y = pk2((f0[2] + h[2]) * gelu_tanh(bflo(uv.y)), (f0[3] + h[3]) * gelu_tanh(bfhi(uv.y)));
              o.z = pk2((f1[0] + h[4]) * gelu_tanh(bflo(uv.z)), (f1[1] + h[5]) * gelu_tanh(bfhi(uv.z))); o.w = pk2((f1[2] + h[6]) * gelu_tanh(bflo(uv.w)), (f1[3] + h[7]) * gelu_tanh(bfhi(uv.w)));
              *(u32x4*)(UXY + (size_t)(row0 + t) * 1024 + lane * 8) = o;
          } }
    }
}

DI void phase_qk(const Params& p, int l, unsigned char* smem) {
    const bf16_t* qraw = (const bf16_t*)p.out; const bf16_t* kn = qraw + (size_t)MA * 768;
    const bf16_t* P1 = (const bf16_t*)(p.ws + O_R1);
    bf16_t* Q = (bf16_t*)(p.ws + O_S); bf16_t* Kb = Q + (size_t)32 * TK * 96;
    const int tid = TIDX, lane = tid & 63, wave = tid >> 6, gw = BIDX * 8 + wave, nw = gridDim.x * 8, h = lane >> 3, j = lane & 7;
    unsigned char* wq = smem + wave * 4096; unsigned char* wk = wq + 1536;
    const float* qn = p.q_norm + l * 96; const float* knm = p.k_norm + l * 96;
    float gq[12], gk[12];
#pragma unroll
    for (int i = 0; i < 12; ++i) { gq[i] = qn[8 * i + j] * QSCALE; gk[i] = knm[8 * i + j]; }
    const float freq = exp2f(-(float)j * 1.6609640474436813f);
    for (int row = gw; row < MA; row += nw) {
        { const u32x4 q0 = *(const u32x4*)(qraw + (size_t)row * 768 + lane * 8);
          u32x4 q1 = {0u, 0u, 0u, 0u}, k1 = {0u, 0u, 0u, 0u};
          if (lane < 32) q1 = *(const u32x4*)(qraw + (size_t)row * 768 + 512 + lane * 8);
          const u32x4 k0 = *(const u32x4*)(kn + (size_t)row * 512 + lane * 8);
          if (lane < 4) k1 = *(const u32x4*)(P1 + (size_t)row * 768 + 640 + lane * 8);
          *(u32x4*)(wq + lane * 16) = q0; if (lane < 32) *(u32x4*)(wq + 1024 + lane * 16) = q1;
          *(u32x4*)(wk + lane * 16) = k0; if (lane < 4) *(u32x4*)(wk + 1024 + lane * 16) = k1; }
        __builtin_amdgcn_fence(__ATOMIC_RELEASE, "wavefront"); __builtin_amdgcn_wave_barrier(); __builtin_amdgcn_fence(__ATOMIC_ACQUIRE, "wavefront");
        float xq[12], xk[12];
#pragma unroll
        for (int i = 0; i < 12; ++i) xq[i] = bf2f(*(const bf16_t*)(wq + (h * 96 + 8 * i + j) * 2));
#pragma unroll
        for (int i = 0; i < 8; ++i) xk[i] = bf2f(*(const bf16_t*)(wk + (h * 64 + 8 * i + j) * 2));
#pragma unroll
        for (int i = 8; i < 12; ++i) xk[i] = bf2f(*(const bf16_t*)(wk + 1024 + (8 * (i - 8) + j) * 2));
        __builtin_amdgcn_fence(__ATOMIC_RELEASE, "wavefront"); __builtin_amdgcn_wave_barrier(); __builtin_amdgcn_fence(__ATOMIC_ACQUIRE, "wavefront");
        const bool lat = row < ML; int b, pos;
        if (lat) { b = row >> 13; pos = row & (SEQ - 1); } else { const int r = row - ML; b = r >> 8; pos = SEQ + (r & 255); }
        float c0 = 1.f, s0 = 0.f, c1 = 1.f, s1 = 0.f;
        if (lat) { float r0 = (float)(pos >> 6) * freq * 0.15915494309189535f, r1 = (float)(pos & 63) * freq * 0.15915494309189535f;
            r0 -= floorf(r0); r1 -= floorf(r1);
            c0 = __builtin_amdgcn_cosf(r0); s0 = __builtin_amdgcn_sinf(r0); c1 = __builtin_amdgcn_cosf(r1); s1 = __builtin_amdgcn_sinf(r1); }
        float sq = 0.f, sk = 0.f;
#pragma unroll
        for (int i = 0; i < 12; ++i) { sq += xq[i] * xq[i]; sk += xk[i] * xk[i]; }
        sq += __shfl_xor(sq, 1); sk += __shfl_xor(sk, 1); sq += __shfl_xor(sq, 2); sk += __shfl_xor(sk, 2); sq += __shfl_xor(sq, 4); sk += __shfl_xor(sk, 4);
        const float rq = rsqrtf(sq * (1.f / 96.f) + EPS), rk = rsqrtf(sk * (1.f / 96.f) + EPS);
#pragma unroll
        for (int i = 0; i < 12; ++i) { xq[i] *= rq * gq[i]; xk[i] *= rk * gk[i]; }
        { const float y8 = xq[8] * c0 - xq[9] * s0, y9 = xq[8] * s0 + xq[9] * c0, y10 = xq[10] * c1 - xq[11] * s1, y11 = xq[10] * s1 + xq[11] * c1;
          xq[8] = y8; xq[9] = y9; xq[10] = y10; xq[11] = y11; }
        { const float y8 = xk[8] * c0 - xk[9] * s0, y9 = xk[8] * s0 + xk[9] * c0, y10 = xk[10] * c1 - xk[11] * s1, y11 = xk[10] * s1 + xk[11] * c1;
          xk[8] = y8; xk[9] = y9; xk[10] = y10; xk[11] = y11; }
#pragma unroll
        for (int i = 0; i < 12; ++i) { *(bf16_t*)(wq + (h * 96 + 8 * i + j) * 2) = f2bf(xq[i]); *(bf16_t*)(wk + (h * 96 + 8 * i + j) * 2) = f2bf(xk[i]); }
        __builtin_amdgcn_fence(__ATOMIC_RELEASE, "wavefront"); __builtin_amdgcn_wave_barrier(); __builtin_amdgcn_fence(__ATOMIC_ACQUIRE, "wavefront");
        { const int c0i = lane, c1i = 64 + lane;
          const u32x4 oq0 = *(const u32x4*)(wq + c0i * 16), ok0 = *(const u32x4*)(wk + c0i * 16);
          const size_t d0 = ((size_t)(b * NH + c0i / 12) * TK + pos) * 96 + (c0i % 12) * 8;
          *(u32x4*)(Q + d0) = oq0; *(u32x4*)(Kb + d0) = ok0;
          if (lane < 32) { const u32x4 oq1 = *(const u32x4*)(wq + c1i * 16), ok1 = *(const u32x4*)(wk + c1i * 16);
              const size_t d1 = ((size_t)(b * NH + c1i / 12) * TK + pos) * 96 + (c1i % 12) * 8;
              *(u32x4*)(Q + d1) = oq1; *(u32x4*)(Kb + d1) = ok1; } }
        __builtin_amdgcn_fence(__ATOMIC_RELEASE, "wavefront"); __builtin_amdgcn_wave_barrier(); __builtin_amdgcn_fence(__ATOMIC_ACQUIRE, "wavefront");
    }
}

constexpr int KROW = 208, VROW = 144, KBYTES = 64 * KROW, ABUF = KBYTES + 64 * VROW;
DI void attn_item(unsigned char* lds, const bf16_t* Q, const bf16_t* Kb, const bf16_t* Vt, bf16_t* att, int bh, int qposA, int qposB, int kt0, int kt1, int outrowA, int outrowB, bool writeB) {
    const int tid = TIDX, lane = tid & 63, l31 = lane & 31, half = lane >> 5;
    bf16x8 qa[6], qb[6];
    { const bf16_t* qp = Q + ((size_t)bh * TK + qposA + l31) * 96 + 8 * half; const bf16_t* qq = Q + ((size_t)bh * TK + qposB + l31) * 96 + 8 * half;
#pragma unroll
      for (int ks = 0; ks < 6; ++ks) { qa[ks] = *(const bf16x8*)(qp + 16 * ks); qb[ks] = *(const bf16x8*)(qq + 16 * ks); } }
    f32x16 oa0, oa1, ob0, ob1;
#pragma unroll
    for (int i = 0; i < 16; ++i) { oa0[i] = 0.f; oa1[i] = 0.f; ob0[i] = 0.f; ob1[i] = 0.f; }
    float la = 0.f, lb = 0.f;
    const unsigned char* kg = (const unsigned char*)(Kb + (size_t)bh * TK * 96) + (size_t)tid * 16;
    const unsigned char* vg = (const unsigned char*)(Vt + ((size_t)bh * 64 + (tid >> 3)) * TK) + (tid & 7) * 16;
    const int kc1 = 512 + tid;
    const int koff0 = (tid / 12) * KROW + (tid % 12) * 16, koff1 = (kc1 / 12) * KROW + (kc1 % 12) * 16;
    const int voff = KBYTES + (tid >> 3) * VROW + ((tid & 7) >> 1) * 32 + (tid & 1) * 8;
    const int klo = l31 * KROW + 16 * half, vlo = KBYTES + l31 * VROW + 16 * half;
    u32x4 kr0, kr1 = {0u, 0u, 0u, 0u}, vr;
#define AT_GLOAD(kt) do { kr0 = *(const u32x4*)(kg + (size_t)(kt) * 12288); if (tid < 256) kr1 = *(const u32x4*)(kg + (size_t)(kt) * 12288 + 8192); vr = *(const u32x4*)(vg + (size_t)(kt) * 128); } while (0)
#define AT_SSTORE(stg) do { unsigned char* bp_ = lds + (stg) * ABUF; *(u32x4*)(bp_ + koff0) = kr0; if (tid < 256) *(u32x4*)(bp_ + koff1) = kr1; \
        *(u32x2*)(bp_ + voff) = (u32x2){vr.x, vr.y}; *(u32x2*)(bp_ + voff + 16) = (u32x2){vr.z, vr.w}; } while (0)
#define AT_PK(v, o) (u32x4){pk2(v[o], v[o + 1]), pk2(v[o + 2], v[o + 3]), pk2(v[o + 4], v[o + 5]), pk2(v[o + 6], v[o + 7])}
    AT_GLOAD(kt0); AT_SSTORE(0);
    __syncthreads();
    for (int kt = kt0; kt < kt1; ++kt) {
        const int cur = (kt - kt0) & 1;
        const bool more = kt + 1 < kt1;
        if (more) AT_GLOAD(kt + 1);
        const unsigned char* kl = lds + cur * ABUF + klo;
        const unsigned char* vl = lds + cur * ABUF + vlo;
        f32x16 sa0, sa1, sb0, sb1;
        const f32x16 zero16 = {0.f, 0.f, 0.f, 0.f, 0.f, 0.f, 0.f, 0.f, 0.f, 0.f, 0.f, 0.f, 0.f, 0.f, 0.f, 0.f};
        __builtin_amdgcn_s_setprio(1);
#pragma unroll
        for (int ks = 0; ks < 6; ++ks) {
            const bf16x8 a0 = *(const bf16x8*)(kl + 32 * ks), a1 = *(const bf16x8*)(kl + 32 * KROW + 32 * ks);
            sa0 = __builtin_amdgcn_mfma_f32_32x32x16_bf16(a0, qa[ks], ks == 0 ? zero16 : sa0, 0, 0, 0);
            sa1 = __builtin_amdgcn_mfma_f32_32x32x16_bf16(a1, qa[ks], ks == 0 ? zero16 : sa1, 0, 0, 0);
            sb0 = __builtin_amdgcn_mfma_f32_32x32x16_bf16(a0, qb[ks], ks == 0 ? zero16 : sb0, 0, 0, 0);
            sb1 = __builtin_amdgcn_mfma_f32_32x32x16_bf16(a1, qb[ks], ks == 0 ? zero16 : sb1, 0, 0, 0);
        }
        __builtin_amdgcn_s_setprio(0);
        float pa = 0.f, pb = 0.f;
#pragma unroll
        for (int i = 0; i < 16; ++i) { sa0[i] = __builtin_amdgcn_exp2f(sa0[i]); sa1[i] = __builtin_amdgcn_exp2f(sa1[i]); pa += sa0[i] + sa1[i];
                                       sb0[i] = __builtin_amdgcn_exp2f(sb0[i]); sb1[i] = __builtin_amdgcn_exp2f(sb1[i]); pb += sb0[i] + sb1[i]; }
        la += pa; lb += pb;
        __builtin_amdgcn_s_setprio(1);
#pragma unroll
        for (int s = 0; s < 4; ++s) {
            const bf16x8 v0 = *(const bf16x8*)(vl + 32 * s), v1 = *(const bf16x8*)(vl + 32 * VROW + 32 * s);
            const bf16x8 fa = __builtin_bit_cast(bf16x8, s < 2 ? AT_PK(sa0, 8 * (s & 1)) : AT_PK(sa1, 8 * (s & 1)));
            const bf16x8 fb = __builtin_bit_cast(bf16x8, s < 2 ? AT_PK(sb0, 8 * (s & 1)) : AT_PK(sb1, 8 * (s & 1)));
            oa0 = __builtin_amdgcn_mfma_f32_32x32x16_bf16(v0, fa, oa0, 0, 0, 0); oa1 = __builtin_amdgcn_mfma_f32_32x32x16_bf16(v1, fa, oa1, 0, 0, 0);
            ob0 = __builtin_amdgcn_mfma_f32_32x32x16_bf16(v0, fb, ob0, 0, 0, 0); ob1 = __builtin_amdgcn_mfma_f32_32x32x16_bf16(v1, fb, ob1, 0, 0, 0);
        }
        __builtin_amdgcn_s_setprio(0);
        if (more) AT_SSTORE(cur ^ 1);
        __syncthreads();
    }
#undef AT_GLOAD
#undef AT_SSTORE
#undef AT_PK
    { const float lt = la + __shfl_xor(la, 32), inv = 1.f / lt;
      bf16_t* op = att + (size_t)(outrowA + l31) * 512 + (bh & 7) * 64 + 4 * half;
#pragma unroll
      for (int g = 0; g < 4; ++g) {
          st_bf4(op + 8 * g, (f32x4){oa0[4 * g] * inv, oa0[4 * g + 1] * inv, oa0[4 * g + 2] * inv, oa0[4 * g + 3] * inv});
          st_bf4(op + 32 + 8 * g, (f32x4){oa1[4 * g] * inv, oa1[4 * g + 1] * inv, oa1[4 * g + 2] * inv, oa1[4 * g + 3] * inv}); } }
    if (writeB) { const float lt = lb + __shfl_xor(lb, 32), inv = 1.f / lt;
      bf16_t* op = att + (size_t)(outrowB + l31) * 512 + (bh & 7) * 64 + 4 * half;
#pragma unroll
      for (int g = 0; g < 4; ++g) {
          st_bf4(op + 8 * g, (f32x4){ob0[4 * g] * inv, ob0[4 * g + 1] * inv, ob0[4 * g + 2] * inv, ob0[4 * g + 3] * inv});
          st_bf4(op + 32 + 8 * g, (f32x4){ob1[4 * g] * inv, ob1[4 * g + 1] * inv, ob1[4 * g + 2] * inv, ob1[4 * g + 3] * inv}); } }
}
DI void phase_attn(const Params& p, unsigned char* lds, bool with_ctx) {
    const bf16_t* Q = (const bf16_t*)(p.ws + O_S); const bf16_t* Kb = Q + (size_t)32 * TK * 96; const bf16_t* Vt = Kb + (size_t)32 * TK * 96;
    bf16_t* att = (bf16_t*)p.out;
    const int nitems = 512 + (with_ctx ? 32 : 0);
    for (int it = BIDX; it < nitems; it += gridDim.x) {
        const int wave = TIDX >> 6;
        if (it < 512) {
            const int j = (it >> 3) & 31, bh = (it >> 8) * 16 + (it & 7) * 2 + (j >> 4), q0 = (j & 15) * 512 + wave * 64, r0 = (bh >> 3) * SEQ + q0;
            attn_item(lds, Q, Kb, Vt, att, bh, q0, q0 + 32, 0, TK / 64, r0, r0 + 32, true);
        } else {
            const int bh = it - 512, q0 = SEQ + wave * 32, r0 = ML + (bh >> 3) * CTXL + wave * 32;
            attn_item(lds, Q, Kb, Vt, att, bh, q0, q0, SEQ / 64, TK / 64, r0, r0, false);
        }
    }
}

constexpr int PH_PER_LAYER = 15, N_PHASES = 1 + DEPTH * PH_PER_LAYER;
DI int phase_case(int ph) { const int i = (ph - 1) % PH_PER_LAYER; return i < 3 ? i : (i < 13 ? i + 1 : i + 2); }
DI void run_phase(const Params& p, int ph, unsigned char* smem) {
    LAS unsigned char* lds = (LAS unsigned char*)smem;
    unsigned char* ws = p.ws;
    if (ph == 0) { phase_mod(p, (float*)smem); return; }
    const int l = (ph - 1) / PH_PER_LAYER, s = phase_case(ph);
    const bool last = (l == DEPTH - 1);
    const float* mod = (const float*)(ws + O_MOD) + (size_t)l * 5 * NMOD;
    float* X = (float*)(ws + O_X);
    bf16_t* XNY = (bf16_t*)(ws + O_XNY); bf16_t* H = (bf16_t*)(ws + O_R1); bf16_t* P1 = (bf16_t*)(ws + O_R1); bf16_t* GATE = P1 + (size_t)MA * 768;
    bf16_t* UXY = (bf16_t*)(ws + O_UXY);
    float* SS = (float*)(ws + O_SS); const float* shw = (const float*)(ws + O_SHW);
    const int Mtail = last ? ML : MA;
    switch (s) {
    case 0: phase_prep(p, l, (float*)smem); if (l == 0) phase_norm0(p); break;
    case 1: { ESwiglu E{H, SS, shw}; gemm_phase<ESwiglu, false, true>(lds, Gemm{XNY, (const bf16_t*)(ws + O_WFF1IN), MA, 2 * DFF, DM, DM, DM}, E); } break;
    case 2: { EResid<1, true> E{X, X, mod + 2 * DM, mod + 4 * DM, XNY, SS + (size_t)MA * 16}; gemm_phase<EResid<1, true>, false, true>(lds, Gemm{H, (const bf16_t*)(ws + O_WFF1OUT), MA, DM, DFF, DFF, DFF}, E); }
              { const int nthird = (MA / BM) * (DM / BM) - 2 * (int)gridDim.x, vb = (int)BIDX - nthird; if (nthird > 0 && nthird < (int)gridDim.x && vb >= 0) phase_prep_ff(p, l, 1, (float*)smem, vb, (int)gridDim.x - nthird); else if (nthird <= 0 || nthird >= (int)gridDim.x) phase_prep_ff(p, l, 1, (float*)smem, BIDX, gridDim.x); }
              break;
    case 4: { EWin E{P1, UXY, GATE, SS + (size_t)MA * 16, shw + 5 * 5632}; gemm_phase<EWin, false, true>(lds, Gemm{XNY, (const bf16_t*)(ws + O_WIN), MA, NIN, DM, DM, DM}, E); } break;
    case 5: phase_conv(p, l); break;
    case 6: { bf16_t* OM = (bf16_t*)(ws + O_S); EGate E{XNY, OM, OM + (size_t)2 * MA * 512, (const float*)(ws + O_SP), p.b_rgate + l * 1024, p.b_igate + l * 1024};
              gemm_phase<EGate, true, true>(lds, Gemm{XNY, (const bf16_t*)(ws + O_WGATE), MA, 2048, 256, 512, 256}, E); } break;
    case 7: phase_scan_agg(p); break;
    case 8: phase_scan_apply(p); break;
    case 9: { bf16_t* qraw = (bf16_t*)p.out; bf16_t* kn = qraw + (size_t)MA * 768; bf16_t* Vt = (bf16_t*)(ws + O_S) + (size_t)2 * 32 * TK * 96;
              const float* rsq = (const float*)(ws + O_RSQ); const float* rskv = (const float*)(ws + O_RSKV);
              const bf16_t* wukv = (const bf16_t*)(ws + O_WUKV);
              { EpiElem8<FRowScale> E{{qraw, 768, rsq}}; gemm_phase<EpiElem8<FRowScale>, false, true>(lds, Gemm{P1, (const bf16_t*)(ws + O_WUQ), MA, 768, 384, 768, 384}, E); }
              { EpiElem8<FRowScale> E{{kn, 512, rskv}}; gemm_phase<EpiElem8<FRowScale>, false, true>(lds, Gemm{P1 + 384, wukv, MA, 512, 256, 768, 256, 144}, E); }
              { EpiElem8<FVt> E{{Vt, rskv}}; gemm_phase<EpiElem8<FVt>, false, true>(lds, Gemm{wukv + (size_t)512 * 256, P1 + 384, 512, MA, 256, 256, 768, 152}, E); }
              } break;
    case 10: phase_qk(p, l, smem); break;
    case 11: phase_attn(p, smem, !last); break;
    case 12: { { EpiElem8<FMergeA> E{{GATE, XNY}}; gemm_phase<EpiElem8<FMergeA>, false, true>(lds, Gemm{(const bf16_t*)p.out, (const bf16_t*)(ws + O_WOA), Mtail, DM, 512, 512, 512}, E); }
               { EpiElem8<FMergeB> E{{GATE, XNY}}; gemm_phase<EpiElem8<FMergeB>, false, true>(lds, Gemm{UXY, (const bf16_t*)(ws + O_WOL), Mtail, DM, 512, 1024, 512}, E); } } break;
    case 13: { EResid<2, true> E{X, X, mod + 5 * DM, mod + 7 * DM, UXY, SS + (size_t)2 * MA * 16}; gemm_phase<EResid<2, true>, false, true>(lds, Gemm{XNY, (const bf16_t*)(ws + O_WOUT), Mtail, DM, DM, DM, DM}, E); } break;
    case 15: { ESwiglu E{H, SS + (size_t)2 * MA * 16, shw + 2 * 5 * 5632}; gemm_phase<ESwiglu, false, true>(lds, Gemm{UXY, (const bf16_t*)(ws + O_WFF2IN), Mtail, 2 * DFF, DM, DM, DM}, E); } break;
    case 16: if (last) { EResid<1, false> E{X, p.out, mod + 8 * DM, nullptr, nullptr, nullptr}; gemm_phase<EResid<1, false>, false, true>(lds, Gemm{H, (const bf16_t*)(ws + O_WFF2OUT), Mtail, DM, DFF, DFF, DFF}, E); }
             else { EResid<1, true> E{X, X, mod + 8 * DM, mod + 5 * NMOD + DM, XNY, SS}; gemm_phase<EResid<1, true>, false, true>(lds, Gemm{H, (const bf16_t*)(ws + O_WFF2OUT), Mtail, DM, DFF, DFF, DFF}, E); }
             if (!last) { const int nthird = (MA / BM) * (DM / BM) - 2 * (int)gridDim.x, vb = (int)BIDX - nthird; if (nthird > 0 && nthird < (int)gridDim.x && vb >= 0) phase_prep_ff(p, l + 1, 0, (float*)smem, vb, (int)gridDim.x - nthird); else if (nthird <= 0 || nthird >= (int)gridDim.x) phase_prep_ff(p, l + 1, 0, (float*)smem, BIDX, gridDim.x); }
             break;
    }
}

#ifndef PROBE_MASK
#define PROBE_MASK 0u
#endif
#define XB_TMO      128
#define XB_XCNT(j)  (256  + 64 * (j))
#define XB_XSUB(j)  (1280 + 64 * (j))
#define XB_XGEN(j)  (2304 + 64 * (j))
#define XB_TOP      3328
#define XB_TOPGEN   3392
#define XCD_BAR_WORDS 3456
#define XB_SPIN_CAP (1u << 18)
DI unsigned xb_ld(unsigned* p)              { return __hip_atomic_load(p, __ATOMIC_RELAXED, __HIP_MEMORY_SCOPE_AGENT); }
DI unsigned xb_add(unsigned* p, unsigned v) { return __hip_atomic_fetch_add(p, v, __ATOMIC_RELAXED, __HIP_MEMORY_SCOPE_AGENT); }
DI unsigned xb_xcc_id() { return (unsigned)__builtin_amdgcn_s_getreg((3 << 11) | 20) & 0xFu; }
#define XB_SPIN(cond, bar) do { unsigned _sp = 0; while (cond) { __builtin_amdgcn_s_sleep(1); \
    if ((++_sp & 255u) == 0u) { if (xb_ld(&(bar)[XB_TMO])) break; if (_sp > XB_SPIN_CAP) { atomicAdd(&(bar)[XB_TMO], 1u); break; } } } } while (0)
struct XcdBarrier { unsigned* bar; unsigned x; volatile LAS unsigned* st; };
DI XcdBarrier xcd_barrier_post(unsigned* bar, volatile LAS unsigned* st) {
    XcdBarrier b; b.bar = bar; b.x = xb_xcc_id(); b.st = st;
    if (threadIdx.x == 0) (void)xb_add(&bar[XB_XCNT(b.x)], 1u);
    return b;
}
DI void xcd_barrier_complete(unsigned* bar, unsigned x, unsigned& nloc, unsigned& nx) {
    const unsigned G = gridDim.x * gridDim.y * gridDim.z;
    unsigned sum, cnt, mine, sp = 0u;
    for (;;) {
        sum = 0u; cnt = 0u; mine = 0u;
#pragma unroll
        for (unsigned j = 0; j < 16; ++j) { const unsigned c = xb_ld(&bar[XB_XCNT(j)]); sum += c; cnt += (c > 0u) ? 1u : 0u; mine = (j == x) ? c : mine; }
        if (sum == G) break;
        __builtin_amdgcn_s_sleep(1);
        if ((++sp & 255u) == 0u) { if (xb_ld(&bar[XB_TMO])) break; if (sp > XB_SPIN_CAP) { atomicAdd(&bar[XB_TMO], 1u); break; } }
    }
    nloc = mine > 0u ? mine : 1u; nx = cnt > 0u ? cnt : 1u;
}
DI void xcd_barrier(const XcdBarrier& b) {
    asm volatile("s_waitcnt vmcnt(0)" ::: "memory");
    __syncthreads();
    if (threadIdx.x == 0) {
        unsigned* bar = b.bar;
        __builtin_amdgcn_s_waitcnt(0);
        unsigned nloc = b.st[0], nx = b.st[1];
        if (nloc == 0u) { xcd_barrier_complete(bar, b.x, nloc, nx); b.st[0] = nloc; b.st[1] = nx; }
        const unsigned old = xb_add(&bar[XB_XSUB(b.x)], 1u);
        const unsigned gen = old / nloc;
        if (old + 1u == (gen + 1u) * nloc) {
            __builtin_amdgcn_fence(__ATOMIC_RELEASE, "agent");
            asm volatile("s_waitcnt vmcnt(0)" ::: "memory");
            const unsigned og = xb_add(&bar[XB_TOP], 1u);
            const unsigned tg = og / nx;
            if (og + 1u == (tg + 1u) * nx) xb_add(&bar[XB_TOPGEN], 1u);
            else XB_SPIN(xb_ld(&bar[XB_TOPGEN]) == tg, bar);
            __builtin_amdgcn_fence(__ATOMIC_ACQUIRE, "agent");
            xb_add(&bar[XB_XGEN(b.x)], 1u);
            asm volatile("s_waitcnt vmcnt(0)" ::: "memory");
        } else {
            XB_SPIN(xb_ld(&bar[XB_XGEN(b.x)]) == gen, bar);
            __builtin_amdgcn_fence(__ATOMIC_ACQUIRE, "agent");
            asm volatile("s_waitcnt vmcnt(0)" ::: "memory");
        }
    }
    __syncthreads();
}
__global__ void __launch_bounds__(512) mega(Params p) {
    extern __shared__ __attribute__((aligned(16))) unsigned char smem[];
    __shared__ uint4 xb_words;
    cg::grid_group grid = cg::this_grid();
    if (threadIdx.x == 0) xb_words = make_uint4(0u, 0u, 0u, 0u);
    __syncthreads();
    const XcdBarrier xb = xcd_barrier_post((unsigned*)(p.ws + O_BAR), (volatile LAS unsigned*)&xb_words);
    unsigned long long tsel = 0;
    for (int ph = p.ph_lo; ph < p.ph_hi; ++ph) {
        const unsigned long long t0 = PROBE_MASK ? wall_clock64() : 0ull;
        run_phase(p, ph, smem);
        if (p.coop && ph + 1 < p.ph_hi) { if (ph == 0) grid.sync(); else xcd_barrier(xb); }
        if (PROBE_MASK) { const int sidx = ph == 0 ? 17 : phase_case(ph); if ((PROBE_MASK >> sidx) & 1u) tsel += wall_clock64() - t0; }
    }
    if (PROBE_MASK && blockIdx.x == 0) { const unsigned long long t0 = wall_clock64(); while (wall_clock64() - t0 < tsel) __builtin_amdgcn_s_sleep(64); }
}

extern "C" void kernel_launch(void* const* d_in, const int* in_sizes, int n_in, void* d_out, int out_size, void* d_ws, size_t ws_size, hipStream_t stream) {
    static int grid = 0;
    if (grid == 0) {
        if (n_in != 27 || ws_size < WS_END) { fprintf(stderr, "kernel_launch: need 27 inputs and %zu bytes of workspace; got %d, %zu\n", (size_t)WS_END, n_in, ws_size); grid = -1; return; }
        int dev = 0, cus = 0, per_cu = 0;
        hipGetDevice(&dev); hipDeviceGetAttribute(&cus, hipDeviceAttributeMultiprocessorCount, dev);
        if (hipFuncSetAttribute((const void*)mega, hipFuncAttributeMaxDynamicSharedMemorySize, LDS_BYTES) != hipSuccess) { fprintf(stderr, "kernel_launch: hipFuncSetAttribute failed\n"); grid = -1; return; }
        if (hipOccupancyMaxActiveBlocksPerMultiprocessor(&per_cu, (const void*)mega, 512, LDS_BYTES) != hipSuccess || per_cu < 1) { fprintf(stderr, "kernel_launch: occupancy query gave %d\n", per_cu); per_cu = 1; }
        (void)hipGetLastError();
        grid = cus;
    }
    if (grid < 0) return;
    Params p{};
    const float** pp = (const float**)&p;
    for (int i = 0; i < 27; ++i) pp[i] = (const float*)d_in[i];
    p.out = (float*)d_out; p.ws = (unsigned char*)d_ws; p.ph_lo = 0; p.ph_hi = N_PHASES; p.coop = 1; p.pad = 0;
    (void)hipMemsetAsync((unsigned char*)d_ws + O_BAR, 0, XCD_BAR_WORDS * 4, stream);
    void* args[] = {&p};
    hipError_t e = hipLaunchCooperativeKernel((const void*)mega, dim3(grid), dim3(512), args, LDS_BYTES, stream);
    if (e != hipSuccess) {
        fprintf(stderr, "cooperative launch failed: %s (grid %d); falling back to one launch per phase\n", hipGetErrorString(e), grid);
        (void)hipGetLastError();
        p.coop = 0;
        for (int ph = 0; ph < N_PHASES; ++ph) { p.ph_lo = ph; p.ph_hi = ph + 1; hipLaunchKernelGGL(mega, dim3(grid), dim3(512), LDS_BYTES, stream, p); }
    }
}
```

```cpp
#include <hip/hip_runtime.h>
#include <hip/hip_cooperative_groups.h>
#include <cstdio>
namespace cg = cooperative_groups;

#define DI __device__ __forceinline__
#define LAS __attribute__((address_space(3)))
typedef unsigned short bf16_t;
typedef short bf16x8 __attribute__((ext_vector_type(8)));
typedef float f32x2 __attribute__((ext_vector_type(2)));
typedef float f32x4 __attribute__((ext_vector_type(4)));
typedef float f32x16 __attribute__((ext_vector_type(16)));
typedef unsigned u32x2 __attribute__((ext_vector_type(2)));
typedef unsigned u32x4 __attribute__((ext_vector_type(4)));
typedef __bf16 bfv2 __attribute__((ext_vector_type(2)));

constexpr int DM = 1024, NB = 4, SEQ = 8192, CTXL = 256, DEPTH = 4;
constexpr int ML = NB * SEQ, MC = NB * CTXL, MA = ML + MC;
constexpr int DFF = 2816, NH = 8, TK = SEQ + CTXL;
constexpr int NIN = 3840;
constexpr int NMOD = 9 * DM;
constexpr float EPS = 1e-6f;
constexpr float QSCALE = 0.10206207261596577f * 1.4426950408889634f;
constexpr int NCH = 132;

constexpr size_t SZ_FFIN = (size_t)2 * DFF * DM * 2, SZ_FFOUT = (size_t)DM * DFF * 2;
constexpr size_t O_WFF1IN = 0;
constexpr size_t O_WFF1OUT = O_WFF1IN + SZ_FFIN;
constexpr size_t O_WFF2IN = O_WFF1OUT + SZ_FFOUT;
constexpr size_t O_WFF2OUT = O_WFF2IN + SZ_FFIN;
constexpr size_t O_WIN = O_WFF2OUT + SZ_FFOUT;
constexpr size_t O_WUQ = O_WIN + (size_t)NIN * DM * 2;
constexpr size_t O_WUKV = O_WUQ + (size_t)768 * 384 * 2;
constexpr size_t O_WOA = O_WUKV + (size_t)1024 * 256 * 2;
constexpr size_t O_WOL = O_WOA + (size_t)1024 * 512 * 2;
constexpr size_t O_WOUT = O_WOL + (size_t)1024 * 512 * 2;
constexpr size_t O_WGATE = O_WOUT + (size_t)1024 * 1024 * 2;
constexpr size_t O_MOD = O_WGATE + (size_t)2048 * 256 * 2;
constexpr size_t O_RSQ = O_MOD + (size_t)DEPTH * 5 * NMOD * 4;
constexpr size_t O_RSKV = O_RSQ + (size_t)MA * 4;
constexpr size_t O_AGG = O_RSKV + (size_t)MA * 4;
constexpr size_t O_SP = O_AGG + (size_t)2 * NB * NCH * 512 * 8;
constexpr size_t O_BAR = O_SP + 4096;
constexpr size_t O_SS = O_BAR + 16384;
constexpr size_t O_SHW = O_SS + (size_t)3 * MA * 16 * 4;
constexpr size_t O_X = O_SHW + (size_t)3 * 5 * 5632 * 4;
constexpr size_t O_R1 = O_X + (size_t)MA * DM * 4;
constexpr size_t O_UXY = O_R1 + (size_t)MA * DFF * 2;
constexpr size_t O_XNY = O_UXY + (size_t)MA * 1024 * 2;
constexpr size_t O_S = O_XNY + (size_t)MA * 1024 * 2;
constexpr size_t WS_END = O_S + (size_t)MA * 1024 * 4;
constexpr int LDS_BYTES = 131072;

struct Params {
    const float *x, *c, *ctx, *c_ctx, *w_ada, *b_ada, *ff1_w_in, *ff1_w_out, *ff2_w_in, *ff2_w_out, *w_in, *q_a_norm, *w_uq, *kv_a_norm, *w_ukv, *q_norm, *k_norm,
        *conv_w, *conv_b, *lru_lambda, *w_rgate, *b_rgate, *w_igate, *b_igate, *w_o_attn, *w_o_lru, *w_out;
    float* out; unsigned char* ws;
    int ph_lo, ph_hi, coop, pad;
};

DI int tidx_() { int t = threadIdx.x; asm volatile("" : "+v"(t)); return t; }
DI int bidx_() { int t = blockIdx.x; asm volatile("" : "+s"(t)); return t; }
#define TIDX tidx_()
#define BIDX bidx_()
DI unsigned pk2(float lo, float hi) { f32x2 v = {lo, hi}; bfv2 r = __builtin_convertvector(v, bfv2); return __builtin_bit_cast(unsigned, r); }
DI bf16_t f2bf(float x) { return (bf16_t)(pk2(x, 0.f) & 0xffffu); }
DI float bf2f(bf16_t v) { return __uint_as_float((unsigned)v << 16); }
DI float bflo(unsigned v) { return __uint_as_float(v << 16); }
DI float bfhi(unsigned v) { return __uint_as_float(v & 0xffff0000u); }
DI float wave_sum(float v) {
#pragma unroll
    for (int o = 1; o < 64; o <<= 1) v += __shfl_xor(v, o);
    return v;
}
DI float sigmoidf_(float x) { return __builtin_amdgcn_rcpf(1.f + __expf(-x)); }
DI int mod_row(int row) { return row < ML ? (row >> 13) : 4; }
DI float row_rstd(const float* SSP, int row) {
    const f32x4* q = (const f32x4*)(SSP + (size_t)row * 16); const f32x4 a = q[0], b = q[1], c = q[2], d = q[3];
    const float s = ((a[0] + a[1]) + (a[2] + a[3])) + ((b[0] + b[1]) + (b[2] + b[3])) + ((c[0] + c[1]) + (c[2] + c[3])) + ((d[0] + d[1]) + (d[2] + d[3]));
    return __builtin_amdgcn_rsqf(s * (1.f / DM) + EPS);
}

constexpr int BM = 256, BK = 64, HALF = 128, HTB = HALF * BK * 2, NXCD = 8, WGM = 8;
DI int lds_byte(int r, int c) { const int st = (r >> 4) * 2 + (c >> 5), rr = r & 15, cc = c & 31, ob = rr * 64 + cc * 2; return st * 1024 + (ob ^ (((ob >> 9) & 1) << 5)); }
DI void stage_rc(int b, int& R, int& C) { const int st = b / 1024, sb = b % 1024, swz = sb ^ (((sb >> 9) & 1) << 5); R = (st >> 1) * 16 + swz / 64; C = (st & 1) * 32 + (swz % 64) / 2; }
struct Unit { int pm, pn; };
struct Gemm { const bf16_t* A; const bf16_t* Bt; int M, N, K, lda, ldb; int rot = 0; };
struct StaticOrder {
    int nM, nN, nwg, G, c;
    DI void init(int M, int N, int G_, int c_) { nM = M / BM; nN = N / BM; nwg = nM * nN; G = G_; c = c_; }
    DI bool next(int i, Unit& u) const {
        const long L = (long)i * G + c; if (L >= nwg) return false;
        int wgid = (int)L; { const int q = nwg / NXCD, r = nwg % NXCD, xcd = wgid % NXCD, off = wgid / NXCD; wgid = (xcd < r ? xcd * (q + 1) : r * (q + 1) + (xcd - r) * q) + off; }
        const int nig = WGM * nN, gid = wgid / nig, fm = gid * WGM, gsz = (nM - fm) < WGM ? (nM - fm) : WGM;
        u.pm = fm + ((wgid % nig) % gsz); u.pn = (wgid % nig) / gsz; return true;
    }
};

DI int perm32(int rho) { const int n = rho >> 4, i = rho & 15; return 8 * (i >> 2) + 4 * n + (i & 3); }
template <class Epi, bool GATE_A, bool PERM = false>
DI void gemm_phase(LAS unsigned char* lds, const Gemm g, const Epi& E) {
    const int tid = TIDX, wid = __builtin_amdgcn_readfirstlane(tid >> 6), lane = tid & 63, wr = wid >> 2, wc = wid & 3, fr = lane & 15, fq = lane >> 4;
    const int K = g.K, nt = K / BK;
    StaticOrder S; S.init(g.M, g.N, gridDim.x, (BIDX - g.rot + (int)gridDim.x) % (int)gridDim.x);
    unsigned voffA[2], voffB[2];
#pragma unroll
    for (int i = 0; i < 2; ++i) { int R, C; stage_rc(tid * 16 + i * 8192, R, C); const int Rb = PERM ? ((R & ~31) + perm32(R & 31)) : R; voffA[i] = (unsigned)(R * g.lda + C) * 2u; voffB[i] = (unsigned)(Rb * g.ldb + C) * 2u; }
#pragma unroll
    for (int i = 0; i < 2; ++i) { asm volatile("" : "+v"(voffA[i])); asm volatile("" : "+v"(voffB[i])); }
    const size_t kstep = (size_t)(BK * 2);
    const size_t hstepA = (size_t)HALF * g.lda * 2, hstepB = (size_t)HALF * g.ldb * 2;
    const size_t tstepA = 2 * hstepA, tstepB = 2 * hstepB;
    const unsigned ldsw = (unsigned)wid * 1024u;
    const int aoff = lds_byte(wr * 64 + fr, fq * 8), boff = lds_byte(wc * 32 + fr, fq * 8);
#define PG8_SA(b, h) (((b) * 2 + (h)) * HTB)
#define PG8_SB(b, h) ((4 + (b) * 2 + (h)) * HTB)
#define PG8_STAGE(bufoff, gbase, voff) do { _Pragma("unroll") for (int _i = 0; _i < 2; ++_i) \
        __builtin_amdgcn_global_load_lds((const unsigned*)((const char*)(gbase) + (voff)[_i]), (LAS unsigned*)(lds + (bufoff) + ldsw + _i * 8192), 16, 0, 0); } while (0)
#define PG8_LDA(dst, b, h) do { _Pragma("unroll") for (int m = 0; m < 4; ++m) _Pragma("unroll") for (int k = 0; k < 2; ++k) dst[m][k] = *(const LAS bf16x8*)(lds + PG8_SA(b, h) + aoff + m * 2048 + k * 1024); } while (0)
#define PG8_LDB(dst, b, h) do { _Pragma("unroll") for (int n = 0; n < 2; ++n) _Pragma("unroll") for (int k = 0; k < 2; ++k) dst[n][k] = *(const LAS bf16x8*)(lds + PG8_SB(b, h) + boff + n * 2048 + k * 1024); } while (0)
#define PG8_MMA(ai, bj, At, Bt) do { __builtin_amdgcn_s_setprio(1); _Pragma("unroll") for (int m = 0; m < 4; ++m) _Pragma("unroll") for (int n = 0; n < 2; ++n) _Pragma("unroll") for (int k = 0; k < 2; ++k) \
        acc[ai][bj][m][n] = __builtin_amdgcn_mfma_f32_16x16x32_bf16(Bt[n][k], At[m][k], acc[ai][bj][m][n], 0, 0, 0); __builtin_amdgcn_s_setprio(0); } while (0)
#define PG8_WAIT_V(n) asm volatile("s_waitcnt vmcnt(" #n ")" ::: "memory")
#define PG8_WAIT_L(n) asm volatile("s_waitcnt lgkmcnt(" #n ")" ::: "memory")
#define PG8_BAR __builtin_amdgcn_s_barrier()
#define PG8_SCHED __builtin_amdgcn_sched_barrier(0)
#define PG8_ABASE(u) ((const char*)g.A + (size_t)(u).pm * tstepA + (GATE_A ? (size_t)((((u).pn & 3) >> 1) * 512) : (size_t)0))
    Unit cur, nxt; int ui = 0;
    if (!S.next(0, cur)) return;
    f32x4 acc[2][2][4][2];
#pragma unroll
    for (int a = 0; a < 2; ++a)
#pragma unroll
        for (int b = 0; b < 2; ++b)
#pragma unroll
            for (int m = 0; m < 4; ++m)
#pragma unroll
                for (int n = 0; n < 2; ++n) acc[a][b][m][n] = (f32x4){0.f, 0.f, 0.f, 0.f};
    bf16x8 At[4][2], B0[2][2], B1[2][2];
    const char* cA = PG8_ABASE(cur); const char* cB = (const char*)g.Bt + (size_t)cur.pn * tstepB;
    PG8_STAGE(PG8_SB(0, 0), cB, voffB); PG8_STAGE(PG8_SA(0, 0), cA, voffA); PG8_STAGE(PG8_SB(0, 1), cB + hstepB, voffB); PG8_STAGE(PG8_SA(0, 1), cA + hstepA, voffA);
    if (wr == 1) PG8_BAR;
    PG8_WAIT_V(4); PG8_BAR;
    PG8_STAGE(PG8_SB(1, 0), cB + kstep, voffB); PG8_STAGE(PG8_SA(1, 0), cA + kstep, voffA); PG8_STAGE(PG8_SB(1, 1), cB + hstepB + kstep, voffB);
    PG8_WAIT_V(6); PG8_BAR;
    for (;;) {
        const bool has_next = S.next(ui + 1, nxt);
        const char* nA = has_next ? PG8_ABASE(nxt) : cA; const char* nB = has_next ? (const char*)g.Bt + (size_t)nxt.pn * tstepB : cB;
#pragma nounroll
        for (int t = 0; t < nt; t += 2) {
            const bool last = (t == nt - 2);
            const char* a1 = cA + (size_t)(t + 1) * kstep;
            const char* a2 = last ? nA : cA + (size_t)(t + 2) * kstep; const char* b2 = last ? nB : cB + (size_t)(t + 2) * kstep;
            const char* a3 = a2 + kstep; const char* b3 = b2 + kstep;
            PG8_LDB(B0, 0, 0); PG8_SCHED; PG8_LDA(At, 0, 0); PG8_STAGE(PG8_SA(1, 1), a1 + hstepA, voffA);
            PG8_WAIT_L(8); PG8_BAR; PG8_WAIT_L(0); PG8_MMA(0, 0, At, B0); PG8_BAR; PG8_SCHED;
            PG8_LDB(B1, 0, 1); PG8_STAGE(PG8_SB(0, 0), b2, voffB);
            PG8_BAR; PG8_WAIT_L(0); PG8_MMA(0, 1, At, B1); PG8_BAR;
            PG8_LDA(At, 0, 1); PG8_STAGE(PG8_SA(0, 0), a2, voffA);
            PG8_BAR; PG8_WAIT_L(0); PG8_MMA(1, 0, At, B0); PG8_BAR; PG8_SCHED;
            PG8_STAGE(PG8_SB(0, 1), b2 + hstepB, voffB);
            PG8_WAIT_V(6); PG8_BAR; PG8_MMA(1, 1, At, B1); PG8_BAR;
            PG8_LDB(B0, 1, 0); PG8_SCHED; PG8_LDA(At, 1, 0); PG8_STAGE(PG8_SA(0, 1), a2 + hstepA, voffA);
            PG8_WAIT_L(8); PG8_BAR; PG8_WAIT_L(0); PG8_MMA(0, 0, At, B0); PG8_BAR; PG8_SCHED;
            PG8_LDB(B1, 1, 1); PG8_STAGE(PG8_SB(1, 0), b3, voffB);
            PG8_BAR; PG8_WAIT_L(0); PG8_MMA(0, 1, At, B1); PG8_BAR;
            PG8_LDA(At, 1, 1); PG8_STAGE(PG8_SA(1, 0), a3, voffA);
            PG8_BAR; PG8_WAIT_L(0); PG8_MMA(1, 0, At, B0); PG8_BAR; PG8_SCHED;
            PG8_STAGE(PG8_SB(1, 1), b3 + hstepB, voffB);
            PG8_WAIT_V(6); PG8_BAR; PG8_MMA(1, 1, At, B1); PG8_BAR;
        }
        E(acc, cur, wr, wc, fr, fq);
        if (!has_next) break;
#pragma unroll
        for (int a = 0; a < 2; ++a)
#pragma unroll
            for (int b = 0; b < 2; ++b)
#pragma unroll
                for (int m = 0; m < 4; ++m)
#pragma unroll
                    for (int n = 0; n < 2; ++n) acc[a][b][m][n] = (f32x4){0.f, 0.f, 0.f, 0.f};
        cur = nxt; cA = nA; cB = nB; ++ui;
    }
    PG8_WAIT_V(0);
    if (wr == 0) PG8_BAR;
    PG8_BAR;
#undef PG8_SA
#undef PG8_SB
#undef PG8_STAGE
#undef PG8_LDA
#undef PG8_LDB
#undef PG8_MMA
#undef PG8_WAIT_V
#undef PG8_WAIT_L
#undef PG8_BAR
#undef PG8_SCHED
#undef PG8_ABASE
}

DI float row_rstd4(const float* SSP, int row, int fq) {
    const f32x4 a = *(const f32x4*)(SSP + (size_t)row * 16 + 4 * fq);
    float s = (a[0] + a[1]) + (a[2] + a[3]); s += __shfl_xor(s, 16); s += __shfl_xor(s, 32);
    return __builtin_amdgcn_rsqf(s * (1.f / DM) + EPS);
}
template <class F> struct EpiElem {
    F f;
    DI void operator()(const f32x4 (&acc)[2][2][4][2], const Unit& u, int wr, int wc, int fr, int fq) const {
        const int row0 = u.pm * BM + wr * 64 + fr, col0 = u.pn * BM + wc * 32 + 4 * fq;
#pragma unroll
        for (int ai = 0; ai < 2; ++ai)
#pragma unroll
            for (int m = 0; m < 4; ++m)
#pragma unroll
                for (int bj = 0; bj < 2; ++bj)
#pragma unroll
                    for (int n = 0; n < 2; ++n) { f(row0 + ai * HALF + m * 16, col0 + bj * HALF + n * 16, acc[ai][bj][m][n]); }
    }
};
template <class F> struct EpiElemRow {
    F f;
    DI void operator()(const f32x4 (&acc)[2][2][4][2], const Unit& u, int wr, int wc, int fr, int fq) const {
        const int row0 = u.pm * BM + wr * 64 + fr, col0 = u.pn * BM + wc * 32 + 4 * fq;
#pragma unroll
        for (int ai = 0; ai < 2; ++ai)
#pragma unroll
            for (int m = 0; m < 4; ++m) {
                float ssq = 0.f;
#pragma unroll
                for (int bj = 0; bj < 2; ++bj)
#pragma unroll
                    for (int n = 0; n < 2; ++n) { ssq += f(row0 + ai * HALF + m * 16, col0 + bj * HALF + n * 16, acc[ai][bj][m][n]); }
                ssq += __shfl_xor(ssq, 16); ssq += __shfl_xor(ssq, 32);
                if (fq == 0) f.row(row0 + ai * HALF + m * 16, (u.pn & 3) * 4 + wc, ssq);
            }
    }
};
template <class F> struct EpiElemRS {
    F f;
    DI void operator()(const f32x4 (&acc)[2][2][4][2], const Unit& u, int wr, int wc, int fr, int fq) const {
        const int row0 = u.pm * BM + wr * 64 + fr, col0 = u.pn * BM + wc * 32 + 4 * fq;
#pragma unroll
        for (int ai = 0; ai < 2; ++ai)
#pragma unroll
            for (int m = 0; m < 4; ++m) {
                const float rs = f.rs(row0 + ai * HALF + m * 16);
#pragma unroll
                for (int bj = 0; bj < 2; ++bj)
#pragma unroll
                    for (int n = 0; n < 2; ++n) { f(row0 + ai * HALF + m * 16, col0 + bj * HALF + n * 16, acc[ai][bj][m][n], rs); }
            }
    }
};
template <class F> struct EpiPairRS {
    F f;
    DI void operator()(const f32x4 (&acc)[2][2][4][2], const Unit& u, int wr, int wc, int fr, int fq) const {
        const int row0 = u.pm * BM + wr * 64 + fr, c0 = wc * 32 + 4 * fq;
#pragma unroll
        for (int ai = 0; ai < 2; ++ai)
#pragma unroll
            for (int m = 0; m < 4; ++m) {
                const float rs = f.rs(row0 + ai * HALF + m * 16);
#pragma unroll
                for (int n = 0; n < 2; ++n) { f(row0 + ai * HALF + m * 16, u.pn, c0 + n * 16, acc[ai][0][m][n], acc[ai][1][m][n], rs); }
            }
    }
};
template <class F> struct EpiElem2 {
    F f;
    DI void operator()(const f32x4 (&acc)[2][2][4][2], const Unit& u, int wr, int wc, int fr, int fq) const {
        const int row0 = u.pm * BM + wr * 64 + fr, col0 = u.pn * BM + wc * 32 + 4 * fq;
        typename F::L cur[2][2], nxt[2][2];
#pragma unroll
        for (int bj = 0; bj < 2; ++bj)
#pragma unroll
            for (int n = 0; n < 2; ++n) cur[bj][n] = f.load(row0, col0 + bj * HALF + n * 16);
#pragma unroll
        for (int i = 0; i < 8; ++i) {
            const int row = row0 + (i >> 2) * HALF + (i & 3) * 16;
            if (i < 7) { const int rown = row0 + ((i + 1) >> 2) * HALF + ((i + 1) & 3) * 16;
#pragma unroll
                for (int bj = 0; bj < 2; ++bj)
#pragma unroll
                    for (int n = 0; n < 2; ++n) nxt[bj][n] = f.load(rown, col0 + bj * HALF + n * 16); }
#pragma unroll
            for (int bj = 0; bj < 2; ++bj)
#pragma unroll
                for (int n = 0; n < 2; ++n) f.apply(row, col0 + bj * HALF + n * 16, acc[i >> 2][bj][i & 3][n], cur[bj][n]);
#pragma unroll
            for (int bj = 0; bj < 2; ++bj)
#pragma unroll
                for (int n = 0; n < 2; ++n) cur[bj][n] = nxt[bj][n];
        }
    }
};
template <class F> struct EpiElem8 {
    F f;
    DI void operator()(const f32x4 (&acc)[2][2][4][2], const Unit& u, int wr, int wc, int fr, int fq) const {
        const int row0 = u.pm * BM + wr * 64 + fr, col0 = u.pn * BM + wc * 32 + 8 * fq;
        typename F::L cur[2], nxt[2];
#pragma unroll
        for (int bj = 0; bj < 2; ++bj) cur[bj] = f.load(row0, col0 + bj * HALF);
#pragma unroll
        for (int i = 0; i < 8; ++i) {
            const int row = row0 + (i >> 2) * HALF + (i & 3) * 16;
            if (i < 7) { const int rown = row0 + ((i + 1) >> 2) * HALF + ((i + 1) & 3) * 16;
#pragma unroll
                for (int bj = 0; bj < 2; ++bj) nxt[bj] = f.load(rown, col0 + bj * HALF); }
#pragma unroll
            for (int bj = 0; bj < 2; ++bj) f.apply(row, col0 + bj * HALF, acc[i >> 2][bj][i & 3][0], acc[i >> 2][bj][i & 3][1], cur[bj]);
#pragma unroll
            for (int bj = 0; bj < 2; ++bj) cur[bj] = nxt[bj];
        }
    }
};
template <class F> struct EpiPair {
    F f;
    DI void operator()(const f32x4 (&acc)[2][2][4][2], const Unit& u, int wr, int wc, int fr, int fq) const {
        const int row0 = u.pm * BM + wr * 64 + fr, c0 = wc * 32 + 4 * fq;
#pragma unroll
        for (int ai = 0; ai < 2; ++ai)
#pragma unroll
            for (int m = 0; m < 4; ++m)
#pragma unroll
                for (int n = 0; n < 2; ++n) { f(row0 + ai * HALF + m * 16, u.pn, c0 + n * 16, acc[ai][0][m][n], acc[ai][1][m][n]); }
    }
};
DI void st_bf4(bf16_t* p, f32x4 v) { u32x2 o; o.x = pk2(v[0], v[1]); o.y = pk2(v[2], v[3]); *(u32x2*)p = o; }
DI void st_bf8(bf16_t* p, f32x4 lo, f32x4 hi) { u32x4 o; o.x = pk2(lo[0], lo[1]); o.y = pk2(lo[2], lo[3]); o.z = pk2(hi[0], hi[1]); o.w = pk2(hi[2], hi[3]); *(u32x4*)p = o; }

struct FSwiglu { bf16_t* H; const float* SS; const float* shw;
    DI float rs(int row) const { return row_rstd(SS, row); }
    DI void operator()(int row, int pn, int c, f32x4 g, f32x4 u, float rs) const {
        const float* sw = shw + mod_row(row) * 5632 + pn * 256 + c;
        g = g * rs + *(const f32x4*)sw; u = u * rs + *(const f32x4*)(sw + 128);
        f32x4 h;
#pragma unroll
        for (int e = 0; e < 4; ++e) h[e] = g[e] * sigmoidf_(g[e]) * u[e];
        st_bf4(H + (size_t)row * DFF + pn * 128 + c, h);
    } };
struct FResid { const float* src; float* dst; const float* mod; float coef;
    DI void operator()(int row, int col, f32x4 v) const {
        const f32x4 g = *(const f32x4*)(mod + mod_row(row) * NMOD + col);
        const f32x4 x = *(const f32x4*)(src + (size_t)row * DM + col);
        *(f32x4*)(dst + (size_t)row * DM + col) = x + coef * g * v;
    } };
template <int COEF2> struct FResidN { const float* src; float* dst; const float* mod; const float* scn; bf16_t* XS; float* SS;
    DI float operator()(int row, int col, f32x4 v) const {
        const int r = mod_row(row);
        const f32x4 g = *(const f32x4*)(mod + r * NMOD + col);
        const f32x4 x = *(const f32x4*)(src + (size_t)row * DM + col);
        const f32x4 xn = x + (0.5f * COEF2) * g * v;
        *(f32x4*)(dst + (size_t)row * DM + col) = xn;
        const f32x4 sc = *(const f32x4*)(scn + r * NMOD + col);
        st_bf4(XS + (size_t)row * DM + col, xn * (1.f + sc));
        return (xn[0] * xn[0] + xn[1] * xn[1]) + (xn[2] * xn[2] + xn[3] * xn[3]);
    }
    DI void row(int row, int slot, float ssq) const { SS[(size_t)row * 16 + slot] = ssq; } };
struct FWin { bf16_t *P1, *UXY, *GATE; const float* SS; const float* shw;
    DI float rs(int row) const { return row_rstd(SS, row); }
    DI void operator()(int row, int col, f32x4 v, float rs) const {
        v = v * rs + *(const f32x4*)(shw + mod_row(row) * 5632 + col);
        bf16_t* p = col < 768 ? P1 + (size_t)row * 768 + col : (col < 1792 ? UXY + (size_t)row * 1024 + (col - 768) : GATE + (size_t)row * 2048 + (col - 1792));
        st_bf4(p, v);
    } };
struct FRowScale { bf16_t* dst; int ld; const float* rs;
    typedef float L;
    DI L load(int row, int) const { return rs[row]; }
    DI void apply(int row, int col, f32x4 v0, f32x4 v1, L sc) const { st_bf8(dst + (size_t)row * ld + col, v0 * sc, v1 * sc); } };
struct FVt { bf16_t* Vt; const float* rs;
    struct L { f32x4 a, b; };
    DI L load(int, int col) const { return L{*(const f32x4*)(rs + col), *(const f32x4*)(rs + col + 4)}; }
    DI void apply(int row, int col, f32x4 v0, f32x4 v1, L sc) const {
        int b, kpos; if (col < ML) { b = col >> 13; kpos = col & (SEQ - 1); } else { const int r = col - ML; b = r >> 8; kpos = SEQ + (r & 255); }
        st_bf8(Vt + ((size_t)(b * NH + (row >> 6)) * 64 + (row & 63)) * TK + kpos, v0 * sc.a, v1 * sc.b);
    } };
struct EGate { const bf16_t* xc; bf16_t *OM, *BB; const float *sp8, *br, *bi;
    DI void operator()(const f32x4 (&acc)[2][2][4][2], const Unit& u, int wr, int wc, int fr, int fq) const {
        const int row0 = u.pm * BM + wr * 64 + fr, d = u.pn >> 2, ch0 = (u.pn & 3) * 128 + wc * 32 + 8 * fq;
        f32x4 s4[2], br4[2], bi4[2]; u32x4 xcur, xnxt;
#pragma unroll
        for (int n = 0; n < 2; ++n) { s4[n] = *(const f32x4*)(sp8 + d * 512 + ch0 + 4 * n); br4[n] = *(const f32x4*)(br + d * 512 + ch0 + 4 * n); bi4[n] = *(const f32x4*)(bi + d * 512 + ch0 + 4 * n); }
        xcur = *(const u32x4*)(xc + (size_t)row0 * 512 + ch0);
#pragma unroll
        for (int i = 0; i < 8; ++i) {
            const int row = row0 + (i >> 2) * HALF + (i & 3) * 16;
            if (i < 7) { const int rown = row0 + ((i + 1) >> 2) * HALF + ((i + 1) & 3) * 16; xnxt = *(const u32x4*)(xc + (size_t)rown * 512 + ch0); }
            f32x4 om[2], bb[2];
#pragma unroll
            for (int n = 0; n < 2; ++n) {
                const f32x4 r4 = acc[i >> 2][0][i & 3][n], i4 = acc[i >> 2][1][i & 3][n];
                const unsigned w0 = n == 0 ? xcur.x : xcur.z, w1 = n == 0 ? xcur.y : xcur.w;
                const f32x4 xf = {bflo(w0), bfhi(w0), bflo(w1), bfhi(w1)};
#pragma unroll
                for (int e = 0; e < 4; ++e) {
                    const float r = sigmoidf_(r4[e] + br4[n][e]), ig = sigmoidf_(i4[e] + bi4[n][e]);
                    const float a = __expf(s4[n][e] * r);
                    om[n][e] = 1.f - a; bb[n][e] = __builtin_amdgcn_sqrtf(fmaxf(1.f - a * a, 0.f)) * (ig * xf[e]);
                }
            }
            const size_t o = ((size_t)d * MA + row) * 512 + ch0;
            st_bf8(OM + o, om[0], om[1]); st_bf8(BB + o, bb[0], bb[1]);
            xcur = xnxt;
        }
    } };
DI f32x4 sig_lo(u32x4 g) { return (f32x4){sigmoidf_(bflo(g.x)), sigmoidf_(bfhi(g.x)), sigmoidf_(bflo(g.y)), sigmoidf_(bfhi(g.y))}; }
DI f32x4 sig_hi(u32x4 g) { return (f32x4){sigmoidf_(bflo(g.z)), sigmoidf_(bfhi(g.z)), sigmoidf_(bflo(g.w)), sigmoidf_(bfhi(g.w))}; }
struct FMergeA { const bf16_t* GATE; bf16_t* Y;
    typedef u32x4 L;
    DI L load(int row, int col) const { return *(const u32x4*)(GATE + (size_t)row * 2048 + col); }
    DI void apply(int row, int col, f32x4 v0, f32x4 v1, L gv) const { st_bf8(Y + (size_t)row * DM + col, sig_lo(gv) * v0, sig_hi(gv) * v1); } };
struct FMergeB { const bf16_t* GATE; bf16_t* Y;
    struct L { u32x4 g, y; };
    DI L load(int row, int col) const { return L{*(const u32x4*)(GATE + (size_t)row * 2048 + 1024 + col), *(const u32x4*)(Y + (size_t)row * DM + col)}; }
    DI void apply(int row, int col, f32x4 v0, f32x4 v1, L q) const {
        const f32x4 y0 = {bflo(q.y.x), bfhi(q.y.x), bflo(q.y.y), bfhi(q.y.y)}, y1 = {bflo(q.y.z), bfhi(q.y.z), bflo(q.y.w), bfhi(q.y.w)};
        st_bf8(Y + (size_t)row * DM + col, y0 + sig_lo(q.g) * v0, y1 + sig_hi(q.g) * v1);
    } };

struct ESwiglu { bf16_t* H; const float* SS; const float* shw;
    DI void operator()(const f32x4 (&acc)[2][2][4][2], const Unit& u, int wr, int wc, int fr, int fq) const {
        const int row0 = u.pm * BM + wr * 64 + fr, c0 = wc * 32 + 8 * fq;
        const float* sw = shw + mod_row(u.pm * BM) * 5632 + u.pn * 256 + c0;
        f32x4 sg[2], su[2]; float rs[8];
#pragma unroll
        for (int n = 0; n < 2; ++n) { sg[n] = *(const f32x4*)(sw + 4 * n); su[n] = *(const f32x4*)(sw + 128 + 4 * n); }
#pragma unroll
        for (int i = 0; i < 8; ++i) rs[i] = row_rstd4(SS, row0 + (i >> 2) * HALF + (i & 3) * 16, fq);
#pragma unroll
        for (int ai = 0; ai < 2; ++ai)
#pragma unroll
            for (int m = 0; m < 4; ++m) {
                f32x4 h[2];
#pragma unroll
                for (int n = 0; n < 2; ++n) {
                    const f32x4 g = acc[ai][0][m][n] * rs[ai * 4 + m] + sg[n], uu = acc[ai][1][m][n] * rs[ai * 4 + m] + su[n];
#pragma unroll
                    for (int e = 0; e < 4; ++e) h[n][e] = g[e] * sigmoidf_(g[e]) * uu[e];
                }
                st_bf8(H + (size_t)(row0 + ai * HALF + m * 16) * DFF + u.pn * 128 + c0, h[0], h[1]);
            }
    } };
struct EWin { bf16_t *P1, *UXY, *GATE; const float* SS; const float* shw;
    template <int LD> DI void body(const f32x4 (&acc)[2][2][4][2], bf16_t* dst, const f32x4 (&sh)[2][2], const float (&rs)[8]) const {
#pragma unroll
        for (int ai = 0; ai < 2; ++ai)
#pragma unroll
            for (int m = 0; m < 4; ++m)
#pragma unroll
                for (int bj = 0; bj < 2; ++bj)
                    st_bf8(dst + (size_t)(ai * HALF + m * 16) * LD + 128 * bj, acc[ai][bj][m][0] * rs[ai * 4 + m] + sh[bj][0], acc[ai][bj][m][1] * rs[ai * 4 + m] + sh[bj][1]);
    }
    DI void operator()(const f32x4 (&acc)[2][2][4][2], const Unit& u, int wr, int wc, int fr, int fq) const {
        const int row0 = u.pm * BM + wr * 64 + fr, c0 = wc * 32 + 8 * fq;
        const float* sw = shw + mod_row(u.pm * BM) * 5632 + u.pn * 256 + c0;
        f32x4 sh[2][2]; float rs[8];
#pragma unroll
        for (int bj = 0; bj < 2; ++bj)
#pragma unroll
            for (int n = 0; n < 2; ++n) sh[bj][n] = *(const f32x4*)(sw + 128 * bj + 4 * n);
#pragma unroll
        for (int i = 0; i < 8; ++i) rs[i] = row_rstd4(SS, row0 + (i >> 2) * HALF + (i & 3) * 16, fq);
        if (u.pn < 3) body<768>(acc, P1 + (size_t)row0 * 768 + u.pn * 256 + c0, sh, rs);
        else if (u.pn < 7) body<1024>(acc, UXY + (size_t)row0 * 1024 + (u.pn - 3) * 256 + c0, sh, rs);
        else body<2048>(acc, GATE + (size_t)row0 * 2048 + (u.pn - 7) * 256 + c0, sh, rs);
    } };
template <int COEF2, bool NORM> struct EResid { const float* src; float* dst; const float* mod; const float* scn; bf16_t* XS; float* SS;
    DI void operator()(const f32x4 (&acc)[2][2][4][2], const Unit& u, int wr, int wc, int fr, int fq) const {
        const int row0 = u.pm * BM + wr * 64 + fr, col0 = u.pn * BM + wc * 32 + 8 * fq, r = mod_row(u.pm * BM);
        f32x4 g[2][2], sc[2][2];
#pragma unroll
        for (int bj = 0; bj < 2; ++bj)
#pragma unroll
            for (int n = 0; n < 2; ++n) { g[bj][n] = *(const f32x4*)(mod + r * NMOD + col0 + 128 * bj + 4 * n) * (0.5f * COEF2);
                if (NORM) sc[bj][n] = *(const f32x4*)(scn + r * NMOD + col0 + 128 * bj + 4 * n) + 1.f; }
        f32x4 xc[2][2], xn_[2][2];
#pragma unroll
        for (int bj = 0; bj < 2; ++bj)
#pragma unroll
            for (int n = 0; n < 2; ++n) xc[bj][n] = *(const f32x4*)(src + (size_t)row0 * DM + col0 + 128 * bj + 4 * n);
#pragma unroll
        for (int i = 0; i < 8; ++i) {
            const int row = row0 + (i >> 2) * HALF + (i & 3) * 16;
            if (i < 7) { const int rown = row0 + ((i + 1) >> 2) * HALF + ((i + 1) & 3) * 16;
#pragma unroll
                for (int bj = 0; bj < 2; ++bj)
#pragma unroll
                    for (int n = 0; n < 2; ++n) xn_[bj][n] = *(const f32x4*)(src + (size_t)rown * DM + col0 + 128 * bj + 4 * n); }
            float ssq = 0.f;
#pragma unroll
            for (int bj = 0; bj < 2; ++bj) {
                f32x4 y[2];
#pragma unroll
                for (int n = 0; n < 2; ++n) {
                    y[n] = xc[bj][n] + g[bj][n] * acc[i >> 2][bj][i & 3][n];
                    *(f32x4*)(dst + (size_t)row * DM + col0 + 128 * bj + 4 * n) = y[n];
                    if (NORM) ssq += (y[n][0] * y[n][0] + y[n][1] * y[n][1]) + (y[n][2] * y[n][2] + y[n][3] * y[n][3]);
                }
                if (NORM) st_bf8(XS + (size_t)row * DM + col0 + 128 * bj, y[0] * sc[bj][0], y[1] * sc[bj][1]);
            }
            if (NORM) { ssq += __shfl_xor(ssq, 16); ssq += __shfl_xor(ssq, 32); if (fq == 0) SS[(size_t)row * 16 + (u.pn & 3) * 4 + wc] = ssq; }
#pragma unroll
            for (int bj = 0; bj < 2; ++bj)
#pragma unroll
                for (int n = 0; n < 2; ++n) xc[bj][n] = xn_[bj][n];
        }
    } };

DI void phase_mod(const Params& p, float* lds) {
    float* sc = lds;
    float* red = lds + 5 * DM;
    const int tid = TIDX, lane = tid & 63, wave = tid >> 6;
    for (int i = tid; i < 5 * DM; i += 512) { const float v = i < 4 * DM ? p.c[i] : p.c_ctx[i - 4 * DM]; sc[i] = v * sigmoidf_(v); }
    __syncthreads();
    float* mod = (float*)(p.ws + O_MOD);
    for (int it = BIDX; it < DEPTH * (NMOD / 64); it += gridDim.x) {
        const int l = it / (NMOD / 64), n = (it % (NMOD / 64)) * 64 + lane;
        const float* w = p.w_ada + ((size_t)l * DM + wave * 128) * NMOD + n;
        float a0 = 0.f, a1 = 0.f, a2 = 0.f, a3 = 0.f, a4 = 0.f;
#pragma unroll 8
        for (int k = 0; k < 128; ++k) { const float wv = w[(size_t)k * NMOD]; const int kk = wave * 128 + k;
            a0 += sc[kk] * wv; a1 += sc[DM + kk] * wv; a2 += sc[2 * DM + kk] * wv; a3 += sc[3 * DM + kk] * wv; a4 += sc[4 * DM + kk] * wv; }
        red[(wave * 5 + 0) * 64 + lane] = a0; red[(wave * 5 + 1) * 64 + lane] = a1; red[(wave * 5 + 2) * 64 + lane] = a2; red[(wave * 5 + 3) * 64 + lane] = a3; red[(wave * 5 + 4) * 64 + lane] = a4;
        __syncthreads();
        if (tid < 320) { const int r = tid >> 6; float s = p.b_ada[(size_t)l * NMOD + n];
#pragma unroll
            for (int w8 = 0; w8 < 8; ++w8) s += red[(w8 * 5 + r) * 64 + lane];
            mod[((size_t)l * 5 + r) * NMOD + n] = s; }
        __syncthreads();
    }
}

template <int MAP> DI int colmap(int n) {
    if (MAP == 0) return n;
    if (MAP == 1) { const int pn = n >> 8, bj = (n >> 7) & 1, c = n & 127; return bj * DFF + pn * 128 + c; }
    if (MAP == 2) return n < 672 ? n : (n < 768 ? -1 : n - 96);
    { const int m = n & 511, h = m >> 6, d = m & 63; return h * 128 + (n >> 9) * 64 + d; }
}
template <int MAP> DI void tjob(const float* src, int ld, int K, int N, bf16_t* dst, const float* kscale, float* tile, int& base, int vbid, int G) {
    const int tid = TIDX, ntn = N / 64, ntiles = ntn * (K / 64);
    int first = (vbid - base % G + G) % G;
    for (int t = first; t < ntiles; t += G) {
        const int n0 = (t % ntn) * 64, k0 = (t / ntn) * 64;
        const int c = colmap<MAP>(n0 + (tid & 63));
#pragma unroll
        for (int i = 0; i < 8; ++i) { const int kk = (tid >> 6) + 8 * i; float v = c >= 0 ? src[(size_t)(k0 + kk) * ld + c] : 0.f; if (kscale) v *= kscale[k0 + kk]; tile[kk * 65 + (tid & 63)] = v; }
        __syncthreads();
        { const int kc = tid & 7, nn = tid >> 3;
          const float* tp = tile + (kc * 8) * 65 + nn;
          u32x4 o; o.x = pk2(tp[0], tp[65]); o.y = pk2(tp[2 * 65], tp[3 * 65]); o.z = pk2(tp[4 * 65], tp[5 * 65]); o.w = pk2(tp[6 * 65], tp[7 * 65]);
          *(u32x4*)(dst + (size_t)(n0 + nn) * K + k0 + kc * 8) = o; }
        __syncthreads();
    }
    base += ntiles;
}
DI void phase_prep_ff(const Params& p, int l, int which, float* tile, int vbid, int vG) {
    unsigned char* ws = p.ws; int base = 0;
    if (which == 0) {
        tjob<1>(p.ff1_w_in + (size_t)l * DM * 2 * DFF, 2 * DFF, DM, 2 * DFF, (bf16_t*)(ws + O_WFF1IN), nullptr, tile, base, vbid, vG);
        tjob<0>(p.ff1_w_out + (size_t)l * DFF * DM, DM, DFF, DM, (bf16_t*)(ws + O_WFF1OUT), nullptr, tile, base, vbid, vG);
    } else {
        tjob<1>(p.ff2_w_in + (size_t)l * DM * 2 * DFF, 2 * DFF, DM, 2 * DFF, (bf16_t*)(ws + O_WFF2IN), nullptr, tile, base, vbid, vG);
        tjob<0>(p.ff2_w_out + (size_t)l * DFF * DM, DM, DFF, DM, (bf16_t*)(ws + O_WFF2OUT), nullptr, tile, base, vbid, vG);
    }
}
DI void phase_prep(const Params& p, int l, float* tile) {
    unsigned char* ws = p.ws; int base = 0;
    const int vbid = BIDX, vG = gridDim.x;
    const float* modl = (const float*)(ws + O_MOD) + (size_t)l * 5 * NMOD; float* shw = (float*)(ws + O_SHW);
    if (l == 0) phase_prep_ff(p, 0, 0, tile, vbid, vG);
    tjob<2>(p.w_in + (size_t)l * DM * 3744, 3744, DM, NIN, (bf16_t*)(ws + O_WIN), nullptr, tile, base, vbid, vG);
    tjob<0>(p.w_uq + (size_t)l * 384 * 768, 768, 384, 768, (bf16_t*)(ws + O_WUQ), p.q_a_norm + l * 384, tile, base, vbid, vG);
    tjob<3>(p.w_ukv + (size_t)l * 256 * 1024, 1024, 256, 1024, (bf16_t*)(ws + O_WUKV), p.kv_a_norm + l * 256, tile, base, vbid, vG);
    tjob<0>(p.w_o_attn + (size_t)l * 512 * 1024, 1024, 512, 1024, (bf16_t*)(ws + O_WOA), nullptr, tile, base, vbid, vG);
    tjob<0>(p.w_o_lru + (size_t)l * 512 * 1024, 1024, 512, 1024, (bf16_t*)(ws + O_WOL), nullptr, tile, base, vbid, vG);
    tjob<0>(p.w_out + (size_t)l * 1024 * 1024, 1024, 1024, 1024, (bf16_t*)(ws + O_WOUT), nullptr, tile, base, vbid, vG);
    { float* sh = tile; float* red = tile + 5 * DM;
      const int tid = TIDX, nn = tid & 63, ks = tid >> 6;
      for (int it = BIDX; it < 88 + 60 + 88; it += gridDim.x) {
          const int m = it < 88 ? 0 : (it < 148 ? 1 : 2), n0 = (m == 0 ? it : (m == 1 ? it - 88 : it - 148)) * 64;
          const float* W = m == 0 ? p.ff1_w_in + (size_t)l * DM * 2 * DFF : (m == 1 ? p.w_in + (size_t)l * DM * 3744 : p.ff2_w_in + (size_t)l * DM * 2 * DFF);
          const int ld = m == 1 ? 3744 : 2 * DFF, c = m == 1 ? colmap<2>(n0 + nn) : colmap<1>(n0 + nn);
          __syncthreads();
          for (int i = tid; i < 5 * DM; i += 512) sh[i] = modl[(size_t)(i >> 10) * NMOD + m * 3 * DM + (i & 1023)];
          __syncthreads();
          float a0 = 0.f, a1 = 0.f, a2 = 0.f, a3 = 0.f, a4 = 0.f;
          if (c >= 0) {
#pragma unroll 8
              for (int k = ks * 128; k < ks * 128 + 128; ++k) { const float wv = W[(size_t)k * ld + c]; a0 += sh[k] * wv; a1 += sh[DM + k] * wv; a2 += sh[2 * DM + k] * wv; a3 += sh[3 * DM + k] * wv; a4 += sh[4 * DM + k] * wv; }
          }
          red[(ks * 5 + 0) * 64 + nn] = a0; red[(ks * 5 + 1) * 64 + nn] = a1; red[(ks * 5 + 2) * 64 + nn] = a2; red[(ks * 5 + 3) * 64 + nn] = a3; red[(ks * 5 + 4) * 64 + nn] = a4;
          __syncthreads();
          if (tid < 320) { const int r = tid >> 6; float sum = 0.f;
#pragma unroll
              for (int w8 = 0; w8 < 8; ++w8) sum += red[(w8 * 5 + r) * 64 + nn];
              shw[(size_t)(m * 5 + r) * 5632 + n0 + nn] = sum; }
      }
      __syncthreads(); }
    if (BIDX == 0) { float* sp8 = (float*)(ws + O_SP);
        for (int i = TIDX; i < 1024; i += 512) { const float nl = -p.lru_lambda[l * 1024 + i]; sp8[i] = -8.f * (fmaxf(nl, 0.f) + log1pf(__expf(-fabsf(nl)))); } }
    bf16_t* wg = (bf16_t*)(ws + O_WGATE);
    for (int idx = BIDX * 512 + TIDX; idx < 2048 * 256; idx += gridDim.x * 512) {
        const int n = idx >> 8, k = idx & 255, d = n >> 10, cb = (n >> 8) & 3, gt = (n >> 7) & 1, c = n & 127, ch = cb * 128 + c, g = ch >> 6, j = ch & 63, ci = 256 * (cb >> 1) + k, gi = ci >> 6, i = ci & 63;
        float v = 0.f;
        if (gi == g) v = (gt ? p.w_igate : p.w_rgate)[((((size_t)l * 2 + d) * 8 + g) * 64 + i) * 64 + j];
        wg[idx] = f2bf(v);
    }
}

DI void phase_norm0(const Params& p) {
    const int tid = TIDX, lane = tid & 63, gw = BIDX * 8 + (tid >> 6), nw = gridDim.x * 8;
    float* X = (float*)(p.ws + O_X); bf16_t* XS = (bf16_t*)(p.ws + O_XNY); float* SS = (float*)(p.ws + O_SS);
    const float* mod = (const float*)(p.ws + O_MOD);
    for (int row = gw; row < MA; row += nw) {
        const float* src = row < ML ? p.x + (size_t)row * DM : p.ctx + (size_t)(row - ML) * DM;
        f32x4 v[4]; float s = 0.f;
#pragma unroll
        for (int j = 0; j < 4; ++j) { v[j] = *(const f32x4*)(src + 256 * j + 4 * lane); s += (v[j][0] * v[j][0] + v[j][1] * v[j][1]) + (v[j][2] * v[j][2] + v[j][3] * v[j][3]); }
        s = wave_sum(s);
        if (lane < 16) SS[(size_t)row * 16 + lane] = lane == 0 ? s : 0.f;
        const float* mr = mod + (size_t)mod_row(row) * NMOD;
#pragma unroll
        for (int j = 0; j < 4; ++j) {
            const int col = 256 * j + 4 * lane;
            *(f32x4*)(X + (size_t)row * DM + col) = v[j];
            const f32x4 sc = *(const f32x4*)(mr + DM + col);
            st_bf4(XS + (size_t)row * DM + col, v[j] * (1.f + sc));
        }
    }
}

DI void phase_conv(const Params& p, int l) {
    const bf16_t* UXY = (const bf16_t*)(p.ws + O_UXY); const bf16_t* P1 = (const bf16_t*)(p.ws + O_R1);
    bf16_t* xc = (bf16_t*)(p.ws + O_XNY);
    const float* cw = p.conv_w + (size_t)l * 4 * 512; const float* cb = p.conv_b + (size_t)l * 512;
    { const int e0 = BIDX * 512 + TIDX, ch = (e0 & 63) * 8;
      f32x4 w[4][2], bias[2];
#pragma unroll
      for (int k = 0; k < 4; ++k) { w[k][0] = *(const f32x4*)(cw + k * 512 + ch); w[k][1] = *(const f32x4*)(cw + k * 512 + ch + 4); }
      bias[0] = *(const f32x4*)(cb + ch); bias[1] = *(const f32x4*)(cb + ch + 4);
      for (int e = e0; e < MA * 64; e += gridDim.x * 512) {
        const int row = e >> 6;
        int t, T; if (row < ML) { t = row & (SEQ - 1); T = SEQ; } else { t = (row - ML) & 255; T = CTXL; }
        u32x4 uv[4]; float ok[4];
#pragma unroll
        for (int k = 0; k < 4; ++k) { const int tt = t + k - 2; const bool in = tt >= 0 && tt < T; ok[k] = in ? 1.f : 0.f;
            uv[k] = *(const u32x4*)(UXY + (size_t)(in ? row + k - 2 : row) * 1024 + ch); }
        f32x4 y0 = bias[0], y1 = bias[1];
#pragma unroll
        for (int k = 0; k < 4; ++k) {
            const f32x4 a = {bflo(uv[k].x), bfhi(uv[k].x), bflo(uv[k].y), bfhi(uv[k].y)}, c = {bflo(uv[k].z), bfhi(uv[k].z), bflo(uv[k].w), bfhi(uv[k].w)};
            y0 += (w[k][0] * ok[k]) * a; y1 += (w[k][1] * ok[k]) * c;
        }
        u32x4 o; o.x = pk2(y0[0], y0[1]); o.y = pk2(y0[2], y0[3]); o.z = pk2(y1[0], y1[1]); o.w = pk2(y1[2], y1[3]);
        *(u32x4*)(xc + (size_t)row * 512 + ch) = o;
      } }
    float* rsq = (float*)(p.ws + O_RSQ); float* rskv = (float*)(p.ws + O_RSKV);
    const int tid2 = TIDX, l16 = tid2 & 15, gq = BIDX * 32 + (tid2 >> 4), nq = gridDim.x * 32;
    for (int row = gq; row < MA; row += nq) {
        const bf16_t* pr = P1 + (size_t)row * 768;
        u32x4 v[5];
#pragma unroll
        for (int i = 0; i < 5; ++i) v[i] = *(const u32x4*)(pr + (l16 + 16 * i) * 8);
        float sq = 0.f, skv = 0.f;
#pragma unroll
        for (int i = 0; i < 5; ++i) {
            const float s2 = bflo(v[i].x) * bflo(v[i].x) + bfhi(v[i].x) * bfhi(v[i].x) + bflo(v[i].y) * bflo(v[i].y) + bfhi(v[i].y) * bfhi(v[i].y)
                           + bflo(v[i].z) * bflo(v[i].z) + bfhi(v[i].z) * bfhi(v[i].z) + bflo(v[i].w) * bflo(v[i].w) + bfhi(v[i].w) * bfhi(v[i].w);
            if (i < 3) sq += s2; else skv += s2;
        }
#pragma unroll
        for (int o = 1; o < 16; o <<= 1) { sq += __shfl_xor(sq, o); skv += __shfl_xor(skv, o); }
        if (l16 == 0) { rsq[row] = rsqrtf(sq * (1.f / 384.f) + EPS); rskv[row] = rsqrtf(skv * (1.f / 256.f) + EPS); }
    }
}

DI int chunk_row0(int b, int pch) { return pch < 4 ? ML + b * CTXL + pch * 64 : b * SEQ + (pch - 4) * 64; }
DI void phase_scan_agg(const Params& p) {
    const bf16_t* OM = (const bf16_t*)(p.ws + O_S); const bf16_t* BB = OM + (size_t)2 * MA * 512;
    f32x4* agg = (f32x4*)(p.ws + O_AGG);
    const int tid = TIDX, lane = tid & 63, gw = (tid >> 6) * gridDim.x + BIDX, nw = gridDim.x * 8;
    for (int it = gw; it < 2 * NB * NCH; it += nw) {
        const int d = it & 1, bp = it >> 1, b = bp / NCH, pch = bp % NCH, row0 = chunk_row0(b, pch);
        const bf16_t* om = OM + ((size_t)d * MA + row0) * 512 + lane * 8; const bf16_t* bb = BB + ((size_t)d * MA + row0) * 512 + lane * 8;
        float h[8], A[8];
#pragma unroll
        for (int i = 0; i < 8; ++i) { h[i] = 0.f; A[i] = 1.f; }
#pragma unroll 8
        for (int t = 0; t < 64; ++t) {
            const int tt = d ? 63 - t : t;
            const u32x4 ov = *(const u32x4*)(om + (size_t)tt * 512), bv = *(const u32x4*)(bb + (size_t)tt * 512);
            const float a[8] = {1.f - bflo(ov.x), 1.f - bfhi(ov.x), 1.f - bflo(ov.y), 1.f - bfhi(ov.y), 1.f - bflo(ov.z), 1.f - bfhi(ov.z), 1.f - bflo(ov.w), 1.f - bfhi(ov.w)};
            const float bq[8] = {bflo(bv.x), bfhi(bv.x), bflo(bv.y), bfhi(bv.y), bflo(bv.z), bfhi(bv.z), bflo(bv.w), bfhi(bv.w)};
#pragma unroll
            for (int i = 0; i < 8; ++i) { h[i] = a[i] * h[i] + bq[i]; A[i] *= a[i]; }
        }
        f32x4* dst = agg + (((size_t)(d * NB + b) * NCH + pch) * 512 + lane * 8) / 2;
#pragma unroll
        for (int i = 0; i < 4; ++i) dst[i] = (f32x4){A[2 * i], h[2 * i], A[2 * i + 1], h[2 * i + 1]};
    }
}
DI float gelu_tanh(float x) { const float u = 0.7978845608028654f * (x + 0.044715f * x * x * x); const float e = __expf(2.f * u); const float th = 1.f - 2.f * __builtin_amdgcn_rcpf(e + 1.f); return 0.5f * x * (1.f + th); }
DI void agg_step(const f32x4* e, float (&h)[8]) {
    const f32x4 e0 = e[0], e1 = e[1], e2 = e[2], e3 = e[3];
    h[0] = e0[0] * h[0] + e0[1]; h[1] = e0[2] * h[1] + e0[3]; h[2] = e1[0] * h[2] + e1[1]; h[3] = e1[2] * h[3] + e1[3];
    h[4] = e2[0] * h[4] + e2[1]; h[5] = e2[2] * h[5] + e2[3]; h[6] = e3[0] * h[6] + e3[1]; h[7] = e3[2] * h[7] + e3[3];
}
DI void phase_scan_apply(const Params& p) {
    const bf16_t* OM = (const bf16_t*)(p.ws + O_S); const bf16_t* BB = OM + (size_t)2 * MA * 512;
    const f32x4* agg = (const f32x4*)(p.ws + O_AGG);
    bf16_t* UXY = (bf16_t*)(p.ws + O_UXY); float* HF = p.out;
    const int tid = TIDX, lane = tid & 63, gw = (tid >> 6) * gridDim.x + BIDX, nw = gridDim.x * 8;
    for (int it = gw; it < NB * NCH; it += nw) {
        const int b = it / NCH, pch = it % NCH, row0 = chunk_row0(b, pch);
        const f32x4* af = agg + (((size_t)(0 * NB + b) * NCH) * 512 + lane * 8) / 2; const f32x4* ab = agg + (((size_t)(1 * NB + b) * NCH) * 512 + lane * 8) / 2;
        float h[8];
#pragma unroll
        for (int i = 0; i < 8; ++i) h[i] = 0.f;
#pragma unroll 4
        for (int q = 0; q < pch; ++q) agg_step(af + (size_t)q * 256, h);
        { const bf16_t* om = OM + ((size_t)row0) * 512 + lane * 8; const bf16_t* bb = BB + ((size_t)row0) * 512 + lane * 8; float* hf = HF + (size_t)row0 * 512 + lane * 8;
#pragma unroll 8
          for (int t = 0; t < 64; ++t) {
              const u32x4 ov = *(const u32x4*)(om + (size_t)t * 512), bv = *(const u32x4*)(bb + (size_t)t * 512);
              h[0] = (1.f - bflo(ov.x)) * h[0] + bflo(bv.x); h[1] = (1.f - bfhi(ov.x)) * h[1] + bfhi(bv.x); h[2] = (1.f - bflo(ov.y)) * h[2] + bflo(bv.y); h[3] = (1.f - bfhi(ov.y)) * h[3] + bfhi(bv.y);
              h[4] = (1.f - bflo(ov.z)) * h[4] + bflo(bv.z); h[5] = (1.f - bfhi(ov.z)) * h[5] + bfhi(bv.z); h[6] = (1.f - bflo(ov.w)) * h[6] + bflo(bv.w); h[7] = (1.f - bfhi(ov.w)) * h[7] + bfhi(bv.w);
              *(f32x4*)(hf + (size_t)t * 512) = (f32x4){h[0], h[1], h[2], h[3]}; *(f32x4*)(hf + (size_t)t * 512 + 4) = (f32x4){h[4], h[5], h[6], h[7]};
          } }
#pragma unroll
        for (int i = 0; i < 8; ++i) h[i] = 0.f;
        if (pch >= 4) {
#pragma unroll
            for (int q = 3; q >= 0; --q) agg_step(ab + (size_t)q * 256, h);
#pragma unroll 4
            for (int q = NCH - 1; q > pch; --q) agg_step(ab + (size_t)q * 256, h);
        } else {
            for (int q = 3; q > pch; --q) agg_step(ab + (size_t)q * 256, h);
        }
        { const bf16_t* om = OM + ((size_t)MA + row0) * 512 + lane * 8; const bf16_t* bb = BB + ((size_t)MA + row0) * 512 + lane * 8; const float* hf = HF + (size_t)row0 * 512 + lane * 8;
#pragma unroll 4
          for (int t = 63; t >= 0; --t) {
              const u32x4 ov = *(const u32x4*)(om + (size_t)t * 512), bv = *(const u32x4*)(bb + (size_t)t * 512);
              const f32x4 f0 = *(const f32x4*)(hf + (size_t)t * 512), f1 = *(const f32x4*)(hf + (size_t)t * 512 + 4);
              const u32x4 uv = *(const u32x4*)(UXY + (size_t)(row0 + t) * 1024 + 512 + lane * 8);
              h[0] = (1.f - bflo(ov.x)) * h[0] + bflo(bv.x); h[1] = (1.f - bfhi(ov.x)) * h[1] + bfhi(bv.x); h[2] = (1.f - bflo(ov.y)) * h[2] + bflo(bv.y); h[3] = (1.f - bfhi(ov.y)) * h[3] + bfhi(bv.y);
              h[4] = (1.f - bflo(ov.z)) * h[4] + bflo(bv.z); h[5] = (1.f - bfhi(ov.z)) * h[5] + bfhi(bv.z); h[6] = (1.f - bflo(ov.w)) * h[6] + bflo(bv.w); h[7] = (1.f - bfhi(ov.w)) * h[7] + bfhi(bv.w);
              u32x4 o;
              o.x = pk2((f0[0] + h[0]) * gelu_tanh(bflo(uv.x)), (f0[1] + h[1]) * gelu_tanh(bfhi(uv.x))); o.y = pk2((f0[2] + h[2]) * gelu_tanh(bflo(uv.y)), (f0[3] + h[3]) * gelu_tanh(bfhi(uv.y)));
              o.z = pk2((f1[0] + h[4]) * gelu_tanh(bflo(uv.z)), (f1[1] + h[5]) * gelu_tanh(bfhi(uv.z))); o.w = pk2((f1[2] + h[6]) * gelu_tanh(bflo(uv.w)), (f1[3] + h[7]) * gelu_tanh(bfhi(uv.w)));
              *(u32x4*)(UXY + (size_t)(row0 + t) * 1024 + lane * 8) = o;
          } }
    }
}

DI void phase_qk(const Params& p, int l, unsigned char* smem) {
    const bf16_t* qraw = (const bf16_t*)p.out; const bf16_t* kn = qraw + (size_t)MA * 768;
    const bf16_t* P1 = (const bf16_t*)(p.ws + O_R1);
    bf16_t* Q = (bf16_t*)(p.ws + O_S); bf16_t* Kb = Q + (size_t)32 * TK * 96;
    const int tid = TIDX, lane = tid & 63, wave = tid >> 6, gw = BIDX * 8 + wave, nw = gridDim.x * 8, h = lane >> 3, j = lane & 7;
    unsigned char* wq = smem + wave * 4096; unsigned char* wk = wq + 1536;
    const float* qn = p.q_norm + l * 96; const float* knm = p.k_norm + l * 96;
    float gq[12], gk[12];
#pragma unroll
    for (int i = 0; i < 12; ++i) { gq[i] = qn[8 * i + j] * QSCALE; gk[i] = knm[8 * i + j]; }
    const float freq = exp2f(-(float)j * 1.6609640474436813f);
    for (int row = gw; row < MA; row += nw) {
        { const u32x4 q0 = *(const u32x4*)(qraw + (size_t)row * 768 + lane * 8);
          u32x4 q1 = {0u, 0u, 0u, 0u}, k1 = {0u, 0u, 0u, 0u};
          if (lane < 32) q1 = *(const u32x4*)(qraw + (size_t)row * 768 + 512 + lane * 8);
          const u32x4 k0 = *(const u32x4*)(kn + (size_t)row * 512 + lane * 8);
          if (lane < 4) k1 = *(const u32x4*)(P1 + (size_t)row * 768 + 640 + lane * 8);
          *(u32x4*)(wq + lane * 16) = q0; if (lane < 32) *(u32x4*)(wq + 1024 + lane * 16) = q1;
          *(u32x4*)(wk + lane * 16) = k0; if (lane < 4) *(u32x4*)(wk + 1024 + lane * 16) = k1; }
        __builtin_amdgcn_fence(__ATOMIC_RELEASE, "wavefront"); __builtin_amdgcn_wave_barrier(); __builtin_amdgcn_fence(__ATOMIC_ACQUIRE, "wavefront");
        float xq[12], xk[12];
#pragma unroll
        for (int i = 0; i < 12; ++i) xq[i] = bf2f(*(const bf16_t*)(wq + (h * 96 + 8 * i + j) * 2));
#pragma unroll
        for (int i = 0; i < 8; ++i) xk[i] = bf2f(*(const bf16_t*)(wk + (h * 64 + 8 * i + j) * 2));
#pragma unroll
        for (int i = 8; i < 12; ++i) xk[i] = bf2f(*(const bf16_t*)(wk + 1024 + (8 * (i - 8) + j) * 2));
        __builtin_amdgcn_fence(__ATOMIC_RELEASE, "wavefront"); __builtin_amdgcn_wave_barrier(); __builtin_amdgcn_fence(__ATOMIC_ACQUIRE, "wavefront");
        const bool lat = row < ML; int b, pos;
        if (lat) { b = row >> 13; pos = row & (SEQ - 1); } else { const int r = row - ML; b = r >> 8; pos = SEQ + (r & 255); }
        float c0 = 1.f, s0 = 0.f, c1 = 1.f, s1 = 0.f;
        if (lat) { float r0 = (float)(pos >> 6) * freq * 0.15915494309189535f, r1 = (float)(pos & 63) * freq * 0.15915494309189535f;
            r0 -= floorf(r0); r1 -= floorf(r1);
            c0 = __builtin_amdgcn_cosf(r0); s0 = __builtin_amdgcn_sinf(r0); c1 = __builtin_amdgcn_cosf(r1); s1 = __builtin_amdgcn_sinf(r1); }
        float sq = 0.f, sk = 0.f;
#pragma unroll
        for (int i = 0; i < 12; ++i) { sq += xq[i] * xq[i]; sk += xk[i] * xk[i]; }
        sq += __shfl_xor(sq, 1); sk += __shfl_xor(sk, 1); sq += __shfl_xor(sq, 2); sk += __shfl_xor(sk, 2); sq += __shfl_xor(sq, 4); sk += __shfl_xor(sk, 4);
        const float rq = rsqrtf(sq * (1.f / 96.f) + EPS), rk = rsqrtf(sk * (1.f / 96.f) + EPS);
#pragma unroll
        for (int i = 0; i < 12; ++i) { xq[i] *= rq * gq[i]; xk[i] *= rk * gk[i]; }
        { const float y8 = xq[8] * c0 - xq[9] * s0, y9 = xq[8] * s0 + xq[9] * c0, y10 = xq[10] * c1 - xq[11] * s1, y11 = xq[10] * s1 + xq[11] * c1;
          xq[8] = y8; xq[9] = y9; xq[10] = y10; xq[11] = y11; }
        { const float y8 = xk[8] * c0 - xk[9] * s0, y9 = xk[8] * s0 + xk[9] * c0, y10 = xk[10] * c1 - xk[11] * s1, y11 = xk[10] * s1 + xk[11] * c1;
          xk[8] = y8; xk[9] = y9; xk[10] = y10; xk[11] = y11; }
#pragma unroll
        for (int i = 0; i < 12; ++i) { *(bf16_t*)(wq + (h * 96 + 8 * i + j) * 2) = f2bf(xq[i]); *(bf16_t*)(wk + (h * 96 + 8 * i + j) * 2) = f2bf(xk[i]); }
        __builtin_amdgcn_fence(__ATOMIC_RELEASE, "wavefront"); __builtin_amdgcn_wave_barrier(); __builtin_amdgcn_fence(__ATOMIC_ACQUIRE, "wavefront");
        { const int c0i = lane, c1i = 64 + lane;
          const u32x4 oq0 = *(const u32x4*)(wq + c0i * 16), ok0 = *(const u32x4*)(wk + c0i * 16);
          const size_t d0 = ((size_t)(b * NH + c0i / 12) * TK + pos) * 96 + (c0i % 12) * 8;
          *(u32x4*)(Q + d0) = oq0; *(u32x4*)(Kb + d0) = ok0;
          if (lane < 32) { const u32x4 oq1 = *(const u32x4*)(wq + c1i * 16), ok1 = *(const u32x4*)(wk + c1i * 16);
              const size_t d1 = ((size_t)(b * NH + c1i / 12) * TK + pos) * 96 + (c1i % 12) * 8;
              *(u32x4*)(Q + d1) = oq1; *(u32x4*)(Kb + d1) = ok1; } }
        __builtin_amdgcn_fence(__ATOMIC_RELEASE, "wavefront"); __builtin_amdgcn_wave_barrier(); __builtin_amdgcn_fence(__ATOMIC_ACQUIRE, "wavefront");
    }
}

constexpr int KROW = 208, VROW = 144, KBYTES = 64 * KROW, ABUF = KBYTES + 64 * VROW;
DI void attn_item(unsigned char* lds, const bf16_t* Q, const bf16_t* Kb, const bf16_t* Vt, bf16_t* att, int bh, int qposA, int qposB, int kt0, int kt1, int outrowA, int outrowB, bool writeB) {
    const int tid = TIDX, lane = tid & 63, l31 = lane & 31, half = lane >> 5;
    bf16x8 qa[6], qb[6];
    { const bf16_t* qp = Q + ((size_t)bh * TK + qposA + l31) * 96 + 8 * half; const bf16_t* qq = Q + ((size_t)bh * TK + qposB + l31) * 96 + 8 * half;
#pragma unroll
      for (int ks = 0; ks < 6; ++ks) { qa[ks] = *(const bf16x8*)(qp + 16 * ks); qb[ks] = *(const bf16x8*)(qq + 16 * ks); } }
    f32x16 oa0, oa1, ob0, ob1;
#pragma unroll
    for (int i = 0; i < 16; ++i) { oa0[i] = 0.f; oa1[i] = 0.f; ob0[i] = 0.f; ob1[i] = 0.f; }
    float la = 0.f, lb = 0.f;
    const unsigned char* kg = (const unsigned char*)(Kb + (size_t)bh * TK * 96) + (size_t)tid * 16;
    const unsigned char* vg = (const unsigned char*)(Vt + ((size_t)bh * 64 + (tid >> 3)) * TK) + (tid & 7) * 16;
    const int kc1 = 512 + tid;
    const int koff0 = (tid / 12) * KROW + (tid % 12) * 16, koff1 = (kc1 / 12) * KROW + (kc1 % 12) * 16;
    const int voff = KBYTES + (tid >> 3) * VROW + ((tid & 7) >> 1) * 32 + (tid & 1) * 8;
    const int klo = l31 * KROW + 16 * half, vlo = KBYTES + l31 * VROW + 16 * half;
    u32x4 kr0, kr1 = {0u, 0u, 0u, 0u}, vr;
#define AT_GLOAD(kt) do { kr0 = *(const u32x4*)(kg + (size_t)(kt) * 12288); if (tid < 256) kr1 = *(const u32x4*)(kg + (size_t)(kt) * 12288 + 8192); vr = *(const u32x4*)(vg + (size_t)(kt) * 128); } while (0)
#define AT_SSTORE(stg) do { unsigned char* bp_ = lds + (stg) * ABUF; *(u32x4*)(bp_ + koff0) = kr0; if (tid < 256) *(u32x4*)(bp_ + koff1) = kr1; \
        *(u32x2*)(bp_ + voff) = (u32x2){vr.x, vr.y}; *(u32x2*)(bp_ + voff + 16) = (u32x2){vr.z, vr.w}; } while (0)
#define AT_PK(v, o) (u32x4){pk2(v[o], v[o + 1]), pk2(v[o + 2], v[o + 3]), pk2(v[o + 4], v[o + 5]), pk2(v[o + 6], v[o + 7])}
    AT_GLOAD(kt0); AT_SSTORE(0);
    __syncthreads();
    for (int kt = kt0; kt < kt1; ++kt) {
        const int cur = (kt - kt0) & 1;
        const bool more = kt + 1 < kt1;
        if (more) AT_GLOAD(kt + 1);
        const unsigned char* kl = lds + cur * ABUF + klo;
        const unsigned char* vl = lds + cur * ABUF + vlo;
        f32x16 sa0, sa1, sb0, sb1;
        const f32x16 zero16 = {0.f, 0.f, 0.f, 0.f, 0.f, 0.f, 0.f, 0.f, 0.f, 0.f, 0.f, 0.f, 0.f, 0.f, 0.f, 0.f};
        __builtin_amdgcn_s_setprio(3);
#pragma unroll
        for (int ks = 0; ks < 6; ++ks) {
            const bf16x8 a0 = *(const bf16x8*)(kl + 32 * ks), a1 = *(const bf16x8*)(kl + 32 * KROW + 32 * ks);
            sa0 = __builtin_amdgcn_mfma_f32_32x32x16_bf16(a0, qa[ks], ks == 0 ? zero16 : sa0, 0, 0, 0);
            sa1 = __builtin_amdgcn_mfma_f32_32x32x16_bf16(a1, qa[ks], ks == 0 ? zero16 : sa1, 0, 0, 0);
            sb0 = __builtin_amdgcn_mfma_f32_32x32x16_bf16(a0, qb[ks], ks == 0 ? zero16 : sb0, 0, 0, 0);
            sb1 = __builtin_amdgcn_mfma_f32_32x32x16_bf16(a1, qb[ks], ks == 0 ? zero16 : sb1, 0, 0, 0);
        }
        __builtin_amdgcn_s_setprio(0);
        float pa = 0.f, pb = 0.f;
#pragma unroll
        for (int i = 0; i < 16; ++i) { sa0[i] = __builtin_amdgcn_exp2f(sa0[i]); sa1[i] = __builtin_amdgcn_exp2f(sa1[i]); pa += sa0[i] + sa1[i];
                                       sb0[i] = __builtin_amdgcn_exp2f(sb0[i]); sb1[i] = __builtin_amdgcn_exp2f(sb1[i]); pb += sb0[i] + sb1[i]; }
        la += pa; lb += pb;
        __builtin_amdgcn_s_setprio(3);
#pragma unroll
        for (int s = 0; s < 4; ++s) {
            const bf16x8 v0 = *(const bf16x8*)(vl + 32 * s), v1 = *(const bf16x8*)(vl + 32 * VROW + 32 * s);
            const bf16x8 fa = __builtin_bit_cast(bf16x8, s < 2 ? AT_PK(sa0, 8 * (s & 1)) : AT_PK(sa1, 8 * (s & 1)));
            const bf16x8 fb = __builtin_bit_cast(bf16x8, s < 2 ? AT_PK(sb0, 8 * (s & 1)) : AT_PK(sb1, 8 * (s & 1)));
            oa0 = __builtin_amdgcn_mfma_f32_32x32x16_bf16(v0, fa, oa0, 0, 0, 0); oa1 = __builtin_amdgcn_mfma_f32_32x32x16_bf16(v1, fa, oa1, 0, 0, 0);
            ob0 = __builtin_amdgcn_mfma_f32_32x32x16_bf16(v0, fb, ob0, 0, 0, 0); ob1 = __builtin_amdgcn_mfma_f32_32x32x16_bf16(v1, fb, ob1, 0, 0, 0);
        }
        __builtin_amdgcn_s_setprio(0);
        if (more) AT_SSTORE(cur ^ 1);
        __syncthreads();
    }
#undef AT_GLOAD
#undef AT_SSTORE
#undef AT_PK
    { const float lt = la + __shfl_xor(la, 32), inv = 1.f / lt;
      bf16_t* op = att + (size_t)(outrowA + l31) * 512 + (bh & 7) * 64 + 4 * half;
#pragma unroll
      for (int g = 0; g < 4; ++g) {
          st_bf4(op + 8 * g, (f32x4){oa0[4 * g] * inv, oa0[4 * g + 1] * inv, oa0[4 * g + 2] * inv, oa0[4 * g + 3] * inv});
          st_bf4(op + 32 + 8 * g, (f32x4){oa1[4 * g] * inv, oa1[4 * g + 1] * inv, oa1[4 * g + 2] * inv, oa1[4 * g + 3] * inv}); } }
    if (writeB) { const float lt = lb + __shfl_xor(lb, 32), inv = 1.f / lt;
      bf16_t* op = att + (size_t)(outrowB + l31) * 512 + (bh & 7) * 64 + 4 * half;
#pragma unroll
      for (int g = 0; g < 4; ++g) {
          st_bf4(op + 8 * g, (f32x4){ob0[4 * g] * inv, ob0[4 * g + 1] * inv, ob0[4 * g + 2] * inv, ob0[4 * g + 3] * inv});
          st_bf4(op + 32 + 8 * g, (f32x4){ob1[4 * g] * inv, ob1[4 * g + 1] * inv, ob1[4 * g + 2] * inv, ob1[4 * g + 3] * inv}); } }
}
DI void phase_attn(const Params& p, unsigned char* lds, bool with_ctx) {
    const bf16_t* Q = (const bf16_t*)(p.ws + O_S); const bf16_t* Kb = Q + (size_t)32 * TK * 96; const bf16_t* Vt = Kb + (size_t)32 * TK * 96;
    bf16_t* att = (bf16_t*)p.out;
    const int nitems = 512 + (with_ctx ? 32 : 0);
    for (int it = BIDX; it < nitems; it += gridDim.x) {
        const int wave = TIDX >> 6;
        if (it < 512) {
            const int j = (it >> 3) & 31, bh = (it >> 8) * 16 + (it & 7) * 2 + (j >> 4), q0 = (j & 15) * 512 + wave * 64, r0 = (bh >> 3) * SEQ + q0;
            attn_item(lds, Q, Kb, Vt, att, bh, q0, q0 + 32, 0, TK / 64, r0, r0 + 32, true);
        } else {
            const int bh = it - 512, q0 = SEQ + wave * 32, r0 = ML + (bh >> 3) * CTXL + wave * 32;
            attn_item(lds, Q, Kb, Vt, att, bh, q0, q0, SEQ / 64, TK / 64, r0, r0, false);
        }
    }
}

constexpr int PH_PER_LAYER = 15, N_PHASES = 1 + DEPTH * PH_PER_LAYER;
DI int phase_case(int ph) { const int i = (ph - 1) % PH_PER_LAYER; return i < 3 ? i : (i < 13 ? i + 1 : i + 2); }
DI void run_phase(const Params& p, int ph, unsigned char* smem) {
    LAS unsigned char* lds = (LAS unsigned char*)smem;
    unsigned char* ws = p.ws;
    if (ph == 0) { phase_mod(p, (float*)smem); return; }
    const int l = (ph - 1) / PH_PER_LAYER, s = phase_case(ph);
    const bool last = (l == DEPTH - 1);
    const float* mod = (const float*)(ws + O_MOD) + (size_t)l * 5 * NMOD;
    float* X = (float*)(ws + O_X);
    bf16_t* XNY = (bf16_t*)(ws + O_XNY); bf16_t* H = (bf16_t*)(ws + O_R1); bf16_t* P1 = (bf16_t*)(ws + O_R1); bf16_t* GATE = P1 + (size_t)MA * 768;
    bf16_t* UXY = (bf16_t*)(ws + O_UXY);
    float* SS = (float*)(ws + O_SS); const float* shw = (const float*)(ws + O_SHW);
    const int Mtail = last ? ML : MA;
    switch (s) {
    case 0: phase_prep(p, l, (float*)smem); if (l == 0) phase_norm0(p); break;
    case 1: { ESwiglu E{H, SS, shw}; gemm_phase<ESwiglu, false, true>(lds, Gemm{XNY, (const bf16_t*)(ws + O_WFF1IN), MA, 2 * DFF, DM, DM, DM}, E); } break;
    case 2: { EResid<1, true> E{X, X, mod + 2 * DM, mod + 4 * DM, XNY, SS + (size_t)MA * 16}; gemm_phase<EResid<1, true>, false, true>(lds, Gemm{H, (const bf16_t*)(ws + O_WFF1OUT), MA, DM, DFF, DFF, DFF}, E); }
              { const int nthird = (MA / BM) * (DM / BM) - 2 * (int)gridDim.x, vb = (int)BIDX - nthird; if (nthird > 0 && nthird < (int)gridDim.x && vb >= 0) phase_prep_ff(p, l, 1, (float*)smem, vb, (int)gridDim.x - nthird); else if (nthird <= 0 || nthird >= (int)gridDim.x) phase_prep_ff(p, l, 1, (float*)smem, BIDX, gridDim.x); }
              break;
    case 4: { EWin E{P1, UXY, GATE, SS + (size_t)MA * 16, shw + 5 * 5632}; gemm_phase<EWin, false, true>(lds, Gemm{XNY, (const bf16_t*)(ws + O_WIN), MA, NIN, DM, DM, DM}, E); } break;
    case 5: phase_conv(p, l); break;
    case 6: { bf16_t* OM = (bf16_t*)(ws + O_S); EGate E{XNY, OM, OM + (size_t)2 * MA * 512, (const float*)(ws + O_SP), p.b_rgate + l * 1024, p.b_igate + l * 1024};
              gemm_phase<EGate, true, true>(lds, Gemm{XNY, (const bf16_t*)(ws + O_WGATE), MA, 2048, 256, 512, 256}, E); } break;
    case 7: phase_scan_agg(p); break;
    case 8: phase_scan_apply(p); break;
    case 9: { bf16_t* qraw = (bf16_t*)p.out; bf16_t* kn = qraw + (size_t)MA * 768; bf16_t* Vt = (bf16_t*)(ws + O_S) + (size_t)2 * 32 * TK * 96;
              const float* rsq = (const float*)(ws + O_RSQ); const float* rskv = (const float*)(ws + O_RSKV);
              const bf16_t* wukv = (const bf16_t*)(ws + O_WUKV);
              { EpiElem8<FRowScale> E{{qraw, 768, rsq}}; gemm_phase<EpiElem8<FRowScale>, false, true>(lds, Gemm{P1, (const bf16_t*)(ws + O_WUQ), MA, 768, 384, 768, 384}, E); }
              { EpiElem8<FRowScale> E{{kn, 512, rskv}}; gemm_phase<EpiElem8<FRowScale>, false, true>(lds, Gemm{P1 + 384, wukv, MA, 512, 256, 768, 256, 144}, E); }
              { EpiElem8<FVt> E{{Vt, rskv}}; gemm_phase<EpiElem8<FVt>, false, true>(lds, Gemm{wukv + (size_t)512 * 256, P1 + 384, 512, MA, 256, 256, 768, 152}, E); }
              } break;
    case 10: phase_qk(p, l, smem); break;
    case 11: phase_attn(p, smem, !last); break;
    case 12: { { EpiElem8<FMergeA> E{{GATE, XNY}}; gemm_phase<EpiElem8<FMergeA>, false, true>(lds, Gemm{(const bf16_t*)p.out, (const bf16_t*)(ws + O_WOA), Mtail, DM, 512, 512, 512}, E); }
               { EpiElem8<FMergeB> E{{GATE, XNY}}; gemm_phase<EpiElem8<FMergeB>, false, true>(lds, Gemm{UXY, (const bf16_t*)(ws + O_WOL), Mtail, DM, 512, 1024, 512}, E); } } break;
    case 13: { EResid<2, true> E{X, X, mod + 5 * DM, mod + 7 * DM, UXY, SS + (size_t)2 * MA * 16}; gemm_phase<EResid<2, true>, false, true>(lds, Gemm{XNY, (const bf16_t*)(ws + O_WOUT), Mtail, DM, DM, DM, DM}, E); } break;
    case 15: { ESwiglu E{H, SS + (size_t)2 * MA * 16, shw + 2 * 5 * 5632}; gemm_phase<ESwiglu, false, true>(lds, Gemm{UXY, (const bf16_t*)(ws + O_WFF2IN), Mtail, 2 * DFF, DM, DM, DM}, E); } break;
    case 16: if (last) { EResid<1, false> E{X, p.out, mod + 8 * DM, nullptr, nullptr, nullptr}; gemm_phase<EResid<1, false>, false, true>(lds, Gemm{H, (const bf16_t*)(ws + O_WFF2OUT), Mtail, DM, DFF, DFF, DFF}, E); }
             else { EResid<1, true> E{X, X, mod + 8 * DM, mod + 5 * NMOD + DM, XNY, SS}; gemm_phase<EResid<1, true>, false, true>(lds, Gemm{H, (const bf16_t*)(ws + O_WFF2OUT), Mtail, DM, DFF, DFF, DFF}, E); }
             if (!last) { const int nthird = (MA / BM) * (DM / BM) - 2 * (int)gridDim.x, vb = (int)BIDX - nthird; if (nthird > 0 && nthird < (int)gridDim.x && vb >= 0) phase_prep_ff(p, l + 1, 0, (float*)smem, vb, (int)gridDim.x - nthird); else if (nthird <= 0 || nthird >= (int)gridDim.x) phase_prep_ff(p, l + 1, 0, (float*)smem, BIDX, gridDim.x); }
             break;
    }
}

#ifndef PROBE_MASK
#define PROBE_MASK 0u
#endif
#define XB_TMO      128
#define XB_XCNT(j)  (256  + 64 * (j))
#define XB_XSUB(j)  (1280 + 64 * (j))
#define XB_XGEN(j)  (2304 + 64 * (j))
#define XB_TOP      3328
#define XB_TOPGEN   3392
#define XCD_BAR_WORDS 3456
#define XB_SPIN_CAP (1u << 18)
DI unsigned xb_ld(unsigned* p)              { return __hip_atomic_load(p, __ATOMIC_RELAXED, __HIP_MEMORY_SCOPE_AGENT); }
DI unsigned xb_add(unsigned* p, unsigned v) { return __hip_atomic_fetch_add(p, v, __ATOMIC_RELAXED, __HIP_MEMORY_SCOPE_AGENT); }
DI unsigned xb_xcc_id() { return (unsigned)__builtin_amdgcn_s_getreg((3 << 11) | 20) & 0xFu; }
#define XB_SPIN(cond, bar) do { unsigned _sp = 0; while (cond) { __builtin_amdgcn_s_sleep(1); \
    if ((++_sp & 255u) == 0u) { if (xb_ld(&(bar)[XB_TMO])) break; if (_sp > XB_SPIN_CAP) { atomicAdd(&(bar)[XB_TMO], 1u); break; } } } } while (0)
struct XcdBarrier { unsigned* bar; unsigned x; volatile LAS unsigned* st; };
DI XcdBarrier xcd_barrier_post(unsigned* bar, volatile LAS unsigned* st) {
    XcdBarrier b; b.bar = bar; b.x = xb_xcc_id(); b.st = st;
    if (threadIdx.x == 0) (void)xb_add(&bar[XB_XCNT(b.x)], 1u);
    return b;
}
DI void xcd_barrier_complete(unsigned* bar, unsigned x, unsigned& nloc, unsigned& nx) {
    const unsigned G = gridDim.x * gridDim.y * gridDim.z;
    unsigned sum, cnt, mine, sp = 0u;
    for (;;) {
        sum = 0u; cnt = 0u; mine = 0u;
#pragma unroll
        for (unsigned j = 0; j < 16; ++j) { const unsigned c = xb_ld(&bar[XB_XCNT(j)]); sum += c; cnt += (c > 0u) ? 1u : 0u; mine = (j == x) ? c : mine; }
        if (sum == G) break;
        __builtin_amdgcn_s_sleep(1);
        if ((++sp & 255u) == 0u) { if (xb_ld(&bar[XB_TMO])) break; if (sp > XB_SPIN_CAP) { atomicAdd(&bar[XB_TMO], 1u); break; } }
    }
    nloc = mine > 0u ? mine : 1u; nx = cnt > 0u ? cnt : 1u;
}
DI void xcd_barrier(const XcdBarrier& b) {
    asm volatile("s_waitcnt vmcnt(0)" ::: "memory");
    __syncthreads();
    if (threadIdx.x == 0) {
        unsigned* bar = b.bar;
        __builtin_amdgcn_s_waitcnt(0);
        unsigned nloc = b.st[0], nx = b.st[1];
        if (nloc == 0u) { xcd_barrier_complete(bar, b.x, nloc, nx); b.st[0] = nloc; b.st[1] = nx; }
        const unsigned old = xb_add(&bar[XB_XSUB(b.x)], 1u);
        const unsigned gen = old / nloc;
        if (old + 1u == (gen + 1u) * nloc) {
            __builtin_amdgcn_fence(__ATOMIC_RELEASE, "agent");
            asm volatile("s_waitcnt vmcnt(0)" ::: "memory");
            const unsigned og = xb_add(&bar[XB_TOP], 1u);
            const unsigned tg = og / nx;
            if (og + 1u == (tg + 1u) * nx) xb_add(&bar[XB_TOPGEN], 1u);
            else XB_SPIN(xb_ld(&bar[XB_TOPGEN]) == tg, bar);
            __builtin_amdgcn_fence(__ATOMIC_ACQUIRE, "agent");
            xb_add(&bar[XB_XGEN(b.x)], 1u);
            asm volatile("s_waitcnt vmcnt(0)" ::: "memory");
        } else {
            XB_SPIN(xb_ld(&bar[XB_XGEN(b.x)]) == gen, bar);
            __builtin_amdgcn_fence(__ATOMIC_ACQUIRE, "agent");
            asm volatile("s_waitcnt vmcnt(0)" ::: "memory");
        }
    }
    __syncthreads();
}
__global__ void __launch_bounds__(512) mega(Params p) {
    extern __shared__ __attribute__((aligned(16))) unsigned char smem[];
    __shared__ uint4 xb_words;
    cg::grid_group grid = cg::this_grid();
    if (threadIdx.x == 0) xb_words = make_uint4(0u, 0u, 0u, 0u);
    __syncthreads();
    const XcdBarrier xb = xcd_barrier_post((unsigned*)(p.ws + O_BAR), (volatile LAS unsigned*)&xb_words);
    unsigned long long tsel = 0;
    for (int ph = p.ph_lo; ph < p.ph_hi; ++ph) {
        const unsigned long long t0 = PROBE_MASK ? wall_clock64() : 0ull;
        run_phase(p, ph, smem);
        if (p.coop && ph + 1 < p.ph_hi) { if (ph == 0) grid.sync(); else xcd_barrier(xb); }
        if (PROBE_MASK) { const int sidx = ph == 0 ? 17 : phase_case(ph); if ((PROBE_MASK >> sidx) & 1u) tsel += wall_clock64() - t0; }
    }
    if (PROBE_MASK && blockIdx.x == 0) { const unsigned long long t0 = wall_clock64(); while (wall_clock64() - t0 < tsel) __builtin_amdgcn_s_sleep(64); }
}

extern "C" void kernel_launch(void* const* d_in, const int* in_sizes, int n_in, void* d_out, int out_size, void* d_ws, size_t ws_size, hipStream_t stream) {
    static int grid = 0;
    if (grid == 0) {
        if (n_in != 27 || ws_size < WS_END) { fprintf(stderr, "kernel_launch: need 27 inputs and %zu bytes of workspace; got %d, %zu\n", (size_t)WS_END, n_in, ws_size); grid = -1; return; }
        int dev = 0, cus = 0, per_cu = 0;
        hipGetDevice(&dev); hipDeviceGetAttribute(&cus, hipDeviceAttributeMultiprocessorCount, dev);
        if (hipFuncSetAttribute((const void*)mega, hipFuncAttributeMaxDynamicSharedMemorySize, LDS_BYTES) != hipSuccess) { fprintf(stderr, "kernel_launch: hipFuncSetAttribute failed\n"); grid = -1; return; }
        if (hipOccupancyMaxActiveBlocksPerMultiprocessor(&per_cu, (const void*)mega, 512, LDS_BYTES) != hipSuccess || per_cu < 1) { fprintf(stderr, "kernel_launch: occupancy query gave %d\n", per_cu); per_cu = 1; }
        (void)hipGetLastError();
        grid = cus;
    }
    if (grid < 0) return;
    Params p{};
    const float** pp = (const float**)&p;
    for (int i = 0; i < 27; ++i) pp[i] = (const float*)d_in[i];
    p.out = (float*)d_out; p.ws = (unsigned char*)d_ws; p.ph_lo = 0; p.ph_hi = N_PHASES; p.coop = 1; p.pad = 0;
    (void)hipMemsetAsync((unsigned char*)d_ws + O_BAR, 0, XCD_BAR_WORDS * 4, stream);
    void* args[] = {&p};
    hipError_t e = hipLaunchCooperativeKernel((const void*)mega, dim3(grid), dim3(512), args, LDS_BYTES, stream);
    if (e != hipSuccess) {
        fprintf(stderr, "cooperative launch failed: %s (grid %d); falling back to one launch per phase\n", hipGetErrorString(e), grid);
        (void)hipGetLastError();
        p.coop = 0;
        for (int ph = 0; ph < N_PHASES; ++ph) { p.ph_lo = ph; p.ph_hi = ph + 1; hipLaunchKernelGGL(mega, dim3(grid), dim3(512), LDS_BYTES, stream, p); }
    }
}
```
